# Optimizing an MI355X kernel written in HIP

```python
import math
import jax
import jax.numpy as jnp
from jax import lax
import numpy as np

D_MODEL = 1024
BATCH = 1
SEQ = 16384
DEPTH = 2
DEC_BATCH = 8
DEC_SEQ = 4096
PAST_LEN = 128

N_BRANCH = 4
BRANCH_WIDTH = D_MODEL // N_BRANCH
HEAD_DIM = 64
EPS = 1e-6
A_HEADS = BRANCH_WIDTH // HEAD_DIM
A_CHUNK = 64
CONV_WIDTH = 5
B_HEADS = BRANCH_WIDTH // HEAD_DIM
DILATED_PATTERNS = ((128, 1), (512, 4), (2048, 16))
B_MAX_BLOCK = 128
S5_GROUP_CH = 16
S5_GROUPS = BRANCH_WIDTH // S5_GROUP_CH
S5_STATE = 64
D_HEADS = BRANCH_WIDTH // HEAD_DIM
D_KV_HEADS = D_HEADS // 2
D_RADIUS = 128
D_BLOCK = 128
FFN_HIDDEN = -(-8 * D_MODEL // (3 * 256)) * 256
IN_SPLITS = (BRANCH_WIDTH, BRANCH_WIDTH, BRANCH_WIDTH, BRANCH_WIDTH, 2 * A_HEADS, 2 * A_HEADS,
             BRANCH_WIDTH, BRANCH_WIDTH, BRANCH_WIDTH,
             BRANCH_WIDTH,
             D_HEADS * HEAD_DIM, D_KV_HEADS * HEAD_DIM, D_KV_HEADS * HEAD_DIM)
IN_WIDTH = sum(IN_SPLITS)

kernel_name = 'hybrid_bidir_encoder'


def _rms_norm(x, w):
    x32 = x.astype(jnp.float32)
    y = x32 * lax.rsqrt(jnp.mean(x32 * x32, axis=-1, keepdims=True) + EPS)
    return (y * w.astype(jnp.float32)).astype(x.dtype)


def _l2norm(x):
    return x * lax.rsqrt(jnp.sum(x * x, axis=-1, keepdims=True) + EPS)


def _alibi_slopes():
    n = D_HEADS + B_HEADS
    s = 2.0 ** (-8.0 * np.arange(1, n + 1) / n)
    return jnp.asarray(s[:D_HEADS], jnp.float32), jnp.asarray(s[D_HEADS:], jnp.float32)


def _banded_attention(q, k, v, slopes, radius, dist_scale, block, sink=None):
    b, L, hq, dh = q.shape
    hkv = k.shape[2]
    grp = hq // hkv
    nb = L // block
    kw = block + 2 * radius
    pad = ((0, 0), (radius, radius), (0, 0), (0, 0))
    idx = (jnp.arange(nb) * block)[:, None] + jnp.arange(kw)[None, :]
    kb = jnp.pad(k, pad)[:, idx]
    vb = jnp.pad(v, pad)[:, idx]
    qb = q.reshape(b, nb, block, hkv, grp, dh)
    s = jnp.einsum('bnqhgd,bnkhd->bnhgqk', qb, kb) * (dh ** -0.5)
    rel = jnp.arange(kw)[None, :] - radius - jnp.arange(block)[:, None]
    key_pos = idx - radius
    valid = (jnp.abs(rel) <= radius)[None] & ((key_pos >= 0) & (key_pos < L))[:, None, :]
    dist = (dist_scale * jnp.abs(rel)).astype(jnp.float32)
    s = s - slopes.reshape(hkv, grp, 1, 1) * dist
    s = jnp.where(valid[None, :, None, None], s, -jnp.inf)
    m = jnp.max(s, axis=-1)
    if sink is not None:
        sink_l = sink.reshape(hkv, grp, 1)
        m = jnp.maximum(m, sink_l)
    p = jnp.exp(s - m[..., None])
    denom = jnp.sum(p, axis=-1)
    if sink is not None:
        denom = denom + jnp.exp(sink_l - m)
    o = jnp.einsum('bnhgqk,bnkhd->bnqhgd', p, vb) / jnp.moveaxis(denom, -1, 2)[..., None]
    lse = jnp.moveaxis(m + jnp.log(denom), -1, 2)
    return o.reshape(b, L, hq, dh), lse.reshape(b, L, hq)


def _gated_delta_chunked(q, k, v, g, beta):
    b, L, h, dk = q.shape
    dv = v.shape[-1]
    c = A_CHUNK
    n = L // c

    def chunk(t):
        return jnp.moveaxis(t.reshape((b, n, c, h) + t.shape[3:]), 3, 1)

    q, k, v, g, beta = chunk(q), chunk(k), chunk(v), chunk(g), chunk(beta)
    g_cum = jnp.cumsum(g, axis=-1)
    incl = jnp.tril(jnp.ones((c, c), bool))
    strict = jnp.tril(jnp.ones((c, c), bool), -1)
    decay = jnp.exp(jnp.where(incl, g_cum[..., :, None] - g_cum[..., None, :], -jnp.inf))
    k_beta = k * beta[..., None]
    a_mat = jnp.where(strict, jnp.einsum('bhnid,bhnjd->bhnij', k_beta, k) * decay, 0.0)
    rhs = jnp.concatenate([v * beta[..., None], k_beta * jnp.exp(g_cum)[..., None]], axis=-1)
    sol = lax.linalg.triangular_solve(a_mat, rhs, left_side=True, lower=True, unit_diagonal=True)
    u, w = sol[..., :dv], sol[..., dv:]
    qk = jnp.einsum('bhnid,bhnjd->bhnij', q, k) * decay
    q_dec = q * jnp.exp(g_cum)[..., None]
    k_dec = k * jnp.exp(g_cum[..., -1:] - g_cum)[..., None]
    g_last = jnp.exp(g_cum[..., -1])
    xs = tuple(jnp.moveaxis(t, 2, 0) for t in (q_dec, k_dec, u, w, qk, g_last))

    def step(state, inp):
        qd, kd, uc, wc, qkc, gl = inp
        v_new = uc - jnp.einsum('bhcd,bhde->bhce', wc, state)
        out = jnp.einsum('bhcd,bhde->bhce', qd, state) + jnp.einsum('bhcs,bhse->bhce', qkc, v_new)
        state = state * gl[..., None, None] + jnp.einsum('bhcd,bhce->bhde', kd, v_new)
        return state, out

    s0 = jnp.zeros((b, h, dk, dv), jnp.float32)
    _, o = lax.scan(step, s0, xs)
    return o.transpose(1, 0, 3, 2, 4).reshape(b, L, h, dv)


def _mixer_gdn(q, k, v, z, alpha, beta, conv_w, a_log, dt_bias, norm_w):
    b, L, _ = q.shape
    f32 = jnp.float32
    qkv = jnp.concatenate([q, k, v], axis=-1).astype(f32)
    ch = qkv.shape[-1]
    pad = CONV_WIDTH // 2
    qkv = lax.conv_general_dilated(qkv, conv_w.astype(f32)[:, None, :], window_strides=(1,),
                                   padding=[(pad, pad)], dimension_numbers=('NWC', 'WIO', 'NWC'),
                                   feature_group_count=ch)
    qkv = jax.nn.silu(qkv)
    q, k, v = jnp.split(qkv, 3, axis=-1)
    heads = lambda t: t.reshape(b, L, A_HEADS, HEAD_DIM)
    q = _l2norm(heads(q)) * (HEAD_DIM ** -0.5)
    k = _l2norm(heads(k))
    v = heads(v)
    alpha = alpha.astype(f32).reshape(b, L, 2, A_HEADS)
    beta = jax.nn.sigmoid(beta.astype(f32).reshape(b, L, 2, A_HEADS))
    g = -jnp.exp(a_log.astype(f32)) * jax.nn.softplus(alpha + dt_bias.astype(f32))
    flip = lambda t: jnp.flip(t, axis=1)
    fwd = _gated_delta_chunked(q, k, v, g[:, :, 0], beta[:, :, 0])
    bwd = flip(_gated_delta_chunked(flip(q), flip(k), flip(v), flip(g[:, :, 1]), flip(beta[:, :, 1])))
    o = fwd + bwd
    o = o * lax.rsqrt(jnp.mean(o * o, axis=-1, keepdims=True) + EPS) * norm_w.astype(f32)
    o = o * jax.nn.silu(heads(z.astype(f32)))
    return o.reshape(b, L, BRANCH_WIDTH)


def _stride_gather(t, dil):
    b, L = t.shape[:2]
    return t.reshape((b, L // dil, dil) + t.shape[2:]).swapaxes(1, 2).reshape((b * dil, L // dil) + t.shape[2:])


def _stride_scatter(t, b):
    bd, ld = t.shape[:2]
    dil = bd // b
    return t.reshape((b, dil, ld) + t.shape[2:]).swapaxes(1, 2).reshape((b, ld * dil) + t.shape[2:])


def _mixer_dilated(q, k, v, slopes):
    b, L, _ = q.shape
    heads = lambda t: t.astype(jnp.float32).reshape(b, L, B_HEADS, HEAD_DIM)
    q, k, v = heads(q), heads(k), heads(v)
    outs, lses = [], []
    for window, dil in DILATED_PATTERNS:
        ld = L // dil
        o, lse = _banded_attention(_stride_gather(q, dil), _stride_gather(k, dil), _stride_gather(v, dil),
                                   slopes, window // (2 * dil), dil, math.gcd(ld, B_MAX_BLOCK))
        outs.append(_stride_scatter(o, b))
        lses.append(_stride_scatter(lse, b))
    wts = jax.nn.softmax(jnp.stack(lses, axis=-1), axis=-1)
    o = jnp.einsum('blhp,pblhd->blhd', wts, jnp.stack(outs, axis=0))
    return o.reshape(b, L, BRANCH_WIDTH)


def _cmul(ar, ai, br, bi):
    return ar * br - ai * bi, ar * bi + ai * br


def _ssm_combine(e1, e2):
    a1r, a1i, b1r, b1i = e1
    a2r, a2i, b2r, b2i = e2
    ar, ai = _cmul(a2r, a2i, a1r, a1i)
    br, bi = _cmul(a2r, a2i, b1r, b1i)
    return ar, ai, br + b2r, bi + b2i


def _mixer_s5(u, lam_re, lam_im, log_step, b_re, b_im, c_re, c_im, d_skip, w_glu):
    f32 = jnp.float32
    b, L, _ = u.shape
    u = u.astype(f32)
    ug = u.reshape(b, L, S5_GROUPS, S5_GROUP_CH)
    bu_re = jnp.einsum('blgc,gpc->blgp', ug, b_re.astype(f32))
    bu_im = jnp.einsum('blgc,gpc->blgp', ug, b_im.astype(f32))
    y = u * d_skip.astype(f32)
    for direction in range(2):
        lr = lam_re[direction].astype(f32)
        li = lam_im[direction].astype(f32)
        step = jnp.exp(log_step[direction].astype(f32))[:, None]
        mag = jnp.exp(lr * step)
        ab_re, ab_im = mag * jnp.cos(li * step), mag * jnp.sin(li * step)
        inv = 1.0 / (lr * lr + li * li)
        coef_re, coef_im = _cmul(ab_re - 1.0, ab_im, lr * inv, -li * inv)
        x_re, x_im = _cmul(coef_re, coef_im, bu_re, bu_im)
        a_re = jnp.broadcast_to(ab_re, x_re.shape)
        a_im = jnp.broadcast_to(ab_im, x_im.shape)
        _, _, s_re, s_im = lax.associative_scan(_ssm_combine, (a_re, a_im, x_re, x_im),
                                                reverse=(direction == 1), axis=1)
        yc = (jnp.einsum('blgp,gcp->blgc', s_re, c_re[direction].astype(f32))
              - jnp.einsum('blgp,gcp->blgc', s_im, c_im[direction].astype(f32)))
        y = y + yc.reshape(b, L, BRANCH_WIDTH)
    hg = jax.nn.gelu(y) @ w_glu.astype(f32)
    return hg[..., :BRANCH_WIDTH] * jax.nn.sigmoid(hg[..., BRANCH_WIDTH:])


def _mixer_window(q, k, v, slopes, sink):
    b, L, _ = q.shape
    f32 = jnp.float32
    q = q.astype(f32).reshape(b, L, D_HEADS, HEAD_DIM)
    k = k.astype(f32).reshape(b, L, D_KV_HEADS, HEAD_DIM)
    v = v.astype(f32).reshape(b, L, D_KV_HEADS, HEAD_DIM)
    o, _ = _banded_attention(q, k, v, slopes, D_RADIUS, 1, D_BLOCK, sink.astype(f32))
    return o.reshape(b, L, BRANCH_WIDTH)


def _trunk(x, params):
    (norm1, w_in, conv_a, a_log, dt_bias, a_norm,
     s5_lam_re, s5_lam_im, s5_log_step, s5_b_re, s5_b_im, s5_c_re, s5_c_im, s5_d, s5_w_glu,
     attn_sink, w_gate, w_branch, w_out, norm2, w_ffn_gate, w_ffn_up, w_ffn_down, final_norm) = params
    slopes_d, slopes_b = _alibi_slopes()
    split_points = np.cumsum(IN_SPLITS)[:-1].tolist()
    for l in range(DEPTH):
        h = _rms_norm(x, norm1[l])
        (a_q, a_k, a_v, a_z, a_alpha, a_beta, b_q, b_k, b_v, c_u, d_q, d_k, d_v) = jnp.split(
            h @ w_in[l], split_points, axis=-1)
        branches = (
            _mixer_gdn(a_q, a_k, a_v, a_z, a_alpha, a_beta, conv_a[l], a_log[l], dt_bias[l], a_norm[l]),
            _mixer_dilated(b_q, b_k, b_v, slopes_b),
            _mixer_s5(c_u, s5_lam_re[l], s5_lam_im[l], s5_log_step[l], s5_b_re[l], s5_b_im[l],
                      s5_c_re[l], s5_c_im[l], s5_d[l], s5_w_glu[l]),
            _mixer_window(d_q, d_k, d_v, slopes_d, attn_sink[l]),
        )
        merged = jnp.zeros_like(x)
        for i, o in enumerate(branches):
            gate = jax.nn.sigmoid(h @ w_gate[l, i])
            merged = merged + gate * (o.astype(x.dtype) @ w_branch[l, i])
        x = x + merged @ w_out[l]
        h = _rms_norm(x, norm2[l])
        x = x + (jax.nn.silu(h @ w_ffn_gate[l]) * (h @ w_ffn_up[l])) @ w_ffn_down[l]
    return _rms_norm(x, final_norm)


def setup_inputs(seed: int = 0) -> dict:
    key = jax.random.key(seed)
    ks = jax.random.split(key, 26)
    f32 = jnp.float32
    nrm = lambda k, shape, scale: scale * jax.random.normal(k, shape, f32)
    dt = jnp.exp(jax.random.uniform(ks[5], (DEPTH, 2, A_HEADS), f32, math.log(1e-3), math.log(1e-1)))
    return {
        'x_prompt': nrm(ks[0], (BATCH, SEQ, D_MODEL), 1.0),
        'x_sample': nrm(ks[1], (DEC_BATCH, DEC_SEQ, D_MODEL), 1.0),
        'norm1': 1.0 + nrm(ks[2], (DEPTH, D_MODEL), 0.02),
        'w_in': nrm(ks[3], (DEPTH, D_MODEL, IN_WIDTH), D_MODEL ** -0.5),
        'conv_a': nrm(ks[4], (DEPTH, CONV_WIDTH, 3 * BRANCH_WIDTH), CONV_WIDTH ** -0.5),
        'a_log': jnp.log(jax.random.uniform(ks[6], (DEPTH, 2, A_HEADS), f32, 1.0, 16.0)),
        'dt_bias': dt + jnp.log(-jnp.expm1(-dt)),
        'a_norm': 1.0 + nrm(ks[7], (DEPTH, HEAD_DIM), 0.02),
        's5_lam_re': -0.5 + nrm(ks[8], (DEPTH, 2, S5_GROUPS, S5_STATE), 0.01),
        's5_lam_im': math.pi * jnp.arange(S5_STATE, dtype=f32) + nrm(ks[9], (DEPTH, 2, S5_GROUPS, S5_STATE), 0.01),
        's5_log_step': jax.random.uniform(ks[10], (DEPTH, 2, S5_GROUPS), f32, math.log(1e-3), math.log(1e-1)),
        's5_b_re': nrm(ks[11], (DEPTH, S5_GROUPS, S5_STATE, S5_GROUP_CH), (2 * S5_GROUP_CH) ** -0.5),
        's5_b_im': nrm(ks[12], (DEPTH, S5_GROUPS, S5_STATE, S5_GROUP_CH), (2 * S5_GROUP_CH) ** -0.5),
        's5_c_re': nrm(ks[13], (DEPTH, 2, S5_GROUPS, S5_GROUP_CH, S5_STATE), S5_STATE ** -0.5),
        's5_c_im': nrm(ks[14], (DEPTH, 2, S5_GROUPS, S5_GROUP_CH, S5_STATE), S5_STATE ** -0.5),
        's5_d': nrm(ks[15], (DEPTH, BRANCH_WIDTH), 1.0),
        's5_w_glu': nrm(ks[16], (DEPTH, BRANCH_WIDTH, 2 * BRANCH_WIDTH), BRANCH_WIDTH ** -0.5),
        'attn_sink': nrm(ks[17], (DEPTH, D_HEADS), 0.5),
        'w_gate': nrm(ks[18], (DEPTH, N_BRANCH, D_MODEL, D_MODEL), D_MODEL ** -0.5),
        'w_branch': nrm(ks[19], (DEPTH, N_BRANCH, BRANCH_WIDTH, D_MODEL), BRANCH_WIDTH ** -0.5),
        'w_out': nrm(ks[20], (DEPTH, D_MODEL, D_MODEL), D_MODEL ** -0.5),
        'norm2': 1.0 + nrm(ks[21], (DEPTH, D_MODEL), 0.02),
        'w_ffn_gate': nrm(ks[22], (DEPTH, D_MODEL, FFN_HIDDEN), D_MODEL ** -0.5),
        'w_ffn_up': nrm(ks[23], (DEPTH, D_MODEL, FFN_HIDDEN), D_MODEL ** -0.5),
        'w_ffn_down': nrm(ks[24], (DEPTH, FFN_HIDDEN, D_MODEL), FFN_HIDDEN ** -0.5),
        'final_norm': 1.0 + nrm(ks[25], (D_MODEL,), 0.02),
    }


def reference(x_prompt, x_sample, norm1, w_in, conv_a, a_log, dt_bias, a_norm,
              s5_lam_re, s5_lam_im, s5_log_step, s5_b_re, s5_b_im, s5_c_re, s5_c_im, s5_d, s5_w_glu,
              attn_sink, w_gate, w_branch, w_out, norm2, w_ffn_gate, w_ffn_up, w_ffn_down, final_norm):
    params = (norm1, w_in, conv_a, a_log, dt_bias, a_norm,
              s5_lam_re, s5_lam_im, s5_log_step, s5_b_re, s5_b_im, s5_c_re, s5_c_im, s5_d, s5_w_glu,
              attn_sink, w_gate, w_branch, w_out, norm2, w_ffn_gate, w_ffn_up, w_ffn_down, final_norm)
    y_prompt = _trunk(x_prompt, params)
    y_sample = _trunk(x_sample, params)
    return (y_prompt, y_sample)
```

```cpp
#include <hip/hip_runtime.h>
#include <hip/hip_cooperative_groups.h>
#include <cstdio>
#include <cstring>
namespace cg = cooperative_groups;

#ifndef MEGA
#define MEGA 0
#endif

#define DI __device__ __forceinline__
typedef unsigned short u16;
typedef __attribute__((ext_vector_type(8))) short bf16x8;
typedef __attribute__((ext_vector_type(4))) float f32x4;

constexpr int T = 49152;
constexpr int TP = 16384;
constexpr int DM = 1024;
constexpr int INW = 2576;
constexpr int FH = 2816;
constexpr int NCH64 = T / 64;
constexpr float EPS = 1e-6f;

constexpr int C_AQ = 0, C_AK = 256, C_AV = 512, C_AZ = 768, C_BQ = 1040, C_BK = 1296, C_BV = 1552, C_CU = 1808,
              C_DQ = 2064, C_DK = 2320, C_DV = 2448;

constexpr size_t WO_IN = 0, WO_GATE = 2752512, WO_BR = 6946816, WO_OUT = 7995392, WO_GU = 9043968, WO_DN = 14811136,
                 WO_GLU = 17694720, W_LAYER = 17825792;
constexpr size_t OFF_W = 0;
constexpr size_t OFF_PROJ = 2 * W_LAYER * 2;
constexpr size_t SZ_PROJ = (size_t)T * INW * 2;
constexpr size_t OFF_R1 = OFF_PROJ + SZ_PROJ;
constexpr size_t SZ_H = (size_t)T * DM * 2;
constexpr size_t OFF_H = OFF_R1;
constexpr size_t OFF_UW = OFF_R1;
constexpr size_t OFF_QN = OFF_R1 + SZ_H;
constexpr size_t OFF_KN = OFF_QN + (size_t)T * 256 * 2;
constexpr size_t OFF_GC = OFF_KN + (size_t)T * 256 * 2;
constexpr size_t OFF_SEND = OFF_GC + (size_t)NCH64 * 8 * 64 * 4;
constexpr size_t OFF_G = OFF_SEND + (size_t)NCH64 * 2 * 1024 * 8;
constexpr size_t OFF_AB = OFF_G + (size_t)T * 256 * 2;
constexpr size_t OFF_MERGED = OFF_R1 + SZ_H;
constexpr size_t OFF_H2 = OFF_MERGED;
constexpr size_t OFF_ACT = OFF_PROJ;
constexpr size_t WS_NEED = OFF_MERGED + SZ_H;

constexpr int SMEM_BYTES = 75776;

struct ConvJob { const float* src; u16* dst; int K, ncols, nrows_dst, src_ld, rs, off, ntn; };
struct Params {
  const float *x_prompt, *x_sample, *norm1, *conv_a, *a_log, *dt_bias, *a_norm, *lam_re, *lam_im, *log_step, *b_re,
      *b_im, *c_re, *c_im, *s5_d, *attn_sink, *norm2, *final_norm;
  const float *w_in, *w_gate, *w_branch, *w_out, *w_ffn_gate, *w_ffn_up, *w_ffn_down, *w_glu;
  float* xout;
  char* ws;
};
constexpr int CONV_TILES_LAYER = 4352;

DI u16 f2bf(float x) { unsigned u = __float_as_uint(x); u += 0x7fffu + ((u >> 16) & 1u); return (u16)(u >> 16); }
DI float bf2f(u16 v) { return __uint_as_float(((unsigned)v) << 16); }
DI unsigned pack2(float a, float b) { return (unsigned)f2bf(a) | ((unsigned)f2bf(b) << 16); }
DI float sigmoidf_(float x) { return 1.f / (1.f + __expf(-x)); }
DI float siluf_(float x) { return x / (1.f + __expf(-x)); }
DI float wave_sum(float v) {
#pragma unroll
  for (int o = 32; o > 0; o >>= 1) v += __shfl_xor(v, o, 64);
  return v;
}
DI int seq_lo(int t) { return t < TP ? 0 : (t & ~4095); }
DI int seq_hi(int t) { return t < TP ? TP : (t & ~4095) + 4096; }
DI const float* xrow(const Params& p, int layer, int t) {
  if (layer == 0) return t < TP ? p.x_prompt + (size_t)t * DM : p.x_sample + (size_t)(t - TP) * DM;
  return p.xout + (size_t)t * DM;
}
DI f32x4 mfma16(bf16x8 a, bf16x8 b, f32x4 c) { return __builtin_amdgcn_mfma_f32_16x16x32_bf16(a, b, c, 0, 0, 0); }

DI void mk_job(ConvJob& j, const float* src, u16* dst, int K, int ncols, int nrows_dst, int src_ld, int rs, int off) {
  j.src = src; j.dst = dst; j.K = K; j.ncols = ncols; j.nrows_dst = nrows_dst; j.src_ld = src_ld; j.rs = rs; j.off = off;
  j.ntn = (nrows_dst + 63) >> 6;
}
DI int conv_lookup(const Params& p, int t, ConvJob& j) {
  const int l = t / CONV_TILES_LAYER;
  int r = t % CONV_TILES_LAYER;
  u16* wl = (u16*)(p.ws + OFF_W) + (size_t)l * W_LAYER;
  if (r < 672) { mk_job(j, p.w_in + (size_t)l * DM * INW, wl + WO_IN, DM, INW, 2688, INW, 32, 0); return r; }
  r -= 672;
  if (r < 1024) { const int i = r >> 8; mk_job(j, p.w_gate + (size_t)(l * 4 + i) * DM * DM, wl + WO_GATE + (size_t)i * DM * DM, DM, DM, DM, DM, 32, 0); return r & 255; }
  r -= 1024;
  if (r < 256) { const int i = r >> 6; mk_job(j, p.w_branch + (size_t)(l * 4 + i) * 256 * DM, wl + WO_BR + (size_t)i * DM * 256, 256, DM, DM, DM, 32, 0); return r & 63; }
  r -= 256;
  if (r < 256) { mk_job(j, p.w_out + (size_t)l * DM * DM, wl + WO_OUT, DM, DM, DM, DM, 32, 0); return r; }
  r -= 256;
  if (r < 704) { mk_job(j, p.w_ffn_gate + (size_t)l * DM * FH, wl + WO_GU, DM, FH, FH, FH, 64, 0); return r; }
  r -= 704;
  if (r < 704) { mk_job(j, p.w_ffn_up + (size_t)l * DM * FH, wl + WO_GU, DM, FH, FH, FH, 64, 32); return r; }
  r -= 704;
  if (r < 704) { mk_job(j, p.w_ffn_down + (size_t)l * FH * DM, wl + WO_DN, FH, DM, DM, DM, 32, 0); return r; }
  r -= 704;
  if (r < 16) { mk_job(j, p.w_glu + (size_t)l * 256 * 512, wl + WO_GLU, 256, 256, 256, 512, 64, 0); return r; }
  r -= 16;
  mk_job(j, p.w_glu + (size_t)l * 256 * 512 + 256, wl + WO_GLU, 256, 256, 256, 512, 64, 32);
  return r;
}
DI void conv_tile(const ConvJob& j, int lt, float* tile) {
  const int tid = threadIdx.x;
  const int tk = lt / j.ntn, tn = lt % j.ntn;
  __syncthreads();
#pragma unroll
  for (int i = 0; i < 4; ++i) {
    int r = (tid >> 4) + 16 * i, c4 = (tid & 15) * 4, n = tn * 64 + c4;
    float4 v = make_float4(0.f, 0.f, 0.f, 0.f);
    if (n < j.ncols) v = *(const float4*)(j.src + (size_t)(tk * 64 + r) * j.src_ld + n);
    tile[r * 65 + c4 + 0] = v.x; tile[r * 65 + c4 + 1] = v.y; tile[r * 65 + c4 + 2] = v.z; tile[r * 65 + c4 + 3] = v.w;
  }
  __syncthreads();
  const int cl = tid >> 2, ks = (tid & 3) * 16, n = tn * 64 + cl;
  if (n < j.nrows_dst) {
    unsigned w[8];
#pragma unroll
    for (int e = 0; e < 8; ++e) w[e] = pack2(tile[(ks + 2 * e) * 65 + cl], tile[(ks + 2 * e + 1) * 65 + cl]);
    const int nm = (n >> 5) * j.rs + (n & 31) + j.off;
    uint4* d = (uint4*)(j.dst + (size_t)nm * j.K + tk * 64 + ks);
    d[0] = make_uint4(w[0], w[1], w[2], w[3]);
    d[1] = make_uint4(w[4], w[5], w[6], w[7]);
  }
}

DI void rms_row_bf16(const float* src, const float* w, u16* dst) {
  const int lane = threadIdx.x & 63;
  float4 v[4];
  float ss = 0.f;
#pragma unroll
  for (int i = 0; i < 4; ++i) {
    v[i] = *(const float4*)(src + i * 256 + lane * 4);
    ss += v[i].x * v[i].x + v[i].y * v[i].y + v[i].z * v[i].z + v[i].w * v[i].w;
  }
  ss = wave_sum(ss);
  const float rs = rsqrtf(ss * (1.f / DM) + EPS);
#pragma unroll
  for (int i = 0; i < 4; ++i) {
    float4 g = *(const float4*)(w + i * 256 + lane * 4);
    uint2 o;
    o.x = pack2(v[i].x * rs * g.x, v[i].y * rs * g.y);
    o.y = pack2(v[i].z * rs * g.z, v[i].w * rs * g.w);
    *(uint2*)(dst + i * 256 + lane * 4) = o;
  }
}
DI void rms_phase(const Params& p, int layer, const float* w, u16* dst, int b0, int nb) {
  const int wave = threadIdx.x >> 6;
  for (int r = b0 * 4 + wave; r < T; r += nb * 4) rms_row_bf16(xrow(p, layer, r), w, dst + (size_t)r * DM);
}

constexpr int GP = 72;
template <int NT>
DI void gemm_kloop(const u16* __restrict__ A, size_t lda, const u16* __restrict__ B, size_t ldb, int nk,
                   f32x4 (&acc)[4][NT], u16* sm) {
  const int tid = threadIdx.x, lane = tid & 63, wave = tid >> 6;
  const int fr = lane & 15, fq = lane >> 4, wr = wave >> 1, wc = wave & 1;
  u16* sa = sm;
  u16* sb = sm + 2 * 128 * GP;
  uint4 ra0, ra1, ra2, ra3, rb0, rb1, rb2 = make_uint4(0, 0, 0, 0), rb3 = make_uint4(0, 0, 0, 0);
  const int lrow = tid >> 3, lseg = (tid & 7) * 8;
  const u16* Ap = A + (size_t)lrow * lda + lseg;
  const u16* Bp = B + (size_t)lrow * ldb + lseg;
#define KL_LOAD(KOFF)                                                    \
  ra0 = *(const uint4*)(Ap + (KOFF));                                    \
  ra1 = *(const uint4*)(Ap + 32 * lda + (KOFF));                         \
  ra2 = *(const uint4*)(Ap + 64 * lda + (KOFF));                         \
  ra3 = *(const uint4*)(Ap + 96 * lda + (KOFF));                         \
  rb0 = *(const uint4*)(Bp + (KOFF));                                    \
  rb1 = *(const uint4*)(Bp + 32 * ldb + (KOFF));                         \
  if (NT > 2) { rb2 = *(const uint4*)(Bp + 64 * ldb + (KOFF)); rb3 = *(const uint4*)(Bp + 96 * ldb + (KOFF)); }
#define KL_STORE(SA, SB)                                                 \
  *(uint4*)((SA) + (lrow + 0) * GP + lseg) = ra0;                        \
  *(uint4*)((SA) + (lrow + 32) * GP + lseg) = ra1;                       \
  *(uint4*)((SA) + (lrow + 64) * GP + lseg) = ra2;                       \
  *(uint4*)((SA) + (lrow + 96) * GP + lseg) = ra3;                       \
  *(uint4*)((SB) + (lrow + 0) * GP + lseg) = rb0;                        \
  *(uint4*)((SB) + (lrow + 32) * GP + lseg) = rb1;                       \
  if (NT > 2) { *(uint4*)((SB) + (lrow + 64) * GP + lseg) = rb2; *(uint4*)((SB) + (lrow + 96) * GP + lseg) = rb3; }
  KL_LOAD(0)
  KL_STORE(sa, sb)
  __syncthreads();
#pragma unroll 1
  for (int kt = 0; kt < nk; ++kt) {
    const int cur = kt & 1;
    if (kt + 1 < nk) { KL_LOAD((kt + 1) * 64) }
    const u16* ca = sa + cur * 128 * GP;
    const u16* cb = sb + cur * 128 * GP;
#pragma unroll
    for (int kk = 0; kk < 2; ++kk) {
      bf16x8 wf[NT], xf[4];
#pragma unroll
      for (int nt = 0; nt < NT; ++nt) wf[nt] = *(const bf16x8*)(cb + (wc * NT * 16 + nt * 16 + fr) * GP + kk * 32 + fq * 8);
#pragma unroll
      for (int mt = 0; mt < 4; ++mt) xf[mt] = *(const bf16x8*)(ca + (wr * 64 + mt * 16 + fr) * GP + kk * 32 + fq * 8);
#pragma unroll
      for (int mt = 0; mt < 4; ++mt)
#pragma unroll
        for (int nt = 0; nt < NT; ++nt) acc[mt][nt] = mfma16(wf[nt], xf[mt], acc[mt][nt]);
    }
    if (kt + 1 < nk) {
      u16* na = sa + (cur ^ 1) * 128 * GP;
      u16* nb = sb + (cur ^ 1) * 128 * GP;
      KL_STORE(na, nb)
    }
    __syncthreads();
  }
}
template <int NT>
DI void zero_acc(f32x4 (&acc)[4][NT]) {
#pragma unroll
  for (int a = 0; a < 4; ++a)
#pragma unroll
    for (int b = 0; b < NT; ++b) acc[a][b] = (f32x4){0.f, 0.f, 0.f, 0.f};
}

struct TileIter {
  int idx, step, L, nct, x, mode;
  DI void init(int nrt, int nct_, int b, int G) {
    nct = nct_;
    if ((G & 7) == 0 && G >= 8 && (nrt & 7) == 0) {
      mode = 1; x = b & 7; idx = b >> 3; step = G >> 3; L = (nrt >> 3) * nct;
    } else {
      mode = 0; x = 0; idx = b; step = G; L = nrt * nct;
    }
  }
  DI bool valid() const { return idx < L; }
  DI int rt() const { return mode ? x + 8 * (idx / nct) : idx / nct; }
  DI int ct() const { return idx % nct; }
  DI void next() { idx += step; }
};

#define EPI_COORDS                                                       \
  const int lane = threadIdx.x & 63, wave = threadIdx.x >> 6;           \
  const int fr = lane & 15, fq = lane >> 4, wr = wave >> 1, wc = wave & 1; \
  (void)fr; (void)fq; (void)wr; (void)wc;

DI void gemm_inproj(const Params& p, int layer, int b, int G, u16* sm) {
  const u16* H = (const u16*)(p.ws + OFF_H);
  const u16* W = (const u16*)(p.ws + OFF_W) + layer * W_LAYER + WO_IN;
  u16* proj = (u16*)(p.ws + OFF_PROJ);
  float* AB = (float*)(p.ws + OFF_AB);
  EPI_COORDS
  TileIter it; it.init(T / 128, 21, b, G);
  for (; it.valid(); it.next()) {
    const int row0 = it.rt() * 128, col0 = it.ct() * 128;
    f32x4 acc[4][4]; zero_acc<4>(acc);
    gemm_kloop<4>(H + (size_t)row0 * DM, DM, W + (size_t)col0 * DM, DM, 16, acc, sm);
#pragma unroll
    for (int mt = 0; mt < 4; ++mt) {
      const int row = row0 + wr * 64 + mt * 16 + fr;
#pragma unroll
      for (int nt = 0; nt < 4; ++nt) {
        const int col = col0 + wc * 64 + nt * 16 + fq * 4;
        if (col < INW) {
          uint2 o; o.x = pack2(acc[mt][nt][0], acc[mt][nt][1]); o.y = pack2(acc[mt][nt][2], acc[mt][nt][3]);
          *(uint2*)(proj + (size_t)row * INW + col) = o;
          if (col >= 1024 && col < 1040)
            *(float4*)(AB + (size_t)row * 16 + (col - 1024)) = make_float4(acc[mt][nt][0], acc[mt][nt][1], acc[mt][nt][2], acc[mt][nt][3]);
        }
      }
    }
  }
}

DI void gemm_glu(const Params& p, int layer, int b, int G, u16* sm) {
  const u16* Gb = (const u16*)(p.ws + OFF_G);
  const u16* W = (const u16*)(p.ws + OFF_W) + layer * W_LAYER + WO_GLU;
  u16* proj = (u16*)(p.ws + OFF_PROJ);
  EPI_COORDS
  TileIter it; it.init(T / 128, 4, b, G);
  for (; it.valid(); it.next()) {
    const int row0 = it.rt() * 128, ct = it.ct();
    f32x4 acc[4][4]; zero_acc<4>(acc);
    gemm_kloop<4>(Gb + (size_t)row0 * 256, 256, W + (size_t)ct * 128 * 256, 256, 4, acc, sm);
#pragma unroll
    for (int mt = 0; mt < 4; ++mt) {
      const int row = row0 + wr * 64 + mt * 16 + fr;
#pragma unroll
      for (int nt = 0; nt < 2; ++nt) {
        const int col = (ct * 2 + wc) * 32 + nt * 16 + fq * 4;
        float o[4];
#pragma unroll
        for (int j = 0; j < 4; ++j) o[j] = acc[mt][nt][j] * sigmoidf_(acc[mt][nt + 2][j]);
        uint2 ov; ov.x = pack2(o[0], o[1]); ov.y = pack2(o[2], o[3]);
        *(uint2*)(proj + (size_t)row * INW + C_CU + col) = ov;
      }
    }
  }
}

DI void gemm_merge(const Params& p, int layer, int b, int G, u16* sm) {
  const u16* H = (const u16*)(p.ws + OFF_H);
  const u16* Wg = (const u16*)(p.ws + OFF_W) + layer * W_LAYER + WO_GATE;
  const u16* Wb = (const u16*)(p.ws + OFF_W) + layer * W_LAYER + WO_BR;
  const u16* proj = (const u16*)(p.ws + OFF_PROJ);
  u16* merged = (u16*)(p.ws + OFF_MERGED);
  EPI_COORDS
  TileIter it; it.init(T / 128, 16, b, G);
  for (; it.valid(); it.next()) {
    const int row0 = it.rt() * 128, col0 = it.ct() * 64;
    f32x4 mg[4][2]; zero_acc<2>(mg);
#pragma unroll 1
    for (int i = 0; i < 4; ++i) {
      const int ocol = (i == 0) ? C_AZ : (i == 1) ? C_BQ : (i == 2) ? C_CU : C_DQ;
      f32x4 acc[4][2]; zero_acc<2>(acc);
      gemm_kloop<2>(H + (size_t)row0 * DM, DM, Wg + (size_t)i * DM * DM + (size_t)col0 * DM, DM, 16, acc, sm);
      f32x4 sg[4][2];
#pragma unroll
      for (int a = 0; a < 4; ++a)
#pragma unroll
        for (int c = 0; c < 2; ++c)
#pragma unroll
          for (int j = 0; j < 4; ++j) sg[a][c][j] = sigmoidf_(acc[a][c][j]);
      zero_acc<2>(acc);
      gemm_kloop<2>(proj + (size_t)row0 * INW + ocol, INW, Wb + (size_t)i * DM * 256 + (size_t)col0 * 256, 256, 4, acc, sm);
#pragma unroll
      for (int a = 0; a < 4; ++a)
#pragma unroll
        for (int c = 0; c < 2; ++c)
#pragma unroll
          for (int j = 0; j < 4; ++j) mg[a][c][j] += sg[a][c][j] * acc[a][c][j];
    }
#pragma unroll
    for (int mt = 0; mt < 4; ++mt) {
      const int row = row0 + wr * 64 + mt * 16 + fr;
#pragma unroll
      for (int nt = 0; nt < 2; ++nt) {
        const int col = col0 + wc * 32 + nt * 16 + fq * 4;
        uint2 o; o.x = pack2(mg[mt][nt][0], mg[mt][nt][1]); o.y = pack2(mg[mt][nt][2], mg[mt][nt][3]);
        *(uint2*)(merged + (size_t)row * DM + col) = o;
      }
    }
  }
}

DI void gemm_resid(const Params& p, int layer_src, const u16* A, int K, const u16* W, int b, int G, u16* sm) {
  EPI_COORDS
  TileIter it; it.init(T / 128, 8, b, G);
  for (; it.valid(); it.next()) {
    const int row0 = it.rt() * 128, col0 = it.ct() * 128;
    f32x4 acc[4][4]; zero_acc<4>(acc);
    gemm_kloop<4>(A + (size_t)row0 * K, K, W + (size_t)col0 * K, K, K / 64, acc, sm);
#pragma unroll
    for (int mt = 0; mt < 4; ++mt) {
      const int row = row0 + wr * 64 + mt * 16 + fr;
      const float* xs = xrow(p, layer_src, row);
      float* xd = p.xout + (size_t)row * DM;
#pragma unroll
      for (int nt = 0; nt < 4; ++nt) {
        const int col = col0 + wc * 64 + nt * 16 + fq * 4;
        float4 r = *(const float4*)(xs + col);
        r.x += acc[mt][nt][0]; r.y += acc[mt][nt][1]; r.z += acc[mt][nt][2]; r.w += acc[mt][nt][3];
        *(float4*)(xd + col) = r;
      }
    }
  }
}

DI void gemm_ffn1(const Params& p, int layer, int b, int G, u16* sm) {
  const u16* H = (const u16*)(p.ws + OFF_H2);
  const u16* W = (const u16*)(p.ws + OFF_W) + layer * W_LAYER + WO_GU;
  u16* act = (u16*)(p.ws + OFF_ACT);
  EPI_COORDS
  TileIter it; it.init(T / 128, 44, b, G);
  for (; it.valid(); it.next()) {
    const int row0 = it.rt() * 128, ct = it.ct();
    f32x4 acc[4][4]; zero_acc<4>(acc);
    gemm_kloop<4>(H + (size_t)row0 * DM, DM, W + (size_t)ct * 128 * DM, DM, 16, acc, sm);
#pragma unroll
    for (int mt = 0; mt < 4; ++mt) {
      const int row = row0 + wr * 64 + mt * 16 + fr;
#pragma unroll
      for (int nt = 0; nt < 2; ++nt) {
        const int col = (ct * 2 + wc) * 32 + nt * 16 + fq * 4;
        float o[4];
#pragma unroll
        for (int j = 0; j < 4; ++j) o[j] = siluf_(acc[mt][nt][j]) * acc[mt][nt + 2][j];
        uint2 ov; ov.x = pack2(o[0], o[1]); ov.y = pack2(o[2], o[3]);
        *(uint2*)(act + (size_t)row * FH + col) = ov;
      }
    }
  }
}

DI void gdn_pre(const Params& p, int layer, int task, char* smem) {
  const int tid = threadIdx.x, lane = tid & 63, wave = tid >> 6;
  const int n = task >> 2, h = task & 3, c0 = n * 64;
  const int lo = seq_lo(c0), hi = seq_hi(c0);
  float* ks = (float*)smem;
  float* vs = ks + 64 * 65;
  float* AmT = vs + 64 * 65;
  float* gcs = AmT + 2 * 64 * 64;
  float* bts = gcs + 128;
  const u16* proj = (const u16*)(p.ws + OFF_PROJ);
  u16* QN = (u16*)(p.ws + OFF_QN);
  u16* KN = (u16*)(p.ws + OFF_KN);
  float* GC = (float*)(p.ws + OFF_GC);
  const float* AB = (const float*)(p.ws + OFF_AB);
  u16* UW = (u16*)(p.ws + OFF_UW);
  __syncthreads();
#pragma unroll 1
  for (int mat = 0; mat < 3; ++mat) {
    const int ch = mat * 256 + h * 64 + lane;
    float w[5];
#pragma unroll
    for (int j = 0; j < 5; ++j) w[j] = p.conv_a[(size_t)(layer * 5 + j) * 768 + ch];
    float raw[20];
#pragma unroll
    for (int i = 0; i < 20; ++i) {
      const int tok = c0 + wave * 16 + i - 2;
      raw[i] = (tok >= lo && tok < hi) ? bf2f(proj[(size_t)tok * INW + ch]) : 0.f;
    }
#pragma unroll
    for (int i = 0; i < 16; ++i) {
      float v = 0.f;
#pragma unroll
      for (int j = 0; j < 5; ++j) v += raw[i + j] * w[j];
      v = siluf_(v);
      const int tl = wave * 16 + i;
      if (mat < 2) {
        const float ss = wave_sum(v * v);
        v *= rsqrtf(ss + EPS) * (mat == 0 ? 0.125f : 1.f);
      }
      if (mat == 0) QN[(size_t)(c0 + tl) * 256 + h * 64 + lane] = f2bf(v);
      else if (mat == 1) { KN[(size_t)(c0 + tl) * 256 + h * 64 + lane] = f2bf(v); ks[tl * 65 + lane] = v; }
      else vs[tl * 65 + lane] = v;
    }
  }
  if (wave < 2) {
    const int d = wave;
    const int tok = c0 + (d ? 63 - lane : lane);
    const float al = AB[(size_t)tok * 16 + d * 4 + h];
    const float br = AB[(size_t)tok * 16 + 8 + d * 4 + h];
    const float xx = al + p.dt_bias[(layer * 2 + d) * 4 + h];
    const float sp = fmaxf(xx, 0.f) + log1pf(__expf(-fabsf(xx)));
    float g = -__expf(p.a_log[(layer * 2 + d) * 4 + h]) * sp;
#pragma unroll
    for (int o = 1; o < 64; o <<= 1) {
      const float t = __shfl_up(g, o, 64);
      if (lane >= o) g += t;
    }
    gcs[d * 64 + lane] = g;
    bts[d * 64 + lane] = sigmoidf_(br);
    GC[(size_t)(task * 2 + d) * 64 + lane] = g;
  }
  __syncthreads();
#pragma unroll 1
  for (int m = 0; m < 16; ++m) {
    const int a = wave + 4 * m, b = lane;
    float dot = 0.f;
#pragma unroll 16
    for (int dd = 0; dd < 64; ++dd) dot += ks[a * 65 + dd] * ks[b * 65 + dd];
    if (a > b) {
      AmT[b * 64 + a] = bts[a] * dot * __expf(gcs[a] - gcs[b]);
      const int i1 = 63 - b, j1 = 63 - a;
      AmT[4096 + j1 * 64 + i1] = bts[64 + i1] * dot * __expf(gcs[64 + i1] - gcs[64 + j1]);
    }
  }
  __syncthreads();
  {
    int d = tid >> 7, c = tid & 127;
    asm volatile("" : "+v"(d), "+v"(c));
    float r[64];
    {
      const int stride = d ? -65 : 65;
      int off = (d ? 63 * 65 : 0) + (c & 63);
      const float* srcm = (c < 64) ? vs : ks;
      const bool isw = c >= 64;
#pragma unroll
      for (int i = 0; i < 64; ++i) {
        float v = srcm[off] * bts[d * 64 + i];
        if (isw) v *= __expf(gcs[d * 64 + i]);
        r[i] = v;
        off += stride;
        asm volatile("" : "+v"(off));
        if ((i & 7) == 7) __builtin_amdgcn_sched_barrier(0);
      }
    }
    const float* Ad = AmT + d * 4096;
#pragma unroll
    for (int j = 0; j < 63; ++j) {
      const float rj = r[j];
#pragma unroll
      for (int i = j + 1; i < 64; ++i) {
        r[i] = fmaf(-Ad[j * 64 + i], rj, r[i]);
        if ((i & 15) == 15) __builtin_amdgcn_sched_barrier(0);
      }
      __builtin_amdgcn_sched_barrier(0);
    }
    u16* base = UW + (size_t)(task * 2 + d) * 8192;
    if (c < 64) {
      uint4* dst = (uint4*)(base + c * 64);
#pragma unroll
      for (int q = 0; q < 8; ++q)
        dst[q] = make_uint4(pack2(r[8 * q], r[8 * q + 1]), pack2(r[8 * q + 2], r[8 * q + 3]), pack2(r[8 * q + 4], r[8 * q + 5]),
                            pack2(r[8 * q + 6], r[8 * q + 7]));
    } else {
      u16* dst = base + 4096 + (c - 64);
#pragma unroll
      for (int i = 0; i < 64; ++i) dst[i * 64] = f2bf(r[i]);
    }
  }
}

struct Quad { f32x4 q00, q01, q10, q11; };
DI f32x4& qref(Quad& q, int a, int b) { return a == 0 ? (b == 0 ? q.q00 : q.q01) : (b == 0 ? q.q10 : q.q11); }
DI void mma_quad(const u16* X, int xr0, const u16* Y, int yr0, Quad& acc, int fr, int fq) {
#pragma unroll
  for (int kk = 0; kk < 2; ++kk) {
    const bf16x8 x0 = *(const bf16x8*)(X + (xr0 + fr) * 72 + kk * 32 + fq * 8);
    const bf16x8 x1 = *(const bf16x8*)(X + (xr0 + 16 + fr) * 72 + kk * 32 + fq * 8);
    const bf16x8 y0 = *(const bf16x8*)(Y + (yr0 + fr) * 72 + kk * 32 + fq * 8);
    const bf16x8 y1 = *(const bf16x8*)(Y + (yr0 + 16 + fr) * 72 + kk * 32 + fq * 8);
    acc.q00 = mfma16(x0, y0, acc.q00);
    acc.q01 = mfma16(x0, y1, acc.q01);
    acc.q10 = mfma16(x1, y0, acc.q10);
    acc.q11 = mfma16(x1, y1, acc.q11);
  }
}
DI void quad_zero(Quad& q) { q.q00 = (f32x4){0.f, 0.f, 0.f, 0.f}; q.q01 = q.q00; q.q10 = q.q00; q.q11 = q.q00; }

DI void gdn_scan(const Params& p, int chain, char* smem) {
  const int tid = threadIdx.x, lane = tid & 63, wave = tid >> 6;
  const int fr = lane & 15, fq = lane >> 4, wr = wave >> 1, wc = wave & 1;
  const int s = chain >> 3, h = (chain >> 1) & 3, d = chain & 1;
  const int sb = s == 0 ? 0 : TP + (s - 1) * 4096;
  const int nch = s == 0 ? 256 : 64;
  u16* St = (u16*)smem;
  u16* Wc = St + 64 * 72;
  u16* Qc = Wc + 64 * 72;
  u16* Kc = Qc + 64 * 72;
  u16* KcT = Kc + 64 * 72;
  u16* QKm = KcT + 64 * 72;
  u16* Vt = QKm + 64 * 72;
  u16* Vts = Vt + 64 * 72;
  float* gcs = (float*)(Vts + 64 * 72);
  u16* proj = (u16*)(p.ws + OFF_PROJ);
  const u16* QN = (const u16*)(p.ws + OFF_QN);
  const u16* KN = (const u16*)(p.ws + OFF_KN);
  const float* GC = (const float*)(p.ws + OFF_GC);
  const u16* UW = (const u16*)(p.ws + OFF_UW);
  __syncthreads();
  for (int i = tid; i < 64 * 72; i += 256) St[i] = 0;
  Quad S; quad_zero(S);
  uint4 pw0, pw1, pq0, pq1, pk0, pk1;
  uint2 pu00, pu01, pu10, pu11;
  float pg = 0.f;
  const int prow0 = tid >> 3, prow1 = (tid >> 3) + 32, pseg = (tid & 7) * 8;
#define GDN_PREFETCH(J)                                                                              \
  {                                                                                                  \
    const int n_ = sb / 64 + (d ? nch - 1 - (J) : (J));                                              \
    const int c0_ = n_ * 64;                                                                         \
    const size_t tb_ = (size_t)((n_ * 4 + h) * 2 + d);                                               \
    const u16* ub_ = UW + tb_ * 8192;                                                                \
    const int tok0_ = c0_ + (d ? 63 - prow0 : prow0), tok1_ = c0_ + (d ? 63 - prow1 : prow1);        \
    pw0 = *(const uint4*)(ub_ + 4096 + prow0 * 64 + pseg);                                           \
    pw1 = *(const uint4*)(ub_ + 4096 + prow1 * 64 + pseg);                                           \
    pq0 = *(const uint4*)(QN + (size_t)tok0_ * 256 + h * 64 + pseg);                                 \
    pq1 = *(const uint4*)(QN + (size_t)tok1_ * 256 + h * 64 + pseg);                                 \
    pk0 = *(const uint4*)(KN + (size_t)tok0_ * 256 + h * 64 + pseg);                                 \
    pk1 = *(const uint4*)(KN + (size_t)tok1_ * 256 + h * 64 + pseg);                                 \
    pu00 = *(const uint2*)(ub_ + (wc * 32 + fr) * 64 + wr * 32 + fq * 4);                            \
    pu01 = *(const uint2*)(ub_ + (wc * 32 + 16 + fr) * 64 + wr * 32 + fq * 4);                       \
    pu10 = *(const uint2*)(ub_ + (wc * 32 + fr) * 64 + wr * 32 + 16 + fq * 4);                       \
    pu11 = *(const uint2*)(ub_ + (wc * 32 + 16 + fr) * 64 + wr * 32 + 16 + fq * 4);                  \
    if (tid < 64) pg = GC[tb_ * 64 + tid];                                                           \
  }
  GDN_PREFETCH(0)
  for (int j = 0; j < nch; ++j) {
    const int n = sb / 64 + (d ? nch - 1 - j : j);
    const int c0 = n * 64;
#define GDN_STAGE(ROW, PW, PQ, PK)                                                                   \
    *(uint4*)(Wc + (ROW) * 72 + pseg) = PW;                                                          \
    *(uint4*)(Qc + (ROW) * 72 + pseg) = PQ;                                                          \
    *(uint4*)(Kc + (ROW) * 72 + pseg) = PK;                                                          \
    KcT[(pseg + 0) * 72 + (ROW)] = (u16)(PK.x & 0xffff); KcT[(pseg + 1) * 72 + (ROW)] = (u16)(PK.x >> 16); \
    KcT[(pseg + 2) * 72 + (ROW)] = (u16)(PK.y & 0xffff); KcT[(pseg + 3) * 72 + (ROW)] = (u16)(PK.y >> 16); \
    KcT[(pseg + 4) * 72 + (ROW)] = (u16)(PK.z & 0xffff); KcT[(pseg + 5) * 72 + (ROW)] = (u16)(PK.z >> 16); \
    KcT[(pseg + 6) * 72 + (ROW)] = (u16)(PK.w & 0xffff); KcT[(pseg + 7) * 72 + (ROW)] = (u16)(PK.w >> 16);
    GDN_STAGE(prow0, pw0, pq0, pk0)
    GDN_STAGE(prow1, pw1, pq1, pk1)
    if (tid < 64) gcs[tid] = pg;
    const uint2 cu00 = pu00, cu01 = pu01, cu10 = pu10, cu11 = pu11;
    __syncthreads();
    if (j + 1 < nch) GDN_PREFETCH(j + 1)
    Quad P1, P2, QKt; quad_zero(P1); quad_zero(P2); quad_zero(QKt);
    mma_quad(Wc, wr * 32, St, wc * 32, P1, fr, fq);
    mma_quad(Qc, wr * 32, St, wc * 32, P2, fr, fq);
    mma_quad(Kc, wr * 32, Qc, wc * 32, QKt, fr, fq);
    const float glog = gcs[63];
#pragma unroll
    for (int a = 0; a < 2; ++a)
#pragma unroll
      for (int b = 0; b < 2; ++b) {
        {
          const int s0 = wr * 32 + a * 16 + fq * 4, c = wc * 32 + b * 16 + fr;
          const float gcc = gcs[c];
          float v[4];
#pragma unroll
          for (int jj = 0; jj < 4; ++jj) v[jj] = (c >= s0 + jj) ? qref(QKt, a, b)[jj] * __expf(gcc - gcs[s0 + jj]) : 0.f;
          uint2 o; o.x = pack2(v[0], v[1]); o.y = pack2(v[2], v[3]);
          *(uint2*)(QKm + c * 72 + s0) = o;
        }
        {
          const int cc0 = wr * 32 + a * 16 + fq * 4, e = wc * 32 + b * 16 + fr;
          const uint2 cuv = a == 0 ? (b == 0 ? cu00 : cu01) : (b == 0 ? cu10 : cu11);
          float uu[4];
          uu[0] = bf2f((u16)(cuv.x & 0xffff)); uu[1] = bf2f((u16)(cuv.x >> 16));
          uu[2] = bf2f((u16)(cuv.y & 0xffff)); uu[3] = bf2f((u16)(cuv.y >> 16));
          float v[4], vsn[4];
#pragma unroll
          for (int jj = 0; jj < 4; ++jj) {
            v[jj] = uu[jj] - qref(P1, a, b)[jj];
            vsn[jj] = v[jj] * __expf(glog - gcs[cc0 + jj]);
          }
          uint2 o; o.x = pack2(v[0], v[1]); o.y = pack2(v[2], v[3]);
          *(uint2*)(Vt + e * 72 + cc0) = o;
          uint2 o2; o2.x = pack2(vsn[0], vsn[1]); o2.y = pack2(vsn[2], vsn[3]);
          *(uint2*)(Vts + e * 72 + cc0) = o2;
        }
      }
    __syncthreads();
    Quad O;
#pragma unroll
    for (int a = 0; a < 2; ++a)
#pragma unroll
      for (int b = 0; b < 2; ++b) {
        const int cc0 = wr * 32 + a * 16 + fq * 4;
#pragma unroll
        for (int jj = 0; jj < 4; ++jj) qref(O, a, b)[jj] = qref(P2, a, b)[jj] * __expf(gcs[cc0 + jj]);
      }
    mma_quad(QKm, wr * 32, Vt, wc * 32, O, fr, fq);
    const float gl = __expf(glog);
    S.q00 *= gl; S.q01 *= gl; S.q10 *= gl; S.q11 *= gl;
    mma_quad(KcT, wr * 32, Vts, wc * 32, S, fr, fq);
#pragma unroll
    for (int a = 0; a < 2; ++a)
#pragma unroll
      for (int b = 0; b < 2; ++b) {
        const int r0 = wr * 32 + a * 16 + fq * 4, e = wc * 32 + b * 16 + fr;
        const f32x4 sv = qref(S, a, b);
        uint2 o; o.x = pack2(sv[0], sv[1]); o.y = pack2(sv[2], sv[3]);
        *(uint2*)(St + e * 72 + r0) = o;
        const f32x4 ov = qref(O, a, b);
#pragma unroll
        for (int jj = 0; jj < 4; ++jj) {
          const int c = r0 + jj;
          const int tok = c0 + (d ? 63 - c : c);
          proj[(size_t)tok * INW + d * 256 + h * 64 + e] = f2bf(ov[jj]);
        }
      }
    __syncthreads();
  }
}

DI void gdn_post_row(const Params& p, int layer, int t) {
  const int lane = threadIdx.x & 63;
  u16* row = (u16*)(p.ws + OFF_PROJ) + (size_t)t * INW;
  const uint2 f = *(const uint2*)(row + lane * 4);
  const uint2 bw = *(const uint2*)(row + 256 + lane * 4);
  const uint2 z = *(const uint2*)(row + C_AZ + lane * 4);
  float o[4], zz[4];
  o[0] = bf2f((u16)(f.x & 0xffff)) + bf2f((u16)(bw.x & 0xffff));
  o[1] = bf2f((u16)(f.x >> 16)) + bf2f((u16)(bw.x >> 16));
  o[2] = bf2f((u16)(f.y & 0xffff)) + bf2f((u16)(bw.y & 0xffff));
  o[3] = bf2f((u16)(f.y >> 16)) + bf2f((u16)(bw.y >> 16));
  zz[0] = bf2f((u16)(z.x & 0xffff)); zz[1] = bf2f((u16)(z.x >> 16)); zz[2] = bf2f((u16)(z.y & 0xffff)); zz[3] = bf2f((u16)(z.y >> 16));
  float ss = o[0] * o[0] + o[1] * o[1] + o[2] * o[2] + o[3] * o[3];
#pragma unroll
  for (int m = 1; m < 16; m <<= 1) ss += __shfl_xor(ss, m, 64);
  const float rs = rsqrtf(ss * (1.f / 64.f) + EPS);
  const int e0 = (lane & 15) * 4;
  float r[4];
#pragma unroll
  for (int j = 0; j < 4; ++j) r[j] = o[j] * rs * p.a_norm[layer * 64 + e0 + j] * siluf_(zz[j]);
  uint2 ov; ov.x = pack2(r[0], r[1]); ov.y = pack2(r[2], r[3]);
  *(uint2*)(row + C_AZ + lane * 4) = ov;
}

struct S5Const { float are, aim; float bpr[16], bpi[16]; };
DI void s5_consts(const Params& p, int layer, int d, int g, int lane, S5Const& k, float& lr, float& li, float& step) {
  const int gi = ((layer * 2 + d) * 16 + g);
  lr = p.lam_re[(size_t)gi * 64 + lane];
  li = p.lam_im[(size_t)gi * 64 + lane];
  step = expf(p.log_step[gi]);
  const float mag = expf(lr * step);
  float sn, cs; sincosf(li * step, &sn, &cs);
  k.are = mag * cs; k.aim = mag * sn;
  const float inv = 1.f / (lr * lr + li * li);
  const float ir = lr * inv, ii = -li * inv;
  const float cr = (k.are - 1.f) * ir - k.aim * ii;
  const float ci = (k.are - 1.f) * ii + k.aim * ir;
  const float* br = p.b_re + ((size_t)(layer * 16 + g) * 64 + lane) * 16;
  const float* bi = p.b_im + ((size_t)(layer * 16 + g) * 64 + lane) * 16;
#pragma unroll
  for (int c = 0; c < 16; ++c) {
    const float a = br[c], b = bi[c];
    k.bpr[c] = cr * a - ci * b;
    k.bpi[c] = cr * b + ci * a;
  }
}
DI void s5_stage_u(const Params& p, int c0, int gq, float* us) {
  const u16* proj = (const u16*)(p.ws + OFF_PROJ);
  const int tid = threadIdx.x;
#pragma unroll
  for (int i = 0; i < 4; ++i) {
    const int idx = tid + 256 * i, tok = idx >> 4, c4 = (idx & 15) * 4;
    const uint2 v = *(const uint2*)(proj + (size_t)(c0 + tok) * INW + C_CU + gq * 64 + c4);
    us[tok * 64 + c4 + 0] = bf2f((u16)(v.x & 0xffff));
    us[tok * 64 + c4 + 1] = bf2f((u16)(v.x >> 16));
    us[tok * 64 + c4 + 2] = bf2f((u16)(v.y & 0xffff));
    us[tok * 64 + c4 + 3] = bf2f((u16)(v.y >> 16));
  }
}
DI void s5_step(const S5Const& k, const float* u, float& sr, float& si) {
  float xr = 0.f, xi = 0.f;
#pragma unroll
  for (int c4 = 0; c4 < 4; ++c4) {
    const float4 uu = *(const float4*)(u + c4 * 4);
    xr += k.bpr[c4 * 4 + 0] * uu.x + k.bpr[c4 * 4 + 1] * uu.y + k.bpr[c4 * 4 + 2] * uu.z + k.bpr[c4 * 4 + 3] * uu.w;
    xi += k.bpi[c4 * 4 + 0] * uu.x + k.bpi[c4 * 4 + 1] * uu.y + k.bpi[c4 * 4 + 2] * uu.z + k.bpi[c4 * 4 + 3] * uu.w;
  }
  const float nr = k.are * sr - k.aim * si + xr;
  const float ni = k.are * si + k.aim * sr + xi;
  sr = nr; si = ni;
}
DI void s5_pass1(const Params& p, int layer, int task, char* smem) {
  const int lane = threadIdx.x & 63, wave = threadIdx.x >> 6;
  const int n = task >> 2, gq = task & 3, g = gq * 4 + wave, c0 = n * 64;
  float* us = (float*)smem;
  float2* SEND = (float2*)(p.ws + OFF_SEND);
  __syncthreads();
  s5_stage_u(p, c0, gq, us);
  __syncthreads();
#pragma unroll 1
  for (int d = 0; d < 2; ++d) {
    S5Const k; float lr, li, step;
    s5_consts(p, layer, d, g, lane, k, lr, li, step);
    float sr = 0.f, si = 0.f;
#pragma unroll 4
    for (int i = 0; i < 64; ++i) {
      const int t = d ? 63 - i : i;
      s5_step(k, us + t * 64 + wave * 16, sr, si);
    }
    SEND[((size_t)(n * 2 + d) * 16 + g) * 64 + lane] = make_float2(sr, si);
  }
}
DI float gelu_tanh(float x) {
  const float u = 0.7978845608028654f * (x + 0.044715f * x * x * x);
  return 0.5f * x * (1.f + tanhf(u));
}
DI void s5_pass3(const Params& p, int layer, int task, char* smem) {
  const int lane = threadIdx.x & 63, wave = threadIdx.x >> 6;
  const int fr = lane & 15, fq = lane >> 4;
  const int n = task >> 2, gq = task & 3, g = gq * 4 + wave, c0 = n * 64;
  const int nlo = seq_lo(c0) / 64, nhi = seq_hi(c0) / 64;
  float* us = (float*)smem;
  u16* Sb = (u16*)(smem + 16384) + wave * 16 * 136;
  const float2* SEND = (const float2*)(p.ws + OFF_SEND);
  u16* Gb = (u16*)(p.ws + OFF_G);
  __syncthreads();
  s5_stage_u(p, c0, gq, us);
  __syncthreads();
  f32x4 yacc[4];
#pragma unroll
  for (int tb = 0; tb < 4; ++tb) yacc[tb] = (f32x4){0.f, 0.f, 0.f, 0.f};
#pragma unroll
  for (int d = 0; d < 2; ++d) {
    S5Const k; float lr, li, step;
    s5_consts(p, layer, d, g, lane, k, lr, li, step);
    const float m64 = expf(lr * step * 64.f);
    float s64, c64; sincosf(li * step * 64.f, &s64, &c64);
    const float a64r = m64 * c64, a64i = m64 * s64;
    float sr = 0.f, si = 0.f;
    if (d == 0) {
      for (int m = nlo; m < n; ++m) {
        const float2 e = SEND[((size_t)(m * 2 + 0) * 16 + g) * 64 + lane];
        const float nr = a64r * sr - a64i * si + e.x, ni = a64r * si + a64i * sr + e.y;
        sr = nr; si = ni;
      }
    } else {
      for (int m = nhi - 1; m > n; --m) {
        const float2 e = SEND[((size_t)(m * 2 + 1) * 16 + g) * 64 + lane];
        const float nr = a64r * sr - a64i * si + e.x, ni = a64r * si + a64i * sr + e.y;
        sr = nr; si = ni;
      }
    }
    bf16x8 cf[4];
    {
      const float* cr = p.c_re + ((size_t)((layer * 2 + d) * 16 + g) * 16 + fr) * 64;
      const float* ci = p.c_im + ((size_t)((layer * 2 + d) * 16 + g) * 16 + fr) * 64;
#pragma unroll
      for (int kk = 0; kk < 4; ++kk)
#pragma unroll
        for (int e = 0; e < 8; ++e) {
          const int kx = (kk & 1) * 32 + fq * 8 + e;
          const float v = (kk < 2) ? cr[kx] : -ci[kx];
          cf[kk][e] = (short)f2bf(v);
        }
    }
#pragma unroll
    for (int blk = 0; blk < 4; ++blk) {
      const int tb = d ? 3 - blk : blk;
#pragma unroll 4
      for (int i = 0; i < 16; ++i) {
        const int r = d ? 15 - i : i;
        const int t = tb * 16 + r;
        s5_step(k, us + t * 64 + wave * 16, sr, si);
        Sb[r * 136 + lane] = f2bf(sr);
        Sb[r * 136 + 64 + lane] = f2bf(si);
      }
      __syncthreads();
#pragma unroll
      for (int kk = 0; kk < 4; ++kk) {
        const bf16x8 xf = *(const bf16x8*)(Sb + fr * 136 + kk * 32 + fq * 8);
        yacc[tb] = mfma16(xf, cf[kk], yacc[tb]);
      }
      __syncthreads();
    }
  }
  const float dsk = p.s5_d[layer * 256 + g * 16 + fr];
#pragma unroll
  for (int tb = 0; tb < 4; ++tb)
#pragma unroll
    for (int j = 0; j < 4; ++j) {
      const int t = tb * 16 + fq * 4 + j;
      const float y = yacc[tb][j] + us[t * 64 + wave * 16 + fr] * dsk;
      Gb[(size_t)(c0 + t) * 256 + g * 16 + fr] = f2bf(gelu_tanh(y));
    }
}

struct AttnState { float m, l; f32x4 o[4]; };
DI void attn_segment(const u16* proj, int kcol, int vcol, int tk0, int kstride, int npairs, int R, float slope, int tq,
                     int lo, int hi, const bf16x8 (&qf)[2], AttnState& st, u16* Vt, int lane) {
  const int fr = lane & 15, fq = lane >> 4;
#pragma unroll 1
  for (int pr = 0; pr < npairs; ++pr) {
    const int kbase = tk0 + pr * 32 * kstride;
    f32x4 sacc[2];
#pragma unroll
    for (int t = 0; t < 2; ++t) {
      int tk = kbase + (t * 16 + fr) * kstride;
      tk = min(max(tk, lo), hi - 1);
      const u16* kp = proj + (size_t)tk * INW + kcol + fq * 8;
      const bf16x8 k0 = *(const bf16x8*)(kp), k1 = *(const bf16x8*)(kp + 32);
      sacc[t] = mfma16(k0, qf[0], (f32x4){0.f, 0.f, 0.f, 0.f});
      sacc[t] = mfma16(k1, qf[1], sacc[t]);
    }
    uint4 vr[4];
#pragma unroll
    for (int i = 0; i < 4; ++i) {
      const int idx = lane + 64 * i, kl = idx >> 3, seg = (idx & 7) * 8;
      int tk = kbase + kl * kstride;
      tk = min(max(tk, lo), hi - 1);
      vr[i] = *(const uint4*)(proj + (size_t)tk * INW + vcol + seg);
    }
    float sc[2][4]; bool ok[2][4];
    float mx = -1e30f;
#pragma unroll
    for (int t = 0; t < 2; ++t)
#pragma unroll
      for (int j = 0; j < 4; ++j) {
        const int tk = kbase + (t * 16 + fq * 4 + j) * kstride;
        const int ad = abs(tk - tq);
        ok[t][j] = (ad <= R) && (tk >= lo) && (tk < hi);
        sc[t][j] = sacc[t][j] * 0.125f - slope * (float)ad;
        if (ok[t][j]) mx = fmaxf(mx, sc[t][j]);
      }
    mx = fmaxf(mx, __shfl_xor(mx, 16, 64));
    mx = fmaxf(mx, __shfl_xor(mx, 32, 64));
    const float mn = fmaxf(st.m, mx);
    const float alpha = __expf(st.m - mn);
    st.m = mn;
    float pv[2][4], ps = 0.f;
#pragma unroll
    for (int t = 0; t < 2; ++t)
#pragma unroll
      for (int j = 0; j < 4; ++j) { pv[t][j] = ok[t][j] ? __expf(sc[t][j] - mn) : 0.f; ps += pv[t][j]; }
    st.l = st.l * alpha + ps;
#pragma unroll
    for (int dt = 0; dt < 4; ++dt)
#pragma unroll
      for (int j = 0; j < 4; ++j) st.o[dt][j] *= alpha;
    bf16x8 pf;
    {
      const unsigned w0 = pack2(pv[0][0], pv[0][1]), w1 = pack2(pv[0][2], pv[0][3]), w2 = pack2(pv[1][0], pv[1][1]),
                     w3 = pack2(pv[1][2], pv[1][3]);
      uint4 t4 = make_uint4(w0, w1, w2, w3);
      pf = __builtin_bit_cast(bf16x8, t4);
    }
    __syncthreads();
#pragma unroll
    for (int i = 0; i < 4; ++i) {
      const int idx = lane + 64 * i, kl = idx >> 3, seg = (idx & 7) * 8;
      Vt[(seg + 0) * 36 + kl] = (u16)(vr[i].x & 0xffff); Vt[(seg + 1) * 36 + kl] = (u16)(vr[i].x >> 16);
      Vt[(seg + 2) * 36 + kl] = (u16)(vr[i].y & 0xffff); Vt[(seg + 3) * 36 + kl] = (u16)(vr[i].y >> 16);
      Vt[(seg + 4) * 36 + kl] = (u16)(vr[i].z & 0xffff); Vt[(seg + 5) * 36 + kl] = (u16)(vr[i].z >> 16);
      Vt[(seg + 6) * 36 + kl] = (u16)(vr[i].w & 0xffff); Vt[(seg + 7) * 36 + kl] = (u16)(vr[i].w >> 16);
    }
    __syncthreads();
#pragma unroll
    for (int dt = 0; dt < 4; ++dt) {
      const uint2 v0 = *(const uint2*)(Vt + (dt * 16 + fr) * 36 + fq * 4);
      const uint2 v1 = *(const uint2*)(Vt + (dt * 16 + fr) * 36 + 16 + fq * 4);
      uint4 t4 = make_uint4(v0.x, v0.y, v1.x, v1.y);
      const bf16x8 vf = __builtin_bit_cast(bf16x8, t4);
      st.o[dt] = mfma16(vf, pf, st.o[dt]);
    }
  }
}
DI void attn_task(const Params& p, int layer, int mode, int task, char* smem) {
  const int lane = threadIdx.x & 63, wave = threadIdx.x >> 6;
  const int fr = lane & 15, fq = lane >> 4;
  u16* proj = (u16*)(p.ws + OFF_PROJ);
  u16* Vt = (u16*)smem + wave * 64 * 36;
  int tq0, qstride, qcol, kcol, vcol; float slope;
  int hq;
  if (mode == 0) {
    const int blk = task >> 4, h = (task >> 2) & 3, rq = task & 3;
    hq = h; tq0 = blk * 256 + rq * 4 + wave; qstride = 16;
    qcol = C_BQ + h * 64; kcol = C_BK + h * 64; vcol = C_BV + h * 64;
    slope = exp2f(-(float)(5 + h));
  } else {
    const int blk = task >> 2, qh = task & 3;
    hq = qh; tq0 = blk * 64 + wave * 16; qstride = 1;
    qcol = C_DQ + qh * 64; kcol = C_DK + (qh >> 1) * 64; vcol = C_DV + (qh >> 1) * 64;
    slope = exp2f(-(float)(1 + qh));
  }
  const int lo = seq_lo(tq0), hi = seq_hi(tq0);
  const int tq = tq0 + fr * qstride;
  bf16x8 qf[2];
  {
    const u16* qp = proj + (size_t)tq * INW + qcol + fq * 8;
    qf[0] = *(const bf16x8*)(qp); qf[1] = *(const bf16x8*)(qp + 32);
  }
  AttnState st; st.m = -1e30f; st.l = 0.f;
#pragma unroll
  for (int dt = 0; dt < 4; ++dt) st.o[dt] = (f32x4){0.f, 0.f, 0.f, 0.f};
  __syncthreads();
  float scale;
  if (mode == 0) {
    attn_segment(proj, kcol, vcol, tq0 - 64, 1, 12, 64, slope, tq, lo, hi, qf, st, Vt, lane);
    attn_segment(proj, kcol, vcol, tq0 - 256, 4, 6, 256, slope, tq, lo, hi, qf, st, Vt, lane);
    attn_segment(proj, kcol, vcol, tq0 - 1024, 16, 5, 1024, slope, tq, lo, hi, qf, st, Vt, lane);
    float l = st.l; l += __shfl_xor(l, 16, 64); l += __shfl_xor(l, 32, 64);
    scale = 1.f / l;
  } else {
    attn_segment(proj, kcol, vcol, tq0 - 128, 1, 9, 128, slope, tq, lo, hi, qf, st, Vt, lane);
    float l = st.l; l += __shfl_xor(l, 16, 64); l += __shfl_xor(l, 32, 64);
    const float sink = p.attn_sink[layer * 4 + hq];
    const float mf = fmaxf(st.m, sink);
    const float sc = __expf(st.m - mf);
    scale = sc / (l * sc + __expf(sink - mf));
  }
#pragma unroll
  for (int dt = 0; dt < 4; ++dt) {
    uint2 o; o.x = pack2(st.o[dt][0] * scale, st.o[dt][1] * scale); o.y = pack2(st.o[dt][2] * scale, st.o[dt][3] * scale);
    *(uint2*)(proj + (size_t)tq * INW + qcol + dt * 16 + fq * 4) = o;
  }
}

DI void final_row(const Params& p, int t) {
  const int lane = threadIdx.x & 63;
  float* row = p.xout + (size_t)t * DM;
  float4 v[4]; float ss = 0.f;
#pragma unroll
  for (int i = 0; i < 4; ++i) {
    v[i] = *(const float4*)(row + i * 256 + lane * 4);
    ss += v[i].x * v[i].x + v[i].y * v[i].y + v[i].z * v[i].z + v[i].w * v[i].w;
  }
  ss = wave_sum(ss);
  const float rs = rsqrtf(ss * (1.f / DM) + EPS);
#pragma unroll
  for (int i = 0; i < 4; ++i) {
    const float4 g = *(const float4*)(p.final_norm + i * 256 + lane * 4);
    *(float4*)(row + i * 256 + lane * 4) = make_float4(v[i].x * rs * g.x, v[i].y * rs * g.y, v[i].z * rs * g.z, v[i].w * rs * g.w);
  }
}

enum { PH_NORM1 = 0, PH_INPROJ, PH_MIX1, PH_MIX2, PH_MIX3, PH_MERGE, PH_OUT, PH_NORM2, PH_FFN1, PH_FFN2, PH_PER_LAYER, PH_FINAL = 100 };

DI void run_phase(const Params& p, int ph, int layer, char* smem) {
  const int b = blockIdx.x, G = gridDim.x;
  const int wave = threadIdx.x >> 6;
  switch (ph) {
    case PH_NORM1: {
      if (layer == 0) {
        for (int t = b; t < 2 * CONV_TILES_LAYER; t += G) {
          ConvJob j;
          const int lt = conv_lookup(p, t, j);
          conv_tile(j, lt, (float*)smem);
        }
      }
      rms_phase(p, layer, p.norm1 + layer * DM, (u16*)(p.ws + OFF_H), b, G);
    } break;
    case PH_INPROJ: gemm_inproj(p, layer, b, G, (u16*)smem); break;
    case PH_MIX1: {
      for (int t = b; t < 4 * 3072; t += G) {
        const int kind = t / 3072, idx = t % 3072;
        if (kind == 0) gdn_pre(p, layer, idx, smem);
        else if (kind == 1) attn_task(p, layer, 0, idx, smem);
        else if (kind == 2) attn_task(p, layer, 1, idx, smem);
        else s5_pass1(p, layer, idx, smem);
      }
    } break;
    case PH_MIX2: {
      if (G > 72 + 8) {
        if (b < 72) gdn_scan(p, b, smem);
        else for (int t = b - 72; t < 3072; t += G - 72) s5_pass3(p, layer, t, smem);
      } else {
        for (int c = b; c < 72; c += G) gdn_scan(p, c, smem);
        for (int t = b; t < 3072; t += G) s5_pass3(p, layer, t, smem);
      }
    } break;
    case PH_MIX3: {
      gemm_glu(p, layer, b, G, (u16*)smem);
      for (int t = b * 4 + wave; t < T; t += G * 4) gdn_post_row(p, layer, t);
      rms_phase(p, layer, p.norm1 + layer * DM, (u16*)(p.ws + OFF_H), b, G);
    } break;
    case PH_MERGE: gemm_merge(p, layer, b, G, (u16*)smem); break;
    case PH_OUT:
      gemm_resid(p, layer, (const u16*)(p.ws + OFF_MERGED), DM, (const u16*)(p.ws + OFF_W) + layer * W_LAYER + WO_OUT, b, G, (u16*)smem);
      break;
    case PH_NORM2: rms_phase(p, 1, p.norm2 + layer * DM, (u16*)(p.ws + OFF_H2), b, G); break;
    case PH_FFN1: gemm_ffn1(p, layer, b, G, (u16*)smem); break;
    case PH_FFN2:
      gemm_resid(p, 1, (const u16*)(p.ws + OFF_ACT), FH, (const u16*)(p.ws + OFF_W) + layer * W_LAYER + WO_DN, b, G, (u16*)smem);
      break;
    case PH_FINAL:
      for (int t = b * 4 + wave; t < T; t += G * 4) final_row(p, t);
      break;
    default: break;
  }
}

#if !MEGA
__global__ void __launch_bounds__(256, 1) k_phase(Params p, int ph, int layer) {
  __shared__ __attribute__((aligned(16))) char smem[SMEM_BYTES];
  run_phase(p, ph, layer, smem);
}

#else
__global__ void __launch_bounds__(256, 1) k_mega(Params p) {
  __shared__ __attribute__((aligned(16))) char smem[SMEM_BYTES];
  cg::grid_group grid = cg::this_grid();
  for (int layer = 0; layer < 2; ++layer)
    for (int ph = 0; ph < PH_PER_LAYER; ++ph) {
      run_phase(p, ph, layer, smem);
      grid.sync();
    }
  run_phase(p, PH_FINAL, 0, smem);
}
#endif

extern "C" void kernel_launch(void* const* d_in, const int* in_sizes, int n_in, void* d_out, int out_size, void* d_ws,
                              size_t ws_size, hipStream_t stream) {
  (void)in_sizes; (void)n_in; (void)out_size;
  if (ws_size < WS_NEED) { fprintf(stderr, "workspace too small: %zu < %zu\n", ws_size, (size_t)WS_NEED); return; }
  Params p;
  memset(&p, 0, sizeof(p));
  const float* const* in = (const float* const*)d_in;
  p.x_prompt = in[0]; p.x_sample = in[1]; p.norm1 = in[2]; p.conv_a = in[4]; p.a_log = in[5]; p.dt_bias = in[6];
  p.a_norm = in[7]; p.lam_re = in[8]; p.lam_im = in[9]; p.log_step = in[10]; p.b_re = in[11]; p.b_im = in[12];
  p.c_re = in[13]; p.c_im = in[14]; p.s5_d = in[15]; p.attn_sink = in[17]; p.norm2 = in[21]; p.final_norm = in[25];
  p.xout = (float*)d_out;
  p.ws = (char*)d_ws;
  p.w_in = in[3]; p.w_glu = in[16]; p.w_gate = in[18]; p.w_branch = in[19]; p.w_out = in[20];
  p.w_ffn_gate = in[22]; p.w_ffn_up = in[23]; p.w_ffn_down = in[24];
  static int grid_blocks = 0;
  if (!grid_blocks) {
    int dev = 0, cus = 0, per_cu = 0;
    hipGetDevice(&dev);
    hipDeviceGetAttribute(&cus, hipDeviceAttributeMultiprocessorCount, dev);
#if MEGA
    hipOccupancyMaxActiveBlocksPerMultiprocessor(&per_cu, k_mega, 256, 0);
#else
    hipOccupancyMaxActiveBlocksPerMultiprocessor(&per_cu, k_phase, 256, 0);
#endif
    if (per_cu < 1) per_cu = 1;
    if (per_cu > 1) per_cu = 1;
    grid_blocks = cus * per_cu;
  }
#if MEGA
  void* args[] = {&p};
  hipError_t e = hipLaunchCooperativeKernel((void*)k_mega, dim3(grid_blocks), dim3(256), args, 0, stream);
  if (e != hipSuccess) fprintf(stderr, "cooperative launch failed: %s (grid %d)\n", hipGetErrorString(e), grid_blocks);
#else
  for (int layer = 0; layer < 2; ++layer)
    for (int ph = 0; ph < PH_PER_LAYER; ++ph) hipLaunchKernelGGL(k_phase, dim3(grid_blocks), dim3(256), 0, stream, p, ph, layer);
  hipLaunchKernelGGL(k_phase, dim3(grid_blocks), dim3(256), 0, stream, p, (int)PH_FINAL, 0);
#endif
}
```

```cpp
#include <hip/hip_runtime.h>
#include <hip/hip_cooperative_groups.h>
#include <cstdio>
#include <cstring>
namespace cg = cooperative_groups;

#ifndef MEGA
#define MEGA 1
#endif

#define DI __device__ __forceinline__
typedef unsigned short u16;
typedef __attribute__((ext_vector_type(8))) short bf16x8;
typedef __attribute__((ext_vector_type(4))) float f32x4;

constexpr int T = 49152;
constexpr int TP = 16384;
constexpr int DM = 1024;
constexpr int INW = 2576;
constexpr int FH = 2816;
constexpr int NCH64 = T / 64;
constexpr float EPS = 1e-6f;

constexpr int C_AQ = 0, C_AK = 256, C_AV = 512, C_AZ = 768, C_BQ = 1040, C_BK = 1296, C_BV = 1552, C_CU = 1808,
              C_DQ = 2064, C_DK = 2320, C_DV = 2448;

constexpr size_t WO_IN = 0, WO_GATE = 2752512, WO_BR = 6946816, WO_OUT = 7995392, WO_GU = 9043968, WO_DN = 14811136,
                 WO_GLU = 17694720, W_LAYER = 17825792;
constexpr size_t OFF_W = 0;
constexpr size_t OFF_PROJ = 2 * W_LAYER * 2;
constexpr size_t SZ_PROJ = (size_t)T * INW * 2;
constexpr size_t OFF_R1 = OFF_PROJ + SZ_PROJ;
constexpr size_t SZ_H = (size_t)T * DM * 2;
constexpr size_t OFF_H = OFF_R1;
constexpr size_t OFF_UW = OFF_R1;
constexpr size_t OFF_QN = OFF_R1 + SZ_H;
constexpr size_t OFF_KN = OFF_QN + (size_t)T * 256 * 2;
constexpr size_t OFF_GC = OFF_KN + (size_t)T * 256 * 2;
constexpr size_t OFF_SEND = OFF_GC + (size_t)NCH64 * 8 * 64 * 4;
constexpr size_t OFF_G = OFF_SEND + (size_t)NCH64 * 2 * 1024 * 8;
constexpr size_t OFF_AB = OFF_G + (size_t)T * 256 * 2;
constexpr size_t OFF_MERGED = OFF_R1 + SZ_H;
constexpr size_t OFF_H2 = OFF_MERGED;
constexpr size_t OFF_ACT = OFF_PROJ;
constexpr size_t WS_NEED = OFF_MERGED + SZ_H;

constexpr int SMEM_BYTES = 75776;

struct ConvJob { const float* src; u16* dst; int K, ncols, nrows_dst, src_ld, rs, off, ntn; };
struct Params {
  const float *x_prompt, *x_sample, *norm1, *conv_a, *a_log, *dt_bias, *a_norm, *lam_re, *lam_im, *log_step, *b_re,
      *b_im, *c_re, *c_im, *s5_d, *attn_sink, *norm2, *final_norm;
  const float *w_in, *w_gate, *w_branch, *w_out, *w_ffn_gate, *w_ffn_up, *w_ffn_down, *w_glu;
  float* xout;
  char* ws;
};
constexpr int CONV_TILES_LAYER = 4352;

DI int my_tid() { int t = threadIdx.x; asm volatile("" : "+v"(t)); return t; }
DI u16 f2bf(float x) { unsigned u = __float_as_uint(x); u += 0x7fffu + ((u >> 16) & 1u); return (u16)(u >> 16); }
DI float bf2f(u16 v) { return __uint_as_float(((unsigned)v) << 16); }
DI unsigned pack2(float a, float b) { return (unsigned)f2bf(a) | ((unsigned)f2bf(b) << 16); }
DI float sigmoidf_(float x) { return 1.f / (1.f + __expf(-x)); }
DI float siluf_(float x) { return x / (1.f + __expf(-x)); }
DI float wave_sum(float v) {
#pragma unroll
  for (int o = 32; o > 0; o >>= 1) v += __shfl_xor(v, o, 64);
  return v;
}
DI int seq_lo(int t) { return t < TP ? 0 : (t & ~4095); }
DI int seq_hi(int t) { return t < TP ? TP : (t & ~4095) + 4096; }
DI const float* xrow(const Params& p, int layer, int t) {
  if (layer == 0) return t < TP ? p.x_prompt + (size_t)t * DM : p.x_sample + (size_t)(t - TP) * DM;
  return p.xout + (size_t)t * DM;
}
DI f32x4 mfma16(bf16x8 a, bf16x8 b, f32x4 c) { return __builtin_amdgcn_mfma_f32_16x16x32_bf16(a, b, c, 0, 0, 0); }

DI void mk_job(ConvJob& j, const float* src, u16* dst, int K, int ncols, int nrows_dst, int src_ld, int rs, int off) {
  j.src = src; j.dst = dst; j.K = K; j.ncols = ncols; j.nrows_dst = nrows_dst; j.src_ld = src_ld; j.rs = rs; j.off = off;
  j.ntn = (nrows_dst + 63) >> 6;
}
DI int conv_lookup(const Params& p, int t, ConvJob& j) {
  const int l = t / CONV_TILES_LAYER;
  int r = t % CONV_TILES_LAYER;
  u16* wl = (u16*)(p.ws + OFF_W) + (size_t)l * W_LAYER;
  if (r < 672) { mk_job(j, p.w_in + (size_t)l * DM * INW, wl + WO_IN, DM, INW, 2688, INW, 32, 0); return r; }
  r -= 672;
  if (r < 1024) { const int i = r >> 8; mk_job(j, p.w_gate + (size_t)(l * 4 + i) * DM * DM, wl + WO_GATE + (size_t)i * DM * DM, DM, DM, DM, DM, 32, 0); return r & 255; }
  r -= 1024;
  if (r < 256) { const int i = r >> 6; mk_job(j, p.w_branch + (size_t)(l * 4 + i) * 256 * DM, wl + WO_BR + (size_t)i * DM * 256, 256, DM, DM, DM, 32, 0); return r & 63; }
  r -= 256;
  if (r < 256) { mk_job(j, p.w_out + (size_t)l * DM * DM, wl + WO_OUT, DM, DM, DM, DM, 32, 0); return r; }
  r -= 256;
  if (r < 704) { mk_job(j, p.w_ffn_gate + (size_t)l * DM * FH, wl + WO_GU, DM, FH, FH, FH, 64, 0); return r; }
  r -= 704;
  if (r < 704) { mk_job(j, p.w_ffn_up + (size_t)l * DM * FH, wl + WO_GU, DM, FH, FH, FH, 64, 32); return r; }
  r -= 704;
  if (r < 704) { mk_job(j, p.w_ffn_down + (size_t)l * FH * DM, wl + WO_DN, FH, DM, DM, DM, 32, 0); return r; }
  r -= 704;
  if (r < 16) { mk_job(j, p.w_glu + (size_t)l * 256 * 512, wl + WO_GLU, 256, 256, 256, 512, 64, 0); return r; }
  r -= 16;
  mk_job(j, p.w_glu + (size_t)l * 256 * 512 + 256, wl + WO_GLU, 256, 256, 256, 512, 64, 32);
  return r;
}
DI void conv_tile(const ConvJob& j, int lt, float* tile) {
  const int tid = my_tid();
  const int tk = lt / j.ntn, tn = lt % j.ntn;
  __syncthreads();
#pragma unroll
  for (int i = 0; i < 4; ++i) {
    int r = (tid >> 4) + 16 * i, c4 = (tid & 15) * 4, n = tn * 64 + c4;
    float4 v = make_float4(0.f, 0.f, 0.f, 0.f);
    if (n < j.ncols) v = *(const float4*)(j.src + (size_t)(tk * 64 + r) * j.src_ld + n);
    tile[r * 65 + c4 + 0] = v.x; tile[r * 65 + c4 + 1] = v.y; tile[r * 65 + c4 + 2] = v.z; tile[r * 65 + c4 + 3] = v.w;
  }
  __syncthreads();
  const int cl = tid >> 2, ks = (tid & 3) * 16, n = tn * 64 + cl;
  if (n < j.nrows_dst) {
    unsigned w[8];
#pragma unroll
    for (int e = 0; e < 8; ++e) w[e] = pack2(tile[(ks + 2 * e) * 65 + cl], tile[(ks + 2 * e + 1) * 65 + cl]);
    const int nm = (n >> 5) * j.rs + (n & 31) + j.off;
    uint4* d = (uint4*)(j.dst + (size_t)nm * j.K + tk * 64 + ks);
    d[0] = make_uint4(w[0], w[1], w[2], w[3]);
    d[1] = make_uint4(w[4], w[5], w[6], w[7]);
  }
}

DI void rms_row_bf16(const float* src, const float* w, u16* dst) {
  const int lane = my_tid() & 63;
  float4 v[4];
  float ss = 0.f;
#pragma unroll
  for (int i = 0; i < 4; ++i) {
    v[i] = *(const float4*)(src + i * 256 + lane * 4);
    ss += v[i].x * v[i].x + v[i].y * v[i].y + v[i].z * v[i].z + v[i].w * v[i].w;
  }
  ss = wave_sum(ss);
  const float rs = rsqrtf(ss * (1.f / DM) + EPS);
#pragma unroll
  for (int i = 0; i < 4; ++i) {
    float4 g = *(const float4*)(w + i * 256 + lane * 4);
    uint2 o;
    o.x = pack2(v[i].x * rs * g.x, v[i].y * rs * g.y);
    o.y = pack2(v[i].z * rs * g.z, v[i].w * rs * g.w);
    *(uint2*)(dst + i * 256 + lane * 4) = o;
  }
}
DI void rms_phase(const Params& p, int layer, const float* w, u16* dst, int b0, int nb) {
  const int wave = my_tid() >> 6;
  for (int r = b0 * 4 + wave; r < T; r += nb * 4) rms_row_bf16(xrow(p, layer, r), w, dst + (size_t)r * DM);
}

constexpr int GP = 72;
template <int NT>
DI void gemm_kloop(const u16* __restrict__ A, size_t lda, const u16* __restrict__ B, size_t ldb, int nk,
                   f32x4 (&acc)[4][NT], u16* sm) {
  const int tid = my_tid(), lane = tid & 63, wave = tid >> 6;
  const int fr = lane & 15, fq = lane >> 4, wr = wave >> 1, wc = wave & 1;
  u16* sa = sm;
  u16* sb = sm + 2 * 128 * GP;
  uint4 ra0, ra1, ra2, ra3, rb0, rb1, rb2 = make_uint4(0, 0, 0, 0), rb3 = make_uint4(0, 0, 0, 0);
  const int lrow = tid >> 3, lseg = (tid & 7) * 8;
  const u16* Ap = A + (size_t)lrow * lda + lseg;
  const u16* Bp = B + (size_t)lrow * ldb + lseg;
#define KL_LOAD(KOFF)                                                    \
  ra0 = *(const uint4*)(Ap + (KOFF));                                    \
  ra1 = *(const uint4*)(Ap + 32 * lda + (KOFF));                         \
  ra2 = *(const uint4*)(Ap + 64 * lda + (KOFF));                         \
  ra3 = *(const uint4*)(Ap + 96 * lda + (KOFF));                         \
  rb0 = *(const uint4*)(Bp + (KOFF));                                    \
  rb1 = *(const uint4*)(Bp + 32 * ldb + (KOFF));                         \
  if (NT > 2) { rb2 = *(const uint4*)(Bp + 64 * ldb + (KOFF)); rb3 = *(const uint4*)(Bp + 96 * ldb + (KOFF)); }
#define KL_STORE(SA, SB)                                                 \
  *(uint4*)((SA) + (lrow + 0) * GP + lseg) = ra0;                        \
  *(uint4*)((SA) + (lrow + 32) * GP + lseg) = ra1;                       \
  *(uint4*)((SA) + (lrow + 64) * GP + lseg) = ra2;                       \
  *(uint4*)((SA) + (lrow + 96) * GP + lseg) = ra3;                       \
  *(uint4*)((SB) + (lrow + 0) * GP + lseg) = rb0;                        \
  *(uint4*)((SB) + (lrow + 32) * GP + lseg) = rb1;                       \
  if (NT > 2) { *(uint4*)((SB) + (lrow + 64) * GP + lseg) = rb2; *(uint4*)((SB) + (lrow + 96) * GP + lseg) = rb3; }
  KL_LOAD(0)
  KL_STORE(sa, sb)
  __syncthreads();
#pragma unroll 1
  for (int kt = 0; kt < nk; ++kt) {
    const int cur = kt & 1;
    if (kt + 1 < nk) { KL_LOAD((kt + 1) * 64) }
    const u16* ca = sa + cur * 128 * GP;
    const u16* cb = sb + cur * 128 * GP;
#pragma unroll
    for (int kk = 0; kk < 2; ++kk) {
      bf16x8 wf[NT], xf[4];
#pragma unroll
      for (int nt = 0; nt < NT; ++nt) wf[nt] = *(const bf16x8*)(cb + (wc * NT * 16 + nt * 16 + fr) * GP + kk * 32 + fq * 8);
#pragma unroll
      for (int mt = 0; mt < 4; ++mt) xf[mt] = *(const bf16x8*)(ca + (wr * 64 + mt * 16 + fr) * GP + kk * 32 + fq * 8);
#pragma unroll
      for (int mt = 0; mt < 4; ++mt)
#pragma unroll
        for (int nt = 0; nt < NT; ++nt) acc[mt][nt] = mfma16(wf[nt], xf[mt], acc[mt][nt]);
    }
    if (kt + 1 < nk) {
      u16* na = sa + (cur ^ 1) * 128 * GP;
      u16* nb = sb + (cur ^ 1) * 128 * GP;
      KL_STORE(na, nb)
    }
    __syncthreads();
  }
}
template <int NT>
DI void zero_acc(f32x4 (&acc)[4][NT]) {
#pragma unroll
  for (int a = 0; a < 4; ++a)
#pragma unroll
    for (int b = 0; b < NT; ++b) acc[a][b] = (f32x4){0.f, 0.f, 0.f, 0.f};
}

struct TileIter {
  int idx, step, L, nct, x, mode;
  DI void init(int nrt, int nct_, int b, int G) {
    nct = nct_;
    if ((G & 7) == 0 && G >= 8 && (nrt & 7) == 0) {
      mode = 1; x = b & 7; idx = b >> 3; step = G >> 3; L = (nrt >> 3) * nct;
    } else {
      mode = 0; x = 0; idx = b; step = G; L = nrt * nct;
    }
  }
  DI bool valid() const { return idx < L; }
  DI int rt() const { return mode ? x + 8 * (idx / nct) : idx / nct; }
  DI int ct() const { return idx % nct; }
  DI void next() { idx += step; }
};

#define EPI_COORDS                                                       \
  const int lane = my_tid() & 63, wave = my_tid() >> 6;           \
  const int fr = lane & 15, fq = lane >> 4, wr = wave >> 1, wc = wave & 1; \
  (void)fr; (void)fq; (void)wr; (void)wc;

DI void gemm_inproj(const Params& p, int layer, int b, int G, u16* sm) {
  const u16* H = (const u16*)(p.ws + OFF_H);
  const u16* W = (const u16*)(p.ws + OFF_W) + layer * W_LAYER + WO_IN;
  u16* proj = (u16*)(p.ws + OFF_PROJ);
  float* AB = (float*)(p.ws + OFF_AB);
  EPI_COORDS
  TileIter it; it.init(T / 128, 21, b, G);
  for (; it.valid(); it.next()) {
    const int row0 = it.rt() * 128, col0 = it.ct() * 128;
    f32x4 acc[4][4]; zero_acc<4>(acc);
    gemm_kloop<4>(H + (size_t)row0 * DM, DM, W + (size_t)col0 * DM, DM, 16, acc, sm);
#pragma unroll
    for (int mt = 0; mt < 4; ++mt) {
      const int row = row0 + wr * 64 + mt * 16 + fr;
#pragma unroll
      for (int nt = 0; nt < 4; ++nt) {
        const int col = col0 + wc * 64 + nt * 16 + fq * 4;
        if (col < INW) {
          uint2 o; o.x = pack2(acc[mt][nt][0], acc[mt][nt][1]); o.y = pack2(acc[mt][nt][2], acc[mt][nt][3]);
          *(uint2*)(proj + (size_t)row * INW + col) = o;
          if (col >= 1024 && col < 1040)
            *(float4*)(AB + (size_t)row * 16 + (col - 1024)) = make_float4(acc[mt][nt][0], acc[mt][nt][1], acc[mt][nt][2], acc[mt][nt][3]);
        }
      }
    }
  }
}

DI void gemm_glu(const Params& p, int layer, int b, int G, u16* sm) {
  const u16* Gb = (const u16*)(p.ws + OFF_G);
  const u16* W = (const u16*)(p.ws + OFF_W) + layer * W_LAYER + WO_GLU;
  u16* proj = (u16*)(p.ws + OFF_PROJ);
  EPI_COORDS
  TileIter it; it.init(T / 128, 4, b, G);
  for (; it.valid(); it.next()) {
    const int row0 = it.rt() * 128, ct = it.ct();
    f32x4 acc[4][4]; zero_acc<4>(acc);
    gemm_kloop<4>(Gb + (size_t)row0 * 256, 256, W + (size_t)ct * 128 * 256, 256, 4, acc, sm);
#pragma unroll
    for (int mt = 0; mt < 4; ++mt) {
      const int row = row0 + wr * 64 + mt * 16 + fr;
#pragma unroll
      for (int nt = 0; nt < 2; ++nt) {
        const int col = (ct * 2 + wc) * 32 + nt * 16 + fq * 4;
        float o[4];
#pragma unroll
        for (int j = 0; j < 4; ++j) o[j] = acc[mt][nt][j] * sigmoidf_(acc[mt][nt + 2][j]);
        uint2 ov; ov.x = pack2(o[0], o[1]); ov.y = pack2(o[2], o[3]);
        *(uint2*)(proj + (size_t)row * INW + C_CU + col) = ov;
      }
    }
  }
}

DI void gemm_merge(const Params& p, int layer, int b, int G, u16* sm) {
  const u16* H = (const u16*)(p.ws + OFF_H);
  const u16* Wg = (const u16*)(p.ws + OFF_W) + layer * W_LAYER + WO_GATE;
  const u16* Wb = (const u16*)(p.ws + OFF_W) + layer * W_LAYER + WO_BR;
  const u16* proj = (const u16*)(p.ws + OFF_PROJ);
  u16* merged = (u16*)(p.ws + OFF_MERGED);
  EPI_COORDS
  TileIter it; it.init(T / 128, 16, b, G);
  for (; it.valid(); it.next()) {
    const int row0 = it.rt() * 128, col0 = it.ct() * 64;
    f32x4 mg[4][2]; zero_acc<2>(mg);
#pragma unroll 1
    for (int i = 0; i < 4; ++i) {
      const int ocol = (i == 0) ? C_AZ : (i == 1) ? C_BQ : (i == 2) ? C_CU : C_DQ;
      f32x4 acc[4][2]; zero_acc<2>(acc);
      gemm_kloop<2>(H + (size_t)row0 * DM, DM, Wg + (size_t)i * DM * DM + (size_t)col0 * DM, DM, 16, acc, sm);
      f32x4 sg[4][2];
#pragma unroll
      for (int a = 0; a < 4; ++a)
#pragma unroll
        for (int c = 0; c < 2; ++c)
#pragma unroll
          for (int j = 0; j < 4; ++j) sg[a][c][j] = sigmoidf_(acc[a][c][j]);
      zero_acc<2>(acc);
      gemm_kloop<2>(proj + (size_t)row0 * INW + ocol, INW, Wb + (size_t)i * DM * 256 + (size_t)col0 * 256, 256, 4, acc, sm);
#pragma unroll
      for (int a = 0; a < 4; ++a)
#pragma unroll
        for (int c = 0; c < 2; ++c)
#pragma unroll
          for (int j = 0; j < 4; ++j) mg[a][c][j] += sg[a][c][j] * acc[a][c][j];
    }
#pragma unroll
    for (int mt = 0; mt < 4; ++mt) {
      const int row = row0 + wr * 64 + mt * 16 + fr;
#pragma unroll
      for (int nt = 0; nt < 2; ++nt) {
        const int col = col0 + wc * 32 + nt * 16 + fq * 4;
        uint2 o; o.x = pack2(mg[mt][nt][0], mg[mt][nt][1]); o.y = pack2(mg[mt][nt][2], mg[mt][nt][3]);
        *(uint2*)(merged + (size_t)row * DM + col) = o;
      }
    }
  }
}

DI void gemm_resid(const Params& p, int layer_src, const u16* A, int K, const u16* W, int b, int G, u16* sm) {
  EPI_COORDS
  TileIter it; it.init(T / 128, 8, b, G);
  for (; it.valid(); it.next()) {
    const int row0 = it.rt() * 128, col0 = it.ct() * 128;
    f32x4 acc[4][4]; zero_acc<4>(acc);
    gemm_kloop<4>(A + (size_t)row0 * K, K, W + (size_t)col0 * K, K, K / 64, acc, sm);
#pragma unroll
    for (int mt = 0; mt < 4; ++mt) {
      const int row = row0 + wr * 64 + mt * 16 + fr;
      const float* xs = xrow(p, layer_src, row);
      float* xd = p.xout + (size_t)row * DM;
#pragma unroll
      for (int nt = 0; nt < 4; ++nt) {
        const int col = col0 + wc * 64 + nt * 16 + fq * 4;
        float4 r = *(const float4*)(xs + col);
        r.x += acc[mt][nt][0]; r.y += acc[mt][nt][1]; r.z += acc[mt][nt][2]; r.w += acc[mt][nt][3];
        *(float4*)(xd + col) = r;
      }
    }
  }
}

DI void gemm_ffn1(const Params& p, int layer, int b, int G, u16* sm) {
  const u16* H = (const u16*)(p.ws + OFF_H2);
  const u16* W = (const u16*)(p.ws + OFF_W) + layer * W_LAYER + WO_GU;
  u16* act = (u16*)(p.ws + OFF_ACT);
  EPI_COORDS
  TileIter it; it.init(T / 128, 44, b, G);
  for (; it.valid(); it.next()) {
    const int row0 = it.rt() * 128, ct = it.ct();
    f32x4 acc[4][4]; zero_acc<4>(acc);
    gemm_kloop<4>(H + (size_t)row0 * DM, DM, W + (size_t)ct * 128 * DM, DM, 16, acc, sm);
#pragma unroll
    for (int mt = 0; mt < 4; ++mt) {
      const int row = row0 + wr * 64 + mt * 16 + fr;
#pragma unroll
      for (int nt = 0; nt < 2; ++nt) {
        const int col = (ct * 2 + wc) * 32 + nt * 16 + fq * 4;
        float o[4];
#pragma unroll
        for (int j = 0; j < 4; ++j) o[j] = siluf_(acc[mt][nt][j]) * acc[mt][nt + 2][j];
        uint2 ov; ov.x = pack2(o[0], o[1]); ov.y = pack2(o[2], o[3]);
        *(uint2*)(act + (size_t)row * FH + col) = ov;
      }
    }
  }
}

DI void gdn_pre(const Params& p, int layer, int task, char* smem) {
  const int tid = my_tid(), lane = tid & 63, wave = tid >> 6;
  const int n = task >> 2, h = task & 3, c0 = n * 64;
  const int lo = seq_lo(c0), hi = seq_hi(c0);
  float* ks = (float*)smem;
  float* vs = ks + 64 * 65;
  float* AmT = vs + 64 * 65;
  float* gcs = AmT + 2 * 64 * 64;
  float* bts = gcs + 128;
  const u16* proj = (const u16*)(p.ws + OFF_PROJ);
  u16* QN = (u16*)(p.ws + OFF_QN);
  u16* KN = (u16*)(p.ws + OFF_KN);
  float* GC = (float*)(p.ws + OFF_GC);
  const float* AB = (const float*)(p.ws + OFF_AB);
  u16* UW = (u16*)(p.ws + OFF_UW);
  __syncthreads();
#pragma unroll 1
  for (int mat = 0; mat < 3; ++mat) {
    const int ch = mat * 256 + h * 64 + lane;
    float w[5];
#pragma unroll
    for (int j = 0; j < 5; ++j) w[j] = p.conv_a[(size_t)(layer * 5 + j) * 768 + ch];
    float raw[20];
#pragma unroll
    for (int i = 0; i < 20; ++i) {
      const int tok = c0 + wave * 16 + i - 2;
      raw[i] = (tok >= lo && tok < hi) ? bf2f(proj[(size_t)tok * INW + ch]) : 0.f;
    }
#pragma unroll
    for (int i = 0; i < 16; ++i) {
      float v = 0.f;
#pragma unroll
      for (int j = 0; j < 5; ++j) v += raw[i + j] * w[j];
      v = siluf_(v);
      const int tl = wave * 16 + i;
      if (mat < 2) {
        const float ss = wave_sum(v * v);
        v *= rsqrtf(ss + EPS) * (mat == 0 ? 0.125f : 1.f);
      }
      if (mat == 0) QN[(size_t)(c0 + tl) * 256 + h * 64 + lane] = f2bf(v);
      else if (mat == 1) { KN[(size_t)(c0 + tl) * 256 + h * 64 + lane] = f2bf(v); ks[tl * 65 + lane] = v; }
      else vs[tl * 65 + lane] = v;
    }
  }
  if (wave < 2) {
    const int d = wave;
    const int tok = c0 + (d ? 63 - lane : lane);
    const float al = AB[(size_t)tok * 16 + d * 4 + h];
    const float br = AB[(size_t)tok * 16 + 8 + d * 4 + h];
    const float xx = al + p.dt_bias[(layer * 2 + d) * 4 + h];
    const float sp = fmaxf(xx, 0.f) + log1pf(__expf(-fabsf(xx)));
    float g = -__expf(p.a_log[(layer * 2 + d) * 4 + h]) * sp;
#pragma unroll
    for (int o = 1; o < 64; o <<= 1) {
      const float t = __shfl_up(g, o, 64);
      if (lane >= o) g += t;
    }
    gcs[d * 64 + lane] = g;
    bts[d * 64 + lane] = sigmoidf_(br);
    GC[(size_t)(task * 2 + d) * 64 + lane] = g;
  }
  __syncthreads();
#pragma unroll 1
  for (int m = 0; m < 16; ++m) {
    const int a = wave + 4 * m, b = lane;
    float dot = 0.f;
#pragma unroll 16
    for (int dd = 0; dd < 64; ++dd) dot += ks[a * 65 + dd] * ks[b * 65 + dd];
    if (a > b) {
      AmT[b * 64 + a] = bts[a] * dot * __expf(gcs[a] - gcs[b]);
      const int i1 = 63 - b, j1 = 63 - a;
      AmT[4096 + j1 * 64 + i1] = bts[64 + i1] * dot * __expf(gcs[64 + i1] - gcs[64 + j1]);
    }
  }
  __syncthreads();
  {
    int d = tid >> 7, c = tid & 127;
    asm volatile("" : "+v"(d), "+v"(c));
    float r[64];
    {
      const int stride = d ? -65 : 65;
      int off = (d ? 63 * 65 : 0) + (c & 63);
      const float* srcm = (c < 64) ? vs : ks;
      const bool isw = c >= 64;
#pragma unroll
      for (int i = 0; i < 64; ++i) {
        float v = srcm[off] * bts[d * 64 + i];
        if (isw) v *= __expf(gcs[d * 64 + i]);
        r[i] = v;
        off += stride;
        asm volatile("" : "+v"(off));
        if ((i & 7) == 7) __builtin_amdgcn_sched_barrier(0);
      }
    }
    const float* Ad = AmT + d * 4096;
#pragma unroll
    for (int j = 0; j < 63; ++j) {
      const float rj = r[j];
#pragma unroll
      for (int i = j + 1; i < 64; ++i) {
        r[i] = fmaf(-Ad[j * 64 + i], rj, r[i]);
        if ((i & 15) == 15) __builtin_amdgcn_sched_barrier(0);
      }
      __builtin_amdgcn_sched_barrier(0);
    }
    u16* base = UW + (size_t)(task * 2 + d) * 8192;
    if (c < 64) {
      uint4* dst = (uint4*)(base + c * 64);
#pragma unroll
      for (int q = 0; q < 8; ++q)
        dst[q] = make_uint4(pack2(r[8 * q], r[8 * q + 1]), pack2(r[8 * q + 2], r[8 * q + 3]), pack2(r[8 * q + 4], r[8 * q + 5]),
                            pack2(r[8 * q + 6], r[8 * q + 7]));
    } else {
      u16* dst = base + 4096 + (c - 64);
#pragma unroll
      for (int i = 0; i < 64; ++i) dst[i * 64] = f2bf(r[i]);
    }
  }
}

struct Quad { f32x4 q00, q01, q10, q11; };
DI f32x4& qref(Quad& q, int a, int b) { return a == 0 ? (b == 0 ? q.q00 : q.q01) : (b == 0 ? q.q10 : q.q11); }
DI void mma_quad(const u16* X, int xr0, const u16* Y, int yr0, Quad& acc, int fr, int fq) {
#pragma unroll
  for (int kk = 0; kk < 2; ++kk) {
    const bf16x8 x0 = *(const bf16x8*)(X + (xr0 + fr) * 72 + kk * 32 + fq * 8);
    const bf16x8 x1 = *(const bf16x8*)(X + (xr0 + 16 + fr) * 72 + kk * 32 + fq * 8);
    const bf16x8 y0 = *(const bf16x8*)(Y + (yr0 + fr) * 72 + kk * 32 + fq * 8);
    const bf16x8 y1 = *(const bf16x8*)(Y + (yr0 + 16 + fr) * 72 + kk * 32 + fq * 8);
    acc.q00 = mfma16(x0, y0, acc.q00);
    acc.q01 = mfma16(x0, y1, acc.q01);
    acc.q10 = mfma16(x1, y0, acc.q10);
    acc.q11 = mfma16(x1, y1, acc.q11);
  }
}
DI void quad_zero(Quad& q) { q.q00 = (f32x4){0.f, 0.f, 0.f, 0.f}; q.q01 = q.q00; q.q10 = q.q00; q.q11 = q.q00; }

DI void gdn_scan(const Params& p, int chain, char* smem) {
  const int tid = my_tid(), lane = tid & 63, wave = tid >> 6;
  const int fr = lane & 15, fq = lane >> 4, wr = wave >> 1, wc = wave & 1;
  const int s = chain >> 3, h = (chain >> 1) & 3, d = chain & 1;
  const int sb = s == 0 ? 0 : TP + (s - 1) * 4096;
  const int nch = s == 0 ? 256 : 64;
  u16* St = (u16*)smem;
  u16* Wc = St + 64 * 72;
  u16* Qc = Wc + 64 * 72;
  u16* Kc = Qc + 64 * 72;
  u16* KcT = Kc + 64 * 72;
  u16* QKm = KcT + 64 * 72;
  u16* Vt = QKm + 64 * 72;
  u16* Vts = Vt + 64 * 72;
  float* gcs = (float*)(Vts + 64 * 72);
  u16* proj = (u16*)(p.ws + OFF_PROJ);
  const u16* QN = (const u16*)(p.ws + OFF_QN);
  const u16* KN = (const u16*)(p.ws + OFF_KN);
  const float* GC = (const float*)(p.ws + OFF_GC);
  const u16* UW = (const u16*)(p.ws + OFF_UW);
  __syncthreads();
  for (int i = tid; i < 64 * 72; i += 256) St[i] = 0;
  Quad S; quad_zero(S);
  uint4 pw0, pw1, pq0, pq1, pk0, pk1;
  uint2 pu00, pu01, pu10, pu11;
  float pg = 0.f;
  const int prow0 = tid >> 3, prow1 = (tid >> 3) + 32, pseg = (tid & 7) * 8;
#define GDN_PREFETCH(J)                                                                              \
  {                                                                                                  \
    const int n_ = sb / 64 + (d ? nch - 1 - (J) : (J));                                              \
    const int c0_ = n_ * 64;                                                                         \
    const size_t tb_ = (size_t)((n_ * 4 + h) * 2 + d);                                               \
    const u16* ub_ = UW + tb_ * 8192;                                                                \
    const int tok0_ = c0_ + (d ? 63 - prow0 : prow0), tok1_ = c0_ + (d ? 63 - prow1 : prow1);        \
    pw0 = *(const uint4*)(ub_ + 4096 + prow0 * 64 + pseg);                                           \
    pw1 = *(const uint4*)(ub_ + 4096 + prow1 * 64 + pseg);                                           \
    pq0 = *(const uint4*)(QN + (size_t)tok0_ * 256 + h * 64 + pseg);                                 \
    pq1 = *(const uint4*)(QN + (size_t)tok1_ * 256 + h * 64 + pseg);                                 \
    pk0 = *(const uint4*)(KN + (size_t)tok0_ * 256 + h * 64 + pseg);                                 \
    pk1 = *(const uint4*)(KN + (size_t)tok1_ * 256 + h * 64 + pseg);                                 \
    pu00 = *(const uint2*)(ub_ + (wc * 32 + fr) * 64 + wr * 32 + fq * 4);                            \
    pu01 = *(const uint2*)(ub_ + (wc * 32 + 16 + fr) * 64 + wr * 32 + fq * 4);                       \
    pu10 = *(const uint2*)(ub_ + (wc * 32 + fr) * 64 + wr * 32 + 16 + fq * 4);                       \
    pu11 = *(const uint2*)(ub_ + (wc * 32 + 16 + fr) * 64 + wr * 32 + 16 + fq * 4);                  \
    if (tid < 64) pg = GC[tb_ * 64 + tid];                                                           \
  }
  GDN_PREFETCH(0)
  for (int j = 0; j < nch; ++j) {
    const int n = sb / 64 + (d ? nch - 1 - j : j);
    const int c0 = n * 64;
#define GDN_STAGE(ROW, PW, PQ, PK)                                                                   \
    *(uint4*)(Wc + (ROW) * 72 + pseg) = PW;                                                          \
    *(uint4*)(Qc + (ROW) * 72 + pseg) = PQ;                                                          \
    *(uint4*)(Kc + (ROW) * 72 + pseg) = PK;                                                          \
    KcT[(pseg + 0) * 72 + (ROW)] = (u16)(PK.x & 0xffff); KcT[(pseg + 1) * 72 + (ROW)] = (u16)(PK.x >> 16); \
    KcT[(pseg + 2) * 72 + (ROW)] = (u16)(PK.y & 0xffff); KcT[(pseg + 3) * 72 + (ROW)] = (u16)(PK.y >> 16); \
    KcT[(pseg + 4) * 72 + (ROW)] = (u16)(PK.z & 0xffff); KcT[(pseg + 5) * 72 + (ROW)] = (u16)(PK.z >> 16); \
    KcT[(pseg + 6) * 72 + (ROW)] = (u16)(PK.w & 0xffff); KcT[(pseg + 7) * 72 + (ROW)] = (u16)(PK.w >> 16);
    GDN_STAGE(prow0, pw0, pq0, pk0)
    GDN_STAGE(prow1, pw1, pq1, pk1)
    if (tid < 64) gcs[tid] = pg;
    const uint2 cu00 = pu00, cu01 = pu01, cu10 = pu10, cu11 = pu11;
    __syncthreads();
    if (j + 1 < nch) GDN_PREFETCH(j + 1)
    Quad P1, P2, QKt; quad_zero(P1); quad_zero(P2); quad_zero(QKt);
    mma_quad(Wc, wr * 32, St, wc * 32, P1, fr, fq);
    mma_quad(Qc, wr * 32, St, wc * 32, P2, fr, fq);
    mma_quad(Kc, wr * 32, Qc, wc * 32, QKt, fr, fq);
    const float glog = gcs[63];
#pragma unroll
    for (int a = 0; a < 2; ++a)
#pragma unroll
      for (int b = 0; b < 2; ++b) {
        {
          const int s0 = wr * 32 + a * 16 + fq * 4, c = wc * 32 + b * 16 + fr;
          const float gcc = gcs[c];
          float v[4];
#pragma unroll
          for (int jj = 0; jj < 4; ++jj) v[jj] = (c >= s0 + jj) ? qref(QKt, a, b)[jj] * __expf(gcc - gcs[s0 + jj]) : 0.f;
          uint2 o; o.x = pack2(v[0], v[1]); o.y = pack2(v[2], v[3]);
          *(uint2*)(QKm + c * 72 + s0) = o;
        }
        {
          const int cc0 = wr * 32 + a * 16 + fq * 4, e = wc * 32 + b * 16 + fr;
          const uint2 cuv = a == 0 ? (b == 0 ? cu00 : cu01) : (b == 0 ? cu10 : cu11);
          float uu[4];
          uu[0] = bf2f((u16)(cuv.x & 0xffff)); uu[1] = bf2f((u16)(cuv.x >> 16));
          uu[2] = bf2f((u16)(cuv.y & 0xffff)); uu[3] = bf2f((u16)(cuv.y >> 16));
          float v[4], vsn[4];
#pragma unroll
          for (int jj = 0; jj < 4; ++jj) {
            v[jj] = uu[jj] - qref(P1, a, b)[jj];
            vsn[jj] = v[jj] * __expf(glog - gcs[cc0 + jj]);
          }
          uint2 o; o.x = pack2(v[0], v[1]); o.y = pack2(v[2], v[3]);
          *(uint2*)(Vt + e * 72 + cc0) = o;
          uint2 o2; o2.x = pack2(vsn[0], vsn[1]); o2.y = pack2(vsn[2], vsn[3]);
          *(uint2*)(Vts + e * 72 + cc0) = o2;
        }
      }
    __syncthreads();
    Quad O;
#pragma unroll
    for (int a = 0; a < 2; ++a)
#pragma unroll
      for (int b = 0; b < 2; ++b) {
        const int cc0 = wr * 32 + a * 16 + fq * 4;
#pragma unroll
        for (int jj = 0; jj < 4; ++jj) qref(O, a, b)[jj] = qref(P2, a, b)[jj] * __expf(gcs[cc0 + jj]);
      }
    mma_quad(QKm, wr * 32, Vt, wc * 32, O, fr, fq);
    const float gl = __expf(glog);
    S.q00 *= gl; S.q01 *= gl; S.q10 *= gl; S.q11 *= gl;
    mma_quad(KcT, wr * 32, Vts, wc * 32, S, fr, fq);
#pragma unroll
    for (int a = 0; a < 2; ++a)
#pragma unroll
      for (int b = 0; b < 2; ++b) {
        const int r0 = wr * 32 + a * 16 + fq * 4, e = wc * 32 + b * 16 + fr;
        const f32x4 sv = qref(S, a, b);
        uint2 o; o.x = pack2(sv[0], sv[1]); o.y = pack2(sv[2], sv[3]);
        *(uint2*)(St + e * 72 + r0) = o;
        const f32x4 ov = qref(O, a, b);
#pragma unroll
        for (int jj = 0; jj < 4; ++jj) {
          const int c = r0 + jj;
          const int tok = c0 + (d ? 63 - c : c);
          proj[(size_t)tok * INW + d * 256 + h * 64 + e] = f2bf(ov[jj]);
        }
      }
    __syncthreads();
  }
}

DI void gdn_post_row(const Params& p, int layer, int t) {
  const int lane = my_tid() & 63;
  u16* row = (u16*)(p.ws + OFF_PROJ) + (size_t)t * INW;
  const uint2 f = *(const uint2*)(row + lane * 4);
  const uint2 bw = *(const uint2*)(row + 256 + lane * 4);
  const uint2 z = *(const uint2*)(row + C_AZ + lane * 4);
  float o[4], zz[4];
  o[0] = bf2f((u16)(f.x & 0xffff)) + bf2f((u16)(bw.x & 0xffff));
  o[1] = bf2f((u16)(f.x >> 16)) + bf2f((u16)(bw.x >> 16));
  o[2] = bf2f((u16)(f.y & 0xffff)) + bf2f((u16)(bw.y & 0xffff));
  o[3] = bf2f((u16)(f.y >> 16)) + bf2f((u16)(bw.y >> 16));
  zz[0] = bf2f((u16)(z.x & 0xffff)); zz[1] = bf2f((u16)(z.x >> 16)); zz[2] = bf2f((u16)(z.y & 0xffff)); zz[3] = bf2f((u16)(z.y >> 16));
  float ss = o[0] * o[0] + o[1] * o[1] + o[2] * o[2] + o[3] * o[3];
#pragma unroll
  for (int m = 1; m < 16; m <<= 1) ss += __shfl_xor(ss, m, 64);
  const float rs = rsqrtf(ss * (1.f / 64.f) + EPS);
  const int e0 = (lane & 15) * 4;
  float r[4];
#pragma unroll
  for (int j = 0; j < 4; ++j) r[j] = o[j] * rs * p.a_norm[layer * 64 + e0 + j] * siluf_(zz[j]);
  uint2 ov; ov.x = pack2(r[0], r[1]); ov.y = pack2(r[2], r[3]);
  *(uint2*)(row + C_AZ + lane * 4) = ov;
}

struct S5Const { float are, aim; float bpr[16], bpi[16]; };
DI void s5_consts(const Params& p, int layer, int d, int g, int lane, S5Const& k, float& lr, float& li, float& step) {
  const int gi = ((layer * 2 + d) * 16 + g);
  lr = p.lam_re[(size_t)gi * 64 + lane];
  li = p.lam_im[(size_t)gi * 64 + lane];
  step = expf(p.log_step[gi]);
  const float mag = expf(lr * step);
  float sn, cs; sincosf(li * step, &sn, &cs);
  k.are = mag * cs; k.aim = mag * sn;
  const float inv = 1.f / (lr * lr + li * li);
  const float ir = lr * inv, ii = -li * inv;
  const float cr = (k.are - 1.f) * ir - k.aim * ii;
  const float ci = (k.are - 1.f) * ii + k.aim * ir;
  const float* br = p.b_re + ((size_t)(layer * 16 + g) * 64 + lane) * 16;
  const float* bi = p.b_im + ((size_t)(layer * 16 + g) * 64 + lane) * 16;
#pragma unroll
  for (int c = 0; c < 16; ++c) {
    const float a = br[c], b = bi[c];
    k.bpr[c] = cr * a - ci * b;
    k.bpi[c] = cr * b + ci * a;
  }
}
DI void s5_stage_u(const Params& p, int c0, int gq, float* us) {
  const u16* proj = (const u16*)(p.ws + OFF_PROJ);
  const int tid = my_tid();
#pragma unroll
  for (int i = 0; i < 4; ++i) {
    const int idx = tid + 256 * i, tok = idx >> 4, c4 = (idx & 15) * 4;
    const uint2 v = *(const uint2*)(proj + (size_t)(c0 + tok) * INW + C_CU + gq * 64 + c4);
    us[tok * 64 + c4 + 0] = bf2f((u16)(v.x & 0xffff));
    us[tok * 64 + c4 + 1] = bf2f((u16)(v.x >> 16));
    us[tok * 64 + c4 + 2] = bf2f((u16)(v.y & 0xffff));
    us[tok * 64 + c4 + 3] = bf2f((u16)(v.y >> 16));
  }
}
DI void s5_step(const S5Const& k, const float* u, float& sr, float& si) {
  float xr = 0.f, xi = 0.f;
#pragma unroll
  for (int c4 = 0; c4 < 4; ++c4) {
    const float4 uu = *(const float4*)(u + c4 * 4);
    xr += k.bpr[c4 * 4 + 0] * uu.x + k.bpr[c4 * 4 + 1] * uu.y + k.bpr[c4 * 4 + 2] * uu.z + k.bpr[c4 * 4 + 3] * uu.w;
    xi += k.bpi[c4 * 4 + 0] * uu.x + k.bpi[c4 * 4 + 1] * uu.y + k.bpi[c4 * 4 + 2] * uu.z + k.bpi[c4 * 4 + 3] * uu.w;
  }
  const float nr = k.are * sr - k.aim * si + xr;
  const float ni = k.are * si + k.aim * sr + xi;
  sr = nr; si = ni;
}
DI void s5_pass1(const Params& p, int layer, int task, char* smem) {
  const int lane = my_tid() & 63, wave = my_tid() >> 6;
  const int n = task >> 2, gq = task & 3, g = gq * 4 + wave, c0 = n * 64;
  float* us = (float*)smem;
  float2* SEND = (float2*)(p.ws + OFF_SEND);
  __syncthreads();
  s5_stage_u(p, c0, gq, us);
  __syncthreads();
#pragma unroll 1
  for (int d = 0; d < 2; ++d) {
    S5Const k; float lr, li, step;
    s5_consts(p, layer, d, g, lane, k, lr, li, step);
    float sr = 0.f, si = 0.f;
#pragma unroll 4
    for (int i = 0; i < 64; ++i) {
      const int t = d ? 63 - i : i;
      s5_step(k, us + t * 64 + wave * 16, sr, si);
    }
    SEND[((size_t)(n * 2 + d) * 16 + g) * 64 + lane] = make_float2(sr, si);
  }
}
DI float gelu_tanh(float x) {
  const float u = 0.7978845608028654f * (x + 0.044715f * x * x * x);
  return 0.5f * x * (1.f + tanhf(u));
}
DI void s5_pass3(const Params& p, int layer, int task, char* smem) {
  const int lane = my_tid() & 63, wave = my_tid() >> 6;
  const int fr = lane & 15, fq = lane >> 4;
  const int n = task >> 2, gq = task & 3, g = gq * 4 + wave, c0 = n * 64;
  const int nlo = seq_lo(c0) / 64, nhi = seq_hi(c0) / 64;
  float* us = (float*)smem;
  u16* Sb = (u16*)(smem + 16384) + wave * 16 * 136;
  const float2* SEND = (const float2*)(p.ws + OFF_SEND);
  u16* Gb = (u16*)(p.ws + OFF_G);
  __syncthreads();
  s5_stage_u(p, c0, gq, us);
  __syncthreads();
  f32x4 yacc[4];
#pragma unroll
  for (int tb = 0; tb < 4; ++tb) yacc[tb] = (f32x4){0.f, 0.f, 0.f, 0.f};
#pragma unroll
  for (int d = 0; d < 2; ++d) {
    S5Const k; float lr, li, step;
    s5_consts(p, layer, d, g, lane, k, lr, li, step);
    const float m64 = expf(lr * step * 64.f);
    float s64, c64; sincosf(li * step * 64.f, &s64, &c64);
    const float a64r = m64 * c64, a64i = m64 * s64;
    float sr = 0.f, si = 0.f;
    if (d == 0) {
      for (int m = nlo; m < n; ++m) {
        const float2 e = SEND[((size_t)(m * 2 + 0) * 16 + g) * 64 + lane];
        const float nr = a64r * sr - a64i * si + e.x, ni = a64r * si + a64i * sr + e.y;
        sr = nr; si = ni;
      }
    } else {
      for (int m = nhi - 1; m > n; --m) {
        const float2 e = SEND[((size_t)(m * 2 + 1) * 16 + g) * 64 + lane];
        const float nr = a64r * sr - a64i * si + e.x, ni = a64r * si + a64i * sr + e.y;
        sr = nr; si = ni;
      }
    }
    bf16x8 cf[4];
    {
      const float* cr = p.c_re + ((size_t)((layer * 2 + d) * 16 + g) * 16 + fr) * 64;
      const float* ci = p.c_im + ((size_t)((layer * 2 + d) * 16 + g) * 16 + fr) * 64;
#pragma unroll
      for (int kk = 0; kk < 4; ++kk)
#pragma unroll
        for (int e = 0; e < 8; ++e) {
          const int kx = (kk & 1) * 32 + fq * 8 + e;
          const float v = (kk < 2) ? cr[kx] : -ci[kx];
          cf[kk][e] = (short)f2bf(v);
        }
    }
#pragma unroll
    for (int blk = 0; blk < 4; ++blk) {
      const int tb = d ? 3 - blk : blk;
#pragma unroll 4
      for (int i = 0; i < 16; ++i) {
        const int r = d ? 15 - i : i;
        const int t = tb * 16 + r;
        s5_step(k, us + t * 64 + wave * 16, sr, si);
        Sb[r * 136 + lane] = f2bf(sr);
        Sb[r * 136 + 64 + lane] = f2bf(si);
      }
      __syncthreads();
#pragma unroll
      for (int kk = 0; kk < 4; ++kk) {
        const bf16x8 xf = *(const bf16x8*)(Sb + fr * 136 + kk * 32 + fq * 8);
        yacc[tb] = mfma16(xf, cf[kk], yacc[tb]);
      }
      __syncthreads();
    }
  }
  const float dsk = p.s5_d[layer * 256 + g * 16 + fr];
#pragma unroll
  for (int tb = 0; tb < 4; ++tb)
#pragma unroll
    for (int j = 0; j < 4; ++j) {
      const int t = tb * 16 + fq * 4 + j;
      const float y = yacc[tb][j] + us[t * 64 + wave * 16 + fr] * dsk;
      Gb[(size_t)(c0 + t) * 256 + g * 16 + fr] = f2bf(gelu_tanh(y));
    }
}

struct AttnState { float m, l; f32x4 o[4]; };
DI void attn_segment(const u16* proj, int kcol, int vcol, int tk0, int kstride, int npairs, int R, float slope, int tq,
                     int lo, int hi, const bf16x8 (&qf)[2], AttnState& st, u16* Vt, int lane) {
  const int fr = lane & 15, fq = lane >> 4;
#pragma unroll 1
  for (int pr = 0; pr < npairs; ++pr) {
    const int kbase = tk0 + pr * 32 * kstride;
    f32x4 sacc[2];
#pragma unroll
    for (int t = 0; t < 2; ++t) {
      int tk = kbase + (t * 16 + fr) * kstride;
      tk = min(max(tk, lo), hi - 1);
      const u16* kp = proj + (size_t)tk * INW + kcol + fq * 8;
      const bf16x8 k0 = *(const bf16x8*)(kp), k1 = *(const bf16x8*)(kp + 32);
      sacc[t] = mfma16(k0, qf[0], (f32x4){0.f, 0.f, 0.f, 0.f});
      sacc[t] = mfma16(k1, qf[1], sacc[t]);
    }
    uint4 vr[4];
#pragma unroll
    for (int i = 0; i < 4; ++i) {
      const int idx = lane + 64 * i, kl = idx >> 3, seg = (idx & 7) * 8;
      int tk = kbase + kl * kstride;
      tk = min(max(tk, lo), hi - 1);
      vr[i] = *(const uint4*)(proj + (size_t)tk * INW + vcol + seg);
    }
    float sc[2][4]; bool ok[2][4];
    float mx = -1e30f;
#pragma unroll
    for (int t = 0; t < 2; ++t)
#pragma unroll
      for (int j = 0; j < 4; ++j) {
        const int tk = kbase + (t * 16 + fq * 4 + j) * kstride;
        const int ad = abs(tk - tq);
        ok[t][j] = (ad <= R) && (tk >= lo) && (tk < hi);
        sc[t][j] = sacc[t][j] * 0.125f - slope * (float)ad;
        if (ok[t][j]) mx = fmaxf(mx, sc[t][j]);
      }
    mx = fmaxf(mx, __shfl_xor(mx, 16, 64));
    mx = fmaxf(mx, __shfl_xor(mx, 32, 64));
    const float mn = fmaxf(st.m, mx);
    const float alpha = __expf(st.m - mn);
    st.m = mn;
    float pv[2][4], ps = 0.f;
#pragma unroll
    for (int t = 0; t < 2; ++t)
#pragma unroll
      for (int j = 0; j < 4; ++j) { pv[t][j] = ok[t][j] ? __expf(sc[t][j] - mn) : 0.f; ps += pv[t][j]; }
    st.l = st.l * alpha + ps;
#pragma unroll
    for (int dt = 0; dt < 4; ++dt)
#pragma unroll
      for (int j = 0; j < 4; ++j) st.o[dt][j] *= alpha;
    bf16x8 pf;
    {
      const unsigned w0 = pack2(pv[0][0], pv[0][1]), w1 = pack2(pv[0][2], pv[0][3]), w2 = pack2(pv[1][0], pv[1][1]),
                     w3 = pack2(pv[1][2], pv[1][3]);
      uint4 t4 = make_uint4(w0, w1, w2, w3);
      pf = __builtin_bit_cast(bf16x8, t4);
    }
    __syncthreads();
#pragma unroll
    for (int i = 0; i < 4; ++i) {
      const int idx = lane + 64 * i, kl = idx >> 3, seg = (idx & 7) * 8;
      Vt[(seg + 0) * 36 + kl] = (u16)(vr[i].x & 0xffff); Vt[(seg + 1) * 36 + kl] = (u16)(vr[i].x >> 16);
      Vt[(seg + 2) * 36 + kl] = (u16)(vr[i].y & 0xffff); Vt[(seg + 3) * 36 + kl] = (u16)(vr[i].y >> 16);
      Vt[(seg + 4) * 36 + kl] = (u16)(vr[i].z & 0xffff); Vt[(seg + 5) * 36 + kl] = (u16)(vr[i].z >> 16);
      Vt[(seg + 6) * 36 + kl] = (u16)(vr[i].w & 0xffff); Vt[(seg + 7) * 36 + kl] = (u16)(vr[i].w >> 16);
    }
    __syncthreads();
#pragma unroll
    for (int dt = 0; dt < 4; ++dt) {
      const uint2 v0 = *(const uint2*)(Vt + (dt * 16 + fr) * 36 + fq * 4);
      const uint2 v1 = *(const uint2*)(Vt + (dt * 16 + fr) * 36 + 16 + fq * 4);
      uint4 t4 = make_uint4(v0.x, v0.y, v1.x, v1.y);
      const bf16x8 vf = __builtin_bit_cast(bf16x8, t4);
      st.o[dt] = mfma16(vf, pf, st.o[dt]);
    }
  }
}
DI void attn_task(const Params& p, int layer, int mode, int task, char* smem) {
  const int lane = my_tid() & 63, wave = my_tid() >> 6;
  const int fr = lane & 15, fq = lane >> 4;
  u16* proj = (u16*)(p.ws + OFF_PROJ);
  u16* Vt = (u16*)smem + wave * 64 * 36;
  int tq0, qstride, qcol, kcol, vcol; float slope;
  int hq;
  if (mode == 0) {
    const int blk = task >> 4, h = (task >> 2) & 3, rq = task & 3;
    hq = h; tq0 = blk * 256 + rq * 4 + wave; qstride = 16;
    qcol = C_BQ + h * 64; kcol = C_BK + h * 64; vcol = C_BV + h * 64;
    slope = exp2f(-(float)(5 + h));
  } else {
    const int blk = task >> 2, qh = task & 3;
    hq = qh; tq0 = blk * 64 + wave * 16; qstride = 1;
    qcol = C_DQ + qh * 64; kcol = C_DK + (qh >> 1) * 64; vcol = C_DV + (qh >> 1) * 64;
    slope = exp2f(-(float)(1 + qh));
  }
  const int lo = seq_lo(tq0), hi = seq_hi(tq0);
  const int tq = tq0 + fr * qstride;
  bf16x8 qf[2];
  {
    const u16* qp = proj + (size_t)tq * INW + qcol + fq * 8;
    qf[0] = *(const bf16x8*)(qp); qf[1] = *(const bf16x8*)(qp + 32);
  }
  AttnState st; st.m = -1e30f; st.l = 0.f;
#pragma unroll
  for (int dt = 0; dt < 4; ++dt) st.o[dt] = (f32x4){0.f, 0.f, 0.f, 0.f};
  __syncthreads();
  float scale;
  if (mode == 0) {
    attn_segment(proj, kcol, vcol, tq0 - 64, 1, 12, 64, slope, tq, lo, hi, qf, st, Vt, lane);
    attn_segment(proj, kcol, vcol, tq0 - 256, 4, 6, 256, slope, tq, lo, hi, qf, st, Vt, lane);
    attn_segment(proj, kcol, vcol, tq0 - 1024, 16, 5, 1024, slope, tq, lo, hi, qf, st, Vt, lane);
    float l = st.l; l += __shfl_xor(l, 16, 64); l += __shfl_xor(l, 32, 64);
    scale = 1.f / l;
  } else {
    attn_segment(proj, kcol, vcol, tq0 - 128, 1, 9, 128, slope, tq, lo, hi, qf, st, Vt, lane);
    float l = st.l; l += __shfl_xor(l, 16, 64); l += __shfl_xor(l, 32, 64);
    const float sink = p.attn_sink[layer * 4 + hq];
    const float mf = fmaxf(st.m, sink);
    const float sc = __expf(st.m - mf);
    scale = sc / (l * sc + __expf(sink - mf));
  }
#pragma unroll
  for (int dt = 0; dt < 4; ++dt) {
    uint2 o; o.x = pack2(st.o[dt][0] * scale, st.o[dt][1] * scale); o.y = pack2(st.o[dt][2] * scale, st.o[dt][3] * scale);
    *(uint2*)(proj + (size_t)tq * INW + qcol + dt * 16 + fq * 4) = o;
  }
}

DI void final_row(const Params& p, int t) {
  const int lane = my_tid() & 63;
  float* row = p.xout + (size_t)t * DM;
  float4 v[4]; float ss = 0.f;
#pragma unroll
  for (int i = 0; i < 4; ++i) {
    v[i] = *(const float4*)(row + i * 256 + lane * 4);
    ss += v[i].x * v[i].x + v[i].y * v[i].y + v[i].z * v[i].z + v[i].w * v[i].w;
  }
  ss = wave_sum(ss);
  const float rs = rsqrtf(ss * (1.f / DM) + EPS);
#pragma unroll
  for (int i = 0; i < 4; ++i) {
    const float4 g = *(const float4*)(p.final_norm + i * 256 + lane * 4);
    *(float4*)(row + i * 256 + lane * 4) = make_float4(v[i].x * rs * g.x, v[i].y * rs * g.y, v[i].z * rs * g.z, v[i].w * rs * g.w);
  }
}

enum { PH_NORM1 = 0, PH_INPROJ, PH_MIX1, PH_MIX2, PH_MIX3, PH_MERGE, PH_OUT, PH_NORM2, PH_FFN1, PH_FFN2, PH_PER_LAYER, PH_FINAL = 100 };

DI void run_phase(const Params& p, int ph, int layer, char* smem) {
  const int b = blockIdx.x, G = gridDim.x;
  const int wave = my_tid() >> 6;
  switch (ph) {
    case PH_NORM1: {
      if (layer == 0) {
        for (int t = b; t < 2 * CONV_TILES_LAYER; t += G) {
          ConvJob j;
          const int lt = conv_lookup(p, t, j);
          conv_tile(j, lt, (float*)smem);
        }
      }
      rms_phase(p, layer, p.norm1 + layer * DM, (u16*)(p.ws + OFF_H), b, G);
    } break;
    case PH_INPROJ: gemm_inproj(p, layer, b, G, (u16*)smem); break;
    case PH_MIX1: {
      for (int t = b; t < 4 * 3072; t += G) {
        const int kind = t / 3072, idx = t % 3072;
        if (kind == 0) gdn_pre(p, layer, idx, smem);
        else if (kind == 1) attn_task(p, layer, 0, idx, smem);
        else if (kind == 2) attn_task(p, layer, 1, idx, smem);
        else s5_pass1(p, layer, idx, smem);
      }
    } break;
    case PH_MIX2: {
      if (G > 72 + 8) {
        if (b < 72) gdn_scan(p, b, smem);
        else for (int t = b - 72; t < 3072; t += G - 72) s5_pass3(p, layer, t, smem);
      } else {
        for (int c = b; c < 72; c += G) gdn_scan(p, c, smem);
        for (int t = b; t < 3072; t += G) s5_pass3(p, layer, t, smem);
      }
    } break;
    case PH_MIX3: {
      gemm_glu(p, layer, b, G, (u16*)smem);
      for (int t = b * 4 + wave; t < T; t += G * 4) gdn_post_row(p, layer, t);
      rms_phase(p, layer, p.norm1 + layer * DM, (u16*)(p.ws + OFF_H), b, G);
    } break;
    case PH_MERGE: gemm_merge(p, layer, b, G, (u16*)smem); break;
    case PH_OUT:
      gemm_resid(p, layer, (const u16*)(p.ws + OFF_MERGED), DM, (const u16*)(p.ws + OFF_W) + layer * W_LAYER + WO_OUT, b, G, (u16*)smem);
      break;
    case PH_NORM2: rms_phase(p, 1, p.norm2 + layer * DM, (u16*)(p.ws + OFF_H2), b, G); break;
    case PH_FFN1: gemm_ffn1(p, layer, b, G, (u16*)smem); break;
    case PH_FFN2:
      gemm_resid(p, 1, (const u16*)(p.ws + OFF_ACT), FH, (const u16*)(p.ws + OFF_W) + layer * W_LAYER + WO_DN, b, G, (u16*)smem);
      break;
    case PH_FINAL:
      for (int t = b * 4 + wave; t < T; t += G * 4) final_row(p, t);
      break;
    default: break;
  }
}

#if !MEGA
__global__ void __launch_bounds__(256, 2) k_phase(Params p, int ph, int layer) {
  __shared__ __attribute__((aligned(16))) char smem[SMEM_BYTES];
  run_phase(p, ph, layer, smem);
}

#else
__global__ void __launch_bounds__(256, 2) k_mega(Params p) {
  __shared__ __attribute__((aligned(16))) char smem[SMEM_BYTES];
  cg::grid_group grid = cg::this_grid();
  for (int layer = 0; layer < 2; ++layer)
    for (int ph = 0; ph < PH_PER_LAYER; ++ph) {
      run_phase(p, ph, layer, smem);
      grid.sync();
    }
  run_phase(p, PH_FINAL, 0, smem);
}
#endif

extern "C" void kernel_launch(void* const* d_in, const int* in_sizes, int n_in, void* d_out, int out_size, void* d_ws,
                              size_t ws_size, hipStream_t stream) {
  (void)in_sizes; (void)n_in; (void)out_size;
  if (ws_size < WS_NEED) { fprintf(stderr, "workspace too small: %zu < %zu\n", ws_size, (size_t)WS_NEED); return; }
  Params p;
  memset(&p, 0, sizeof(p));
  const float* const* in = (const float* const*)d_in;
  p.x_prompt = in[0]; p.x_sample = in[1]; p.norm1 = in[2]; p.conv_a = in[4]; p.a_log = in[5]; p.dt_bias = in[6];
  p.a_norm = in[7]; p.lam_re = in[8]; p.lam_im = in[9]; p.log_step = in[10]; p.b_re = in[11]; p.b_im = in[12];
  p.c_re = in[13]; p.c_im = in[14]; p.s5_d = in[15]; p.attn_sink = in[17]; p.norm2 = in[21]; p.final_norm = in[25];
  p.xout = (float*)d_out;
  p.ws = (char*)d_ws;
  p.w_in = in[3]; p.w_glu = in[16]; p.w_gate = in[18]; p.w_branch = in[19]; p.w_out = in[20];
  p.w_ffn_gate = in[22]; p.w_ffn_up = in[23]; p.w_ffn_down = in[24];
  static int grid_blocks = 0;
  if (!grid_blocks) {
    int dev = 0, cus = 0, per_cu = 0;
    hipGetDevice(&dev);
    hipDeviceGetAttribute(&cus, hipDeviceAttributeMultiprocessorCount, dev);
#if MEGA
    hipOccupancyMaxActiveBlocksPerMultiprocessor(&per_cu, k_mega, 256, 0);
#else
    hipOccupancyMaxActiveBlocksPerMultiprocessor(&per_cu, k_phase, 256, 0);
#endif
    if (per_cu < 1) per_cu = 1;
    if (per_cu > 2) per_cu = 2;
    grid_blocks = cus * per_cu;
  }
#if MEGA
  void* args[] = {&p};
  hipError_t e = hipLaunchCooperativeKernel((void*)k_mega, dim3(grid_blocks), dim3(256), args, 0, stream);
  if (e != hipSuccess) fprintf(stderr, "cooperative launch failed: %s (grid %d)\n", hipGetErrorString(e), grid_blocks);
#else
  for (int layer = 0; layer < 2; ++layer)
    for (int ph = 0; ph < PH_PER_LAYER; ++ph) hipLaunchKernelGGL(k_phase, dim3(grid_blocks), dim3(256), 0, stream, p, ph, layer);
  hipLaunchKernelGGL(k_phase, dim3(grid_blocks), dim3(256), 0, stream, p, (int)PH_FINAL, 0);
#endif
}
```

```cpp
#include <hip/hip_runtime.h>
#include <hip/hip_cooperative_groups.h>
#include <cstdio>
#include <cstring>
namespace cg = cooperative_groups;

#ifndef MEGA
#define MEGA 1
#endif

#define DI __device__ __forceinline__
typedef unsigned short u16;
typedef __attribute__((ext_vector_type(8))) short bf16x8;
typedef __attribute__((ext_vector_type(4))) float f32x4;

constexpr int T = 49152;
constexpr int TP = 16384;
constexpr int DM = 1024;
constexpr int INW = 2576;
constexpr int FH = 2816;
constexpr int NCH64 = T / 64;
constexpr float EPS = 1e-6f;

constexpr int C_AQ = 0, C_AK = 256, C_AV = 512, C_AZ = 768, C_BQ = 1040, C_BK = 1296, C_BV = 1552, C_CU = 1808,
              C_DQ = 2064, C_DK = 2320, C_DV = 2448;

constexpr size_t WO_IN = 0, WO_GATE = 2752512, WO_BR = 6946816, WO_OUT = 7995392, WO_GU = 9043968, WO_DN = 14811136,
                 WO_GLU = 17694720, W_LAYER = 17825792;
constexpr size_t OFF_W = 0;
constexpr size_t OFF_PROJ = 2 * W_LAYER * 2;
constexpr size_t SZ_PROJ = (size_t)T * INW * 2;
constexpr size_t OFF_R1 = OFF_PROJ + SZ_PROJ;
constexpr size_t SZ_H = (size_t)T * DM * 2;
constexpr size_t OFF_H = OFF_R1;
constexpr size_t OFF_UW = OFF_R1;
constexpr size_t OFF_QN = OFF_R1 + SZ_H;
constexpr size_t OFF_KN = OFF_QN + (size_t)T * 256 * 2;
constexpr size_t OFF_GC = OFF_KN + (size_t)T * 256 * 2;
constexpr size_t OFF_SEND = OFF_GC + (size_t)NCH64 * 8 * 64 * 4;
constexpr size_t OFF_G = OFF_SEND + (size_t)NCH64 * 2 * 1024 * 8;
constexpr size_t OFF_AB = OFF_G + (size_t)T * 256 * 2;
constexpr size_t OFF_MERGED = OFF_R1 + SZ_H;
constexpr size_t OFF_H2 = OFF_MERGED;
constexpr size_t OFF_ACT = OFF_PROJ;
constexpr size_t WS_NEED = OFF_MERGED + SZ_H;

constexpr int SMEM_BYTES = 75776;

struct ConvJob { const float* src; u16* dst; int K, ncols, nrows_dst, src_ld, rs, off, ntn; };
struct Params {
  const float *x_prompt, *x_sample, *norm1, *conv_a, *a_log, *dt_bias, *a_norm, *lam_re, *lam_im, *log_step, *b_re,
      *b_im, *c_re, *c_im, *s5_d, *attn_sink, *norm2, *final_norm;
  const float *w_in, *w_gate, *w_branch, *w_out, *w_ffn_gate, *w_ffn_up, *w_ffn_down, *w_glu;
  float* xout;
  char* ws;
};
constexpr int CONV_TILES_LAYER = 4352;

DI int my_tid() { int t = threadIdx.x; asm volatile("" : "+v"(t)); return t; }
DI u16 f2bf(float x) { unsigned u = __float_as_uint(x); u += 0x7fffu + ((u >> 16) & 1u); return (u16)(u >> 16); }
DI float bf2f(u16 v) { return __uint_as_float(((unsigned)v) << 16); }
DI unsigned pack2(float a, float b) { return (unsigned)f2bf(a) | ((unsigned)f2bf(b) << 16); }
DI float sigmoidf_(float x) { return 1.f / (1.f + __expf(-x)); }
DI float siluf_(float x) { return x / (1.f + __expf(-x)); }
DI float wave_sum(float v) {
#pragma unroll
  for (int o = 32; o > 0; o >>= 1) v += __shfl_xor(v, o, 64);
  return v;
}
DI int seq_lo(int t) { return t < TP ? 0 : (t & ~4095); }
DI int seq_hi(int t) { return t < TP ? TP : (t & ~4095) + 4096; }
DI const float* xrow(const Params& p, int layer, int t) {
  if (layer == 0) return t < TP ? p.x_prompt + (size_t)t * DM : p.x_sample + (size_t)(t - TP) * DM;
  return p.xout + (size_t)t * DM;
}
DI f32x4 mfma16(bf16x8 a, bf16x8 b, f32x4 c) { return __builtin_amdgcn_mfma_f32_16x16x32_bf16(a, b, c, 0, 0, 0); }

DI void mk_job(ConvJob& j, const float* src, u16* dst, int K, int ncols, int nrows_dst, int src_ld, int rs, int off) {
  j.src = src; j.dst = dst; j.K = K; j.ncols = ncols; j.nrows_dst = nrows_dst; j.src_ld = src_ld; j.rs = rs; j.off = off;
  j.ntn = (nrows_dst + 63) >> 6;
}
DI int conv_lookup(const Params& p, int t, ConvJob& j) {
  const int l = t / CONV_TILES_LAYER;
  int r = t % CONV_TILES_LAYER;
  u16* wl = (u16*)(p.ws + OFF_W) + (size_t)l * W_LAYER;
  if (r < 672) { mk_job(j, p.w_in + (size_t)l * DM * INW, wl + WO_IN, DM, INW, 2688, INW, 32, 0); return r; }
  r -= 672;
  if (r < 1024) { const int i = r >> 8; mk_job(j, p.w_gate + (size_t)(l * 4 + i) * DM * DM, wl + WO_GATE + (size_t)i * DM * DM, DM, DM, DM, DM, 32, 0); return r & 255; }
  r -= 1024;
  if (r < 256) { const int i = r >> 6; mk_job(j, p.w_branch + (size_t)(l * 4 + i) * 256 * DM, wl + WO_BR + (size_t)i * DM * 256, 256, DM, DM, DM, 32, 0); return r & 63; }
  r -= 256;
  if (r < 256) { mk_job(j, p.w_out + (size_t)l * DM * DM, wl + WO_OUT, DM, DM, DM, DM, 32, 0); return r; }
  r -= 256;
  if (r < 704) { mk_job(j, p.w_ffn_gate + (size_t)l * DM * FH, wl + WO_GU, DM, FH, FH, FH, 64, 0); return r; }
  r -= 704;
  if (r < 704) { mk_job(j, p.w_ffn_up + (size_t)l * DM * FH, wl + WO_GU, DM, FH, FH, FH, 64, 32); return r; }
  r -= 704;
  if (r < 704) { mk_job(j, p.w_ffn_down + (size_t)l * FH * DM, wl + WO_DN, FH, DM, DM, DM, 32, 0); return r; }
  r -= 704;
  if (r < 16) { mk_job(j, p.w_glu + (size_t)l * 256 * 512, wl + WO_GLU, 256, 256, 256, 512, 64, 0); return r; }
  r -= 16;
  mk_job(j, p.w_glu + (size_t)l * 256 * 512 + 256, wl + WO_GLU, 256, 256, 256, 512, 64, 32);
  return r;
}
DI void conv_tile(const ConvJob& j, int lt, float* tile) {
  const int tid = my_tid();
  const int tk = lt / j.ntn, tn = lt % j.ntn;
  __syncthreads();
#pragma unroll
  for (int i = 0; i < 4; ++i) {
    int r = (tid >> 4) + 16 * i, c4 = (tid & 15) * 4, n = tn * 64 + c4;
    float4 v = make_float4(0.f, 0.f, 0.f, 0.f);
    if (n < j.ncols) v = *(const float4*)(j.src + (size_t)(tk * 64 + r) * j.src_ld + n);
    tile[r * 65 + c4 + 0] = v.x; tile[r * 65 + c4 + 1] = v.y; tile[r * 65 + c4 + 2] = v.z; tile[r * 65 + c4 + 3] = v.w;
  }
  __syncthreads();
  const int cl = tid >> 2, ks = (tid & 3) * 16, n = tn * 64 + cl;
  if (n < j.nrows_dst) {
    unsigned w[8];
#pragma unroll
    for (int e = 0; e < 8; ++e) w[e] = pack2(tile[(ks + 2 * e) * 65 + cl], tile[(ks + 2 * e + 1) * 65 + cl]);
    const int nm = (n >> 5) * j.rs + (n & 31) + j.off;
    uint4* d = (uint4*)(j.dst + (size_t)nm * j.K + tk * 64 + ks);
    d[0] = make_uint4(w[0], w[1], w[2], w[3]);
    d[1] = make_uint4(w[4], w[5], w[6], w[7]);
  }
}

DI void rms_row_bf16(const float* src, const float* w, u16* dst) {
  const int lane = my_tid() & 63;
  float4 v[4];
  float ss = 0.f;
#pragma unroll
  for (int i = 0; i < 4; ++i) {
    v[i] = *(const float4*)(src + i * 256 + lane * 4);
    ss += v[i].x * v[i].x + v[i].y * v[i].y + v[i].z * v[i].z + v[i].w * v[i].w;
  }
  ss = wave_sum(ss);
  const float rs = rsqrtf(ss * (1.f / DM) + EPS);
#pragma unroll
  for (int i = 0; i < 4; ++i) {
    float4 g = *(const float4*)(w + i * 256 + lane * 4);
    uint2 o;
    o.x = pack2(v[i].x * rs * g.x, v[i].y * rs * g.y);
    o.y = pack2(v[i].z * rs * g.z, v[i].w * rs * g.w);
    *(uint2*)(dst + i * 256 + lane * 4) = o;
  }
}
DI void rms_phase(const Params& p, int layer, const float* w, u16* dst, int b0, int nb) {
  const int wave = my_tid() >> 6;
  for (int r = b0 * 4 + wave; r < T; r += nb * 4) rms_row_bf16(xrow(p, layer, r), w, dst + (size_t)r * DM);
}

constexpr int GP = 64;
template <int NT>
DI void gemm_kloop(const u16* __restrict__ A, size_t lda, const u16* __restrict__ B, size_t ldb, int nk,
                   f32x4 (&acc)[4][NT], u16* sm) {
  const int tid = my_tid(), lane = tid & 63, wave = tid >> 6;
  const int fr = lane & 15, fq = lane >> 4, wr = wave >> 1, wc = wave & 1;
  u16* sa = sm;
  u16* sb = sm + 2 * 128 * GP;
  uint4 ra0, ra1, ra2, ra3, rb0, rb1, rb2 = make_uint4(0, 0, 0, 0), rb3 = make_uint4(0, 0, 0, 0);
  uint4 rc0, rc1, rc2, rc3, rd0, rd1, rd2 = make_uint4(0, 0, 0, 0), rd3 = make_uint4(0, 0, 0, 0);
  const int lrow = tid >> 3, lseg = (tid & 7) * 8;
  const int sseg = ((tid & 7) ^ ((lrow >> 1) & 7)) * 8;
  const u16* Ap = A + (size_t)lrow * lda + lseg;
  const u16* Bp = B + (size_t)lrow * ldb + lseg;
#define KL_LOAD(KOFF, A0, A1, A2, A3, B0, B1, B2, B3)                    \
  A0 = *(const uint4*)(Ap + (KOFF));                                     \
  A1 = *(const uint4*)(Ap + 32 * lda + (KOFF));                          \
  A2 = *(const uint4*)(Ap + 64 * lda + (KOFF));                          \
  A3 = *(const uint4*)(Ap + 96 * lda + (KOFF));                          \
  B0 = *(const uint4*)(Bp + (KOFF));                                     \
  B1 = *(const uint4*)(Bp + 32 * ldb + (KOFF));                          \
  if (NT > 2) { B2 = *(const uint4*)(Bp + 64 * ldb + (KOFF)); B3 = *(const uint4*)(Bp + 96 * ldb + (KOFF)); }
#define KL_STORE(SA, SB, A0, A1, A2, A3, B0, B1, B2, B3)                 \
  *(uint4*)((SA) + (lrow + 0) * GP + sseg) = A0;                         \
  *(uint4*)((SA) + (lrow + 32) * GP + sseg) = A1;                        \
  *(uint4*)((SA) + (lrow + 64) * GP + sseg) = A2;                        \
  *(uint4*)((SA) + (lrow + 96) * GP + sseg) = A3;                        \
  *(uint4*)((SB) + (lrow + 0) * GP + sseg) = B0;                         \
  *(uint4*)((SB) + (lrow + 32) * GP + sseg) = B1;                        \
  if (NT > 2) { *(uint4*)((SB) + (lrow + 64) * GP + sseg) = B2; *(uint4*)((SB) + (lrow + 96) * GP + sseg) = B3; }
#define KL_COMPUTE(CA, CB)                                                                                     \
  _Pragma("unroll") for (int kk = 0; kk < 2; ++kk) {                                                           \
    bf16x8 wf[NT], xf[4];                                                                                      \
    _Pragma("unroll") for (int nt = 0; nt < NT; ++nt)                                                          \
      wf[nt] = *(const bf16x8*)((CB) + (wc * NT * 16 + nt * 16 + fr) * GP + (((kk * 4 + fq) ^ swz) * 8));       \
    _Pragma("unroll") for (int mt = 0; mt < 4; ++mt)                                                           \
      xf[mt] = *(const bf16x8*)((CA) + (wr * 64 + mt * 16 + fr) * GP + (((kk * 4 + fq) ^ swz) * 8));            \
    _Pragma("unroll") for (int mt = 0; mt < 4; ++mt)                                                           \
    _Pragma("unroll") for (int nt = 0; nt < NT; ++nt) acc[mt][nt] = mfma16(wf[nt], xf[mt], acc[mt][nt]);      \
  }
  const int swz = (fr >> 1) & 7;
  KL_LOAD(0, ra0, ra1, ra2, ra3, rb0, rb1, rb2, rb3)
  KL_LOAD(64, rc0, rc1, rc2, rc3, rd0, rd1, rd2, rd3)
  KL_STORE(sa, sb, ra0, ra1, ra2, ra3, rb0, rb1, rb2, rb3)
  __syncthreads();
  u16* sa1 = sa + 128 * GP;
  u16* sb1 = sb + 128 * GP;
#pragma unroll 1
  for (int kt = 0; kt < nk; kt += 2) {
    const int k2 = (kt + 2 < nk ? kt + 2 : kt) * 64, k3 = (kt + 3 < nk ? kt + 3 : kt + 1) * 64;
    KL_LOAD(k2, ra0, ra1, ra2, ra3, rb0, rb1, rb2, rb3)
    __builtin_amdgcn_sched_barrier(0);
    KL_COMPUTE(sa, sb)
    KL_STORE(sa1, sb1, rc0, rc1, rc2, rc3, rd0, rd1, rd2, rd3)
    __syncthreads();
    KL_LOAD(k3, rc0, rc1, rc2, rc3, rd0, rd1, rd2, rd3)
    __builtin_amdgcn_sched_barrier(0);
    KL_COMPUTE(sa1, sb1)
    KL_STORE(sa, sb, ra0, ra1, ra2, ra3, rb0, rb1, rb2, rb3)
    __syncthreads();
  }
}
template <int NT>
DI void zero_acc(f32x4 (&acc)[4][NT]) {
#pragma unroll
  for (int a = 0; a < 4; ++a)
#pragma unroll
    for (int b = 0; b < NT; ++b) acc[a][b] = (f32x4){0.f, 0.f, 0.f, 0.f};
}

struct TileIter {
  int step, nsteps, nrb, nct, x, li, lj, mode, idx, stride, L;
  DI void init(int nrt, int nct_, int b, int G) {
    nct = nct_;
    if (G == 512 && (nrt % 64) == 0) {
      mode = 1; x = b & 7;
      const int local = b >> 3;
      li = local >> 3; lj = local & 7;
      nrb = nrt / 64;
      nsteps = nrb * ((nct + 7) >> 3);
      step = 0;
      skip();
    } else {
      mode = 0; idx = b; stride = G; L = nrt * nct;
    }
  }
  DI int ctile() const { return (step / nrb) * 8 + lj; }
  DI void skip() { while (step < nsteps && ctile() >= nct) ++step; }
  DI bool valid() const { return mode ? step < nsteps : idx < L; }
  DI int rt() const { return mode ? x + 8 * ((step % nrb) * 8 + li) : idx / nct; }
  DI int ct() const { return mode ? ctile() : idx % nct; }
  DI void next() { if (mode) { ++step; skip(); } else idx += stride; }
};

#define EPI_COORDS                                                       \
  const int lane = my_tid() & 63, wave = my_tid() >> 6;           \
  const int fr = lane & 15, fq = lane >> 4, wr = wave >> 1, wc = wave & 1; \
  (void)fr; (void)fq; (void)wr; (void)wc;

DI void gemm_inproj(const Params& p, int layer, int b, int G, u16* sm) {
  const u16* H = (const u16*)(p.ws + OFF_H);
  const u16* W = (const u16*)(p.ws + OFF_W) + layer * W_LAYER + WO_IN;
  u16* proj = (u16*)(p.ws + OFF_PROJ);
  float* AB = (float*)(p.ws + OFF_AB);
  EPI_COORDS
  TileIter it; it.init(T / 128, 21, b, G);
  for (; it.valid(); it.next()) {
    const int row0 = it.rt() * 128, col0 = it.ct() * 128;
    f32x4 acc[4][4]; zero_acc<4>(acc);
    gemm_kloop<4>(H + (size_t)row0 * DM, DM, W + (size_t)col0 * DM, DM, 16, acc, sm);
#pragma unroll
    for (int mt = 0; mt < 4; ++mt) {
      const int row = row0 + wr * 64 + mt * 16 + fr;
#pragma unroll
      for (int nt = 0; nt < 4; ++nt) {
        const int col = col0 + wc * 64 + nt * 16 + fq * 4;
        if (col < INW) {
          uint2 o; o.x = pack2(acc[mt][nt][0], acc[mt][nt][1]); o.y = pack2(acc[mt][nt][2], acc[mt][nt][3]);
          *(uint2*)(proj + (size_t)row * INW + col) = o;
          if (col >= 1024 && col < 1040)
            *(float4*)(AB + (size_t)row * 16 + (col - 1024)) = make_float4(acc[mt][nt][0], acc[mt][nt][1], acc[mt][nt][2], acc[mt][nt][3]);
        }
      }
    }
  }
}

DI void gemm_glu(const Params& p, int layer, int b, int G, u16* sm) {
  const u16* Gb = (const u16*)(p.ws + OFF_G);
  const u16* W = (const u16*)(p.ws + OFF_W) + layer * W_LAYER + WO_GLU;
  u16* proj = (u16*)(p.ws + OFF_PROJ);
  EPI_COORDS
  TileIter it; it.init(T / 128, 4, b, G);
  for (; it.valid(); it.next()) {
    const int row0 = it.rt() * 128, ct = it.ct();
    f32x4 acc[4][4]; zero_acc<4>(acc);
    gemm_kloop<4>(Gb + (size_t)row0 * 256, 256, W + (size_t)ct * 128 * 256, 256, 4, acc, sm);
#pragma unroll
    for (int mt = 0; mt < 4; ++mt) {
      const int row = row0 + wr * 64 + mt * 16 + fr;
#pragma unroll
      for (int nt = 0; nt < 2; ++nt) {
        const int col = (ct * 2 + wc) * 32 + nt * 16 + fq * 4;
        float o[4];
#pragma unroll
        for (int j = 0; j < 4; ++j) o[j] = acc[mt][nt][j] * sigmoidf_(acc[mt][nt + 2][j]);
        uint2 ov; ov.x = pack2(o[0], o[1]); ov.y = pack2(o[2], o[3]);
        *(uint2*)(proj + (size_t)row * INW + C_CU + col) = ov;
      }
    }
  }
}

DI void gemm_merge(const Params& p, int layer, int b, int G, u16* sm) {
  const u16* H = (const u16*)(p.ws + OFF_H);
  const u16* Wg = (const u16*)(p.ws + OFF_W) + layer * W_LAYER + WO_GATE;
  const u16* Wb = (const u16*)(p.ws + OFF_W) + layer * W_LAYER + WO_BR;
  const u16* proj = (const u16*)(p.ws + OFF_PROJ);
  u16* merged = (u16*)(p.ws + OFF_MERGED);
  EPI_COORDS
  TileIter it; it.init(T / 128, 16, b, G);
  for (; it.valid(); it.next()) {
    const int row0 = it.rt() * 128, col0 = it.ct() * 64;
    f32x4 mg[4][2]; zero_acc<2>(mg);
#pragma unroll 1
    for (int i = 0; i < 4; ++i) {
      const int ocol = (i == 0) ? C_AZ : (i == 1) ? C_BQ : (i == 2) ? C_CU : C_DQ;
      f32x4 acc[4][2]; zero_acc<2>(acc);
      gemm_kloop<2>(H + (size_t)row0 * DM, DM, Wg + (size_t)i * DM * DM + (size_t)col0 * DM, DM, 16, acc, sm);
      f32x4 sg[4][2];
#pragma unroll
      for (int a = 0; a < 4; ++a)
#pragma unroll
        for (int c = 0; c < 2; ++c)
#pragma unroll
          for (int j = 0; j < 4; ++j) sg[a][c][j] = sigmoidf_(acc[a][c][j]);
      zero_acc<2>(acc);
      gemm_kloop<2>(proj + (size_t)row0 * INW + ocol, INW, Wb + (size_t)i * DM * 256 + (size_t)col0 * 256, 256, 4, acc, sm);
#pragma unroll
      for (int a = 0; a < 4; ++a)
#pragma unroll
        for (int c = 0; c < 2; ++c)
#pragma unroll
          for (int j = 0; j < 4; ++j) mg[a][c][j] += sg[a][c][j] * acc[a][c][j];
    }
#pragma unroll
    for (int mt = 0; mt < 4; ++mt) {
      const int row = row0 + wr * 64 + mt * 16 + fr;
#pragma unroll
      for (int nt = 0; nt < 2; ++nt) {
        const int col = col0 + wc * 32 + nt * 16 + fq * 4;
        uint2 o; o.x = pack2(mg[mt][nt][0], mg[mt][nt][1]); o.y = pack2(mg[mt][nt][2], mg[mt][nt][3]);
        *(uint2*)(merged + (size_t)row * DM + col) = o;
      }
    }
  }
}

DI void gemm_resid(const Params& p, int layer_src, const u16* A, int K, const u16* W, int b, int G, u16* sm) {
  EPI_COORDS
  TileIter it; it.init(T / 128, 8, b, G);
  for (; it.valid(); it.next()) {
    const int row0 = it.rt() * 128, col0 = it.ct() * 128;
    f32x4 acc[4][4]; zero_acc<4>(acc);
    gemm_kloop<4>(A + (size_t)row0 * K, K, W + (size_t)col0 * K, K, K / 64, acc, sm);
#pragma unroll
    for (int mt = 0; mt < 4; ++mt) {
      const int row = row0 + wr * 64 + mt * 16 + fr;
      const float* xs = xrow(p, layer_src, row);
      float* xd = p.xout + (size_t)row * DM;
#pragma unroll
      for (int nt = 0; nt < 4; ++nt) {
        const int col = col0 + wc * 64 + nt * 16 + fq * 4;
        float4 r = *(const float4*)(xs + col);
        r.x += acc[mt][nt][0]; r.y += acc[mt][nt][1]; r.z += acc[mt][nt][2]; r.w += acc[mt][nt][3];
        *(float4*)(xd + col) = r;
      }
    }
  }
}

DI void gemm_ffn1(const Params& p, int layer, int b, int G, u16* sm) {
  const u16* H = (const u16*)(p.ws + OFF_H2);
  const u16* W = (const u16*)(p.ws + OFF_W) + layer * W_LAYER + WO_GU;
  u16* act = (u16*)(p.ws + OFF_ACT);
  EPI_COORDS
  TileIter it; it.init(T / 128, 44, b, G);
  for (; it.valid(); it.next()) {
    const int row0 = it.rt() * 128, ct = it.ct();
    f32x4 acc[4][4]; zero_acc<4>(acc);
    gemm_kloop<4>(H + (size_t)row0 * DM, DM, W + (size_t)ct * 128 * DM, DM, 16, acc, sm);
#pragma unroll
    for (int mt = 0; mt < 4; ++mt) {
      const int row = row0 + wr * 64 + mt * 16 + fr;
#pragma unroll
      for (int nt = 0; nt < 2; ++nt) {
        const int col = (ct * 2 + wc) * 32 + nt * 16 + fq * 4;
        float o[4];
#pragma unroll
        for (int j = 0; j < 4; ++j) o[j] = siluf_(acc[mt][nt][j]) * acc[mt][nt + 2][j];
        uint2 ov; ov.x = pack2(o[0], o[1]); ov.y = pack2(o[2], o[3]);
        *(uint2*)(act + (size_t)row * FH + col) = ov;
      }
    }
  }
}

DI void gdn_pre(const Params& p, int layer, int task, char* smem) {
  const int tid = my_tid(), lane = tid & 63, wave = tid >> 6;
  const int n = task >> 2, h = task & 3, c0 = n * 64;
  const int lo = seq_lo(c0), hi = seq_hi(c0);
  float* ks = (float*)smem;
  float* vs = ks + 64 * 65;
  float* AmT = vs + 64 * 65;
  float* gcs = AmT + 2 * 64 * 64;
  float* bts = gcs + 128;
  const u16* proj = (const u16*)(p.ws + OFF_PROJ);
  u16* QN = (u16*)(p.ws + OFF_QN);
  u16* KN = (u16*)(p.ws + OFF_KN);
  float* GC = (float*)(p.ws + OFF_GC);
  const float* AB = (const float*)(p.ws + OFF_AB);
  u16* UW = (u16*)(p.ws + OFF_UW);
  __syncthreads();
#pragma unroll 1
  for (int mat = 0; mat < 3; ++mat) {
    const int ch = mat * 256 + h * 64 + lane;
    float w[5];
#pragma unroll
    for (int j = 0; j < 5; ++j) w[j] = p.conv_a[(size_t)(layer * 5 + j) * 768 + ch];
    float raw[20];
#pragma unroll
    for (int i = 0; i < 20; ++i) {
      const int tok = c0 + wave * 16 + i - 2;
      raw[i] = (tok >= lo && tok < hi) ? bf2f(proj[(size_t)tok * INW + ch]) : 0.f;
    }
#pragma unroll
    for (int i = 0; i < 16; ++i) {
      float v = 0.f;
#pragma unroll
      for (int j = 0; j < 5; ++j) v += raw[i + j] * w[j];
      v = siluf_(v);
      const int tl = wave * 16 + i;
      if (mat < 2) {
        const float ss = wave_sum(v * v);
        v *= rsqrtf(ss + EPS) * (mat == 0 ? 0.125f : 1.f);
      }
      if (mat == 0) QN[(size_t)(c0 + tl) * 256 + h * 64 + lane] = f2bf(v);
      else if (mat == 1) { KN[(size_t)(c0 + tl) * 256 + h * 64 + lane] = f2bf(v); ks[tl * 65 + lane] = v; }
      else vs[tl * 65 + lane] = v;
    }
  }
  if (wave < 2) {
    const int d = wave;
    const int tok = c0 + (d ? 63 - lane : lane);
    const float al = AB[(size_t)tok * 16 + d * 4 + h];
    const float br = AB[(size_t)tok * 16 + 8 + d * 4 + h];
    const float xx = al + p.dt_bias[(layer * 2 + d) * 4 + h];
    const float sp = fmaxf(xx, 0.f) + log1pf(__expf(-fabsf(xx)));
    float g = -__expf(p.a_log[(layer * 2 + d) * 4 + h]) * sp;
#pragma unroll
    for (int o = 1; o < 64; o <<= 1) {
      const float t = __shfl_up(g, o, 64);
      if (lane >= o) g += t;
    }
    gcs[d * 64 + lane] = g;
    bts[d * 64 + lane] = sigmoidf_(br);
    GC[(size_t)(task * 2 + d) * 64 + lane] = g;
  }
  __syncthreads();
#pragma unroll 1
  for (int m = 0; m < 16; ++m) {
    const int a = wave + 4 * m, b = lane;
    float dot = 0.f;
#pragma unroll 16
    for (int dd = 0; dd < 64; ++dd) dot += ks[a * 65 + dd] * ks[b * 65 + dd];
    if (a > b) {
      AmT[b * 64 + a] = bts[a] * dot * __expf(gcs[a] - gcs[b]);
      const int i1 = 63 - b, j1 = 63 - a;
      AmT[4096 + j1 * 64 + i1] = bts[64 + i1] * dot * __expf(gcs[64 + i1] - gcs[64 + j1]);
    }
  }
  __syncthreads();
  {
    int d = tid >> 7, c = tid & 127;
    asm volatile("" : "+v"(d), "+v"(c));
    float r[64];
    {
      const int stride = d ? -65 : 65;
      int off = (d ? 63 * 65 : 0) + (c & 63);
      const float* srcm = (c < 64) ? vs : ks;
      const bool isw = c >= 64;
#pragma unroll
      for (int i = 0; i < 64; ++i) {
        float v = srcm[off] * bts[d * 64 + i];
        if (isw) v *= __expf(gcs[d * 64 + i]);
        r[i] = v;
        off += stride;
        asm volatile("" : "+v"(off));
        if ((i & 7) == 7) __builtin_amdgcn_sched_barrier(0);
      }
    }
    const float* Ad = AmT + d * 4096;
#pragma unroll
    for (int j = 0; j < 63; ++j) {
      const float rj = r[j];
#pragma unroll
      for (int i = j + 1; i < 64; ++i) {
        r[i] = fmaf(-Ad[j * 64 + i], rj, r[i]);
        if ((i & 15) == 15) __builtin_amdgcn_sched_barrier(0);
      }
      __builtin_amdgcn_sched_barrier(0);
    }
    u16* base = UW + (size_t)(task * 2 + d) * 8192;
    if (c < 64) {
      uint4* dst = (uint4*)(base + c * 64);
#pragma unroll
      for (int q = 0; q < 8; ++q)
        dst[q] = make_uint4(pack2(r[8 * q], r[8 * q + 1]), pack2(r[8 * q + 2], r[8 * q + 3]), pack2(r[8 * q + 4], r[8 * q + 5]),
                            pack2(r[8 * q + 6], r[8 * q + 7]));
    } else {
      u16* dst = base + 4096 + (c - 64);
#pragma unroll
      for (int i = 0; i < 64; ++i) dst[i * 64] = f2bf(r[i]);
    }
  }
}

DI f32x4 mma_t(const u16* X, int xr, const u16* Y, int yr, f32x4 acc, int fr, int fq) {
#pragma unroll
  for (int kk = 0; kk < 2; ++kk) {
    const bf16x8 x = *(const bf16x8*)(X + (xr + fr) * 72 + kk * 32 + fq * 8);
    const bf16x8 y = *(const bf16x8*)(Y + (yr + fr) * 72 + kk * 32 + fq * 8);
    acc = mfma16(x, y, acc);
  }
  return acc;
}
DI f32x4 mma_t_swz(const u16* X, int xr, const u16* Y, int yr, f32x4 acc, int fr, int fq) {
  const int sw = ((xr + fr) >> 3) & 7;
#pragma unroll
  for (int kk = 0; kk < 2; ++kk) {
    const bf16x8 x = *(const bf16x8*)(X + (xr + fr) * 72 + (((kk * 4 + fq) ^ sw) * 8));
    const bf16x8 y = *(const bf16x8*)(Y + (yr + fr) * 72 + kk * 32 + fq * 8);
    acc = mfma16(x, y, acc);
  }
  return acc;
}

DI void gdn_scan(const Params& p, int item, char* smem) {
  const int tid = my_tid(), lane = tid & 63, w = tid >> 6;
  const int fr = lane & 15, fq = lane >> 4;
  const int chain = item >> 1, eh = item & 1;
  const int s = chain >> 3, h = (chain >> 1) & 3, d = chain & 1;
  const int sb = s == 0 ? 0 : TP + (s - 1) * 4096;
  const int nch = s == 0 ? 256 : 64;
  u16* St = (u16*)smem;
  u16* Vt = St + 32 * 72;
  u16* Vts = Vt + 32 * 72;
  u16* Wc = Vts + 32 * 72;
  u16* Qc = Wc + 64 * 72;
  u16* Kc = Qc + 64 * 72;
  u16* KcT = Kc + 64 * 72;
  u16* QKm = KcT + 64 * 72;
  float* gcs = (float*)(QKm + 64 * 72);
  u16* proj = (u16*)(p.ws + OFF_PROJ);
  const u16* QN = (const u16*)(p.ws + OFF_QN);
  const u16* KN = (const u16*)(p.ws + OFF_KN);
  const float* GC = (const float*)(p.ws + OFF_GC);
  const u16* UW = (const u16*)(p.ws + OFF_UW);
  __syncthreads();
  for (int i = tid; i < 32 * 72; i += 256) St[i] = 0;
  f32x4 S0 = (f32x4){0.f, 0.f, 0.f, 0.f}, S1 = S0;
  uint4 pw0, pw1, pq0, pq1, pk0, pk1;
  uint2 pu0, pu1;
  float pg = 0.f;
  const int prow0 = tid >> 3, prow1 = (tid >> 3) + 32, pseg = (tid & 7) * 8;
#define GDN_PREFETCH(J)                                                                              \
  {                                                                                                  \
    const int n_ = sb / 64 + (d ? nch - 1 - (J) : (J));                                              \
    const int c0_ = n_ * 64;                                                                         \
    const size_t tb_ = (size_t)((n_ * 4 + h) * 2 + d);                                               \
    const u16* ub_ = UW + tb_ * 8192;                                                                \
    const int tok0_ = c0_ + (d ? 63 - prow0 : prow0), tok1_ = c0_ + (d ? 63 - prow1 : prow1);        \
    pw0 = *(const uint4*)(ub_ + 4096 + prow0 * 64 + pseg);                                           \
    pw1 = *(const uint4*)(ub_ + 4096 + prow1 * 64 + pseg);                                           \
    pq0 = *(const uint4*)(QN + (size_t)tok0_ * 256 + h * 64 + pseg);                                 \
    pq1 = *(const uint4*)(QN + (size_t)tok1_ * 256 + h * 64 + pseg);                                 \
    pk0 = *(const uint4*)(KN + (size_t)tok0_ * 256 + h * 64 + pseg);                                 \
    pk1 = *(const uint4*)(KN + (size_t)tok1_ * 256 + h * 64 + pseg);                                 \
    pu0 = *(const uint2*)(ub_ + (eh * 32 + fr) * 64 + w * 16 + fq * 4);                              \
    pu1 = *(const uint2*)(ub_ + (eh * 32 + 16 + fr) * 64 + w * 16 + fq * 4);                         \
    if (tid < 64) pg = GC[tb_ * 64 + tid];                                                           \
  }
  GDN_PREFETCH(0)
  for (int j = 0; j < nch; ++j) {
    const int n = sb / 64 + (d ? nch - 1 - j : j);
    const int c0 = n * 64;
#define GDN_STAGE(ROW, PW, PQ, PK)                                                                   \
    {                                                                                                \
      *(uint4*)(Wc + (ROW) * 72 + pseg) = PW;                                                        \
      *(uint4*)(Qc + (ROW) * 72 + pseg) = PQ;                                                        \
      *(uint4*)(Kc + (ROW) * 72 + pseg) = PK;                                                        \
      u16* kt_ = KcT + pseg * 72 + ((((ROW) >> 3) ^ (tid & 7)) * 8) + ((ROW) & 7);                   \
      kt_[0 * 72] = (u16)(PK.x & 0xffff); kt_[1 * 72] = (u16)(PK.x >> 16);                           \
      kt_[2 * 72] = (u16)(PK.y & 0xffff); kt_[3 * 72] = (u16)(PK.y >> 16);                           \
      kt_[4 * 72] = (u16)(PK.z & 0xffff); kt_[5 * 72] = (u16)(PK.z >> 16);                           \
      kt_[6 * 72] = (u16)(PK.w & 0xffff); kt_[7 * 72] = (u16)(PK.w >> 16);                           \
    }
    GDN_STAGE(prow0, pw0, pq0, pk0)
    GDN_STAGE(prow1, pw1, pq1, pk1)
    if (tid < 64) gcs[tid] = pg;
    const uint2 cu0 = pu0, cu1 = pu1;
    __syncthreads();
    if (j + 1 < nch) GDN_PREFETCH(j + 1)
    const f32x4 z4 = (f32x4){0.f, 0.f, 0.f, 0.f};
    const f32x4 P1a = mma_t(Wc, w * 16, St, 0, z4, fr, fq);
    const f32x4 P1b = mma_t(Wc, w * 16, St, 16, z4, fr, fq);
    const f32x4 P2a = mma_t(St, 0, Qc, w * 16, z4, fr, fq);
    const f32x4 P2b = mma_t(St, 16, Qc, w * 16, z4, fr, fq);
    const float glog = gcs[63];
    {
      const int c = w * 16 + fr;
      const float gcc = gcs[c];
#pragma unroll
      for (int t = 0; t < 4; ++t) {
        const f32x4 qk = mma_t(Kc, t * 16, Qc, w * 16, z4, fr, fq);
        const int s0 = t * 16 + fq * 4;
        float v[4];
#pragma unroll
        for (int jj = 0; jj < 4; ++jj) v[jj] = (c >= s0 + jj) ? qk[jj] * __expf(gcc - gcs[s0 + jj]) : 0.f;
        uint2 o; o.x = pack2(v[0], v[1]); o.y = pack2(v[2], v[3]);
        *(uint2*)(QKm + c * 72 + s0) = o;
      }
    }
    {
      const int cc0 = w * 16 + fq * 4;
      float sc[4];
#pragma unroll
      for (int jj = 0; jj < 4; ++jj) sc[jj] = __expf(glog - gcs[cc0 + jj]);
#define GDN_VNEW(CU, P1, EROW)                                                                        \
      {                                                                                               \
        float uu[4], v[4];                                                                            \
        uu[0] = bf2f((u16)(CU.x & 0xffff)); uu[1] = bf2f((u16)(CU.x >> 16));                          \
        uu[2] = bf2f((u16)(CU.y & 0xffff)); uu[3] = bf2f((u16)(CU.y >> 16));                          \
        _Pragma("unroll") for (int jj = 0; jj < 4; ++jj) v[jj] = uu[jj] - P1[jj];                     \
        uint2 o; o.x = pack2(v[0], v[1]); o.y = pack2(v[2], v[3]);                                    \
        *(uint2*)(Vt + (EROW) * 72 + cc0) = o;                                                        \
        uint2 o2; o2.x = pack2(v[0] * sc[0], v[1] * sc[1]); o2.y = pack2(v[2] * sc[2], v[3] * sc[3]); \
        *(uint2*)(Vts + (EROW) * 72 + cc0) = o2;                                                      \
      }
      GDN_VNEW(cu0, P1a, fr)
      GDN_VNEW(cu1, P1b, 16 + fr)
    }
    __syncthreads();
    {
      const int c = w * 16 + fr;
      const float eg = __expf(gcs[c]);
      const int tok = c0 + (d ? 63 - c : c);
      u16* orow = proj + (size_t)tok * INW + d * 256 + h * 64 + eh * 32 + fq * 4;
      f32x4 oa = P2a * eg, ob = P2b * eg;
      oa = mma_t(Vt, 0, QKm, w * 16, oa, fr, fq);
      ob = mma_t(Vt, 16, QKm, w * 16, ob, fr, fq);
      uint2 o; o.x = pack2(oa[0], oa[1]); o.y = pack2(oa[2], oa[3]);
      *(uint2*)(orow) = o;
      uint2 o2; o2.x = pack2(ob[0], ob[1]); o2.y = pack2(ob[2], ob[3]);
      *(uint2*)(orow + 16) = o2;
    }
    {
      const float gl = __expf(glog);
      S0 *= gl; S1 *= gl;
      S0 = mma_t_swz(KcT, w * 16, Vts, 0, S0, fr, fq);
      S1 = mma_t_swz(KcT, w * 16, Vts, 16, S1, fr, fq);
      const int r0 = w * 16 + fq * 4;
      uint2 o; o.x = pack2(S0[0], S0[1]); o.y = pack2(S0[2], S0[3]);
      *(uint2*)(St + fr * 72 + r0) = o;
      uint2 o2; o2.x = pack2(S1[0], S1[1]); o2.y = pack2(S1[2], S1[3]);
      *(uint2*)(St + (16 + fr) * 72 + r0) = o2;
    }
    __syncthreads();
  }
}

DI void gdn_post_row(const Params& p, int layer, int t) {
  const int lane = my_tid() & 63;
  u16* row = (u16*)(p.ws + OFF_PROJ) + (size_t)t * INW;
  const uint2 f = *(const uint2*)(row + lane * 4);
  const uint2 bw = *(const uint2*)(row + 256 + lane * 4);
  const uint2 z = *(const uint2*)(row + C_AZ + lane * 4);
  float o[4], zz[4];
  o[0] = bf2f((u16)(f.x & 0xffff)) + bf2f((u16)(bw.x & 0xffff));
  o[1] = bf2f((u16)(f.x >> 16)) + bf2f((u16)(bw.x >> 16));
  o[2] = bf2f((u16)(f.y & 0xffff)) + bf2f((u16)(bw.y & 0xffff));
  o[3] = bf2f((u16)(f.y >> 16)) + bf2f((u16)(bw.y >> 16));
  zz[0] = bf2f((u16)(z.x & 0xffff)); zz[1] = bf2f((u16)(z.x >> 16)); zz[2] = bf2f((u16)(z.y & 0xffff)); zz[3] = bf2f((u16)(z.y >> 16));
  float ss = o[0] * o[0] + o[1] * o[1] + o[2] * o[2] + o[3] * o[3];
#pragma unroll
  for (int m = 1; m < 16; m <<= 1) ss += __shfl_xor(ss, m, 64);
  const float rs = rsqrtf(ss * (1.f / 64.f) + EPS);
  const int e0 = (lane & 15) * 4;
  float r[4];
#pragma unroll
  for (int j = 0; j < 4; ++j) r[j] = o[j] * rs * p.a_norm[layer * 64 + e0 + j] * siluf_(zz[j]);
  uint2 ov; ov.x = pack2(r[0], r[1]); ov.y = pack2(r[2], r[3]);
  *(uint2*)(row + C_AZ + lane * 4) = ov;
}

struct S5Const { float are, aim; float bpr[16], bpi[16]; };
DI void s5_consts(const Params& p, int layer, int d, int g, int lane, S5Const& k, float& lr, float& li, float& step) {
  const int gi = ((layer * 2 + d) * 16 + g);
  lr = p.lam_re[(size_t)gi * 64 + lane];
  li = p.lam_im[(size_t)gi * 64 + lane];
  step = expf(p.log_step[gi]);
  const float mag = expf(lr * step);
  float sn, cs; sincosf(li * step, &sn, &cs);
  k.are = mag * cs; k.aim = mag * sn;
  const float inv = 1.f / (lr * lr + li * li);
  const float ir = lr * inv, ii = -li * inv;
  const float cr = (k.are - 1.f) * ir - k.aim * ii;
  const float ci = (k.are - 1.f) * ii + k.aim * ir;
  const float* br = p.b_re + ((size_t)(layer * 16 + g) * 64 + lane) * 16;
  const float* bi = p.b_im + ((size_t)(layer * 16 + g) * 64 + lane) * 16;
#pragma unroll
  for (int c = 0; c < 16; ++c) {
    const float a = br[c], b = bi[c];
    k.bpr[c] = cr * a - ci * b;
    k.bpi[c] = cr * b + ci * a;
  }
}
DI void s5_stage_u(const Params& p, int c0, int gq, float* us) {
  const u16* proj = (const u16*)(p.ws + OFF_PROJ);
  const int tid = my_tid();
#pragma unroll
  for (int i = 0; i < 4; ++i) {
    const int idx = tid + 256 * i, tok = idx >> 4, c4 = (idx & 15) * 4;
    const uint2 v = *(const uint2*)(proj + (size_t)(c0 + tok) * INW + C_CU + gq * 64 + c4);
    us[tok * 64 + c4 + 0] = bf2f((u16)(v.x & 0xffff));
    us[tok * 64 + c4 + 1] = bf2f((u16)(v.x >> 16));
    us[tok * 64 + c4 + 2] = bf2f((u16)(v.y & 0xffff));
    us[tok * 64 + c4 + 3] = bf2f((u16)(v.y >> 16));
  }
}
DI void s5_step(const S5Const& k, const float* u, float& sr, float& si) {
  float xr = 0.f, xi = 0.f;
#pragma unroll
  for (int c4 = 0; c4 < 4; ++c4) {
    const float4 uu = *(const float4*)(u + c4 * 4);
    xr += k.bpr[c4 * 4 + 0] * uu.x + k.bpr[c4 * 4 + 1] * uu.y + k.bpr[c4 * 4 + 2] * uu.z + k.bpr[c4 * 4 + 3] * uu.w;
    xi += k.bpi[c4 * 4 + 0] * uu.x + k.bpi[c4 * 4 + 1] * uu.y + k.bpi[c4 * 4 + 2] * uu.z + k.bpi[c4 * 4 + 3] * uu.w;
  }
  const float nr = k.are * sr - k.aim * si + xr;
  const float ni = k.are * si + k.aim * sr + xi;
  sr = nr; si = ni;
}
DI void s5_pass1(const Params& p, int layer, int task, char* smem) {
  const int lane = my_tid() & 63, wave = my_tid() >> 6;
  const int n = task >> 2, gq = task & 3, g = gq * 4 + wave, c0 = n * 64;
  float* us = (float*)smem;
  float2* SEND = (float2*)(p.ws + OFF_SEND);
  __syncthreads();
  s5_stage_u(p, c0, gq, us);
  __syncthreads();
#pragma unroll 1
  for (int d = 0; d < 2; ++d) {
    S5Const k; float lr, li, step;
    s5_consts(p, layer, d, g, lane, k, lr, li, step);
    float sr = 0.f, si = 0.f;
#pragma unroll 4
    for (int i = 0; i < 64; ++i) {
      const int t = d ? 63 - i : i;
      s5_step(k, us + t * 64 + wave * 16, sr, si);
    }
    SEND[((size_t)(n * 2 + d) * 16 + g) * 64 + lane] = make_float2(sr, si);
  }
}
DI float gelu_tanh(float x) {
  const float u = 0.7978845608028654f * (x + 0.044715f * x * x * x);
  return 0.5f * x * (1.f + tanhf(u));
}
DI void s5_pass3(const Params& p, int layer, int task, char* smem) {
  const int lane = my_tid() & 63, wave = my_tid() >> 6;
  const int fr = lane & 15, fq = lane >> 4;
  const int n = task >> 2, gq = task & 3, g = gq * 4 + wave, c0 = n * 64;
  const int nlo = seq_lo(c0) / 64, nhi = seq_hi(c0) / 64;
  float* us = (float*)smem;
  u16* Sb = (u16*)(smem + 16384) + wave * 16 * 136;
  const float2* SEND = (const float2*)(p.ws + OFF_SEND);
  u16* Gb = (u16*)(p.ws + OFF_G);
  __syncthreads();
  s5_stage_u(p, c0, gq, us);
  __syncthreads();
  f32x4 yacc[4];
#pragma unroll
  for (int tb = 0; tb < 4; ++tb) yacc[tb] = (f32x4){0.f, 0.f, 0.f, 0.f};
#pragma unroll
  for (int d = 0; d < 2; ++d) {
    S5Const k; float lr, li, step;
    s5_consts(p, layer, d, g, lane, k, lr, li, step);
    const float m64 = expf(lr * step * 64.f);
    float s64, c64; sincosf(li * step * 64.f, &s64, &c64);
    const float a64r = m64 * c64, a64i = m64 * s64;
    float sr = 0.f, si = 0.f;
    {
      const int cnt = d == 0 ? n - nlo : nhi - 1 - n;
      const int first = d == 0 ? nlo : nhi - 1;
      const int sgn = d == 0 ? 1 : -1;
      const float2* sp = SEND + ((size_t)(first * 2 + d) * 16 + g) * 64 + lane;
      const long stride = (long)sgn * 2 * 16 * 64;
      int m = 0;
      for (; m + 8 <= cnt; m += 8) {
        float2 e0 = sp[0], e1 = sp[stride], e2 = sp[2 * stride], e3 = sp[3 * stride];
        float2 e4 = sp[4 * stride], e5 = sp[5 * stride], e6 = sp[6 * stride], e7 = sp[7 * stride];
        sp += 8 * stride;
#define HSTEP(E) { const float nr = a64r * sr - a64i * si + E.x, ni = a64r * si + a64i * sr + E.y; sr = nr; si = ni; }
        HSTEP(e0) HSTEP(e1) HSTEP(e2) HSTEP(e3) HSTEP(e4) HSTEP(e5) HSTEP(e6) HSTEP(e7)
      }
      for (; m < cnt; ++m) {
        const float2 e = sp[0];
        sp += stride;
        HSTEP(e)
      }
    }
    bf16x8 cf[4];
    {
      const float* cr = p.c_re + ((size_t)((layer * 2 + d) * 16 + g) * 16 + fr) * 64;
      const float* ci = p.c_im + ((size_t)((layer * 2 + d) * 16 + g) * 16 + fr) * 64;
#pragma unroll
      for (int kk = 0; kk < 4; ++kk)
#pragma unroll
        for (int e = 0; e < 8; ++e) {
          const int kx = (kk & 1) * 32 + fq * 8 + e;
          const float v = (kk < 2) ? cr[kx] : -ci[kx];
          cf[kk][e] = (short)f2bf(v);
        }
    }
#pragma unroll
    for (int blk = 0; blk < 4; ++blk) {
      const int tb = d ? 3 - blk : blk;
#pragma unroll 4
      for (int i = 0; i < 16; ++i) {
        const int r = d ? 15 - i : i;
        const int t = tb * 16 + r;
        s5_step(k, us + t * 64 + wave * 16, sr, si);
        Sb[r * 136 + lane] = f2bf(sr);
        Sb[r * 136 + 64 + lane] = f2bf(si);
      }
      __syncthreads();
#pragma unroll
      for (int kk = 0; kk < 4; ++kk) {
        const bf16x8 xf = *(const bf16x8*)(Sb + fr * 136 + kk * 32 + fq * 8);
        yacc[tb] = mfma16(xf, cf[kk], yacc[tb]);
      }
      __syncthreads();
    }
  }
  const float dsk = p.s5_d[layer * 256 + g * 16 + fr];
#pragma unroll
  for (int tb = 0; tb < 4; ++tb)
#pragma unroll
    for (int j = 0; j < 4; ++j) {
      const int t = tb * 16 + fq * 4 + j;
      const float y = yacc[tb][j] + us[t * 64 + wave * 16 + fr] * dsk;
      Gb[(size_t)(c0 + t) * 256 + g * 16 + fr] = f2bf(gelu_tanh(y));
    }
}

struct AttnState { float m, l; f32x4 o[4]; };
DI void attn_segment(const u16* proj, int kcol, int vcol, int tk0, int kstride, int npairs, int R, float slope, int tq,
                     int lo, int hi, const bf16x8 (&qf)[2], AttnState& st, u16* Vt, int lane) {
  const int fr = lane & 15, fq = lane >> 4;
#pragma unroll 1
  for (int pr = 0; pr < npairs; ++pr) {
    const int kbase = tk0 + pr * 32 * kstride;
    f32x4 sacc[2];
#pragma unroll
    for (int t = 0; t < 2; ++t) {
      int tk = kbase + (t * 16 + fr) * kstride;
      tk = min(max(tk, lo), hi - 1);
      const u16* kp = proj + (size_t)tk * INW + kcol + fq * 8;
      const bf16x8 k0 = *(const bf16x8*)(kp), k1 = *(const bf16x8*)(kp + 32);
      sacc[t] = mfma16(k0, qf[0], (f32x4){0.f, 0.f, 0.f, 0.f});
      sacc[t] = mfma16(k1, qf[1], sacc[t]);
    }
    uint4 vr[4];
#pragma unroll
    for (int i = 0; i < 4; ++i) {
      const int idx = lane + 64 * i, kl = idx >> 3, seg = (idx & 7) * 8;
      int tk = kbase + kl * kstride;
      tk = min(max(tk, lo), hi - 1);
      vr[i] = *(const uint4*)(proj + (size_t)tk * INW + vcol + seg);
    }
    float sc[2][4]; bool ok[2][4];
    float mx = -1e30f;
#pragma unroll
    for (int t = 0; t < 2; ++t)
#pragma unroll
      for (int j = 0; j < 4; ++j) {
        const int tk = kbase + (t * 16 + fq * 4 + j) * kstride;
        const int ad = abs(tk - tq);
        ok[t][j] = (ad <= R) && (tk >= lo) && (tk < hi);
        sc[t][j] = sacc[t][j] * 0.125f - slope * (float)ad;
        if (ok[t][j]) mx = fmaxf(mx, sc[t][j]);
      }
    mx = fmaxf(mx, __shfl_xor(mx, 16, 64));
    mx = fmaxf(mx, __shfl_xor(mx, 32, 64));
    const float mn = fmaxf(st.m, mx);
    const float alpha = __expf(st.m - mn);
    st.m = mn;
    float pv[2][4], ps = 0.f;
#pragma unroll
    for (int t = 0; t < 2; ++t)
#pragma unroll
      for (int j = 0; j < 4; ++j) { pv[t][j] = ok[t][j] ? __expf(sc[t][j] - mn) : 0.f; ps += pv[t][j]; }
    st.l = st.l * alpha + ps;
#pragma unroll
    for (int dt = 0; dt < 4; ++dt)
#pragma unroll
      for (int j = 0; j < 4; ++j) st.o[dt][j] *= alpha;
    bf16x8 pf;
    {
      const unsigned w0 = pack2(pv[0][0], pv[0][1]), w1 = pack2(pv[0][2], pv[0][3]), w2 = pack2(pv[1][0], pv[1][1]),
                     w3 = pack2(pv[1][2], pv[1][3]);
      uint4 t4 = make_uint4(w0, w1, w2, w3);
      pf = __builtin_bit_cast(bf16x8, t4);
    }
    __syncthreads();
#pragma unroll
    for (int i = 0; i < 4; ++i) {
      const int idx = lane + 64 * i, kl = idx >> 3, seg = (idx & 7) * 8;
      Vt[(seg + 0) * 36 + kl] = (u16)(vr[i].x & 0xffff); Vt[(seg + 1) * 36 + kl] = (u16)(vr[i].x >> 16);
      Vt[(seg + 2) * 36 + kl] = (u16)(vr[i].y & 0xffff); Vt[(seg + 3) * 36 + kl] = (u16)(vr[i].y >> 16);
      Vt[(seg + 4) * 36 + kl] = (u16)(vr[i].z & 0xffff); Vt[(seg + 5) * 36 + kl] = (u16)(vr[i].z >> 16);
      Vt[(seg + 6) * 36 + kl] = (u16)(vr[i].w & 0xffff); Vt[(seg + 7) * 36 + kl] = (u16)(vr[i].w >> 16);
    }
    __syncthreads();
#pragma unroll
    for (int dt = 0; dt < 4; ++dt) {
      const uint2 v0 = *(const uint2*)(Vt + (dt * 16 + fr) * 36 + fq * 4);
      const uint2 v1 = *(const uint2*)(Vt + (dt * 16 + fr) * 36 + 16 + fq * 4);
      uint4 t4 = make_uint4(v0.x, v0.y, v1.x, v1.y);
      const bf16x8 vf = __builtin_bit_cast(bf16x8, t4);
      st.o[dt] = mfma16(vf, pf, st.o[dt]);
    }
  }
}
DI void attn_task(const Params& p, int layer, int mode, int task, char* smem) {
  const int lane = my_tid() & 63, wave = my_tid() >> 6;
  const int fr = lane & 15, fq = lane >> 4;
  u16* proj = (u16*)(p.ws + OFF_PROJ);
  u16* Vt = (u16*)smem + wave * 64 * 36;
  int tq0, qstride, qcol, kcol, vcol; float slope;
  int hq;
  if (mode == 0) {
    const int blk = task >> 4, h = (task >> 2) & 3, rq = task & 3;
    hq = h; tq0 = blk * 256 + rq * 4 + wave; qstride = 16;
    qcol = C_BQ + h * 64; kcol = C_BK + h * 64; vcol = C_BV + h * 64;
    slope = exp2f(-(float)(5 + h));
  } else {
    const int blk = task >> 2, qh = task & 3;
    hq = qh; tq0 = blk * 64 + wave * 16; qstride = 1;
    qcol = C_DQ + qh * 64; kcol = C_DK + (qh >> 1) * 64; vcol = C_DV + (qh >> 1) * 64;
    slope = exp2f(-(float)(1 + qh));
  }
  const int lo = seq_lo(tq0), hi = seq_hi(tq0);
  const int tq = tq0 + fr * qstride;
  bf16x8 qf[2];
  {
    const u16* qp = proj + (size_t)tq * INW + qcol + fq * 8;
    qf[0] = *(const bf16x8*)(qp); qf[1] = *(const bf16x8*)(qp + 32);
  }
  AttnState st; st.m = -1e30f; st.l = 0.f;
#pragma unroll
  for (int dt = 0; dt < 4; ++dt) st.o[dt] = (f32x4){0.f, 0.f, 0.f, 0.f};
  __syncthreads();
  float scale;
  if (mode == 0) {
    attn_segment(proj, kcol, vcol, tq0 - 64, 1, 12, 64, slope, tq, lo, hi, qf, st, Vt, lane);
    attn_segment(proj, kcol, vcol, tq0 - 256, 4, 6, 256, slope, tq, lo, hi, qf, st, Vt, lane);
    attn_segment(proj, kcol, vcol, tq0 - 1024, 16, 5, 1024, slope, tq, lo, hi, qf, st, Vt, lane);
    float l = st.l; l += __shfl_xor(l, 16, 64); l += __shfl_xor(l, 32, 64);
    scale = 1.f / l;
  } else {
    attn_segment(proj, kcol, vcol, tq0 - 128, 1, 9, 128, slope, tq, lo, hi, qf, st, Vt, lane);
    float l = st.l; l += __shfl_xor(l, 16, 64); l += __shfl_xor(l, 32, 64);
    const float sink = p.attn_sink[layer * 4 + hq];
    const float mf = fmaxf(st.m, sink);
    const float sc = __expf(st.m - mf);
    scale = sc / (l * sc + __expf(sink - mf));
  }
#pragma unroll
  for (int dt = 0; dt < 4; ++dt) {
    uint2 o; o.x = pack2(st.o[dt][0] * scale, st.o[dt][1] * scale); o.y = pack2(st.o[dt][2] * scale, st.o[dt][3] * scale);
    *(uint2*)(proj + (size_t)tq * INW + qcol + dt * 16 + fq * 4) = o;
  }
}

DI void final_row(const Params& p, int t) {
  const int lane = my_tid() & 63;
  float* row = p.xout + (size_t)t * DM;
  float4 v[4]; float ss = 0.f;
#pragma unroll
  for (int i = 0; i < 4; ++i) {
    v[i] = *(const float4*)(row + i * 256 + lane * 4);
    ss += v[i].x * v[i].x + v[i].y * v[i].y + v[i].z * v[i].z + v[i].w * v[i].w;
  }
  ss = wave_sum(ss);
  const float rs = rsqrtf(ss * (1.f / DM) + EPS);
#pragma unroll
  for (int i = 0; i < 4; ++i) {
    const float4 g = *(const float4*)(p.final_norm + i * 256 + lane * 4);
    *(float4*)(row + i * 256 + lane * 4) = make_float4(v[i].x * rs * g.x, v[i].y * rs * g.y, v[i].z * rs * g.z, v[i].w * rs * g.w);
  }
}

enum { PH_NORM1 = 0, PH_INPROJ, PH_MIX1, PH_MIX2, PH_MIX3, PH_MERGE, PH_OUT, PH_NORM2, PH_FFN1, PH_FFN2, PH_PER_LAYER, PH_FINAL = 100 };

DI void run_phase(const Params& p, int ph, int layer, char* smem) {
  const int b = blockIdx.x, G = gridDim.x;
  const int wave = my_tid() >> 6;
  switch (ph) {
    case PH_NORM1: {
      if (layer == 0) {
        for (int t = b; t < 2 * CONV_TILES_LAYER; t += G) {
          ConvJob j;
          const int lt = conv_lookup(p, t, j);
          conv_tile(j, lt, (float*)smem);
        }
      }
      rms_phase(p, layer, p.norm1 + layer * DM, (u16*)(p.ws + OFF_H), b, G);
    } break;
    case PH_INPROJ: gemm_inproj(p, layer, b, G, (u16*)smem); break;
    case PH_MIX1: {
      for (int t = b; t < 4 * 3072; t += G) {
        const int kind = t / 3072, idx = t % 3072;
        if (kind == 0) gdn_pre(p, layer, idx, smem);
        else if (kind == 1) attn_task(p, layer, 0, idx, smem);
        else if (kind == 2) attn_task(p, layer, 1, idx, smem);
        else s5_pass1(p, layer, idx, smem);
      }
    } break;
    case PH_MIX2: {
      if (G > 144 + 8) {
        if (b < 144) gdn_scan(p, b, smem);
        else for (int t = b - 144; t < 3072; t += G - 144) s5_pass3(p, layer, t, smem);
      } else {
        for (int c = b; c < 144; c += G) gdn_scan(p, c, smem);
        for (int t = b; t < 3072; t += G) s5_pass3(p, layer, t, smem);
      }
    } break;
    case PH_MIX3: {
      gemm_glu(p, layer, b, G, (u16*)smem);
      for (int t = b * 4 + wave; t < T; t += G * 4) gdn_post_row(p, layer, t);
      rms_phase(p, layer, p.norm1 + layer * DM, (u16*)(p.ws + OFF_H), b, G);
    } break;
    case PH_MERGE: gemm_merge(p, layer, b, G, (u16*)smem); break;
    case PH_OUT:
      gemm_resid(p, layer, (const u16*)(p.ws + OFF_MERGED), DM, (const u16*)(p.ws + OFF_W) + layer * W_LAYER + WO_OUT, b, G, (u16*)smem);
      break;
    case PH_NORM2: rms_phase(p, 1, p.norm2 + layer * DM, (u16*)(p.ws + OFF_H2), b, G); break;
    case PH_FFN1: gemm_ffn1(p, layer, b, G, (u16*)smem); break;
    case PH_FFN2:
      gemm_resid(p, 1, (const u16*)(p.ws + OFF_ACT), FH, (const u16*)(p.ws + OFF_W) + layer * W_LAYER + WO_DN, b, G, (u16*)smem);
      break;
    case PH_FINAL:
      for (int t = b * 4 + wave; t < T; t += G * 4) final_row(p, t);
      break;
    default: break;
  }
}

#if !MEGA
__global__ void __launch_bounds__(256, 2) k_phase(Params p, int ph, int layer) {
  __shared__ __attribute__((aligned(16))) char smem[SMEM_BYTES];
  run_phase(p, ph, layer, smem);
}

#else
__global__ void __launch_bounds__(256, 2) k_mega(Params p) {
  __shared__ __attribute__((aligned(16))) char smem[SMEM_BYTES];
  cg::grid_group grid = cg::this_grid();
  for (int layer = 0; layer < 2; ++layer)
    for (int ph = 0; ph < PH_PER_LAYER; ++ph) {
      run_phase(p, ph, layer, smem);
      grid.sync();
#ifdef PROBE_DUP
      if (ph == PROBE_DUP) { run_phase(p, ph, layer, smem); grid.sync(); }
#endif
    }
  run_phase(p, PH_FINAL, 0, smem);
}
#endif

extern "C" void kernel_launch(void* const* d_in, const int* in_sizes, int n_in, void* d_out, int out_size, void* d_ws,
                              size_t ws_size, hipStream_t stream) {
  (void)in_sizes; (void)n_in; (void)out_size;
  if (ws_size < WS_NEED) { fprintf(stderr, "workspace too small: %zu < %zu\n", ws_size, (size_t)WS_NEED); return; }
  Params p;
  memset(&p, 0, sizeof(p));
  const float* const* in = (const float* const*)d_in;
  p.x_prompt = in[0]; p.x_sample = in[1]; p.norm1 = in[2]; p.conv_a = in[4]; p.a_log = in[5]; p.dt_bias = in[6];
  p.a_norm = in[7]; p.lam_re = in[8]; p.lam_im = in[9]; p.log_step = in[10]; p.b_re = in[11]; p.b_im = in[12];
  p.c_re = in[13]; p.c_im = in[14]; p.s5_d = in[15]; p.attn_sink = in[17]; p.norm2 = in[21]; p.final_norm = in[25];
  p.xout = (float*)d_out;
  p.ws = (char*)d_ws;
  p.w_in = in[3]; p.w_glu = in[16]; p.w_gate = in[18]; p.w_branch = in[19]; p.w_out = in[20];
  p.w_ffn_gate = in[22]; p.w_ffn_up = in[23]; p.w_ffn_down = in[24];
  static int grid_blocks = 0;
  if (!grid_blocks) {
    int dev = 0, cus = 0, per_cu = 0;
    hipGetDevice(&dev);
    hipDeviceGetAttribute(&cus, hipDeviceAttributeMultiprocessorCount, dev);
#if MEGA
    hipOccupancyMaxActiveBlocksPerMultiprocessor(&per_cu, k_mega, 256, 0);
#else
    hipOccupancyMaxActiveBlocksPerMultiprocessor(&per_cu, k_phase, 256, 0);
#endif
    per_cu = 2;
    grid_blocks = cus * per_cu;
  }
#if MEGA
  void* args[] = {&p};
  hipError_t e = hipLaunchCooperativeKernel((void*)k_mega, dim3(grid_blocks), dim3(256), args, 0, stream);
  if (e != hipSuccess) fprintf(stderr, "cooperative launch failed: %s (grid %d)\n", hipGetErrorString(e), grid_blocks);
#else
  for (int layer = 0; layer < 2; ++layer)
    for (int ph = 0; ph < PH_PER_LAYER; ++ph) hipLaunchKernelGGL(k_phase, dim3(grid_blocks), dim3(256), 0, stream, p, ph, layer);
  hipLaunchKernelGGL(k_phase, dim3(grid_blocks), dim3(256), 0, stream, p, (int)PH_FINAL, 0);
#endif
}
```

```cpp
#include <hip/hip_runtime.h>
#include <hip/hip_cooperative_groups.h>
#include <cstdio>
#include <cstring>
namespace cg = cooperative_groups;

#ifndef MEGA
#define MEGA 1
#endif

#define DI __device__ __forceinline__
typedef unsigned short u16;
typedef __attribute__((ext_vector_type(8))) short bf16x8;
typedef __attribute__((ext_vector_type(4))) float f32x4;

constexpr int T = 49152;
constexpr int TP = 16384;
constexpr int DM = 1024;
constexpr int INW = 2576;
constexpr int FH = 2816;
constexpr int NCH64 = T / 64;
constexpr float EPS = 1e-6f;

constexpr int C_AQ = 0, C_AK = 256, C_AV = 512, C_AZ = 768, C_BQ = 1040, C_BK = 1296, C_BV = 1552, C_CU = 1808,
              C_DQ = 2064, C_DK = 2320, C_DV = 2448;

constexpr size_t WO_IN = 0, WO_GATE = 2752512, WO_BR = 6946816, WO_OUT = 7995392, WO_GU = 9043968, WO_DN = 14811136,
                 WO_GLU = 17694720, W_LAYER = 17825792;
constexpr size_t OFF_W = 0;
constexpr size_t OFF_PROJ = 2 * W_LAYER * 2;
constexpr size_t SZ_PROJ = (size_t)T * INW * 2;
constexpr size_t OFF_R1 = OFF_PROJ + SZ_PROJ;
constexpr size_t SZ_H = (size_t)T * DM * 2;
constexpr size_t OFF_H = OFF_R1;
constexpr size_t OFF_UW = OFF_R1;
constexpr size_t OFF_QN = OFF_R1 + SZ_H;
constexpr size_t OFF_KN = OFF_QN + (size_t)T * 256 * 2;
constexpr size_t OFF_GC = OFF_KN + (size_t)T * 256 * 2;
constexpr size_t OFF_SEND = OFF_GC + (size_t)NCH64 * 8 * 64 * 4;
constexpr size_t OFF_G = OFF_SEND + (size_t)NCH64 * 2 * 1024 * 8;
constexpr size_t OFF_AB = OFF_G + (size_t)T * 256 * 2;
constexpr size_t OFF_CNT = OFF_AB + (size_t)T * 16 * 4;
constexpr size_t OFF_MERGED = OFF_R1 + SZ_H;
constexpr size_t OFF_H2 = OFF_MERGED;
constexpr size_t OFF_ACT = OFF_PROJ;
constexpr size_t WS_NEED = OFF_MERGED + SZ_H;

constexpr int SMEM_BYTES = 75776;

struct ConvJob { const float* src; u16* dst; int K, ncols, nrows_dst, src_ld, rs, off, ntn; };
struct Params {
  const float *x_prompt, *x_sample, *norm1, *conv_a, *a_log, *dt_bias, *a_norm, *lam_re, *lam_im, *log_step, *b_re,
      *b_im, *c_re, *c_im, *s5_d, *attn_sink, *norm2, *final_norm;
  const float *w_in, *w_gate, *w_branch, *w_out, *w_ffn_gate, *w_ffn_up, *w_ffn_down, *w_glu;
  float* xout;
  char* ws;
};
constexpr int CONV_TILES_LAYER = 4352;

DI int my_tid() { int t = threadIdx.x; asm volatile("" : "+v"(t)); return t; }
DI u16 f2bf(float x) { unsigned u = __float_as_uint(x); u += 0x7fffu + ((u >> 16) & 1u); return (u16)(u >> 16); }
DI float bf2f(u16 v) { return __uint_as_float(((unsigned)v) << 16); }
DI unsigned pack2(float a, float b) { return (unsigned)f2bf(a) | ((unsigned)f2bf(b) << 16); }
DI float sigmoidf_(float x) { return 1.f / (1.f + __expf(-x)); }
DI float siluf_(float x) { return x / (1.f + __expf(-x)); }
DI float wave_sum(float v) {
#pragma unroll
  for (int o = 32; o > 0; o >>= 1) v += __shfl_xor(v, o, 64);
  return v;
}
DI int seq_lo(int t) { return t < TP ? 0 : (t & ~4095); }
DI int seq_hi(int t) { return t < TP ? TP : (t & ~4095) + 4096; }
DI const float* xrow(const Params& p, int layer, int t) {
  if (layer == 0) return t < TP ? p.x_prompt + (size_t)t * DM : p.x_sample + (size_t)(t - TP) * DM;
  return p.xout + (size_t)t * DM;
}
DI f32x4 mfma16(bf16x8 a, bf16x8 b, f32x4 c) { return __builtin_amdgcn_mfma_f32_16x16x32_bf16(a, b, c, 0, 0, 0); }

DI void mk_job(ConvJob& j, const float* src, u16* dst, int K, int ncols, int nrows_dst, int src_ld, int rs, int off) {
  j.src = src; j.dst = dst; j.K = K; j.ncols = ncols; j.nrows_dst = nrows_dst; j.src_ld = src_ld; j.rs = rs; j.off = off;
  j.ntn = (nrows_dst + 63) >> 6;
}
DI int conv_lookup(const Params& p, int t, ConvJob& j) {
  const int l = t / CONV_TILES_LAYER;
  int r = t % CONV_TILES_LAYER;
  u16* wl = (u16*)(p.ws + OFF_W) + (size_t)l * W_LAYER;
  if (r < 672) { mk_job(j, p.w_in + (size_t)l * DM * INW, wl + WO_IN, DM, INW, 2688, INW, 32, 0); return r; }
  r -= 672;
  if (r < 1024) { const int i = r >> 8; mk_job(j, p.w_gate + (size_t)(l * 4 + i) * DM * DM, wl + WO_GATE + (size_t)i * DM * DM, DM, DM, DM, DM, 32, 0); return r & 255; }
  r -= 1024;
  if (r < 256) { const int i = r >> 6; mk_job(j, p.w_branch + (size_t)(l * 4 + i) * 256 * DM, wl + WO_BR + (size_t)i * DM * 256, 256, DM, DM, DM, 32, 0); return r & 63; }
  r -= 256;
  if (r < 256) { mk_job(j, p.w_out + (size_t)l * DM * DM, wl + WO_OUT, DM, DM, DM, DM, 32, 0); return r; }
  r -= 256;
  if (r < 704) { mk_job(j, p.w_ffn_gate + (size_t)l * DM * FH, wl + WO_GU, DM, FH, FH, FH, 64, 0); return r; }
  r -= 704;
  if (r < 704) { mk_job(j, p.w_ffn_up + (size_t)l * DM * FH, wl + WO_GU, DM, FH, FH, FH, 64, 32); return r; }
  r -= 704;
  if (r < 704) { mk_job(j, p.w_ffn_down + (size_t)l * FH * DM, wl + WO_DN, FH, DM, DM, DM, 32, 0); return r; }
  r -= 704;
  if (r < 16) { mk_job(j, p.w_glu + (size_t)l * 256 * 512, wl + WO_GLU, 256, 256, 256, 512, 64, 0); return r; }
  r -= 16;
  mk_job(j, p.w_glu + (size_t)l * 256 * 512 + 256, wl + WO_GLU, 256, 256, 256, 512, 64, 32);
  return r;
}
DI void conv_tile(const ConvJob& j, int lt, float* tile) {
  const int tid = my_tid();
  const int tk = lt / j.ntn, tn = lt % j.ntn;
  __syncthreads();
#pragma unroll
  for (int i = 0; i < 4; ++i) {
    int r = (tid >> 4) + 16 * i, c4 = (tid & 15) * 4, n = tn * 64 + c4;
    float4 v = make_float4(0.f, 0.f, 0.f, 0.f);
    if (n < j.ncols) v = *(const float4*)(j.src + (size_t)(tk * 64 + r) * j.src_ld + n);
    tile[r * 65 + c4 + 0] = v.x; tile[r * 65 + c4 + 1] = v.y; tile[r * 65 + c4 + 2] = v.z; tile[r * 65 + c4 + 3] = v.w;
  }
  __syncthreads();
  const int cl = tid >> 2, ks = (tid & 3) * 16, n = tn * 64 + cl;
  if (n < j.nrows_dst) {
    unsigned w[8];
#pragma unroll
    for (int e = 0; e < 8; ++e) w[e] = pack2(tile[(ks + 2 * e) * 65 + cl], tile[(ks + 2 * e + 1) * 65 + cl]);
    const int nm = (n >> 5) * j.rs + (n & 31) + j.off;
    uint4* d = (uint4*)(j.dst + (size_t)nm * j.K + tk * 64 + ks);
    d[0] = make_uint4(w[0], w[1], w[2], w[3]);
    d[1] = make_uint4(w[4], w[5], w[6], w[7]);
  }
}

DI void rms_row_bf16(const float* src, const float* w, u16* dst) {
  const int lane = my_tid() & 63;
  float4 v[4];
  float ss = 0.f;
#pragma unroll
  for (int i = 0; i < 4; ++i) {
    v[i] = *(const float4*)(src + i * 256 + lane * 4);
    ss += v[i].x * v[i].x + v[i].y * v[i].y + v[i].z * v[i].z + v[i].w * v[i].w;
  }
  ss = wave_sum(ss);
  const float rs = rsqrtf(ss * (1.f / DM) + EPS);
#pragma unroll
  for (int i = 0; i < 4; ++i) {
    float4 g = *(const float4*)(w + i * 256 + lane * 4);
    uint2 o;
    o.x = pack2(v[i].x * rs * g.x, v[i].y * rs * g.y);
    o.y = pack2(v[i].z * rs * g.z, v[i].w * rs * g.w);
    *(uint2*)(dst + i * 256 + lane * 4) = o;
  }
}
DI void rms_phase(const Params& p, int layer, const float* w, u16* dst, int b0, int nb) {
  const int wave = my_tid() >> 6;
  for (int r = b0 * 4 + wave; r < T; r += nb * 4) rms_row_bf16(xrow(p, layer, r), w, dst + (size_t)r * DM);
}

constexpr int GP = 64;
#ifndef GEMM_DMA
#define GEMM_DMA 1
#endif
#if GEMM_DMA
template <int NT>
DI void gemm_kloop(const u16* __restrict__ A, size_t lda, const u16* __restrict__ B, size_t ldb, int nk,
                   f32x4 (&acc)[4][NT], u16* sm) {
  const int tid = my_tid(), lane = tid & 63;
  const int wave = __builtin_amdgcn_readfirstlane(tid >> 6);
  const int fr = lane & 15, fq = lane >> 4, wr = wave >> 1, wc = wave & 1;
  u16* sa = sm;
  u16* sb = sm + 2 * 128 * 64;
  const int swz = (fr >> 1) & 7;
  const int lr = lane >> 3;
  const int lc = ((lane & 7) ^ ((lr >> 1) & 3)) * 8;
#define DMA_PIECE(BASE, LD, G, KOFF, DST)                                                              \
  {                                                                                                    \
    const int row_ = (G) * 8 + lr;                                                                     \
    const int col_ = lc ^ ((((G) & 1) * 4) * 8);                                                       \
    __builtin_amdgcn_global_load_lds((const unsigned*)((BASE) + (size_t)row_ * (LD) + (KOFF) + col_),  \
                                     (unsigned*)((DST) + (G) * 512), 16, 0, 0);                        \
  }
#define DMA_TILE(KOFF, STAGE)                                                                          \
  {                                                                                                    \
    u16* da_ = sa + (STAGE) * 8192;                                                                    \
    u16* db_ = sb + (STAGE) * 8192;                                                                    \
    DMA_PIECE(A, lda, wave * 4 + 0, KOFF, da_) DMA_PIECE(A, lda, wave * 4 + 1, KOFF, da_)              \
    DMA_PIECE(A, lda, wave * 4 + 2, KOFF, da_) DMA_PIECE(A, lda, wave * 4 + 3, KOFF, da_)              \
    if (NT == 4) {                                                                                     \
      DMA_PIECE(B, ldb, wave * 4 + 0, KOFF, db_) DMA_PIECE(B, ldb, wave * 4 + 1, KOFF, db_)            \
      DMA_PIECE(B, ldb, wave * 4 + 2, KOFF, db_) DMA_PIECE(B, ldb, wave * 4 + 3, KOFF, db_)            \
    } else {                                                                                           \
      DMA_PIECE(B, ldb, wave * 2 + 0, KOFF, db_) DMA_PIECE(B, ldb, wave * 2 + 1, KOFF, db_)            \
    }                                                                                                  \
  }
  __builtin_amdgcn_s_barrier();
  DMA_TILE(0, 0)
#pragma unroll 1
  for (int kt = 0; kt < nk; ++kt) {
    const int cur = kt & 1;
    asm volatile("s_waitcnt vmcnt(0)" ::: "memory");
    __builtin_amdgcn_s_barrier();
    asm volatile("" ::: "memory");
    const u16* ca = sa + cur * 8192;
    const u16* cb = sb + cur * 8192;
    bf16x8 wf[2][NT], xf[2][4];
#pragma unroll
    for (int kk = 0; kk < 2; ++kk) {
#pragma unroll
      for (int nt = 0; nt < NT; ++nt) wf[kk][nt] = *(const bf16x8*)(cb + (wc * NT * 16 + nt * 16 + fr) * 64 + (((kk * 4 + fq) ^ swz) * 8));
#pragma unroll
      for (int mt = 0; mt < 4; ++mt) xf[kk][mt] = *(const bf16x8*)(ca + (wr * 64 + mt * 16 + fr) * 64 + (((kk * 4 + fq) ^ swz) * 8));
    }
    __builtin_amdgcn_sched_barrier(0);
    if (kt + 1 < nk) DMA_TILE((kt + 1) * 64, cur ^ 1)
    __builtin_amdgcn_sched_barrier(0);
#pragma unroll
    for (int kk = 0; kk < 2; ++kk)
#pragma unroll
      for (int mt = 0; mt < 4; ++mt)
#pragma unroll
        for (int nt = 0; nt < NT; ++nt) acc[mt][nt] = mfma16(wf[kk][nt], xf[kk][mt], acc[mt][nt]);
  }
}
#else
template <int NT>
DI void gemm_kloop(const u16* __restrict__ A, size_t lda, const u16* __restrict__ B, size_t ldb, int nk,
                   f32x4 (&acc)[4][NT], u16* sm) {
  const int tid = my_tid(), lane = tid & 63, wave = tid >> 6;
  const int fr = lane & 15, fq = lane >> 4, wr = wave >> 1, wc = wave & 1;
  u16* sa = sm;
  u16* sb = sm + 2 * 128 * GP;
  uint4 ra0, ra1, ra2, ra3, rb0, rb1, rb2 = make_uint4(0, 0, 0, 0), rb3 = make_uint4(0, 0, 0, 0);
  uint4 rc0, rc1, rc2, rc3, rd0, rd1, rd2 = make_uint4(0, 0, 0, 0), rd3 = make_uint4(0, 0, 0, 0);
  const int lrow = tid >> 3, lseg = (tid & 7) * 8;
  const int sseg = ((tid & 7) ^ ((lrow >> 1) & 7)) * 8;
  const u16* Ap = A + (size_t)lrow * lda + lseg;
  const u16* Bp = B + (size_t)lrow * ldb + lseg;
#define KL_LOAD(KOFF, A0, A1, A2, A3, B0, B1, B2, B3)                    \
  A0 = *(const uint4*)(Ap + (KOFF));                                     \
  A1 = *(const uint4*)(Ap + 32 * lda + (KOFF));                          \
  A2 = *(const uint4*)(Ap + 64 * lda + (KOFF));                          \
  A3 = *(const uint4*)(Ap + 96 * lda + (KOFF));                          \
  B0 = *(const uint4*)(Bp + (KOFF));                                     \
  B1 = *(const uint4*)(Bp + 32 * ldb + (KOFF));                          \
  if (NT > 2) { B2 = *(const uint4*)(Bp + 64 * ldb + (KOFF)); B3 = *(const uint4*)(Bp + 96 * ldb + (KOFF)); }
#define KL_STORE(SA, SB, A0, A1, A2, A3, B0, B1, B2, B3)                 \
  *(uint4*)((SA) + (lrow + 0) * GP + sseg) = A0;                         \
  *(uint4*)((SA) + (lrow + 32) * GP + sseg) = A1;                        \
  *(uint4*)((SA) + (lrow + 64) * GP + sseg) = A2;                        \
  *(uint4*)((SA) + (lrow + 96) * GP + sseg) = A3;                        \
  *(uint4*)((SB) + (lrow + 0) * GP + sseg) = B0;                         \
  *(uint4*)((SB) + (lrow + 32) * GP + sseg) = B1;                        \
  if (NT > 2) { *(uint4*)((SB) + (lrow + 64) * GP + sseg) = B2; *(uint4*)((SB) + (lrow + 96) * GP + sseg) = B3; }
#define KL_COMPUTE(CA, CB)                                                                                     \
  _Pragma("unroll") for (int kk = 0; kk < 2; ++kk) {                                                           \
    bf16x8 wf[NT], xf[4];                                                                                      \
    _Pragma("unroll") for (int nt = 0; nt < NT; ++nt)                                                          \
      wf[nt] = *(const bf16x8*)((CB) + (wc * NT * 16 + nt * 16 + fr) * GP + (((kk * 4 + fq) ^ swz) * 8));       \
    _Pragma("unroll") for (int mt = 0; mt < 4; ++mt)                                                           \
      xf[mt] = *(const bf16x8*)((CA) + (wr * 64 + mt * 16 + fr) * GP + (((kk * 4 + fq) ^ swz) * 8));            \
    _Pragma("unroll") for (int mt = 0; mt < 4; ++mt)                                                           \
    _Pragma("unroll") for (int nt = 0; nt < NT; ++nt) acc[mt][nt] = mfma16(wf[nt], xf[mt], acc[mt][nt]);      \
  }
  const int swz = (fr >> 1) & 7;
  KL_LOAD(0, ra0, ra1, ra2, ra3, rb0, rb1, rb2, rb3)
  KL_LOAD(64, rc0, rc1, rc2, rc3, rd0, rd1, rd2, rd3)
  KL_STORE(sa, sb, ra0, ra1, ra2, ra3, rb0, rb1, rb2, rb3)
  __syncthreads();
  u16* sa1 = sa + 128 * GP;
  u16* sb1 = sb + 128 * GP;
#pragma unroll 1
  for (int kt = 0; kt < nk; kt += 2) {
    const int k2 = (kt + 2 < nk ? kt + 2 : kt) * 64, k3 = (kt + 3 < nk ? kt + 3 : kt + 1) * 64;
    KL_LOAD(k2, ra0, ra1, ra2, ra3, rb0, rb1, rb2, rb3)
    __builtin_amdgcn_sched_barrier(0);
    KL_COMPUTE(sa, sb)
    KL_STORE(sa1, sb1, rc0, rc1, rc2, rc3, rd0, rd1, rd2, rd3)
    __syncthreads();
    KL_LOAD(k3, rc0, rc1, rc2, rc3, rd0, rd1, rd2, rd3)
    __builtin_amdgcn_sched_barrier(0);
    KL_COMPUTE(sa1, sb1)
    KL_STORE(sa, sb, ra0, ra1, ra2, ra3, rb0, rb1, rb2, rb3)
    __syncthreads();
  }
}
#endif
template <int NT>
DI void zero_acc(f32x4 (&acc)[4][NT]) {
#pragma unroll
  for (int a = 0; a < 4; ++a)
#pragma unroll
    for (int b = 0; b < NT; ++b) acc[a][b] = (f32x4){0.f, 0.f, 0.f, 0.f};
}

struct TileIter {
  int step, nsteps, nrb, nct, x, li, lj, mode, idx, stride, L;
  DI void init(int nrt, int nct_, int b, int G) {
    nct = nct_;
    if (G == 512 && (nrt % 64) == 0) {
      mode = 1; x = b & 7;
      const int local = b >> 3;
      li = local >> 3; lj = local & 7;
      nrb = nrt / 64;
      nsteps = nrb * ((nct + 7) >> 3);
      step = 0;
      skip();
    } else {
      mode = 0; idx = b; stride = G; L = nrt * nct;
    }
  }
  DI int ctile() const { return (step / nrb) * 8 + lj; }
  DI void skip() { while (step < nsteps && ctile() >= nct) ++step; }
  DI bool valid() const { return mode ? step < nsteps : idx < L; }
  DI int rt() const { return mode ? x + 8 * ((step % nrb) * 8 + li) : idx / nct; }
  DI int ct() const { return mode ? ctile() : idx % nct; }
  DI void next() { if (mode) { ++step; skip(); } else idx += stride; }
};

#define EPI_COORDS                                                       \
  const int lane = my_tid() & 63, wave = my_tid() >> 6;           \
  const int fr = lane & 15, fq = lane >> 4, wr = wave >> 1, wc = wave & 1; \
  (void)fr; (void)fq; (void)wr; (void)wc;

DI void gemm_inproj(const Params& p, int layer, int b, int G, u16* sm) {
  const u16* H = (const u16*)(p.ws + OFF_H);
  const u16* W = (const u16*)(p.ws + OFF_W) + layer * W_LAYER + WO_IN;
  u16* proj = (u16*)(p.ws + OFF_PROJ);
  float* AB = (float*)(p.ws + OFF_AB);
  EPI_COORDS
  TileIter it; it.init(T / 128, 21, b, G);
  for (; it.valid(); it.next()) {
    const int row0 = it.rt() * 128, col0 = it.ct() * 128;
    f32x4 acc[4][4]; zero_acc<4>(acc);
    gemm_kloop<4>(H + (size_t)row0 * DM, DM, W + (size_t)col0 * DM, DM, 16, acc, sm);
#pragma unroll
    for (int mt = 0; mt < 4; ++mt) {
      const int row = row0 + wr * 64 + mt * 16 + fr;
#pragma unroll
      for (int nt = 0; nt < 4; ++nt) {
        const int col = col0 + wc * 64 + nt * 16 + fq * 4;
        if (col < INW) {
          uint2 o; o.x = pack2(acc[mt][nt][0], acc[mt][nt][1]); o.y = pack2(acc[mt][nt][2], acc[mt][nt][3]);
          *(uint2*)(proj + (size_t)row * INW + col) = o;
          if (col >= 1024 && col < 1040)
            *(float4*)(AB + (size_t)row * 16 + (col - 1024)) = make_float4(acc[mt][nt][0], acc[mt][nt][1], acc[mt][nt][2], acc[mt][nt][3]);
        }
      }
    }
  }
}

DI void gemm_glu(const Params& p, int layer, int b, int G, u16* sm) {
  const u16* Gb = (const u16*)(p.ws + OFF_G);
  const u16* W = (const u16*)(p.ws + OFF_W) + layer * W_LAYER + WO_GLU;
  u16* proj = (u16*)(p.ws + OFF_PROJ);
  EPI_COORDS
  TileIter it; it.init(T / 128, 4, b, G);
  for (; it.valid(); it.next()) {
    const int row0 = it.rt() * 128, ct = it.ct();
    f32x4 acc[4][4]; zero_acc<4>(acc);
    gemm_kloop<4>(Gb + (size_t)row0 * 256, 256, W + (size_t)ct * 128 * 256, 256, 4, acc, sm);
#pragma unroll
    for (int mt = 0; mt < 4; ++mt) {
      const int row = row0 + wr * 64 + mt * 16 + fr;
#pragma unroll
      for (int nt = 0; nt < 2; ++nt) {
        const int col = (ct * 2 + wc) * 32 + nt * 16 + fq * 4;
        float o[4];
#pragma unroll
        for (int j = 0; j < 4; ++j) o[j] = acc[mt][nt][j] * sigmoidf_(acc[mt][nt + 2][j]);
        uint2 ov; ov.x = pack2(o[0], o[1]); ov.y = pack2(o[2], o[3]);
        *(uint2*)(proj + (size_t)row * INW + C_CU + col) = ov;
      }
    }
  }
}

DI void gemm_merge(const Params& p, int layer, int b, int G, u16* sm) {
  const u16* H = (const u16*)(p.ws + OFF_H);
  const u16* Wg = (const u16*)(p.ws + OFF_W) + layer * W_LAYER + WO_GATE;
  const u16* Wb = (const u16*)(p.ws + OFF_W) + layer * W_LAYER + WO_BR;
  const u16* proj = (const u16*)(p.ws + OFF_PROJ);
  u16* merged = (u16*)(p.ws + OFF_MERGED);
  EPI_COORDS
  TileIter it; it.init(T / 128, 16, b, G);
  for (; it.valid(); it.next()) {
    const int row0 = it.rt() * 128, col0 = it.ct() * 64;
    f32x4 mg[4][2]; zero_acc<2>(mg);
#pragma unroll 1
    for (int i = 0; i < 4; ++i) {
      const int ocol = (i == 0) ? C_AZ : (i == 1) ? C_BQ : (i == 2) ? C_CU : C_DQ;
      f32x4 acc[4][2]; zero_acc<2>(acc);
      gemm_kloop<2>(H + (size_t)row0 * DM, DM, Wg + (size_t)i * DM * DM + (size_t)col0 * DM, DM, 16, acc, sm);
      f32x4 sg[4][2];
#pragma unroll
      for (int a = 0; a < 4; ++a)
#pragma unroll
        for (int c = 0; c < 2; ++c)
#pragma unroll
          for (int j = 0; j < 4; ++j) sg[a][c][j] = sigmoidf_(acc[a][c][j]);
      zero_acc<2>(acc);
      gemm_kloop<2>(proj + (size_t)row0 * INW + ocol, INW, Wb + (size_t)i * DM * 256 + (size_t)col0 * 256, 256, 4, acc, sm);
#pragma unroll
      for (int a = 0; a < 4; ++a)
#pragma unroll
        for (int c = 0; c < 2; ++c)
#pragma unroll
          for (int j = 0; j < 4; ++j) mg[a][c][j] += sg[a][c][j] * acc[a][c][j];
    }
#pragma unroll
    for (int mt = 0; mt < 4; ++mt) {
      const int row = row0 + wr * 64 + mt * 16 + fr;
#pragma unroll
      for (int nt = 0; nt < 2; ++nt) {
        const int col = col0 + wc * 32 + nt * 16 + fq * 4;
        uint2 o; o.x = pack2(mg[mt][nt][0], mg[mt][nt][1]); o.y = pack2(mg[mt][nt][2], mg[mt][nt][3]);
        *(uint2*)(merged + (size_t)row * DM + col) = o;
      }
    }
  }
}

DI void gemm_resid(const Params& p, int layer_src, const u16* A, int K, const u16* W, int b, int G, u16* sm) {
  EPI_COORDS
  TileIter it; it.init(T / 128, 8, b, G);
  for (; it.valid(); it.next()) {
    const int row0 = it.rt() * 128, col0 = it.ct() * 128;
    f32x4 acc[4][4]; zero_acc<4>(acc);
    gemm_kloop<4>(A + (size_t)row0 * K, K, W + (size_t)col0 * K, K, K / 64, acc, sm);
#pragma unroll
    for (int mt = 0; mt < 4; ++mt) {
      const int row = row0 + wr * 64 + mt * 16 + fr;
      const float* xs = xrow(p, layer_src, row);
      float* xd = p.xout + (size_t)row * DM;
#pragma unroll
      for (int nt = 0; nt < 4; ++nt) {
        const int col = col0 + wc * 64 + nt * 16 + fq * 4;
        float4 r = *(const float4*)(xs + col);
        r.x += acc[mt][nt][0]; r.y += acc[mt][nt][1]; r.z += acc[mt][nt][2]; r.w += acc[mt][nt][3];
        *(float4*)(xd + col) = r;
      }
    }
  }
}

DI void gemm_ffn1(const Params& p, int layer, int b, int G, u16* sm) {
  const u16* H = (const u16*)(p.ws + OFF_H2);
  const u16* W = (const u16*)(p.ws + OFF_W) + layer * W_LAYER + WO_GU;
  u16* act = (u16*)(p.ws + OFF_ACT);
  EPI_COORDS
  TileIter it; it.init(T / 128, 44, b, G);
  for (; it.valid(); it.next()) {
    const int row0 = it.rt() * 128, ct = it.ct();
    f32x4 acc[4][4]; zero_acc<4>(acc);
    gemm_kloop<4>(H + (size_t)row0 * DM, DM, W + (size_t)ct * 128 * DM, DM, 16, acc, sm);
#pragma unroll
    for (int mt = 0; mt < 4; ++mt) {
      const int row = row0 + wr * 64 + mt * 16 + fr;
#pragma unroll
      for (int nt = 0; nt < 2; ++nt) {
        const int col = (ct * 2 + wc) * 32 + nt * 16 + fq * 4;
        float o[4];
#pragma unroll
        for (int j = 0; j < 4; ++j) o[j] = siluf_(acc[mt][nt][j]) * acc[mt][nt + 2][j];
        uint2 ov; ov.x = pack2(o[0], o[1]); ov.y = pack2(o[2], o[3]);
        *(uint2*)(act + (size_t)row * FH + col) = ov;
      }
    }
  }
}

DI void gdn_pre(const Params& p, int layer, int task, char* smem) {
  const int tid = my_tid(), lane = tid & 63, wave = tid >> 6;
  const int n = task >> 2, h = task & 3, c0 = n * 64;
  const int lo = seq_lo(c0), hi = seq_hi(c0);
  float* ks = (float*)smem;
  float* vs = ks + 64 * 65;
  float* AmT = vs + 64 * 65;
  float* gcs = AmT + 2 * 64 * 64;
  float* bts = gcs + 128;
  const u16* proj = (const u16*)(p.ws + OFF_PROJ);
  u16* QN = (u16*)(p.ws + OFF_QN);
  u16* KN = (u16*)(p.ws + OFF_KN);
  float* GC = (float*)(p.ws + OFF_GC);
  const float* AB = (const float*)(p.ws + OFF_AB);
  u16* UW = (u16*)(p.ws + OFF_UW);
  __syncthreads();
#pragma unroll 1
  for (int mat = 0; mat < 3; ++mat) {
    const int ch = mat * 256 + h * 64 + lane;
    float w[5];
#pragma unroll
    for (int j = 0; j < 5; ++j) w[j] = p.conv_a[(size_t)(layer * 5 + j) * 768 + ch];
    float raw[20];
#pragma unroll
    for (int i = 0; i < 20; ++i) {
      const int tok = c0 + wave * 16 + i - 2;
      raw[i] = (tok >= lo && tok < hi) ? bf2f(proj[(size_t)tok * INW + ch]) : 0.f;
    }
#pragma unroll
    for (int i = 0; i < 16; ++i) {
      float v = 0.f;
#pragma unroll
      for (int j = 0; j < 5; ++j) v += raw[i + j] * w[j];
      v = siluf_(v);
      const int tl = wave * 16 + i;
      if (mat < 2) {
        const float ss = wave_sum(v * v);
        v *= rsqrtf(ss + EPS) * (mat == 0 ? 0.125f : 1.f);
      }
      if (mat == 0) QN[(size_t)(c0 + tl) * 256 + h * 64 + lane] = f2bf(v);
      else if (mat == 1) { KN[(size_t)(c0 + tl) * 256 + h * 64 + lane] = f2bf(v); ks[tl * 65 + lane] = v; }
      else vs[tl * 65 + lane] = v;
    }
  }
  if (wave < 2) {
    const int d = wave;
    const int tok = c0 + (d ? 63 - lane : lane);
    const float al = AB[(size_t)tok * 16 + d * 4 + h];
    const float br = AB[(size_t)tok * 16 + 8 + d * 4 + h];
    const float xx = al + p.dt_bias[(layer * 2 + d) * 4 + h];
    const float sp = fmaxf(xx, 0.f) + log1pf(__expf(-fabsf(xx)));
    float g = -__expf(p.a_log[(layer * 2 + d) * 4 + h]) * sp;
#pragma unroll
    for (int o = 1; o < 64; o <<= 1) {
      const float t = __shfl_up(g, o, 64);
      if (lane >= o) g += t;
    }
    gcs[d * 64 + lane] = g;
    bts[d * 64 + lane] = sigmoidf_(br);
    GC[(size_t)(task * 2 + d) * 64 + lane] = g;
  }
  __syncthreads();
#pragma unroll 1
  for (int m = 0; m < 16; ++m) {
    const int a = wave + 4 * m, b = lane;
    float dot = 0.f;
#pragma unroll 16
    for (int dd = 0; dd < 64; ++dd) dot += ks[a * 65 + dd] * ks[b * 65 + dd];
    if (a > b) {
      AmT[b * 64 + a] = bts[a] * dot * __expf(gcs[a] - gcs[b]);
      const int i1 = 63 - b, j1 = 63 - a;
      AmT[4096 + j1 * 64 + i1] = bts[64 + i1] * dot * __expf(gcs[64 + i1] - gcs[64 + j1]);
    }
  }
  __syncthreads();
  {
    int d = tid >> 7, c = tid & 127;
    asm volatile("" : "+v"(d), "+v"(c));
    float r[64];
    {
      const int stride = d ? -65 : 65;
      int off = (d ? 63 * 65 : 0) + (c & 63);
      const float* srcm = (c < 64) ? vs : ks;
      const bool isw = c >= 64;
#pragma unroll
      for (int i = 0; i < 64; ++i) {
        float v = srcm[off] * bts[d * 64 + i];
        if (isw) v *= __expf(gcs[d * 64 + i]);
        r[i] = v;
        off += stride;
        asm volatile("" : "+v"(off));
        if ((i & 7) == 7) __builtin_amdgcn_sched_barrier(0);
      }
    }
    const float* Ad = AmT + d * 4096;
#pragma unroll
    for (int j = 0; j < 63; ++j) {
      const float rj = r[j];
#pragma unroll
      for (int i = j + 1; i < 64; ++i) {
        r[i] = fmaf(-Ad[j * 64 + i], rj, r[i]);
        if ((i & 15) == 15) __builtin_amdgcn_sched_barrier(0);
      }
      __builtin_amdgcn_sched_barrier(0);
    }
    u16* base = UW + (size_t)(task * 2 + d) * 8192;
    if (c < 64) {
      uint4* dst = (uint4*)(base + c * 64);
#pragma unroll
      for (int q = 0; q < 8; ++q)
        dst[q] = make_uint4(pack2(r[8 * q], r[8 * q + 1]), pack2(r[8 * q + 2], r[8 * q + 3]), pack2(r[8 * q + 4], r[8 * q + 5]),
                            pack2(r[8 * q + 6], r[8 * q + 7]));
    } else {
      u16* dst = base + 4096 + (c - 64);
#pragma unroll
      for (int i = 0; i < 64; ++i) dst[i * 64] = f2bf(r[i]);
    }
  }
}

DI f32x4 mma_t(const u16* X, int xr, const u16* Y, int yr, f32x4 acc, int fr, int fq) {
#pragma unroll
  for (int kk = 0; kk < 2; ++kk) {
    const bf16x8 x = *(const bf16x8*)(X + (xr + fr) * 72 + kk * 32 + fq * 8);
    const bf16x8 y = *(const bf16x8*)(Y + (yr + fr) * 72 + kk * 32 + fq * 8);
    acc = mfma16(x, y, acc);
  }
  return acc;
}
DI f32x4 mma_t_swz(const u16* X, int xr, const u16* Y, int yr, f32x4 acc, int fr, int fq) {
  const int sw = ((xr + fr) >> 3) & 7;
#pragma unroll
  for (int kk = 0; kk < 2; ++kk) {
    const bf16x8 x = *(const bf16x8*)(X + (xr + fr) * 72 + (((kk * 4 + fq) ^ sw) * 8));
    const bf16x8 y = *(const bf16x8*)(Y + (yr + fr) * 72 + kk * 32 + fq * 8);
    acc = mfma16(x, y, acc);
  }
  return acc;
}

DI void gdn_scan(const Params& p, int item, char* smem) {
  const int tid = my_tid(), lane = tid & 63, w = tid >> 6;
  const int fr = lane & 15, fq = lane >> 4;
  const int chain = item >> 2, eq = item & 3;
  const int s = chain >> 3, h = (chain >> 1) & 3, d = chain & 1;
  const int sb = s == 0 ? 0 : TP + (s - 1) * 4096;
  const int nch = s == 0 ? 256 : 64;
  u16* St = (u16*)smem;
  u16* Vt = St + 16 * 72;
  u16* Vts = Vt + 16 * 72;
  u16* Wc = Vts + 16 * 72;
  u16* Qc = Wc + 64 * 72;
  u16* Kc = Qc + 64 * 72;
  u16* KcT = Kc + 64 * 72;
  u16* QKm = KcT + 64 * 72;
  float* gcs = (float*)(QKm + 64 * 72);
  u16* proj = (u16*)(p.ws + OFF_PROJ);
  const u16* QN = (const u16*)(p.ws + OFF_QN);
  const u16* KN = (const u16*)(p.ws + OFF_KN);
  const float* GC = (const float*)(p.ws + OFF_GC);
  const u16* UW = (const u16*)(p.ws + OFF_UW);
  __syncthreads();
  for (int i = tid; i < 16 * 72; i += 256) St[i] = 0;
  f32x4 S0 = (f32x4){0.f, 0.f, 0.f, 0.f};
  const int prow0 = tid >> 3, prow1 = (tid >> 3) + 32, pseg = (tid & 7) * 8;
  uint4 w0a, w1a, q0a, q1a, k0a, k1a, w0b, w1b, q0b, q1b, k0b, k1b;
  uint2 u0a, u0b;
  float ga, gb;
#define GDN_PREFETCH2(J, S)                                                                          \
  {                                                                                                  \
    const int jj_ = (J) < nch ? (J) : nch - 1;                                                       \
    const int n_ = sb / 64 + (d ? nch - 1 - jj_ : jj_);                                              \
    const int c0_ = n_ * 64;                                                                         \
    const size_t tb_ = (size_t)((n_ * 4 + h) * 2 + d);                                               \
    const u16* ub_ = UW + tb_ * 8192;                                                                \
    const int tok0_ = c0_ + (d ? 63 - prow0 : prow0), tok1_ = c0_ + (d ? 63 - prow1 : prow1);        \
    w0##S = *(const uint4*)(ub_ + 4096 + prow0 * 64 + pseg);                                         \
    w1##S = *(const uint4*)(ub_ + 4096 + prow1 * 64 + pseg);                                         \
    q0##S = *(const uint4*)(QN + (size_t)tok0_ * 256 + h * 64 + pseg);                               \
    q1##S = *(const uint4*)(QN + (size_t)tok1_ * 256 + h * 64 + pseg);                               \
    k0##S = *(const uint4*)(KN + (size_t)tok0_ * 256 + h * 64 + pseg);                               \
    k1##S = *(const uint4*)(KN + (size_t)tok1_ * 256 + h * 64 + pseg);                               \
    u0##S = *(const uint2*)(ub_ + (eq * 16 + fr) * 64 + w * 16 + fq * 4);                            \
    g##S = GC[tb_ * 64 + lane];                                                                      \
  }
#define GDN_STAGE2(ROW, PW, PQ, PK)                                                                  \
  {                                                                                                  \
    *(uint4*)(Wc + (ROW) * 72 + pseg) = PW;                                                          \
    *(uint4*)(Qc + (ROW) * 72 + pseg) = PQ;                                                          \
    *(uint4*)(Kc + (ROW) * 72 + pseg) = PK;                                                          \
    u16* kt_ = KcT + pseg * 72 + ((((ROW) >> 3) ^ (tid & 7)) * 8) + ((ROW) & 7);                     \
    kt_[0 * 72] = (u16)(PK.x & 0xffff); kt_[1 * 72] = (u16)(PK.x >> 16);                             \
    kt_[2 * 72] = (u16)(PK.y & 0xffff); kt_[3 * 72] = (u16)(PK.y >> 16);                             \
    kt_[4 * 72] = (u16)(PK.z & 0xffff); kt_[5 * 72] = (u16)(PK.z >> 16);                             \
    kt_[6 * 72] = (u16)(PK.w & 0xffff); kt_[7 * 72] = (u16)(PK.w >> 16);                             \
  }
#define GDN_STEP(JV, S)                                                                              \
  {                                                                                                  \
    const int j_ = (JV);                                                                             \
    const int n = sb / 64 + (d ? nch - 1 - j_ : j_);                                                 \
    const int c0 = n * 64;                                                                           \
    GDN_STAGE2(prow0, w0##S, q0##S, k0##S)                                                           \
    GDN_STAGE2(prow1, w1##S, q1##S, k1##S)                                                           \
    if (tid < 64) gcs[tid] = g##S;                                                                   \
    const uint2 cu0 = u0##S;                                                                         \
    __syncthreads();                                                                          \
    GDN_PREFETCH2(j_ + 2, S)                                                                         \
    const f32x4 z4 = (f32x4){0.f, 0.f, 0.f, 0.f};                                                    \
    const f32x4 P1a = mma_t(Wc, w * 16, St, 0, z4, fr, fq);                                          \
    const f32x4 P2a = mma_t(St, 0, Qc, w * 16, z4, fr, fq);                                          \
      \
    const float glog = gcs[63];                                                                      \
    const float gcc = gcs[w * 16 + fr];                                                              \
    const float4 gq0 = *(const float4*)(gcs + fq * 4), gq1 = *(const float4*)(gcs + 16 + fq * 4);    \
    const float4 gq2 = *(const float4*)(gcs + 32 + fq * 4), gq3 = *(const float4*)(gcs + 48 + fq * 4); \
    const float4 gw = *(const float4*)(gcs + w * 16 + fq * 4);                                       \
    {                                                                                                \
      const int c = w * 16 + fr;                                                                     \
      _Pragma("unroll") for (int t = 0; t < 4; ++t) {                                                \
        const f32x4 qk = mma_t(Kc, t * 16, Qc, w * 16, z4, fr, fq);                                  \
        const int s0 = t * 16 + fq * 4;                                                              \
        const float4 gs = t == 0 ? gq0 : t == 1 ? gq1 : t == 2 ? gq2 : gq3;                          \
        const float e0 = __expf(fminf(gcc - gs.x, 0.f)), e1 = __expf(fminf(gcc - gs.y, 0.f));       \
        const float e2 = __expf(fminf(gcc - gs.z, 0.f)), e3 = __expf(fminf(gcc - gs.w, 0.f));       \
        const float v0 = (c >= s0 + 0) ? qk[0] * e0 : 0.f;                                           \
        const float v1 = (c >= s0 + 1) ? qk[1] * e1 : 0.f;                                           \
        const float v2 = (c >= s0 + 2) ? qk[2] * e2 : 0.f;                                           \
        const float v3 = (c >= s0 + 3) ? qk[3] * e3 : 0.f;                                           \
        uint2 o; o.x = pack2(v0, v1); o.y = pack2(v2, v3);                                           \
        *(uint2*)(QKm + c * 72 + s0) = o;                                                            \
      }                                                                                              \
    }                                                                                                \
    {                                                                                                \
      const int cc0 = w * 16 + fq * 4;                                                               \
      const float v0 = bf2f((u16)(cu0.x & 0xffff)) - P1a[0], v1 = bf2f((u16)(cu0.x >> 16)) - P1a[1]; \
      const float v2 = bf2f((u16)(cu0.y & 0xffff)) - P1a[2], v3 = bf2f((u16)(cu0.y >> 16)) - P1a[3]; \
      uint2 o; o.x = pack2(v0, v1); o.y = pack2(v2, v3);                                             \
      *(uint2*)(Vt + fr * 72 + cc0) = o;                                                             \
      uint2 o2;                                                                                      \
      o2.x = pack2(v0 * __expf(glog - gw.x), v1 * __expf(glog - gw.y));                              \
      o2.y = pack2(v2 * __expf(glog - gw.z), v3 * __expf(glog - gw.w));                              \
      *(uint2*)(Vts + fr * 72 + cc0) = o2;                                                           \
    }                                                                                                \
    __syncthreads();                                                                          \
    {                                                                                                \
      const int c = w * 16 + fr;                                                                     \
      const float eg = __expf(gcc);                                                                  \
      const int tok = c0 + (d ? 63 - c : c);                                                         \
      u16* orow = proj + (size_t)tok * INW + d * 256 + h * 64 + eq * 16 + fq * 4;                    \
      f32x4 oa = P2a * eg;                                                                           \
      oa = mma_t(Vt, 0, QKm, w * 16, oa, fr, fq);                                                    \
      uint2 o; o.x = pack2(oa[0], oa[1]); o.y = pack2(oa[2], oa[3]);                                 \
      *(uint2*)(orow) = o;                                                                           \
    }                                                                                                \
    {                                                                                                \
      const float gl = __expf(glog);                                                                 \
      S0 *= gl;                                                                                      \
      S0 = mma_t_swz(KcT, w * 16, Vts, 0, S0, fr, fq);                                               \
      const int r0 = w * 16 + fq * 4;                                                                \
      uint2 o; o.x = pack2(S0[0], S0[1]); o.y = pack2(S0[2], S0[3]);                                 \
      *(uint2*)(St + fr * 72 + r0) = o;                                                              \
    }                                                                                                \
    __syncthreads();                                                                          \
  }
  GDN_PREFETCH2(0, a)
  GDN_PREFETCH2(1, b)
  for (int j = 0; j < nch; j += 2) {
    GDN_STEP(j, a)
    GDN_STEP(j + 1, b)
  }
}

DI void gdn_post_row(const Params& p, int layer, int t) {
  const int lane = my_tid() & 63;
  u16* row = (u16*)(p.ws + OFF_PROJ) + (size_t)t * INW;
  const uint2 f = *(const uint2*)(row + lane * 4);
  const uint2 bw = *(const uint2*)(row + 256 + lane * 4);
  const uint2 z = *(const uint2*)(row + C_AZ + lane * 4);
  float o[4], zz[4];
  o[0] = bf2f((u16)(f.x & 0xffff)) + bf2f((u16)(bw.x & 0xffff));
  o[1] = bf2f((u16)(f.x >> 16)) + bf2f((u16)(bw.x >> 16));
  o[2] = bf2f((u16)(f.y & 0xffff)) + bf2f((u16)(bw.y & 0xffff));
  o[3] = bf2f((u16)(f.y >> 16)) + bf2f((u16)(bw.y >> 16));
  zz[0] = bf2f((u16)(z.x & 0xffff)); zz[1] = bf2f((u16)(z.x >> 16)); zz[2] = bf2f((u16)(z.y & 0xffff)); zz[3] = bf2f((u16)(z.y >> 16));
  float ss = o[0] * o[0] + o[1] * o[1] + o[2] * o[2] + o[3] * o[3];
#pragma unroll
  for (int m = 1; m < 16; m <<= 1) ss += __shfl_xor(ss, m, 64);
  const float rs = rsqrtf(ss * (1.f / 64.f) + EPS);
  const int e0 = (lane & 15) * 4;
  float r[4];
#pragma unroll
  for (int j = 0; j < 4; ++j) r[j] = o[j] * rs * p.a_norm[layer * 64 + e0 + j] * siluf_(zz[j]);
  uint2 ov; ov.x = pack2(r[0], r[1]); ov.y = pack2(r[2], r[3]);
  *(uint2*)(row + C_AZ + lane * 4) = ov;
}

struct S5Const { float are, aim; float bpr[16], bpi[16]; };
DI void s5_consts(const Params& p, int layer, int d, int g, int lane, S5Const& k, float& lr, float& li, float& step) {
  const int gi = ((layer * 2 + d) * 16 + g);
  lr = p.lam_re[(size_t)gi * 64 + lane];
  li = p.lam_im[(size_t)gi * 64 + lane];
  step = expf(p.log_step[gi]);
  const float mag = expf(lr * step);
  float sn, cs; sincosf(li * step, &sn, &cs);
  k.are = mag * cs; k.aim = mag * sn;
  const float inv = 1.f / (lr * lr + li * li);
  const float ir = lr * inv, ii = -li * inv;
  const float cr = (k.are - 1.f) * ir - k.aim * ii;
  const float ci = (k.are - 1.f) * ii + k.aim * ir;
  const float* br = p.b_re + ((size_t)(layer * 16 + g) * 64 + lane) * 16;
  const float* bi = p.b_im + ((size_t)(layer * 16 + g) * 64 + lane) * 16;
#pragma unroll
  for (int c = 0; c < 16; ++c) {
    const float a = br[c], b = bi[c];
    k.bpr[c] = cr * a - ci * b;
    k.bpi[c] = cr * b + ci * a;
  }
}
DI void s5_stage_u(const Params& p, int c0, int gq, float* us) {
  const u16* proj = (const u16*)(p.ws + OFF_PROJ);
  const int tid = my_tid();
#pragma unroll
  for (int i = 0; i < 4; ++i) {
    const int idx = tid + 256 * i, tok = idx >> 4, c4 = (idx & 15) * 4;
    const uint2 v = *(const uint2*)(proj + (size_t)(c0 + tok) * INW + C_CU + gq * 64 + c4);
    us[tok * 64 + c4 + 0] = bf2f((u16)(v.x & 0xffff));
    us[tok * 64 + c4 + 1] = bf2f((u16)(v.x >> 16));
    us[tok * 64 + c4 + 2] = bf2f((u16)(v.y & 0xffff));
    us[tok * 64 + c4 + 3] = bf2f((u16)(v.y >> 16));
  }
}
DI void s5_step(const S5Const& k, const float* u, float& sr, float& si) {
  float xr = 0.f, xi = 0.f;
#pragma unroll
  for (int c4 = 0; c4 < 4; ++c4) {
    const float4 uu = *(const float4*)(u + c4 * 4);
    xr += k.bpr[c4 * 4 + 0] * uu.x + k.bpr[c4 * 4 + 1] * uu.y + k.bpr[c4 * 4 + 2] * uu.z + k.bpr[c4 * 4 + 3] * uu.w;
    xi += k.bpi[c4 * 4 + 0] * uu.x + k.bpi[c4 * 4 + 1] * uu.y + k.bpi[c4 * 4 + 2] * uu.z + k.bpi[c4 * 4 + 3] * uu.w;
  }
  const float nr = k.are * sr - k.aim * si + xr;
  const float ni = k.are * si + k.aim * sr + xi;
  sr = nr; si = ni;
}
DI void s5_pass1(const Params& p, int layer, int task, char* smem) {
  const int lane = my_tid() & 63, wave = my_tid() >> 6;
  const int n = task >> 2, gq = task & 3, g = gq * 4 + wave, c0 = n * 64;
  float* us = (float*)smem;
  float2* SEND = (float2*)(p.ws + OFF_SEND);
  __syncthreads();
  s5_stage_u(p, c0, gq, us);
  __syncthreads();
#pragma unroll 1
  for (int d = 0; d < 2; ++d) {
    S5Const k; float lr, li, step;
    s5_consts(p, layer, d, g, lane, k, lr, li, step);
    float sr = 0.f, si = 0.f;
#pragma unroll 4
    for (int i = 0; i < 64; ++i) {
      const int t = d ? 63 - i : i;
      s5_step(k, us + t * 64 + wave * 16, sr, si);
    }
    SEND[((size_t)(n * 2 + d) * 16 + g) * 64 + lane] = make_float2(sr, si);
  }
}
DI float gelu_tanh(float x) {
  const float u = 0.7978845608028654f * (x + 0.044715f * x * x * x);
  return 0.5f * x * (1.f + tanhf(u));
}
DI void s5_pass3(const Params& p, int layer, int task, char* smem) {
  const int lane = my_tid() & 63, wave = my_tid() >> 6;
  const int fr = lane & 15, fq = lane >> 4;
  const int n = task >> 2, gq = task & 3, g = gq * 4 + wave, c0 = n * 64;
  const int nlo = seq_lo(c0) / 64, nhi = seq_hi(c0) / 64;
  float* us = (float*)smem;
  u16* Sb = (u16*)(smem + 16384) + wave * 16 * 136;
  const float2* SEND = (const float2*)(p.ws + OFF_SEND);
  u16* Gb = (u16*)(p.ws + OFF_G);
  __syncthreads();
  s5_stage_u(p, c0, gq, us);
  __syncthreads();
  f32x4 yacc[4];
#pragma unroll
  for (int tb = 0; tb < 4; ++tb) yacc[tb] = (f32x4){0.f, 0.f, 0.f, 0.f};
#pragma unroll
  for (int d = 0; d < 2; ++d) {
    S5Const k; float lr, li, step;
    s5_consts(p, layer, d, g, lane, k, lr, li, step);
    const float m64 = expf(lr * step * 64.f);
    float s64, c64; sincosf(li * step * 64.f, &s64, &c64);
    const float a64r = m64 * c64, a64i = m64 * s64;
    float sr = 0.f, si = 0.f;
    {
      const int cnt = d == 0 ? n - nlo : nhi - 1 - n;
      const int first = d == 0 ? nlo : nhi - 1;
      const int sgn = d == 0 ? 1 : -1;
      const float2* sp = SEND + ((size_t)(first * 2 + d) * 16 + g) * 64 + lane;
      const long stride = (long)sgn * 2 * 16 * 64;
      int m = 0;
      for (; m + 8 <= cnt; m += 8) {
        float2 e0 = sp[0], e1 = sp[stride], e2 = sp[2 * stride], e3 = sp[3 * stride];
        float2 e4 = sp[4 * stride], e5 = sp[5 * stride], e6 = sp[6 * stride], e7 = sp[7 * stride];
        sp += 8 * stride;
#define HSTEP(E) { const float nr = a64r * sr - a64i * si + E.x, ni = a64r * si + a64i * sr + E.y; sr = nr; si = ni; }
        HSTEP(e0) HSTEP(e1) HSTEP(e2) HSTEP(e3) HSTEP(e4) HSTEP(e5) HSTEP(e6) HSTEP(e7)
      }
      for (; m < cnt; ++m) {
        const float2 e = sp[0];
        sp += stride;
        HSTEP(e)
      }
    }
    bf16x8 cf[4];
    {
      const float* cr = p.c_re + ((size_t)((layer * 2 + d) * 16 + g) * 16 + fr) * 64;
      const float* ci = p.c_im + ((size_t)((layer * 2 + d) * 16 + g) * 16 + fr) * 64;
#pragma unroll
      for (int kk = 0; kk < 4; ++kk)
#pragma unroll
        for (int e = 0; e < 8; ++e) {
          const int kx = (kk & 1) * 32 + fq * 8 + e;
          const float v = (kk < 2) ? cr[kx] : -ci[kx];
          cf[kk][e] = (short)f2bf(v);
        }
    }
#pragma unroll
    for (int blk = 0; blk < 4; ++blk) {
      const int tb = d ? 3 - blk : blk;
#pragma unroll 4
      for (int i = 0; i < 16; ++i) {
        const int r = d ? 15 - i : i;
        const int t = tb * 16 + r;
        s5_step(k, us + t * 64 + wave * 16, sr, si);
        Sb[r * 136 + lane] = f2bf(sr);
        Sb[r * 136 + 64 + lane] = f2bf(si);
      }
      __syncthreads();
#pragma unroll
      for (int kk = 0; kk < 4; ++kk) {
        const bf16x8 xf = *(const bf16x8*)(Sb + fr * 136 + kk * 32 + fq * 8);
        yacc[tb] = mfma16(xf, cf[kk], yacc[tb]);
      }
      __syncthreads();
    }
  }
  const float dsk = p.s5_d[layer * 256 + g * 16 + fr];
#pragma unroll
  for (int tb = 0; tb < 4; ++tb)
#pragma unroll
    for (int j = 0; j < 4; ++j) {
      const int t = tb * 16 + fq * 4 + j;
      const float y = yacc[tb][j] + us[t * 64 + wave * 16 + fr] * dsk;
      Gb[(size_t)(c0 + t) * 256 + g * 16 + fr] = f2bf(gelu_tanh(y));
    }
}

struct AttnState { float m, l; f32x4 o[4]; };
DI void attn_segment(const u16* proj, int kcol, int vcol, int tk0, int kstride, int npairs, int R, float slope, int tq,
                     int lo, int hi, const bf16x8 (&qf)[2], AttnState& st, u16* Vt, int lane) {
  const int fr = lane & 15, fq = lane >> 4;
#pragma unroll 1
  for (int pr = 0; pr < npairs; ++pr) {
    const int kbase = tk0 + pr * 32 * kstride;
    f32x4 sacc[2];
#pragma unroll
    for (int t = 0; t < 2; ++t) {
      int tk = kbase + (t * 16 + fr) * kstride;
      tk = min(max(tk, lo), hi - 1);
      const u16* kp = proj + (size_t)tk * INW + kcol + fq * 8;
      const bf16x8 k0 = *(const bf16x8*)(kp), k1 = *(const bf16x8*)(kp + 32);
      sacc[t] = mfma16(k0, qf[0], (f32x4){0.f, 0.f, 0.f, 0.f});
      sacc[t] = mfma16(k1, qf[1], sacc[t]);
    }
    uint4 vr[4];
#pragma unroll
    for (int i = 0; i < 4; ++i) {
      const int idx = lane + 64 * i, kl = idx >> 3, seg = (idx & 7) * 8;
      int tk = kbase + kl * kstride;
      tk = min(max(tk, lo), hi - 1);
      vr[i] = *(const uint4*)(proj + (size_t)tk * INW + vcol + seg);
    }
    float sc[2][4]; bool ok[2][4];
    float mx = -1e30f;
#pragma unroll
    for (int t = 0; t < 2; ++t)
#pragma unroll
      for (int j = 0; j < 4; ++j) {
        const int tk = kbase + (t * 16 + fq * 4 + j) * kstride;
        const int ad = abs(tk - tq);
        ok[t][j] = (ad <= R) && (tk >= lo) && (tk < hi);
        sc[t][j] = sacc[t][j] * 0.125f - slope * (float)ad;
        if (ok[t][j]) mx = fmaxf(mx, sc[t][j]);
      }
    mx = fmaxf(mx, __shfl_xor(mx, 16, 64));
    mx = fmaxf(mx, __shfl_xor(mx, 32, 64));
    const float mn = fmaxf(st.m, mx);
    const float alpha = __expf(st.m - mn);
    st.m = mn;
    float pv[2][4], ps = 0.f;
#pragma unroll
    for (int t = 0; t < 2; ++t)
#pragma unroll
      for (int j = 0; j < 4; ++j) { pv[t][j] = ok[t][j] ? __expf(sc[t][j] - mn) : 0.f; ps += pv[t][j]; }
    st.l = st.l * alpha + ps;
#pragma unroll
    for (int dt = 0; dt < 4; ++dt)
#pragma unroll
      for (int j = 0; j < 4; ++j) st.o[dt][j] *= alpha;
    bf16x8 pf;
    {
      const unsigned w0 = pack2(pv[0][0], pv[0][1]), w1 = pack2(pv[0][2], pv[0][3]), w2 = pack2(pv[1][0], pv[1][1]),
                     w3 = pack2(pv[1][2], pv[1][3]);
      uint4 t4 = make_uint4(w0, w1, w2, w3);
      pf = __builtin_bit_cast(bf16x8, t4);
    }
    __syncthreads();
#pragma unroll
    for (int i = 0; i < 4; ++i) {
      const int idx = lane + 64 * i, kl = idx >> 3, seg = (idx & 7) * 8;
      Vt[(seg + 0) * 36 + kl] = (u16)(vr[i].x & 0xffff); Vt[(seg + 1) * 36 + kl] = (u16)(vr[i].x >> 16);
      Vt[(seg + 2) * 36 + kl] = (u16)(vr[i].y & 0xffff); Vt[(seg + 3) * 36 + kl] = (u16)(vr[i].y >> 16);
      Vt[(seg + 4) * 36 + kl] = (u16)(vr[i].z & 0xffff); Vt[(seg + 5) * 36 + kl] = (u16)(vr[i].z >> 16);
      Vt[(seg + 6) * 36 + kl] = (u16)(vr[i].w & 0xffff); Vt[(seg + 7) * 36 + kl] = (u16)(vr[i].w >> 16);
    }
    __syncthreads();
#pragma unroll
    for (int dt = 0; dt < 4; ++dt) {
      const uint2 v0 = *(const uint2*)(Vt + (dt * 16 + fr) * 36 + fq * 4);
      const uint2 v1 = *(const uint2*)(Vt + (dt * 16 + fr) * 36 + 16 + fq * 4);
      uint4 t4 = make_uint4(v0.x, v0.y, v1.x, v1.y);
      const bf16x8 vf = __builtin_bit_cast(bf16x8, t4);
      st.o[dt] = mfma16(vf, pf, st.o[dt]);
    }
  }
}
DI void attn_task(const Params& p, int layer, int mode, int task, char* smem) {
  const int lane = my_tid() & 63, wave = my_tid() >> 6;
  const int fr = lane & 15, fq = lane >> 4;
  u16* proj = (u16*)(p.ws + OFF_PROJ);
  u16* Vt = (u16*)smem + wave * 64 * 36;
  int tq0, qstride, qcol, kcol, vcol; float slope;
  int hq;
  if (mode == 0) {
    const int blk = task >> 4, h = (task >> 2) & 3, rq = task & 3;
    hq = h; tq0 = blk * 256 + rq * 4 + wave; qstride = 16;
    qcol = C_BQ + h * 64; kcol = C_BK + h * 64; vcol = C_BV + h * 64;
    slope = exp2f(-(float)(5 + h));
  } else {
    const int blk = task >> 2, qh = task & 3;
    hq = qh; tq0 = blk * 64 + wave * 16; qstride = 1;
    qcol = C_DQ + qh * 64; kcol = C_DK + (qh >> 1) * 64; vcol = C_DV + (qh >> 1) * 64;
    slope = exp2f(-(float)(1 + qh));
  }
  const int lo = seq_lo(tq0), hi = seq_hi(tq0);
  const int tq = tq0 + fr * qstride;
  bf16x8 qf[2];
  {
    const u16* qp = proj + (size_t)tq * INW + qcol + fq * 8;
    qf[0] = *(const bf16x8*)(qp); qf[1] = *(const bf16x8*)(qp + 32);
  }
  AttnState st; st.m = -1e30f; st.l = 0.f;
#pragma unroll
  for (int dt = 0; dt < 4; ++dt) st.o[dt] = (f32x4){0.f, 0.f, 0.f, 0.f};
  __syncthreads();
  float scale;
  if (mode == 0) {
    attn_segment(proj, kcol, vcol, tq0 - 64, 1, 12, 64, slope, tq, lo, hi, qf, st, Vt, lane);
    attn_segment(proj, kcol, vcol, tq0 - 256, 4, 6, 256, slope, tq, lo, hi, qf, st, Vt, lane);
    attn_segment(proj, kcol, vcol, tq0 - 1024, 16, 5, 1024, slope, tq, lo, hi, qf, st, Vt, lane);
    float l = st.l; l += __shfl_xor(l, 16, 64); l += __shfl_xor(l, 32, 64);
    scale = 1.f / l;
  } else {
    attn_segment(proj, kcol, vcol, tq0 - 128, 1, 9, 128, slope, tq, lo, hi, qf, st, Vt, lane);
    float l = st.l; l += __shfl_xor(l, 16, 64); l += __shfl_xor(l, 32, 64);
    const float sink = p.attn_sink[layer * 4 + hq];
    const float mf = fmaxf(st.m, sink);
    const float sc = __expf(st.m - mf);
    scale = sc / (l * sc + __expf(sink - mf));
  }
#pragma unroll
  for (int dt = 0; dt < 4; ++dt) {
    uint2 o; o.x = pack2(st.o[dt][0] * scale, st.o[dt][1] * scale); o.y = pack2(st.o[dt][2] * scale, st.o[dt][3] * scale);
    *(uint2*)(proj + (size_t)tq * INW + qcol + dt * 16 + fq * 4) = o;
  }
}

DI void final_row(const Params& p, int t) {
  const int lane = my_tid() & 63;
  float* row = p.xout + (size_t)t * DM;
  float4 v[4]; float ss = 0.f;
#pragma unroll
  for (int i = 0; i < 4; ++i) {
    v[i] = *(const float4*)(row + i * 256 + lane * 4);
    ss += v[i].x * v[i].x + v[i].y * v[i].y + v[i].z * v[i].z + v[i].w * v[i].w;
  }
  ss = wave_sum(ss);
  const float rs = rsqrtf(ss * (1.f / DM) + EPS);
#pragma unroll
  for (int i = 0; i < 4; ++i) {
    const float4 g = *(const float4*)(p.final_norm + i * 256 + lane * 4);
    *(float4*)(row + i * 256 + lane * 4) = make_float4(v[i].x * rs * g.x, v[i].y * rs * g.y, v[i].z * rs * g.z, v[i].w * rs * g.w);
  }
}

enum { PH_NORM1 = 0, PH_INPROJ, PH_MIX1, PH_MIX2, PH_MIX3, PH_MERGE, PH_OUT, PH_NORM2, PH_FFN1, PH_FFN2, PH_PER_LAYER, PH_FINAL = 100 };

DI void run_phase(const Params& p, int ph, int layer, char* smem) {
  const int b = blockIdx.x, G = gridDim.x;
  const int wave = my_tid() >> 6;
  switch (ph) {
    case PH_NORM1: {
      if (layer == 0) {
        for (int t = b; t < 2 * CONV_TILES_LAYER; t += G) {
          ConvJob j;
          const int lt = conv_lookup(p, t, j);
          conv_tile(j, lt, (float*)smem);
        }
      }
      if (b == 0 && my_tid() == 0) *(unsigned*)(p.ws + OFF_CNT) = 0u;
      rms_phase(p, layer, p.norm1 + layer * DM, (u16*)(p.ws + OFF_H), b, G);
    } break;
    case PH_INPROJ: gemm_inproj(p, layer, b, G, (u16*)smem); break;
    case PH_MIX1: {
      for (int t = b; t < 4 * 3072; t += G) {
        const int kind = t / 3072, idx = t % 3072;
        if (kind == 0) gdn_pre(p, layer, idx, smem);
        else if (kind == 1) attn_task(p, layer, 0, idx, smem);
        else if (kind == 2) attn_task(p, layer, 1, idx, smem);
        else s5_pass1(p, layer, idx, smem);
      }
    } break;
    case PH_MIX2: {
      for (int c = b; c < 288; c += G) gdn_scan(p, c, smem);
      {
        unsigned* cnt = (unsigned*)(p.ws + OFF_CNT);
        int* slot = (int*)(smem + SMEM_BYTES - 16);
        for (;;) {
          __syncthreads();
          if (my_tid() == 0) *slot = (int)atomicAdd(cnt, 1u);
          __syncthreads();
          const int t = *slot;
          if (t >= 3072) break;
          s5_pass3(p, layer, t, smem);
        }
      }
    } break;
    case PH_MIX3: {
      gemm_glu(p, layer, b, G, (u16*)smem);
      for (int t = b * 4 + wave; t < T; t += G * 4) gdn_post_row(p, layer, t);
      rms_phase(p, layer, p.norm1 + layer * DM, (u16*)(p.ws + OFF_H), b, G);
    } break;
    case PH_MERGE: gemm_merge(p, layer, b, G, (u16*)smem); break;
    case PH_OUT:
      gemm_resid(p, layer, (const u16*)(p.ws + OFF_MERGED), DM, (const u16*)(p.ws + OFF_W) + layer * W_LAYER + WO_OUT, b, G, (u16*)smem);
      break;
    case PH_NORM2: rms_phase(p, 1, p.norm2 + layer * DM, (u16*)(p.ws + OFF_H2), b, G); break;
    case PH_FFN1: gemm_ffn1(p, layer, b, G, (u16*)smem); break;
    case PH_FFN2:
      gemm_resid(p, 1, (const u16*)(p.ws + OFF_ACT), FH, (const u16*)(p.ws + OFF_W) + layer * W_LAYER + WO_DN, b, G, (u16*)smem);
      break;
    case PH_FINAL:
      for (int t = b * 4 + wave; t < T; t += G * 4) final_row(p, t);
      break;
    default: break;
  }
}

#if !MEGA
__global__ void __launch_bounds__(256, 2) k_phase(Params p, int ph, int layer) {
  __shared__ __attribute__((aligned(16))) char smem[SMEM_BYTES];
  run_phase(p, ph, layer, smem);
}

#else
__global__ void __launch_bounds__(256, 2) k_mega(Params p) {
  __shared__ __attribute__((aligned(16))) char smem[SMEM_BYTES];
  cg::grid_group grid = cg::this_grid();
  for (int layer = 0; layer < 2; ++layer)
    for (int ph = 0; ph < PH_PER_LAYER; ++ph) {
      run_phase(p, ph, layer, smem);
      grid.sync();
#ifdef PROBE_DUP
      if (ph == PROBE_DUP) { run_phase(p, ph, layer, smem); grid.sync(); }
#endif
    }
  run_phase(p, PH_FINAL, 0, smem);
}
#endif

extern "C" void kernel_launch(void* const* d_in, const int* in_sizes, int n_in, void* d_out, int out_size, void* d_ws,
                              size_t ws_size, hipStream_t stream) {
  (void)in_sizes; (void)n_in; (void)out_size;
  if (ws_size < WS_NEED) { fprintf(stderr, "workspace too small: %zu < %zu\n", ws_size, (size_t)WS_NEED); return; }
  Params p;
  memset(&p, 0, sizeof(p));
  const float* const* in = (const float* const*)d_in;
  p.x_prompt = in[0]; p.x_sample = in[1]; p.norm1 = in[2]; p.conv_a = in[4]; p.a_log = in[5]; p.dt_bias = in[6];
  p.a_norm = in[7]; p.lam_re = in[8]; p.lam_im = in[9]; p.log_step = in[10]; p.b_re = in[11]; p.b_im = in[12];
  p.c_re = in[13]; p.c_im = in[14]; p.s5_d = in[15]; p.attn_sink = in[17]; p.norm2 = in[21]; p.final_norm = in[25];
  p.xout = (float*)d_out;
  p.ws = (char*)d_ws;
  p.w_in = in[3]; p.w_glu = in[16]; p.w_gate = in[18]; p.w_branch = in[19]; p.w_out = in[20];
  p.w_ffn_gate = in[22]; p.w_ffn_up = in[23]; p.w_ffn_down = in[24];
  static int grid_blocks = 0;
  if (!grid_blocks) {
    int dev = 0, cus = 0, per_cu = 0;
    hipGetDevice(&dev);
    hipDeviceGetAttribute(&cus, hipDeviceAttributeMultiprocessorCount, dev);
#if MEGA
    hipOccupancyMaxActiveBlocksPerMultiprocessor(&per_cu, k_mega, 256, 0);
#else
    hipOccupancyMaxActiveBlocksPerMultiprocessor(&per_cu, k_phase, 256, 0);
#endif
    per_cu = 2;
    grid_blocks = cus * per_cu;
  }
#if MEGA
  void* args[] = {&p};
  hipError_t e = hipLaunchCooperativeKernel((void*)k_mega, dim3(grid_blocks), dim3(256), args, 0, stream);
  if (e != hipSuccess) fprintf(stderr, "cooperative launch failed: %s (grid %d)\n", hipGetErrorString(e), grid_blocks);
#else
  for (int layer = 0; layer < 2; ++layer)
    for (int ph = 0; ph < PH_PER_LAYER; ++ph) hipLaunchKernelGGL(k_phase, dim3(grid_blocks), dim3(256), 0, stream, p, ph, layer);
  hipLaunchKernelGGL(k_phase, dim3(grid_blocks), dim3(256), 0, stream, p, (int)PH_FINAL, 0);
#endif
}
```

```cpp
#include <hip/hip_runtime.h>
#include <hip/hip_cooperative_groups.h>
#include <cstdio>
#include <cstring>
namespace cg = cooperative_groups;

#ifndef MEGA
#define MEGA 1
#endif

#define DI __device__ __forceinline__
typedef unsigned short u16;
typedef __attribute__((ext_vector_type(8))) short bf16x8;
typedef __attribute__((ext_vector_type(4))) float f32x4;

constexpr int T = 49152;
constexpr int TP = 16384;
constexpr int DM = 1024;
constexpr int INW = 2576;
constexpr int FH = 2816;
constexpr int NCH64 = T / 64;
constexpr float EPS = 1e-6f;

constexpr int C_AQ = 0, C_AK = 256, C_AV = 512, C_AZ = 768, C_BQ = 1040, C_BK = 1296, C_BV = 1552, C_CU = 1808,
              C_DQ = 2064, C_DK = 2320, C_DV = 2448;

constexpr size_t WO_IN = 0, WO_GATE = 2752512, WO_BR = 6946816, WO_OUT = 7995392, WO_GU = 9043968, WO_DN = 14811136,
                 WO_GLU = 17694720, W_LAYER = 17825792;
constexpr size_t OFF_W = 0;
constexpr size_t OFF_PROJ = 2 * W_LAYER * 2;
constexpr size_t SZ_PROJ = (size_t)T * INW * 2;
constexpr size_t OFF_R1 = OFF_PROJ + SZ_PROJ;
constexpr size_t SZ_H = (size_t)T * DM * 2;
constexpr size_t OFF_H = OFF_R1;
constexpr size_t OFF_UW = OFF_R1;
constexpr size_t OFF_QN = OFF_R1 + SZ_H;
constexpr size_t OFF_KN = OFF_QN + (size_t)T * 256 * 2;
constexpr size_t OFF_GC = OFF_KN + (size_t)T * 256 * 2;
constexpr size_t OFF_SEND = OFF_GC + (size_t)NCH64 * 8 * 64 * 4;
constexpr size_t OFF_G = OFF_SEND + (size_t)NCH64 * 2 * 1024 * 8;
constexpr size_t OFF_AB = OFF_G + (size_t)T * 256 * 2;
constexpr size_t OFF_CNT = OFF_AB + (size_t)T * 16 * 4;
constexpr size_t OFF_MERGED = OFF_R1 + SZ_H;
constexpr size_t OFF_H2 = OFF_MERGED;
constexpr size_t OFF_ACT = OFF_PROJ;
constexpr size_t OFF_BAR = OFF_MERGED + SZ_H;
constexpr size_t BAR_BYTES = 3456 * 4;
constexpr size_t WS_NEED = OFF_BAR + 16384;

constexpr int SMEM_BYTES = 75776;

struct ConvJob { const float* src; u16* dst; int K, ncols, nrows_dst, src_ld, rs, off, ntn; };
struct Params {
  const float *x_prompt, *x_sample, *norm1, *conv_a, *a_log, *dt_bias, *a_norm, *lam_re, *lam_im, *log_step, *b_re,
      *b_im, *c_re, *c_im, *s5_d, *attn_sink, *norm2, *final_norm;
  const float *w_in, *w_gate, *w_branch, *w_out, *w_ffn_gate, *w_ffn_up, *w_ffn_down, *w_glu;
  float* xout;
  char* ws;
};
constexpr int CONV_TILES_LAYER = 4352;

DI int my_tid() { int t = threadIdx.x; asm volatile("" : "+v"(t)); return t; }
DI u16 f2bf(float x) { unsigned u = __float_as_uint(x); u += 0x7fffu + ((u >> 16) & 1u); return (u16)(u >> 16); }
DI float bf2f(u16 v) { return __uint_as_float(((unsigned)v) << 16); }
DI unsigned pack2(float a, float b) { return (unsigned)f2bf(a) | ((unsigned)f2bf(b) << 16); }
DI float sigmoidf_(float x) { return 1.f / (1.f + __expf(-x)); }
DI float siluf_(float x) { return x / (1.f + __expf(-x)); }
DI float wave_sum(float v) {
#pragma unroll
  for (int o = 32; o > 0; o >>= 1) v += __shfl_xor(v, o, 64);
  return v;
}
DI int seq_lo(int t) { return t < TP ? 0 : (t & ~4095); }
DI int seq_hi(int t) { return t < TP ? TP : (t & ~4095) + 4096; }
DI const float* xrow(const Params& p, int layer, int t) {
  if (layer == 0) return t < TP ? p.x_prompt + (size_t)t * DM : p.x_sample + (size_t)(t - TP) * DM;
  return p.xout + (size_t)t * DM;
}
DI f32x4 mfma16(bf16x8 a, bf16x8 b, f32x4 c) { return __builtin_amdgcn_mfma_f32_16x16x32_bf16(a, b, c, 0, 0, 0); }

DI void mk_job(ConvJob& j, const float* src, u16* dst, int K, int ncols, int nrows_dst, int src_ld, int rs, int off) {
  j.src = src; j.dst = dst; j.K = K; j.ncols = ncols; j.nrows_dst = nrows_dst; j.src_ld = src_ld; j.rs = rs; j.off = off;
  j.ntn = (nrows_dst + 63) >> 6;
}
DI int conv_lookup(const Params& p, int t, ConvJob& j) {
  const int l = t / CONV_TILES_LAYER;
  int r = t % CONV_TILES_LAYER;
  u16* wl = (u16*)(p.ws + OFF_W) + (size_t)l * W_LAYER;
  if (r < 672) { mk_job(j, p.w_in + (size_t)l * DM * INW, wl + WO_IN, DM, INW, 2688, INW, 32, 0); return r; }
  r -= 672;
  if (r < 1024) { const int i = r >> 8; mk_job(j, p.w_gate + (size_t)(l * 4 + i) * DM * DM, wl + WO_GATE + (size_t)i * DM * DM, DM, DM, DM, DM, 32, 0); return r & 255; }
  r -= 1024;
  if (r < 256) { const int i = r >> 6; mk_job(j, p.w_branch + (size_t)(l * 4 + i) * 256 * DM, wl + WO_BR + (size_t)i * DM * 256, 256, DM, DM, DM, 32, 0); return r & 63; }
  r -= 256;
  if (r < 256) { mk_job(j, p.w_out + (size_t)l * DM * DM, wl + WO_OUT, DM, DM, DM, DM, 32, 0); return r; }
  r -= 256;
  if (r < 704) { mk_job(j, p.w_ffn_gate + (size_t)l * DM * FH, wl + WO_GU, DM, FH, FH, FH, 64, 0); return r; }
  r -= 704;
  if (r < 704) { mk_job(j, p.w_ffn_up + (size_t)l * DM * FH, wl + WO_GU, DM, FH, FH, FH, 64, 32); return r; }
  r -= 704;
  if (r < 704) { mk_job(j, p.w_ffn_down + (size_t)l * FH * DM, wl + WO_DN, FH, DM, DM, DM, 32, 0); return r; }
  r -= 704;
  if (r < 16) { mk_job(j, p.w_glu + (size_t)l * 256 * 512, wl + WO_GLU, 256, 256, 256, 512, 64, 0); return r; }
  r -= 16;
  mk_job(j, p.w_glu + (size_t)l * 256 * 512 + 256, wl + WO_GLU, 256, 256, 256, 512, 64, 32);
  return r;
}
DI void conv_tile(const ConvJob& j, int lt, float* tile) {
  const int tid = my_tid();
  const int tk = lt / j.ntn, tn = lt % j.ntn;
  __syncthreads();
#pragma unroll
  for (int i = 0; i < 4; ++i) {
    int r = (tid >> 4) + 16 * i, c4 = (tid & 15) * 4, n = tn * 64 + c4;
    float4 v = make_float4(0.f, 0.f, 0.f, 0.f);
    if (n < j.ncols) v = *(const float4*)(j.src + (size_t)(tk * 64 + r) * j.src_ld + n);
    tile[r * 65 + c4 + 0] = v.x; tile[r * 65 + c4 + 1] = v.y; tile[r * 65 + c4 + 2] = v.z; tile[r * 65 + c4 + 3] = v.w;
  }
  __syncthreads();
  const int cl = tid >> 2, ks = (tid & 3) * 16, n = tn * 64 + cl;
  if (n < j.nrows_dst) {
    unsigned w[8];
#pragma unroll
    for (int e = 0; e < 8; ++e) w[e] = pack2(tile[(ks + 2 * e) * 65 + cl], tile[(ks + 2 * e + 1) * 65 + cl]);
    const int nm = (n >> 5) * j.rs + (n & 31) + j.off;
    uint4* d = (uint4*)(j.dst + (size_t)nm * j.K + tk * 64 + ks);
    d[0] = make_uint4(w[0], w[1], w[2], w[3]);
    d[1] = make_uint4(w[4], w[5], w[6], w[7]);
  }
}

DI void rms_row_bf16(const float* src, const float* w, u16* dst) {
  const int lane = my_tid() & 63;
  float4 v[4];
  float ss = 0.f;
#pragma unroll
  for (int i = 0; i < 4; ++i) {
    v[i] = *(const float4*)(src + i * 256 + lane * 4);
    ss += v[i].x * v[i].x + v[i].y * v[i].y + v[i].z * v[i].z + v[i].w * v[i].w;
  }
  ss = wave_sum(ss);
  const float rs = rsqrtf(ss * (1.f / DM) + EPS);
#pragma unroll
  for (int i = 0; i < 4; ++i) {
    float4 g = *(const float4*)(w + i * 256 + lane * 4);
    uint2 o;
    o.x = pack2(v[i].x * rs * g.x, v[i].y * rs * g.y);
    o.y = pack2(v[i].z * rs * g.z, v[i].w * rs * g.w);
    *(uint2*)(dst + i * 256 + lane * 4) = o;
  }
}
DI void rms_phase(const Params& p, int layer, const float* w, u16* dst, int b0, int nb) {
  const int wave = my_tid() >> 6;
  for (int r = b0 * 4 + wave; r < T; r += nb * 4) rms_row_bf16(xrow(p, layer, r), w, dst + (size_t)r * DM);
}

constexpr int GP = 64;
#ifndef GEMM_DMA
#define GEMM_DMA 1
#endif
#if GEMM_DMA
template <int NT>
DI void gemm_kloop(const u16* __restrict__ A, size_t lda, const u16* __restrict__ B, size_t ldb, int nk,
                   f32x4 (&acc)[4][NT], u16* sm) {
  const int tid = my_tid(), lane = tid & 63;
  const int wave = __builtin_amdgcn_readfirstlane(tid >> 6);
  const int fr = lane & 15, fq = lane >> 4, wr = wave >> 1, wc = wave & 1;
  u16* sa = sm;
  u16* sb = sm + 2 * 128 * 64;
  const int swz = (fr >> 1) & 7;
  const int lr = lane >> 3;
  const int lc = ((lane & 7) ^ ((lr >> 1) & 3)) * 8;
#define DMA_PIECE(BASE, LD, G, KOFF, DST)                                                              \
  {                                                                                                    \
    const int row_ = (G) * 8 + lr;                                                                     \
    const int col_ = lc ^ ((((G) & 1) * 4) * 8);                                                       \
    __builtin_amdgcn_global_load_lds((const unsigned*)((BASE) + (size_t)row_ * (LD) + (KOFF) + col_),  \
                                     (unsigned*)((DST) + (G) * 512), 16, 0, 0);                        \
  }
#define DMA_TILE(KOFF, STAGE)                                                                          \
  {                                                                                                    \
    u16* da_ = sa + (STAGE) * 8192;                                                                    \
    u16* db_ = sb + (STAGE) * 8192;                                                                    \
    DMA_PIECE(A, lda, wave * 4 + 0, KOFF, da_) DMA_PIECE(A, lda, wave * 4 + 1, KOFF, da_)              \
    DMA_PIECE(A, lda, wave * 4 + 2, KOFF, da_) DMA_PIECE(A, lda, wave * 4 + 3, KOFF, da_)              \
    if (NT == 4) {                                                                                     \
      DMA_PIECE(B, ldb, wave * 4 + 0, KOFF, db_) DMA_PIECE(B, ldb, wave * 4 + 1, KOFF, db_)            \
      DMA_PIECE(B, ldb, wave * 4 + 2, KOFF, db_) DMA_PIECE(B, ldb, wave * 4 + 3, KOFF, db_)            \
    } else {                                                                                           \
      DMA_PIECE(B, ldb, wave * 2 + 0, KOFF, db_) DMA_PIECE(B, ldb, wave * 2 + 1, KOFF, db_)            \
    }                                                                                                  \
  }
  __builtin_amdgcn_s_barrier();
  DMA_TILE(0, 0)
#pragma unroll 1
  for (int kt = 0; kt < nk; ++kt) {
    const int cur = kt & 1;
    asm volatile("s_waitcnt vmcnt(0)" ::: "memory");
    __builtin_amdgcn_s_barrier();
    asm volatile("" ::: "memory");
    const u16* ca = sa + cur * 8192;
    const u16* cb = sb + cur * 8192;
    bf16x8 wf[2][NT], xf[2][4];
#pragma unroll
    for (int kk = 0; kk < 2; ++kk) {
#pragma unroll
      for (int nt = 0; nt < NT; ++nt) wf[kk][nt] = *(const bf16x8*)(cb + (wc * NT * 16 + nt * 16 + fr) * 64 + (((kk * 4 + fq) ^ swz) * 8));
#pragma unroll
      for (int mt = 0; mt < 4; ++mt) xf[kk][mt] = *(const bf16x8*)(ca + (wr * 64 + mt * 16 + fr) * 64 + (((kk * 4 + fq) ^ swz) * 8));
    }
    __builtin_amdgcn_sched_barrier(0);
    if (kt + 1 < nk) DMA_TILE((kt + 1) * 64, cur ^ 1)
    __builtin_amdgcn_sched_barrier(0);
#pragma unroll
    for (int kk = 0; kk < 2; ++kk)
#pragma unroll
      for (int mt = 0; mt < 4; ++mt)
#pragma unroll
        for (int nt = 0; nt < NT; ++nt) acc[mt][nt] = mfma16(wf[kk][nt], xf[kk][mt], acc[mt][nt]);
  }
}
#else
template <int NT>
DI void gemm_kloop(const u16* __restrict__ A, size_t lda, const u16* __restrict__ B, size_t ldb, int nk,
                   f32x4 (&acc)[4][NT], u16* sm) {
  const int tid = my_tid(), lane = tid & 63, wave = tid >> 6;
  const int fr = lane & 15, fq = lane >> 4, wr = wave >> 1, wc = wave & 1;
  u16* sa = sm;
  u16* sb = sm + 2 * 128 * GP;
  uint4 ra0, ra1, ra2, ra3, rb0, rb1, rb2 = make_uint4(0, 0, 0, 0), rb3 = make_uint4(0, 0, 0, 0);
  uint4 rc0, rc1, rc2, rc3, rd0, rd1, rd2 = make_uint4(0, 0, 0, 0), rd3 = make_uint4(0, 0, 0, 0);
  const int lrow = tid >> 3, lseg = (tid & 7) * 8;
  const int sseg = ((tid & 7) ^ ((lrow >> 1) & 7)) * 8;
  const u16* Ap = A + (size_t)lrow * lda + lseg;
  const u16* Bp = B + (size_t)lrow * ldb + lseg;
#define KL_LOAD(KOFF, A0, A1, A2, A3, B0, B1, B2, B3)                    \
  A0 = *(const uint4*)(Ap + (KOFF));                                     \
  A1 = *(const uint4*)(Ap + 32 * lda + (KOFF));                          \
  A2 = *(const uint4*)(Ap + 64 * lda + (KOFF));                          \
  A3 = *(const uint4*)(Ap + 96 * lda + (KOFF));                          \
  B0 = *(const uint4*)(Bp + (KOFF));                                     \
  B1 = *(const uint4*)(Bp + 32 * ldb + (KOFF));                          \
  if (NT > 2) { B2 = *(const uint4*)(Bp + 64 * ldb + (KOFF)); B3 = *(const uint4*)(Bp + 96 * ldb + (KOFF)); }
#define KL_STORE(SA, SB, A0, A1, A2, A3, B0, B1, B2, B3)                 \
  *(uint4*)((SA) + (lrow + 0) * GP + sseg) = A0;                         \
  *(uint4*)((SA) + (lrow + 32) * GP + sseg) = A1;                        \
  *(uint4*)((SA) + (lrow + 64) * GP + sseg) = A2;                        \
  *(uint4*)((SA) + (lrow + 96) * GP + sseg) = A3;                        \
  *(uint4*)((SB) + (lrow + 0) * GP + sseg) = B0;                         \
  *(uint4*)((SB) + (lrow + 32) * GP + sseg) = B1;                        \
  if (NT > 2) { *(uint4*)((SB) + (lrow + 64) * GP + sseg) = B2; *(uint4*)((SB) + (lrow + 96) * GP + sseg) = B3; }
#define KL_COMPUTE(CA, CB)                                                                                     \
  _Pragma("unroll") for (int kk = 0; kk < 2; ++kk) {                                                           \
    bf16x8 wf[NT], xf[4];                                                                                      \
    _Pragma("unroll") for (int nt = 0; nt < NT; ++nt)                                                          \
      wf[nt] = *(const bf16x8*)((CB) + (wc * NT * 16 + nt * 16 + fr) * GP + (((kk * 4 + fq) ^ swz) * 8));       \
    _Pragma("unroll") for (int mt = 0; mt < 4; ++mt)                                                           \
      xf[mt] = *(const bf16x8*)((CA) + (wr * 64 + mt * 16 + fr) * GP + (((kk * 4 + fq) ^ swz) * 8));            \
    _Pragma("unroll") for (int mt = 0; mt < 4; ++mt)                                                           \
    _Pragma("unroll") for (int nt = 0; nt < NT; ++nt) acc[mt][nt] = mfma16(wf[nt], xf[mt], acc[mt][nt]);      \
  }
  const int swz = (fr >> 1) & 7;
  KL_LOAD(0, ra0, ra1, ra2, ra3, rb0, rb1, rb2, rb3)
  KL_LOAD(64, rc0, rc1, rc2, rc3, rd0, rd1, rd2, rd3)
  KL_STORE(sa, sb, ra0, ra1, ra2, ra3, rb0, rb1, rb2, rb3)
  __syncthreads();
  u16* sa1 = sa + 128 * GP;
  u16* sb1 = sb + 128 * GP;
#pragma unroll 1
  for (int kt = 0; kt < nk; kt += 2) {
    const int k2 = (kt + 2 < nk ? kt + 2 : kt) * 64, k3 = (kt + 3 < nk ? kt + 3 : kt + 1) * 64;
    KL_LOAD(k2, ra0, ra1, ra2, ra3, rb0, rb1, rb2, rb3)
    __builtin_amdgcn_sched_barrier(0);
    KL_COMPUTE(sa, sb)
    KL_STORE(sa1, sb1, rc0, rc1, rc2, rc3, rd0, rd1, rd2, rd3)
    __syncthreads();
    KL_LOAD(k3, rc0, rc1, rc2, rc3, rd0, rd1, rd2, rd3)
    __builtin_amdgcn_sched_barrier(0);
    KL_COMPUTE(sa1, sb1)
    KL_STORE(sa, sb, ra0, ra1, ra2, ra3, rb0, rb1, rb2, rb3)
    __syncthreads();
  }
}
#endif
template <int NT>
DI void zero_acc(f32x4 (&acc)[4][NT]) {
#pragma unroll
  for (int a = 0; a < 4; ++a)
#pragma unroll
    for (int b = 0; b < NT; ++b) acc[a][b] = (f32x4){0.f, 0.f, 0.f, 0.f};
}

struct TileIter {
  int step, nsteps, nrb, nct, x, li, lj, mode, idx, stride, L;
  DI void init(int nrt, int nct_, int b, int G) {
    nct = nct_;
    if (G == 512 && (nrt % 64) == 0) {
      mode = 1; x = b & 7;
      const int local = b >> 3;
      li = local >> 3; lj = local & 7;
      nrb = nrt / 64;
      nsteps = nrb * ((nct + 7) >> 3);
      step = 0;
      skip();
    } else {
      mode = 0; idx = b; stride = G; L = nrt * nct;
    }
  }
  DI int ctile() const { return (step / nrb) * 8 + lj; }
  DI void skip() { while (step < nsteps && ctile() >= nct) ++step; }
  DI bool valid() const { return mode ? step < nsteps : idx < L; }
  DI int rt() const { return mode ? x + 8 * ((step % nrb) * 8 + li) : idx / nct; }
  DI int ct() const { return mode ? ctile() : idx % nct; }
  DI void next() { if (mode) { ++step; skip(); } else idx += stride; }
};

#define EPI_COORDS                                                       \
  const int lane = my_tid() & 63, wave = my_tid() >> 6;           \
  const int fr = lane & 15, fq = lane >> 4, wr = wave >> 1, wc = wave & 1; \
  (void)fr; (void)fq; (void)wr; (void)wc;

DI void gemm_inproj(const Params& p, int layer, int b, int G, u16* sm) {
  const u16* H = (const u16*)(p.ws + OFF_H);
  const u16* W = (const u16*)(p.ws + OFF_W) + layer * W_LAYER + WO_IN;
  u16* proj = (u16*)(p.ws + OFF_PROJ);
  float* AB = (float*)(p.ws + OFF_AB);
  EPI_COORDS
  TileIter it; it.init(T / 128, 21, b, G);
  for (; it.valid(); it.next()) {
    const int row0 = it.rt() * 128, col0 = it.ct() * 128;
    f32x4 acc[4][4]; zero_acc<4>(acc);
    gemm_kloop<4>(H + (size_t)row0 * DM, DM, W + (size_t)col0 * DM, DM, 16, acc, sm);
#pragma unroll
    for (int mt = 0; mt < 4; ++mt) {
      const int row = row0 + wr * 64 + mt * 16 + fr;
#pragma unroll
      for (int nt = 0; nt < 4; ++nt) {
        const int col = col0 + wc * 64 + nt * 16 + fq * 4;
        if (col < INW) {
          uint2 o; o.x = pack2(acc[mt][nt][0], acc[mt][nt][1]); o.y = pack2(acc[mt][nt][2], acc[mt][nt][3]);
          *(uint2*)(proj + (size_t)row * INW + col) = o;
          if (col >= 1024 && col < 1040)
            *(float4*)(AB + (size_t)row * 16 + (col - 1024)) = make_float4(acc[mt][nt][0], acc[mt][nt][1], acc[mt][nt][2], acc[mt][nt][3]);
        }
      }
    }
  }
}

DI void gemm_glu(const Params& p, int layer, int b, int G, u16* sm) {
  const u16* Gb = (const u16*)(p.ws + OFF_G);
  const u16* W = (const u16*)(p.ws + OFF_W) + layer * W_LAYER + WO_GLU;
  u16* proj = (u16*)(p.ws + OFF_PROJ);
  EPI_COORDS
  TileIter it; it.init(T / 128, 4, b, G);
  for (; it.valid(); it.next()) {
    const int row0 = it.rt() * 128, ct = it.ct();
    f32x4 acc[4][4]; zero_acc<4>(acc);
    gemm_kloop<4>(Gb + (size_t)row0 * 256, 256, W + (size_t)ct * 128 * 256, 256, 4, acc, sm);
#pragma unroll
    for (int mt = 0; mt < 4; ++mt) {
      const int row = row0 + wr * 64 + mt * 16 + fr;
#pragma unroll
      for (int nt = 0; nt < 2; ++nt) {
        const int col = (ct * 2 + wc) * 32 + nt * 16 + fq * 4;
        float o[4];
#pragma unroll
        for (int j = 0; j < 4; ++j) o[j] = acc[mt][nt][j] * sigmoidf_(acc[mt][nt + 2][j]);
        uint2 ov; ov.x = pack2(o[0], o[1]); ov.y = pack2(o[2], o[3]);
        *(uint2*)(proj + (size_t)row * INW + C_CU + col) = ov;
      }
    }
  }
}

DI void gemm_merge(const Params& p, int layer, int b, int G, u16* sm) {
  const u16* H = (const u16*)(p.ws + OFF_H);
  const u16* Wg = (const u16*)(p.ws + OFF_W) + layer * W_LAYER + WO_GATE;
  const u16* Wb = (const u16*)(p.ws + OFF_W) + layer * W_LAYER + WO_BR;
  const u16* proj = (const u16*)(p.ws + OFF_PROJ);
  u16* merged = (u16*)(p.ws + OFF_MERGED);
  EPI_COORDS
  TileIter it; it.init(T / 128, 16, b, G);
  for (; it.valid(); it.next()) {
    const int row0 = it.rt() * 128, col0 = it.ct() * 64;
    f32x4 mg[4][2]; zero_acc<2>(mg);
#pragma unroll 1
    for (int i = 0; i < 4; ++i) {
      const int ocol = (i == 0) ? C_AZ : (i == 1) ? C_BQ : (i == 2) ? C_CU : C_DQ;
      f32x4 acc[4][2]; zero_acc<2>(acc);
      gemm_kloop<2>(H + (size_t)row0 * DM, DM, Wg + (size_t)i * DM * DM + (size_t)col0 * DM, DM, 16, acc, sm);
      f32x4 sg[4][2];
#pragma unroll
      for (int a = 0; a < 4; ++a)
#pragma unroll
        for (int c = 0; c < 2; ++c)
#pragma unroll
          for (int j = 0; j < 4; ++j) sg[a][c][j] = sigmoidf_(acc[a][c][j]);
      zero_acc<2>(acc);
      gemm_kloop<2>(proj + (size_t)row0 * INW + ocol, INW, Wb + (size_t)i * DM * 256 + (size_t)col0 * 256, 256, 4, acc, sm);
#pragma unroll
      for (int a = 0; a < 4; ++a)
#pragma unroll
        for (int c = 0; c < 2; ++c)
#pragma unroll
          for (int j = 0; j < 4; ++j) mg[a][c][j] += sg[a][c][j] * acc[a][c][j];
    }
#pragma unroll
    for (int mt = 0; mt < 4; ++mt) {
      const int row = row0 + wr * 64 + mt * 16 + fr;
#pragma unroll
      for (int nt = 0; nt < 2; ++nt) {
        const int col = col0 + wc * 32 + nt * 16 + fq * 4;
        uint2 o; o.x = pack2(mg[mt][nt][0], mg[mt][nt][1]); o.y = pack2(mg[mt][nt][2], mg[mt][nt][3]);
        *(uint2*)(merged + (size_t)row * DM + col) = o;
      }
    }
  }
}

DI void gemm_resid(const Params& p, int layer_src, const u16* A, int K, const u16* W, int b, int G, u16* sm) {
  EPI_COORDS
  TileIter it; it.init(T / 128, 8, b, G);
  for (; it.valid(); it.next()) {
    const int row0 = it.rt() * 128, col0 = it.ct() * 128;
    f32x4 acc[4][4]; zero_acc<4>(acc);
    gemm_kloop<4>(A + (size_t)row0 * K, K, W + (size_t)col0 * K, K, K / 64, acc, sm);
#pragma unroll
    for (int mt = 0; mt < 4; ++mt) {
      const int row = row0 + wr * 64 + mt * 16 + fr;
      const float* xs = xrow(p, layer_src, row);
      float* xd = p.xout + (size_t)row * DM;
#pragma unroll
      for (int nt = 0; nt < 4; ++nt) {
        const int col = col0 + wc * 64 + nt * 16 + fq * 4;
        float4 r = *(const float4*)(xs + col);
        r.x += acc[mt][nt][0]; r.y += acc[mt][nt][1]; r.z += acc[mt][nt][2]; r.w += acc[mt][nt][3];
        *(float4*)(xd + col) = r;
      }
    }
  }
}

DI void gemm_ffn1(const Params& p, int layer, int b, int G, u16* sm) {
  const u16* H = (const u16*)(p.ws + OFF_H2);
  const u16* W = (const u16*)(p.ws + OFF_W) + layer * W_LAYER + WO_GU;
  u16* act = (u16*)(p.ws + OFF_ACT);
  EPI_COORDS
  TileIter it; it.init(T / 128, 44, b, G);
  for (; it.valid(); it.next()) {
    const int row0 = it.rt() * 128, ct = it.ct();
    f32x4 acc[4][4]; zero_acc<4>(acc);
    gemm_kloop<4>(H + (size_t)row0 * DM, DM, W + (size_t)ct * 128 * DM, DM, 16, acc, sm);
#pragma unroll
    for (int mt = 0; mt < 4; ++mt) {
      const int row = row0 + wr * 64 + mt * 16 + fr;
#pragma unroll
      for (int nt = 0; nt < 2; ++nt) {
        const int col = (ct * 2 + wc) * 32 + nt * 16 + fq * 4;
        float o[4];
#pragma unroll
        for (int j = 0; j < 4; ++j) o[j] = siluf_(acc[mt][nt][j]) * acc[mt][nt + 2][j];
        uint2 ov; ov.x = pack2(o[0], o[1]); ov.y = pack2(o[2], o[3]);
        *(uint2*)(act + (size_t)row * FH + col) = ov;
      }
    }
  }
}

DI void gdn_pre(const Params& p, int layer, int task, char* smem) {
  const int tid = my_tid(), lane = tid & 63, wave = tid >> 6;
  const int n = task >> 2, h = task & 3, c0 = n * 64;
  const int lo = seq_lo(c0), hi = seq_hi(c0);
  float* ks = (float*)smem;
  float* vs = ks + 64 * 65;
  float* AmT = vs + 64 * 65;
  float* gcs = AmT + 2 * 64 * 64;
  float* bts = gcs + 128;
  const u16* proj = (const u16*)(p.ws + OFF_PROJ);
  u16* QN = (u16*)(p.ws + OFF_QN);
  u16* KN = (u16*)(p.ws + OFF_KN);
  float* GC = (float*)(p.ws + OFF_GC);
  const float* AB = (const float*)(p.ws + OFF_AB);
  u16* UW = (u16*)(p.ws + OFF_UW);
  __syncthreads();
#pragma unroll 1
  for (int mat = 0; mat < 3; ++mat) {
    const int ch = mat * 256 + h * 64 + lane;
    float w[5];
#pragma unroll
    for (int j = 0; j < 5; ++j) w[j] = p.conv_a[(size_t)(layer * 5 + j) * 768 + ch];
    float raw[20];
#pragma unroll
    for (int i = 0; i < 20; ++i) {
      const int tok = c0 + wave * 16 + i - 2;
      raw[i] = (tok >= lo && tok < hi) ? bf2f(proj[(size_t)tok * INW + ch]) : 0.f;
    }
#pragma unroll
    for (int i = 0; i < 16; ++i) {
      float v = 0.f;
#pragma unroll
      for (int j = 0; j < 5; ++j) v += raw[i + j] * w[j];
      v = siluf_(v);
      const int tl = wave * 16 + i;
      if (mat < 2) {
        const float ss = wave_sum(v * v);
        v *= rsqrtf(ss + EPS) * (mat == 0 ? 0.125f : 1.f);
      }
      if (mat == 0) QN[(size_t)(c0 + tl) * 256 + h * 64 + lane] = f2bf(v);
      else if (mat == 1) { KN[(size_t)(c0 + tl) * 256 + h * 64 + lane] = f2bf(v); ks[tl * 65 + lane] = v; }
      else vs[tl * 65 + lane] = v;
    }
  }
  if (wave < 2) {
    const int d = wave;
    const int tok = c0 + (d ? 63 - lane : lane);
    const float al = AB[(size_t)tok * 16 + d * 4 + h];
    const float br = AB[(size_t)tok * 16 + 8 + d * 4 + h];
    const float xx = al + p.dt_bias[(layer * 2 + d) * 4 + h];
    const float sp = fmaxf(xx, 0.f) + log1pf(__expf(-fabsf(xx)));
    float g = -__expf(p.a_log[(layer * 2 + d) * 4 + h]) * sp;
#pragma unroll
    for (int o = 1; o < 64; o <<= 1) {
      const float t = __shfl_up(g, o, 64);
      if (lane >= o) g += t;
    }
    gcs[d * 64 + lane] = g;
    bts[d * 64 + lane] = sigmoidf_(br);
    GC[(size_t)(task * 2 + d) * 64 + lane] = g;
  }
  __syncthreads();
#pragma unroll 1
  for (int m = 0; m < 16; ++m) {
    const int a = wave + 4 * m, b = lane;
    float dot = 0.f;
#pragma unroll 16
    for (int dd = 0; dd < 64; ++dd) dot += ks[a * 65 + dd] * ks[b * 65 + dd];
    if (a > b) {
      AmT[b * 64 + a] = bts[a] * dot * __expf(gcs[a] - gcs[b]);
      const int i1 = 63 - b, j1 = 63 - a;
      AmT[4096 + j1 * 64 + i1] = bts[64 + i1] * dot * __expf(gcs[64 + i1] - gcs[64 + j1]);
    }
  }
  __syncthreads();
  {
    int d = tid >> 7, c = tid & 127;
    asm volatile("" : "+v"(d), "+v"(c));
    float r[64];
    {
      const int stride = d ? -65 : 65;
      int off = (d ? 63 * 65 : 0) + (c & 63);
      const float* srcm = (c < 64) ? vs : ks;
      const bool isw = c >= 64;
#pragma unroll
      for (int i = 0; i < 64; ++i) {
        float v = srcm[off] * bts[d * 64 + i];
        if (isw) v *= __expf(gcs[d * 64 + i]);
        r[i] = v;
        off += stride;
        asm volatile("" : "+v"(off));
        if ((i & 7) == 7) __builtin_amdgcn_sched_barrier(0);
      }
    }
    const float* Ad = AmT + d * 4096;
#pragma unroll
    for (int j = 0; j < 63; ++j) {
      const float rj = r[j];
#pragma unroll
      for (int i = j + 1; i < 64; ++i) {
        r[i] = fmaf(-Ad[j * 64 + i], rj, r[i]);
        if ((i & 15) == 15) __builtin_amdgcn_sched_barrier(0);
      }
      __builtin_amdgcn_sched_barrier(0);
    }
    u16* base = UW + (size_t)(task * 2 + d) * 8192;
    if (c < 64) {
      uint4* dst = (uint4*)(base + c * 64);
#pragma unroll
      for (int q = 0; q < 8; ++q)
        dst[q] = make_uint4(pack2(r[8 * q], r[8 * q + 1]), pack2(r[8 * q + 2], r[8 * q + 3]), pack2(r[8 * q + 4], r[8 * q + 5]),
                            pack2(r[8 * q + 6], r[8 * q + 7]));
    } else {
      u16* dst = base + 4096 + (c - 64);
#pragma unroll
      for (int i = 0; i < 64; ++i) dst[i * 64] = f2bf(r[i]);
    }
  }
}

DI f32x4 mma_t(const u16* X, int xr, const u16* Y, int yr, f32x4 acc, int fr, int fq) {
#pragma unroll
  for (int kk = 0; kk < 2; ++kk) {
    const bf16x8 x = *(const bf16x8*)(X + (xr + fr) * 72 + kk * 32 + fq * 8);
    const bf16x8 y = *(const bf16x8*)(Y + (yr + fr) * 72 + kk * 32 + fq * 8);
    acc = mfma16(x, y, acc);
  }
  return acc;
}
DI f32x4 mma_t_swz(const u16* X, int xr, const u16* Y, int yr, f32x4 acc, int fr, int fq) {
  const int sw = ((xr + fr) >> 3) & 7;
#pragma unroll
  for (int kk = 0; kk < 2; ++kk) {
    const bf16x8 x = *(const bf16x8*)(X + (xr + fr) * 72 + (((kk * 4 + fq) ^ sw) * 8));
    const bf16x8 y = *(const bf16x8*)(Y + (yr + fr) * 72 + kk * 32 + fq * 8);
    acc = mfma16(x, y, acc);
  }
  return acc;
}

DI void gdn_scan(const Params& p, int item, char* smem) {
  const int tid = my_tid(), lane = tid & 63, w = tid >> 6;
  const int fr = lane & 15, fq = lane >> 4;
  const int chain = item >> 2, eq = item & 3;
  const int s = chain >> 3, h = (chain >> 1) & 3, d = chain & 1;
  const int sb = s == 0 ? 0 : TP + (s - 1) * 4096;
  const int nch = s == 0 ? 256 : 64;
  u16* St = (u16*)smem;
  u16* Vt = St + 16 * 72;
  u16* Vts = Vt + 16 * 72;
  u16* Wc = Vts + 16 * 72;
  u16* Qc = Wc + 64 * 72;
  u16* Kc = Qc + 64 * 72;
  u16* KcT = Kc + 64 * 72;
  u16* QKm = KcT + 64 * 72;
  float* gcs = (float*)(QKm + 64 * 72);
  u16* proj = (u16*)(p.ws + OFF_PROJ);
  const u16* QN = (const u16*)(p.ws + OFF_QN);
  const u16* KN = (const u16*)(p.ws + OFF_KN);
  const float* GC = (const float*)(p.ws + OFF_GC);
  const u16* UW = (const u16*)(p.ws + OFF_UW);
  __syncthreads();
  for (int i = tid; i < 16 * 72; i += 256) St[i] = 0;
  f32x4 S0 = (f32x4){0.f, 0.f, 0.f, 0.f};
  const int prow0 = tid >> 3, prow1 = (tid >> 3) + 32, pseg = (tid & 7) * 8;
  uint4 w0a, w1a, q0a, q1a, k0a, k1a, w0b, w1b, q0b, q1b, k0b, k1b;
  uint2 u0a, u0b;
  float ga, gb;
#define GDN_PREFETCH2(J, S)                                                                          \
  {                                                                                                  \
    const int jj_ = (J) < nch ? (J) : nch - 1;                                                       \
    const int n_ = sb / 64 + (d ? nch - 1 - jj_ : jj_);                                              \
    const int c0_ = n_ * 64;                                                                         \
    const size_t tb_ = (size_t)((n_ * 4 + h) * 2 + d);                                               \
    const u16* ub_ = UW + tb_ * 8192;                                                                \
    const int tok0_ = c0_ + (d ? 63 - prow0 : prow0), tok1_ = c0_ + (d ? 63 - prow1 : prow1);        \
    w0##S = *(const uint4*)(ub_ + 4096 + prow0 * 64 + pseg);                                         \
    w1##S = *(const uint4*)(ub_ + 4096 + prow1 * 64 + pseg);                                         \
    q0##S = *(const uint4*)(QN + (size_t)tok0_ * 256 + h * 64 + pseg);                               \
    q1##S = *(const uint4*)(QN + (size_t)tok1_ * 256 + h * 64 + pseg);                               \
    k0##S = *(const uint4*)(KN + (size_t)tok0_ * 256 + h * 64 + pseg);                               \
    k1##S = *(const uint4*)(KN + (size_t)tok1_ * 256 + h * 64 + pseg);                               \
    u0##S = *(const uint2*)(ub_ + (eq * 16 + fr) * 64 + w * 16 + fq * 4);                            \
    g##S = GC[tb_ * 64 + lane];                                                                      \
  }
#define GDN_STAGE2(ROW, PW, PQ, PK)                                                                  \
  {                                                                                                  \
    *(uint4*)(Wc + (ROW) * 72 + pseg) = PW;                                                          \
    *(uint4*)(Qc + (ROW) * 72 + pseg) = PQ;                                                          \
    *(uint4*)(Kc + (ROW) * 72 + pseg) = PK;                                                          \
    u16* kt_ = KcT + pseg * 72 + ((((ROW) >> 3) ^ (tid & 7)) * 8) + ((ROW) & 7);                     \
    kt_[0 * 72] = (u16)(PK.x & 0xffff); kt_[1 * 72] = (u16)(PK.x >> 16);                             \
    kt_[2 * 72] = (u16)(PK.y & 0xffff); kt_[3 * 72] = (u16)(PK.y >> 16);                             \
    kt_[4 * 72] = (u16)(PK.z & 0xffff); kt_[5 * 72] = (u16)(PK.z >> 16);                             \
    kt_[6 * 72] = (u16)(PK.w & 0xffff); kt_[7 * 72] = (u16)(PK.w >> 16);                             \
  }
#define GDN_STEP(JV, S)                                                                              \
  {                                                                                                  \
    const int j_ = (JV);                                                                             \
    const int n = sb / 64 + (d ? nch - 1 - j_ : j_);                                                 \
    const int c0 = n * 64;                                                                           \
    GDN_STAGE2(prow0, w0##S, q0##S, k0##S)                                                           \
    GDN_STAGE2(prow1, w1##S, q1##S, k1##S)                                                           \
    if (tid < 64) gcs[tid] = g##S;                                                                   \
    const uint2 cu0 = u0##S;                                                                         \
    __syncthreads();                                                                          \
    GDN_PREFETCH2(j_ + 2, S)                                                                         \
    const f32x4 z4 = (f32x4){0.f, 0.f, 0.f, 0.f};                                                    \
    const f32x4 P1a = mma_t(Wc, w * 16, St, 0, z4, fr, fq);                                          \
    const f32x4 P2a = mma_t(St, 0, Qc, w * 16, z4, fr, fq);                                          \
      \
    const float glog = gcs[63];                                                                      \
    const float gcc = gcs[w * 16 + fr];                                                              \
    const float4 gq0 = *(const float4*)(gcs + fq * 4), gq1 = *(const float4*)(gcs + 16 + fq * 4);    \
    const float4 gq2 = *(const float4*)(gcs + 32 + fq * 4), gq3 = *(const float4*)(gcs + 48 + fq * 4); \
    const float4 gw = *(const float4*)(gcs + w * 16 + fq * 4);                                       \
    {                                                                                                \
      const int c = w * 16 + fr;                                                                     \
      _Pragma("unroll") for (int t = 0; t < 4; ++t) {                                                \
        const f32x4 qk = mma_t(Kc, t * 16, Qc, w * 16, z4, fr, fq);                                  \
        const int s0 = t * 16 + fq * 4;                                                              \
        const float4 gs = t == 0 ? gq0 : t == 1 ? gq1 : t == 2 ? gq2 : gq3;                          \
        const float e0 = __expf(fminf(gcc - gs.x, 0.f)), e1 = __expf(fminf(gcc - gs.y, 0.f));       \
        const float e2 = __expf(fminf(gcc - gs.z, 0.f)), e3 = __expf(fminf(gcc - gs.w, 0.f));       \
        const float v0 = (c >= s0 + 0) ? qk[0] * e0 : 0.f;                                           \
        const float v1 = (c >= s0 + 1) ? qk[1] * e1 : 0.f;                                           \
        const float v2 = (c >= s0 + 2) ? qk[2] * e2 : 0.f;                                           \
        const float v3 = (c >= s0 + 3) ? qk[3] * e3 : 0.f;                                           \
        uint2 o; o.x = pack2(v0, v1); o.y = pack2(v2, v3);                                           \
        *(uint2*)(QKm + c * 72 + s0) = o;                                                            \
      }                                                                                              \
    }                                                                                                \
    {                                                                                                \
      const int cc0 = w * 16 + fq * 4;                                                               \
      const float v0 = bf2f((u16)(cu0.x & 0xffff)) - P1a[0], v1 = bf2f((u16)(cu0.x >> 16)) - P1a[1]; \
      const float v2 = bf2f((u16)(cu0.y & 0xffff)) - P1a[2], v3 = bf2f((u16)(cu0.y >> 16)) - P1a[3]; \
      uint2 o; o.x = pack2(v0, v1); o.y = pack2(v2, v3);                                             \
      *(uint2*)(Vt + fr * 72 + cc0) = o;                                                             \
      uint2 o2;                                                                                      \
      o2.x = pack2(v0 * __expf(glog - gw.x), v1 * __expf(glog - gw.y));                              \
      o2.y = pack2(v2 * __expf(glog - gw.z), v3 * __expf(glog - gw.w));                              \
      *(uint2*)(Vts + fr * 72 + cc0) = o2;                                                           \
    }                                                                                                \
    __syncthreads();                                                                          \
    {                                                                                                \
      const int c = w * 16 + fr;                                                                     \
      const float eg = __expf(gcc);                                                                  \
      const int tok = c0 + (d ? 63 - c : c);                                                         \
      u16* orow = proj + (size_t)tok * INW + d * 256 + h * 64 + eq * 16 + fq * 4;                    \
      f32x4 oa = P2a * eg;                                                                           \
      oa = mma_t(Vt, 0, QKm, w * 16, oa, fr, fq);                                                    \
      uint2 o; o.x = pack2(oa[0], oa[1]); o.y = pack2(oa[2], oa[3]);                                 \
      *(uint2*)(orow) = o;                                                                           \
    }                                                                                                \
    {                                                                                                \
      const float gl = __expf(glog);                                                                 \
      S0 *= gl;                                                                                      \
      S0 = mma_t_swz(KcT, w * 16, Vts, 0, S0, fr, fq);                                               \
      const int r0 = w * 16 + fq * 4;                                                                \
      uint2 o; o.x = pack2(S0[0], S0[1]); o.y = pack2(S0[2], S0[3]);                                 \
      *(uint2*)(St + fr * 72 + r0) = o;                                                              \
    }                                                                                                \
    __syncthreads();                                                                          \
  }
  GDN_PREFETCH2(0, a)
  GDN_PREFETCH2(1, b)
  for (int j = 0; j < nch; j += 2) {
    GDN_STEP(j, a)
    GDN_STEP(j + 1, b)
  }
}

DI void gdn_post_row(const Params& p, int layer, int t) {
  const int lane = my_tid() & 63;
  u16* row = (u16*)(p.ws + OFF_PROJ) + (size_t)t * INW;
  const uint2 f = *(const uint2*)(row + lane * 4);
  const uint2 bw = *(const uint2*)(row + 256 + lane * 4);
  const uint2 z = *(const uint2*)(row + C_AZ + lane * 4);
  float o[4], zz[4];
  o[0] = bf2f((u16)(f.x & 0xffff)) + bf2f((u16)(bw.x & 0xffff));
  o[1] = bf2f((u16)(f.x >> 16)) + bf2f((u16)(bw.x >> 16));
  o[2] = bf2f((u16)(f.y & 0xffff)) + bf2f((u16)(bw.y & 0xffff));
  o[3] = bf2f((u16)(f.y >> 16)) + bf2f((u16)(bw.y >> 16));
  zz[0] = bf2f((u16)(z.x & 0xffff)); zz[1] = bf2f((u16)(z.x >> 16)); zz[2] = bf2f((u16)(z.y & 0xffff)); zz[3] = bf2f((u16)(z.y >> 16));
  float ss = o[0] * o[0] + o[1] * o[1] + o[2] * o[2] + o[3] * o[3];
#pragma unroll
  for (int m = 1; m < 16; m <<= 1) ss += __shfl_xor(ss, m, 64);
  const float rs = rsqrtf(ss * (1.f / 64.f) + EPS);
  const int e0 = (lane & 15) * 4;
  float r[4];
#pragma unroll
  for (int j = 0; j < 4; ++j) r[j] = o[j] * rs * p.a_norm[layer * 64 + e0 + j] * siluf_(zz[j]);
  uint2 ov; ov.x = pack2(r[0], r[1]); ov.y = pack2(r[2], r[3]);
  *(uint2*)(row + C_AZ + lane * 4) = ov;
}

struct S5Const { float are, aim; float bpr[16], bpi[16]; };
DI void s5_consts(const Params& p, int layer, int d, int g, int lane, S5Const& k, float& lr, float& li, float& step) {
  const int gi = ((layer * 2 + d) * 16 + g);
  lr = p.lam_re[(size_t)gi * 64 + lane];
  li = p.lam_im[(size_t)gi * 64 + lane];
  step = expf(p.log_step[gi]);
  const float mag = expf(lr * step);
  float sn, cs; sincosf(li * step, &sn, &cs);
  k.are = mag * cs; k.aim = mag * sn;
  const float inv = 1.f / (lr * lr + li * li);
  const float ir = lr * inv, ii = -li * inv;
  const float cr = (k.are - 1.f) * ir - k.aim * ii;
  const float ci = (k.are - 1.f) * ii + k.aim * ir;
  const float* br = p.b_re + ((size_t)(layer * 16 + g) * 64 + lane) * 16;
  const float* bi = p.b_im + ((size_t)(layer * 16 + g) * 64 + lane) * 16;
#pragma unroll
  for (int c = 0; c < 16; ++c) {
    const float a = br[c], b = bi[c];
    k.bpr[c] = cr * a - ci * b;
    k.bpi[c] = cr * b + ci * a;
  }
}
DI void s5_stage_u(const Params& p, int c0, int gq, float* us) {
  const u16* proj = (const u16*)(p.ws + OFF_PROJ);
  const int tid = my_tid();
#pragma unroll
  for (int i = 0; i < 4; ++i) {
    const int idx = tid + 256 * i, tok = idx >> 4, c4 = (idx & 15) * 4;
    const uint2 v = *(const uint2*)(proj + (size_t)(c0 + tok) * INW + C_CU + gq * 64 + c4);
    us[tok * 64 + c4 + 0] = bf2f((u16)(v.x & 0xffff));
    us[tok * 64 + c4 + 1] = bf2f((u16)(v.x >> 16));
    us[tok * 64 + c4 + 2] = bf2f((u16)(v.y & 0xffff));
    us[tok * 64 + c4 + 3] = bf2f((u16)(v.y >> 16));
  }
}
DI void s5_step(const S5Const& k, const float* u, float& sr, float& si) {
  float xr = 0.f, xi = 0.f;
#pragma unroll
  for (int c4 = 0; c4 < 4; ++c4) {
    const float4 uu = *(const float4*)(u + c4 * 4);
    xr += k.bpr[c4 * 4 + 0] * uu.x + k.bpr[c4 * 4 + 1] * uu.y + k.bpr[c4 * 4 + 2] * uu.z + k.bpr[c4 * 4 + 3] * uu.w;
    xi += k.bpi[c4 * 4 + 0] * uu.x + k.bpi[c4 * 4 + 1] * uu.y + k.bpi[c4 * 4 + 2] * uu.z + k.bpi[c4 * 4 + 3] * uu.w;
  }
  const float nr = k.are * sr - k.aim * si + xr;
  const float ni = k.are * si + k.aim * sr + xi;
  sr = nr; si = ni;
}
DI void s5_pass1(const Params& p, int layer, int task, char* smem) {
  const int lane = my_tid() & 63, wave = my_tid() >> 6;
  const int n = task >> 2, gq = task & 3, g = gq * 4 + wave, c0 = n * 64;
  float* us = (float*)smem;
  float2* SEND = (float2*)(p.ws + OFF_SEND);
  __syncthreads();
  s5_stage_u(p, c0, gq, us);
  __syncthreads();
#pragma unroll 1
  for (int d = 0; d < 2; ++d) {
    S5Const k; float lr, li, step;
    s5_consts(p, layer, d, g, lane, k, lr, li, step);
    float sr = 0.f, si = 0.f;
#pragma unroll 4
    for (int i = 0; i < 64; ++i) {
      const int t = d ? 63 - i : i;
      s5_step(k, us + t * 64 + wave * 16, sr, si);
    }
    SEND[((size_t)(n * 2 + d) * 16 + g) * 64 + lane] = make_float2(sr, si);
  }
}
DI float gelu_tanh(float x) {
  const float u = 0.7978845608028654f * (x + 0.044715f * x * x * x);
  return 0.5f * x * (1.f + tanhf(u));
}
DI void s5_pass3(const Params& p, int layer, int task, char* smem) {
  const int lane = my_tid() & 63, wave = my_tid() >> 6;
  const int fr = lane & 15, fq = lane >> 4;
  const int n = task >> 2, gq = task & 3, g = gq * 4 + wave, c0 = n * 64;
  const int nlo = seq_lo(c0) / 64, nhi = seq_hi(c0) / 64;
  float* us = (float*)smem;
  u16* Sb = (u16*)(smem + 16384) + wave * 16 * 136;
  const float2* SEND = (const float2*)(p.ws + OFF_SEND);
  u16* Gb = (u16*)(p.ws + OFF_G);
  __syncthreads();
  s5_stage_u(p, c0, gq, us);
  __syncthreads();
  f32x4 yacc[4];
#pragma unroll
  for (int tb = 0; tb < 4; ++tb) yacc[tb] = (f32x4){0.f, 0.f, 0.f, 0.f};
#pragma unroll
  for (int d = 0; d < 2; ++d) {
    S5Const k; float lr, li, step;
    s5_consts(p, layer, d, g, lane, k, lr, li, step);
    const float m64 = expf(lr * step * 64.f);
    float s64, c64; sincosf(li * step * 64.f, &s64, &c64);
    const float a64r = m64 * c64, a64i = m64 * s64;
    float sr = 0.f, si = 0.f;
    {
      const int cnt = d == 0 ? n - nlo : nhi - 1 - n;
      const int first = d == 0 ? nlo : nhi - 1;
      const int sgn = d == 0 ? 1 : -1;
      const float2* sp = SEND + ((size_t)(first * 2 + d) * 16 + g) * 64 + lane;
      const long stride = (long)sgn * 2 * 16 * 64;
      int m = 0;
      for (; m + 8 <= cnt; m += 8) {
        float2 e0 = sp[0], e1 = sp[stride], e2 = sp[2 * stride], e3 = sp[3 * stride];
        float2 e4 = sp[4 * stride], e5 = sp[5 * stride], e6 = sp[6 * stride], e7 = sp[7 * stride];
        sp += 8 * stride;
#define HSTEP(E) { const float nr = a64r * sr - a64i * si + E.x, ni = a64r * si + a64i * sr + E.y; sr = nr; si = ni; }
        HSTEP(e0) HSTEP(e1) HSTEP(e2) HSTEP(e3) HSTEP(e4) HSTEP(e5) HSTEP(e6) HSTEP(e7)
      }
      for (; m < cnt; ++m) {
        const float2 e = sp[0];
        sp += stride;
        HSTEP(e)
      }
    }
    bf16x8 cf[4];
    {
      const float* cr = p.c_re + ((size_t)((layer * 2 + d) * 16 + g) * 16 + fr) * 64;
      const float* ci = p.c_im + ((size_t)((layer * 2 + d) * 16 + g) * 16 + fr) * 64;
#pragma unroll
      for (int kk = 0; kk < 4; ++kk)
#pragma unroll
        for (int e = 0; e < 8; ++e) {
          const int kx = (kk & 1) * 32 + fq * 8 + e;
          const float v = (kk < 2) ? cr[kx] : -ci[kx];
          cf[kk][e] = (short)f2bf(v);
        }
    }
#pragma unroll
    for (int blk = 0; blk < 4; ++blk) {
      const int tb = d ? 3 - blk : blk;
#pragma unroll 4
      for (int i = 0; i < 16; ++i) {
        const int r = d ? 15 - i : i;
        const int t = tb * 16 + r;
        s5_step(k, us + t * 64 + wave * 16, sr, si);
        Sb[r * 136 + lane] = f2bf(sr);
        Sb[r * 136 + 64 + lane] = f2bf(si);
      }
      __syncthreads();
#pragma unroll
      for (int kk = 0; kk < 4; ++kk) {
        const bf16x8 xf = *(const bf16x8*)(Sb + fr * 136 + kk * 32 + fq * 8);
        yacc[tb] = mfma16(xf, cf[kk], yacc[tb]);
      }
      __syncthreads();
    }
  }
  const float dsk = p.s5_d[layer * 256 + g * 16 + fr];
#pragma unroll
  for (int tb = 0; tb < 4; ++tb)
#pragma unroll
    for (int j = 0; j < 4; ++j) {
      const int t = tb * 16 + fq * 4 + j;
      const float y = yacc[tb][j] + us[t * 64 + wave * 16 + fr] * dsk;
      Gb[(size_t)(c0 + t) * 256 + g * 16 + fr] = f2bf(gelu_tanh(y));
    }
}

struct AttnState { float m, l; f32x4 o[4]; };
DI void attn_segment(const u16* proj, int kcol, int vcol, int tk0, int kstride, int npairs, int R, float slope, int tq,
                     int lo, int hi, const bf16x8 (&qf)[2], AttnState& st, u16* Vt, int lane) {
  const int fr = lane & 15, fq = lane >> 4;
#pragma unroll 1
  for (int pr = 0; pr < npairs; ++pr) {
    const int kbase = tk0 + pr * 32 * kstride;
    f32x4 sacc[2];
#pragma unroll
    for (int t = 0; t < 2; ++t) {
      int tk = kbase + (t * 16 + fr) * kstride;
      tk = min(max(tk, lo), hi - 1);
      const u16* kp = proj + (size_t)tk * INW + kcol + fq * 8;
      const bf16x8 k0 = *(const bf16x8*)(kp), k1 = *(const bf16x8*)(kp + 32);
      sacc[t] = mfma16(k0, qf[0], (f32x4){0.f, 0.f, 0.f, 0.f});
      sacc[t] = mfma16(k1, qf[1], sacc[t]);
    }
    uint4 vr[4];
#pragma unroll
    for (int i = 0; i < 4; ++i) {
      const int idx = lane + 64 * i, kl = idx >> 3, seg = (idx & 7) * 8;
      int tk = kbase + kl * kstride;
      tk = min(max(tk, lo), hi - 1);
      vr[i] = *(const uint4*)(proj + (size_t)tk * INW + vcol + seg);
    }
    float sc[2][4]; bool ok[2][4];
    float mx = -1e30f;
#pragma unroll
    for (int t = 0; t < 2; ++t)
#pragma unroll
      for (int j = 0; j < 4; ++j) {
        const int tk = kbase + (t * 16 + fq * 4 + j) * kstride;
        const int ad = abs(tk - tq);
        ok[t][j] = (ad <= R) && (tk >= lo) && (tk < hi);
        sc[t][j] = sacc[t][j] * 0.125f - slope * (float)ad;
        if (ok[t][j]) mx = fmaxf(mx, sc[t][j]);
      }
    mx = fmaxf(mx, __shfl_xor(mx, 16, 64));
    mx = fmaxf(mx, __shfl_xor(mx, 32, 64));
    const float mn = fmaxf(st.m, mx);
    const float alpha = __expf(st.m - mn);
    st.m = mn;
    float pv[2][4], ps = 0.f;
#pragma unroll
    for (int t = 0; t < 2; ++t)
#pragma unroll
      for (int j = 0; j < 4; ++j) { pv[t][j] = ok[t][j] ? __expf(sc[t][j] - mn) : 0.f; ps += pv[t][j]; }
    st.l = st.l * alpha + ps;
#pragma unroll
    for (int dt = 0; dt < 4; ++dt)
#pragma unroll
      for (int j = 0; j < 4; ++j) st.o[dt][j] *= alpha;
    bf16x8 pf;
    {
      const unsigned w0 = pack2(pv[0][0], pv[0][1]), w1 = pack2(pv[0][2], pv[0][3]), w2 = pack2(pv[1][0], pv[1][1]),
                     w3 = pack2(pv[1][2], pv[1][3]);
      uint4 t4 = make_uint4(w0, w1, w2, w3);
      pf = __builtin_bit_cast(bf16x8, t4);
    }
    __syncthreads();
#pragma unroll
    for (int i = 0; i < 4; ++i) {
      const int idx = lane + 64 * i, kl = idx >> 3, seg = (idx & 7) * 8;
      Vt[(seg + 0) * 36 + kl] = (u16)(vr[i].x & 0xffff); Vt[(seg + 1) * 36 + kl] = (u16)(vr[i].x >> 16);
      Vt[(seg + 2) * 36 + kl] = (u16)(vr[i].y & 0xffff); Vt[(seg + 3) * 36 + kl] = (u16)(vr[i].y >> 16);
      Vt[(seg + 4) * 36 + kl] = (u16)(vr[i].z & 0xffff); Vt[(seg + 5) * 36 + kl] = (u16)(vr[i].z >> 16);
      Vt[(seg + 6) * 36 + kl] = (u16)(vr[i].w & 0xffff); Vt[(seg + 7) * 36 + kl] = (u16)(vr[i].w >> 16);
    }
    __syncthreads();
#pragma unroll
    for (int dt = 0; dt < 4; ++dt) {
      const uint2 v0 = *(const uint2*)(Vt + (dt * 16 + fr) * 36 + fq * 4);
      const uint2 v1 = *(const uint2*)(Vt + (dt * 16 + fr) * 36 + 16 + fq * 4);
      uint4 t4 = make_uint4(v0.x, v0.y, v1.x, v1.y);
      const bf16x8 vf = __builtin_bit_cast(bf16x8, t4);
      st.o[dt] = mfma16(vf, pf, st.o[dt]);
    }
  }
}
DI void attn_task(const Params& p, int layer, int mode, int task, char* smem) {
  const int lane = my_tid() & 63, wave = my_tid() >> 6;
  const int fr = lane & 15, fq = lane >> 4;
  u16* proj = (u16*)(p.ws + OFF_PROJ);
  u16* Vt = (u16*)smem + wave * 64 * 36;
  int tq0, qstride, qcol, kcol, vcol; float slope;
  int hq;
  if (mode == 0) {
    const int blk = task >> 4, h = (task >> 2) & 3, rq = task & 3;
    hq = h; tq0 = blk * 256 + rq * 4 + wave; qstride = 16;
    qcol = C_BQ + h * 64; kcol = C_BK + h * 64; vcol = C_BV + h * 64;
    slope = exp2f(-(float)(5 + h));
  } else {
    const int blk = task >> 2, qh = task & 3;
    hq = qh; tq0 = blk * 64 + wave * 16; qstride = 1;
    qcol = C_DQ + qh * 64; kcol = C_DK + (qh >> 1) * 64; vcol = C_DV + (qh >> 1) * 64;
    slope = exp2f(-(float)(1 + qh));
  }
  const int lo = seq_lo(tq0), hi = seq_hi(tq0);
  const int tq = tq0 + fr * qstride;
  bf16x8 qf[2];
  {
    const u16* qp = proj + (size_t)tq * INW + qcol + fq * 8;
    qf[0] = *(const bf16x8*)(qp); qf[1] = *(const bf16x8*)(qp + 32);
  }
  AttnState st; st.m = -1e30f; st.l = 0.f;
#pragma unroll
  for (int dt = 0; dt < 4; ++dt) st.o[dt] = (f32x4){0.f, 0.f, 0.f, 0.f};
  __syncthreads();
  float scale;
  if (mode == 0) {
    attn_segment(proj, kcol, vcol, tq0 - 64, 1, 12, 64, slope, tq, lo, hi, qf, st, Vt, lane);
    attn_segment(proj, kcol, vcol, tq0 - 256, 4, 6, 256, slope, tq, lo, hi, qf, st, Vt, lane);
    attn_segment(proj, kcol, vcol, tq0 - 1024, 16, 5, 1024, slope, tq, lo, hi, qf, st, Vt, lane);
    float l = st.l; l += __shfl_xor(l, 16, 64); l += __shfl_xor(l, 32, 64);
    scale = 1.f / l;
  } else {
    attn_segment(proj, kcol, vcol, tq0 - 128, 1, 9, 128, slope, tq, lo, hi, qf, st, Vt, lane);
    float l = st.l; l += __shfl_xor(l, 16, 64); l += __shfl_xor(l, 32, 64);
    const float sink = p.attn_sink[layer * 4 + hq];
    const float mf = fmaxf(st.m, sink);
    const float sc = __expf(st.m - mf);
    scale = sc / (l * sc + __expf(sink - mf));
  }
#pragma unroll
  for (int dt = 0; dt < 4; ++dt) {
    uint2 o; o.x = pack2(st.o[dt][0] * scale, st.o[dt][1] * scale); o.y = pack2(st.o[dt][2] * scale, st.o[dt][3] * scale);
    *(uint2*)(proj + (size_t)tq * INW + qcol + dt * 16 + fq * 4) = o;
  }
}

DI void final_row(const Params& p, int t) {
  const int lane = my_tid() & 63;
  float* row = p.xout + (size_t)t * DM;
  float4 v[4]; float ss = 0.f;
#pragma unroll
  for (int i = 0; i < 4; ++i) {
    v[i] = *(const float4*)(row + i * 256 + lane * 4);
    ss += v[i].x * v[i].x + v[i].y * v[i].y + v[i].z * v[i].z + v[i].w * v[i].w;
  }
  ss = wave_sum(ss);
  const float rs = rsqrtf(ss * (1.f / DM) + EPS);
#pragma unroll
  for (int i = 0; i < 4; ++i) {
    const float4 g = *(const float4*)(p.final_norm + i * 256 + lane * 4);
    *(float4*)(row + i * 256 + lane * 4) = make_float4(v[i].x * rs * g.x, v[i].y * rs * g.y, v[i].z * rs * g.z, v[i].w * rs * g.w);
  }
}

#define XB_TMO      128
#define XB_XCNT(j)  (256  + 64 * (j))
#define XB_XSUB(j)  (1280 + 64 * (j))
#define XB_XGEN(j)  (2304 + 64 * (j))
#define XB_TOP      3328
#define XB_TOPGEN   3392
#define XB_SPIN_CAP (1u << 22)
#define LAS __attribute__((address_space(3)))
DI unsigned xb_ld(unsigned* p) { return __hip_atomic_load(p, __ATOMIC_RELAXED, __HIP_MEMORY_SCOPE_AGENT); }
DI unsigned xb_add(unsigned* p, unsigned v) { return __hip_atomic_fetch_add(p, v, __ATOMIC_RELAXED, __HIP_MEMORY_SCOPE_AGENT); }
DI unsigned xb_xcc_id() { return (unsigned)__builtin_amdgcn_s_getreg((3 << 11) | 20) & 0xFu; }
#define XB_SPIN(cond, bar) do { unsigned _sp = 0; while (cond) { __builtin_amdgcn_s_sleep(1); \
    if ((++_sp & 255u) == 0u) { if (xb_ld(&(bar)[XB_TMO])) break; if (_sp > XB_SPIN_CAP) { atomicAdd(&(bar)[XB_TMO], 1u); break; } } } } while (0)
struct XcdBarrier { unsigned* bar; unsigned x; volatile LAS unsigned* st; };
DI XcdBarrier xcd_barrier_post(unsigned* bar, volatile LAS unsigned* st) {
  XcdBarrier b; b.bar = bar; b.x = xb_xcc_id(); b.st = st;
  if (threadIdx.x == 0) (void)xb_add(&bar[XB_XCNT(b.x)], 1u);
  return b;
}
DI void xcd_barrier_complete(unsigned* bar, unsigned x, unsigned& nloc, unsigned& nx) {
  const unsigned G = gridDim.x * gridDim.y * gridDim.z;
  unsigned sum, cnt, mine, sp = 0u;
  for (;;) {
    sum = 0u; cnt = 0u; mine = 0u;
#pragma unroll
    for (unsigned j = 0; j < 16; ++j) { const unsigned c = xb_ld(&bar[XB_XCNT(j)]); sum += c; cnt += (c > 0u) ? 1u : 0u; mine = (j == x) ? c : mine; }
    if (sum == G) break;
    __builtin_amdgcn_s_sleep(1);
    if ((++sp & 255u) == 0u) { if (xb_ld(&bar[XB_TMO])) break; if (sp > XB_SPIN_CAP) { atomicAdd(&bar[XB_TMO], 1u); break; } }
  }
  nloc = mine > 0u ? mine : 1u; nx = cnt > 0u ? cnt : 1u;
}
DI void xcd_barrier(const XcdBarrier& b) {
  asm volatile("s_waitcnt vmcnt(0)" ::: "memory");
  __syncthreads();
  if (threadIdx.x == 0) {
    unsigned* bar = b.bar;
    __builtin_amdgcn_s_waitcnt(0);
    unsigned nloc = b.st[0], nx = b.st[1];
    if (nloc == 0u) { xcd_barrier_complete(bar, b.x, nloc, nx); b.st[0] = nloc; b.st[1] = nx; }
    const unsigned old = xb_add(&bar[XB_XSUB(b.x)], 1u);
    const unsigned gen = old / nloc;
    if (old + 1u == (gen + 1u) * nloc) {
      __builtin_amdgcn_fence(__ATOMIC_RELEASE, "agent");
      asm volatile("s_waitcnt vmcnt(0)" ::: "memory");
      const unsigned og = xb_add(&bar[XB_TOP], 1u);
      const unsigned tg = og / nx;
      if (og + 1u == (tg + 1u) * nx) xb_add(&bar[XB_TOPGEN], 1u);
      else XB_SPIN(xb_ld(&bar[XB_TOPGEN]) == tg, bar);
      __builtin_amdgcn_fence(__ATOMIC_ACQUIRE, "agent");
      xb_add(&bar[XB_XGEN(b.x)], 1u);
      asm volatile("s_waitcnt vmcnt(0)" ::: "memory");
    } else {
      XB_SPIN(xb_ld(&bar[XB_XGEN(b.x)]) == gen, bar);
      __builtin_amdgcn_fence(__ATOMIC_ACQUIRE, "agent");
      asm volatile("s_waitcnt vmcnt(0)" ::: "memory");
    }
  }
  __syncthreads();
}

enum { PH_NORM1 = 0, PH_INPROJ, PH_MIX1, PH_MIX2, PH_MIX3, PH_MERGE, PH_OUT, PH_NORM2, PH_FFN1, PH_FFN2, PH_PER_LAYER, PH_FINAL = 100 };

DI void run_phase(const Params& p, int ph, int layer, char* smem) {
  const int b = blockIdx.x, G = gridDim.x;
  const int wave = my_tid() >> 6;
  switch (ph) {
    case PH_NORM1: {
      if (layer == 0) {
        for (int t = b; t < 2 * CONV_TILES_LAYER; t += G) {
          ConvJob j;
          const int lt = conv_lookup(p, t, j);
          conv_tile(j, lt, (float*)smem);
        }
      }
      if (b == 0 && my_tid() == 0) *(unsigned*)(p.ws + OFF_CNT) = 0u;
      rms_phase(p, layer, p.norm1 + layer * DM, (u16*)(p.ws + OFF_H), b, G);
    } break;
    case PH_INPROJ: gemm_inproj(p, layer, b, G, (u16*)smem); break;
    case PH_MIX1: {
      for (int t = b; t < 2 * 3072; t += G) {
        const int kind = t / 3072, idx = t % 3072;
        if (kind == 0) gdn_pre(p, layer, idx, smem);
        else s5_pass1(p, layer, idx, smem);
      }
    } break;
    case PH_MIX2: {
      for (int c = b; c < 288; c += G) gdn_scan(p, c, smem);
      {
        unsigned* cnt = (unsigned*)(p.ws + OFF_CNT);
        int* slot = (int*)(smem + SMEM_BYTES - 16);
        for (;;) {
          __syncthreads();
          if (my_tid() == 0) *slot = (int)atomicAdd(cnt, 1u);
          __syncthreads();
          const int t = *slot;
          if (t >= 3 * 3072) break;
          if (t < 3072) s5_pass3(p, layer, t, smem);
          else if (t < 2 * 3072) attn_task(p, layer, 0, t - 3072, smem);
          else attn_task(p, layer, 1, t - 2 * 3072, smem);
        }
      }
    } break;
    case PH_MIX3: {
      gemm_glu(p, layer, b, G, (u16*)smem);
      for (int t = b * 4 + wave; t < T; t += G * 4) gdn_post_row(p, layer, t);
      rms_phase(p, layer, p.norm1 + layer * DM, (u16*)(p.ws + OFF_H), b, G);
    } break;
    case PH_MERGE: gemm_merge(p, layer, b, G, (u16*)smem); break;
    case PH_OUT:
      gemm_resid(p, layer, (const u16*)(p.ws + OFF_MERGED), DM, (const u16*)(p.ws + OFF_W) + layer * W_LAYER + WO_OUT, b, G, (u16*)smem);
      break;
    case PH_NORM2: rms_phase(p, 1, p.norm2 + layer * DM, (u16*)(p.ws + OFF_H2), b, G); break;
    case PH_FFN1: gemm_ffn1(p, layer, b, G, (u16*)smem); break;
    case PH_FFN2:
      gemm_resid(p, 1, (const u16*)(p.ws + OFF_ACT), FH, (const u16*)(p.ws + OFF_W) + layer * W_LAYER + WO_DN, b, G, (u16*)smem);
      break;
    case PH_FINAL:
      for (int t = b * 4 + wave; t < T; t += G * 4) final_row(p, t);
      break;
    default: break;
  }
}

#if !MEGA
__global__ void __launch_bounds__(256, 2) k_phase(Params p, int ph, int layer) {
  __shared__ __attribute__((aligned(16))) char smem[SMEM_BYTES];
  run_phase(p, ph, layer, smem);
}

#else
__global__ void __launch_bounds__(256, 2) k_mega(Params p) {
  __shared__ __attribute__((aligned(16))) char smem[SMEM_BYTES];
  __shared__ uint4 xb_words;
  cg::grid_group grid = cg::this_grid();
  if (threadIdx.x == 0) xb_words = make_uint4(0u, 0u, 0u, 0u);
  __syncthreads();
  const XcdBarrier xb = xcd_barrier_post((unsigned*)(p.ws + OFF_BAR), (volatile LAS unsigned*)&xb_words);
  for (int layer = 0; layer < 2; ++layer)
    for (int ph = 0; ph < PH_PER_LAYER; ++ph) {
      run_phase(p, ph, layer, smem);
      if (layer == 1 && ph == PH_PER_LAYER - 1) grid.sync(); else xcd_barrier(xb);
#ifdef PROBE_DUP
      if (ph == PROBE_DUP) { run_phase(p, ph, layer, smem); grid.sync(); }
#endif
    }
  run_phase(p, PH_FINAL, 0, smem);
}
#endif

extern "C" void kernel_launch(void* const* d_in, const int* in_sizes, int n_in, void* d_out, int out_size, void* d_ws,
                              size_t ws_size, hipStream_t stream) {
  (void)in_sizes; (void)n_in; (void)out_size;
  if (ws_size < WS_NEED) { fprintf(stderr, "workspace too small: %zu < %zu\n", ws_size, (size_t)WS_NEED); return; }
  Params p;
  memset(&p, 0, sizeof(p));
  const float* const* in = (const float* const*)d_in;
  p.x_prompt = in[0]; p.x_sample = in[1]; p.norm1 = in[2]; p.conv_a = in[4]; p.a_log = in[5]; p.dt_bias = in[6];
  p.a_norm = in[7]; p.lam_re = in[8]; p.lam_im = in[9]; p.log_step = in[10]; p.b_re = in[11]; p.b_im = in[12];
  p.c_re = in[13]; p.c_im = in[14]; p.s5_d = in[15]; p.attn_sink = in[17]; p.norm2 = in[21]; p.final_norm = in[25];
  p.xout = (float*)d_out;
  p.ws = (char*)d_ws;
  p.w_in = in[3]; p.w_glu = in[16]; p.w_gate = in[18]; p.w_branch = in[19]; p.w_out = in[20];
  p.w_ffn_gate = in[22]; p.w_ffn_up = in[23]; p.w_ffn_down = in[24];
  static int grid_blocks = 0;
  if (!grid_blocks) {
    int dev = 0, cus = 0, per_cu = 0;
    hipGetDevice(&dev);
    hipDeviceGetAttribute(&cus, hipDeviceAttributeMultiprocessorCount, dev);
#if MEGA
    hipOccupancyMaxActiveBlocksPerMultiprocessor(&per_cu, k_mega, 256, 0);
#else
    hipOccupancyMaxActiveBlocksPerMultiprocessor(&per_cu, k_phase, 256, 0);
#endif
    per_cu = 2;
    grid_blocks = cus * per_cu;
  }
#if MEGA
  hipMemsetAsync((char*)d_ws + OFF_BAR, 0, BAR_BYTES, stream);
  void* args[] = {&p};
  hipError_t e = hipLaunchCooperativeKernel((void*)k_mega, dim3(grid_blocks), dim3(256), args, 0, stream);
  if (e != hipSuccess) fprintf(stderr, "cooperative launch failed: %s (grid %d)\n", hipGetErrorString(e), grid_blocks);
#else
  for (int layer = 0; layer < 2; ++layer)
    for (int ph = 0; ph < PH_PER_LAYER; ++ph) hipLaunchKernelGGL(k_phase, dim3(grid_blocks), dim3(256), 0, stream, p, ph, layer);
  hipLaunchKernelGGL(k_phase, dim3(grid_blocks), dim3(256), 0, stream, p, (int)PH_FINAL, 0);
#endif
}
```

```cpp
#include <hip/hip_runtime.h>
#include <hip/hip_cooperative_groups.h>
#include <cstdio>
#include <cstring>
namespace cg = cooperative_groups;

#ifndef MEGA
#define MEGA 1
#endif

#define DI __device__ __forceinline__
typedef unsigned short u16;
typedef __attribute__((ext_vector_type(8))) short bf16x8;
typedef __attribute__((ext_vector_type(4))) float f32x4;

constexpr int T = 49152;
constexpr int TP = 16384;
constexpr int DM = 1024;
constexpr int INW = 2576;
constexpr int FH = 2816;
constexpr int NCH64 = T / 64;
constexpr float EPS = 1e-6f;

constexpr int C_AQ = 0, C_AK = 256, C_AV = 512, C_AZ = 768, C_BQ = 1040, C_BK = 1296, C_BV = 1552, C_CU = 1808,
              C_DQ = 2064, C_DK = 2320, C_DV = 2448;

constexpr size_t WO_IN = 0, WO_GATE = 2752512, WO_BR = 6946816, WO_OUT = 7995392, WO_GU = 9043968, WO_DN = 14811136,
                 WO_GLU = 17694720, W_LAYER = 17825792;
constexpr size_t OFF_W = 0;
constexpr size_t OFF_PROJ = 2 * W_LAYER * 2;
constexpr size_t SZ_PROJ = (size_t)T * INW * 2;
constexpr size_t OFF_R1 = OFF_PROJ + SZ_PROJ;
constexpr size_t SZ_H = (size_t)T * DM * 2;
constexpr size_t OFF_H = OFF_R1;
constexpr size_t OFF_UW = OFF_R1;
constexpr size_t OFF_QN = OFF_R1 + SZ_H;
constexpr size_t OFF_KN = OFF_QN + (size_t)T * 256 * 2;
constexpr size_t OFF_GC = OFF_KN + (size_t)T * 256 * 2;
constexpr size_t OFF_SEND = OFF_GC + (size_t)NCH64 * 8 * 64 * 4;
constexpr size_t OFF_G = OFF_SEND + (size_t)NCH64 * 2 * 1024 * 8;
constexpr size_t OFF_AB = OFF_G + (size_t)T * 256 * 2;
constexpr size_t OFF_CNT = OFF_AB + (size_t)T * 16 * 4;
constexpr size_t OFF_MERGED = OFF_R1 + SZ_H;
constexpr size_t OFF_H2 = OFF_MERGED;
constexpr size_t OFF_ACT = OFF_PROJ;
constexpr size_t OFF_BAR = OFF_MERGED + SZ_H;
constexpr size_t BAR_BYTES = 3456 * 4;
constexpr size_t WS_NEED = OFF_BAR + 16384;

constexpr int SMEM_BYTES = 75776;

struct ConvJob { const float* src; u16* dst; int K, ncols, nrows_dst, src_ld, rs, off, ntn; };
struct Params {
  const float *x_prompt, *x_sample, *norm1, *conv_a, *a_log, *dt_bias, *a_norm, *lam_re, *lam_im, *log_step, *b_re,
      *b_im, *c_re, *c_im, *s5_d, *attn_sink, *norm2, *final_norm;
  const float *w_in, *w_gate, *w_branch, *w_out, *w_ffn_gate, *w_ffn_up, *w_ffn_down, *w_glu;
  float* xout;
  char* ws;
};
constexpr int CONV_TILES_LAYER = 4352;

DI int my_tid() { int t = threadIdx.x; asm volatile("" : "+v"(t)); return t; }
DI u16 f2bf(float x) { unsigned u = __float_as_uint(x); u += 0x7fffu + ((u >> 16) & 1u); return (u16)(u >> 16); }
DI float bf2f(u16 v) { return __uint_as_float(((unsigned)v) << 16); }
DI unsigned pack2(float a, float b) { return (unsigned)f2bf(a) | ((unsigned)f2bf(b) << 16); }
DI float sigmoidf_(float x) { return 1.f / (1.f + __expf(-x)); }
DI float siluf_(float x) { return x / (1.f + __expf(-x)); }
DI float wave_sum(float v) {
#pragma unroll
  for (int o = 32; o > 0; o >>= 1) v += __shfl_xor(v, o, 64);
  return v;
}
DI int seq_lo(int t) { return t < TP ? 0 : (t & ~4095); }
DI int seq_hi(int t) { return t < TP ? TP : (t & ~4095) + 4096; }
DI const float* xrow(const Params& p, int layer, int t) {
  if (layer == 0) return t < TP ? p.x_prompt + (size_t)t * DM : p.x_sample + (size_t)(t - TP) * DM;
  return p.xout + (size_t)t * DM;
}
DI f32x4 mfma16(bf16x8 a, bf16x8 b, f32x4 c) { return __builtin_amdgcn_mfma_f32_16x16x32_bf16(a, b, c, 0, 0, 0); }

DI void mk_job(ConvJob& j, const float* src, u16* dst, int K, int ncols, int nrows_dst, int src_ld, int rs, int off) {
  j.src = src; j.dst = dst; j.K = K; j.ncols = ncols; j.nrows_dst = nrows_dst; j.src_ld = src_ld; j.rs = rs; j.off = off;
  j.ntn = (nrows_dst + 63) >> 6;
}
DI int conv_lookup(const Params& p, int t, ConvJob& j) {
  const int l = t / CONV_TILES_LAYER;
  int r = t % CONV_TILES_LAYER;
  u16* wl = (u16*)(p.ws + OFF_W) + (size_t)l * W_LAYER;
  if (r < 672) { mk_job(j, p.w_in + (size_t)l * DM * INW, wl + WO_IN, DM, INW, 2688, INW, 32, 0); return r; }
  r -= 672;
  if (r < 1024) { const int i = r >> 8; mk_job(j, p.w_gate + (size_t)(l * 4 + i) * DM * DM, wl + WO_GATE + (size_t)i * DM * DM, DM, DM, DM, DM, 32, 0); return r & 255; }
  r -= 1024;
  if (r < 256) { const int i = r >> 6; mk_job(j, p.w_branch + (size_t)(l * 4 + i) * 256 * DM, wl + WO_BR + (size_t)i * DM * 256, 256, DM, DM, DM, 32, 0); return r & 63; }
  r -= 256;
  if (r < 256) { mk_job(j, p.w_out + (size_t)l * DM * DM, wl + WO_OUT, DM, DM, DM, DM, 32, 0); return r; }
  r -= 256;
  if (r < 704) { mk_job(j, p.w_ffn_gate + (size_t)l * DM * FH, wl + WO_GU, DM, FH, FH, FH, 64, 0); return r; }
  r -= 704;
  if (r < 704) { mk_job(j, p.w_ffn_up + (size_t)l * DM * FH, wl + WO_GU, DM, FH, FH, FH, 64, 32); return r; }
  r -= 704;
  if (r < 704) { mk_job(j, p.w_ffn_down + (size_t)l * FH * DM, wl + WO_DN, FH, DM, DM, DM, 32, 0); return r; }
  r -= 704;
  if (r < 16) { mk_job(j, p.w_glu + (size_t)l * 256 * 512, wl + WO_GLU, 256, 256, 256, 512, 64, 0); return r; }
  r -= 16;
  mk_job(j, p.w_glu + (size_t)l * 256 * 512 + 256, wl + WO_GLU, 256, 256, 256, 512, 64, 32);
  return r;
}
DI void conv_tile(const ConvJob& j, int lt, float* tile) {
  const int tid = my_tid();
  const int tk = lt / j.ntn, tn = lt % j.ntn;
  __syncthreads();
#pragma unroll
  for (int i = 0; i < 4; ++i) {
    int r = (tid >> 4) + 16 * i, c4 = (tid & 15) * 4, n = tn * 64 + c4;
    float4 v = make_float4(0.f, 0.f, 0.f, 0.f);
    if (n < j.ncols) v = *(const float4*)(j.src + (size_t)(tk * 64 + r) * j.src_ld + n);
    tile[r * 65 + c4 + 0] = v.x; tile[r * 65 + c4 + 1] = v.y; tile[r * 65 + c4 + 2] = v.z; tile[r * 65 + c4 + 3] = v.w;
  }
  __syncthreads();
  const int cl = tid >> 2, ks = (tid & 3) * 16, n = tn * 64 + cl;
  if (n < j.nrows_dst) {
    unsigned w[8];
#pragma unroll
    for (int e = 0; e < 8; ++e) w[e] = pack2(tile[(ks + 2 * e) * 65 + cl], tile[(ks + 2 * e + 1) * 65 + cl]);
    const int nm = (n >> 5) * j.rs + (n & 31) + j.off;
    uint4* d = (uint4*)(j.dst + (size_t)nm * j.K + tk * 64 + ks);
    d[0] = make_uint4(w[0], w[1], w[2], w[3]);
    d[1] = make_uint4(w[4], w[5], w[6], w[7]);
  }
}

DI void rms_row_bf16(const float* src, const float* w, u16* dst) {
  const int lane = my_tid() & 63;
  float4 v[4];
  float ss = 0.f;
#pragma unroll
  for (int i = 0; i < 4; ++i) {
    v[i] = *(const float4*)(src + i * 256 + lane * 4);
    ss += v[i].x * v[i].x + v[i].y * v[i].y + v[i].z * v[i].z + v[i].w * v[i].w;
  }
  ss = wave_sum(ss);
  const float rs = rsqrtf(ss * (1.f / DM) + EPS);
#pragma unroll
  for (int i = 0; i < 4; ++i) {
    float4 g = *(const float4*)(w + i * 256 + lane * 4);
    uint2 o;
    o.x = pack2(v[i].x * rs * g.x, v[i].y * rs * g.y);
    o.y = pack2(v[i].z * rs * g.z, v[i].w * rs * g.w);
    *(uint2*)(dst + i * 256 + lane * 4) = o;
  }
}
DI void rms_phase(const Params& p, int layer, const float* w, u16* dst, int b0, int nb) {
  const int wave = my_tid() >> 6;
  for (int r = b0 * 4 + wave; r < T; r += nb * 4) rms_row_bf16(xrow(p, layer, r), w, dst + (size_t)r * DM);
}

constexpr int GP = 64;
#ifndef GEMM_DMA
#define GEMM_DMA 1
#endif
#if GEMM_DMA
template <int NT, bool SPLIT = false>
DI void gemm_kloop(const u16* __restrict__ A, size_t lda, const u16* __restrict__ B, size_t ldb, int nk,
                   f32x4 (&acc)[4][NT], u16* sm) {
  const int tid = my_tid(), lane = tid & 63;
  const int wave = __builtin_amdgcn_readfirstlane(tid >> 6);
  const int fr = lane & 15, fq = lane >> 4, wr = wave >> 1, wc = wave & 1;
  u16* sa = sm;
  u16* sb = sm + 2 * 128 * 64;
  const int swz = (fr >> 1) & 7;
  const int lr = lane >> 3;
  const int lc = ((lane & 7) ^ ((lr >> 1) & 3)) * 8;
#define DMA_PIECE(BASE, LD, G, KOFF, DST)                                                              \
  {                                                                                                    \
    int lrl_ = lr;                                                                                     \
    asm volatile("" : "+v"(lrl_));   \
    const int row_ = (G) * 8 + lrl_;                                                                   \
    const int col_ = lc ^ ((((G) & 1) * 4) * 8);                                                       \
    __builtin_amdgcn_global_load_lds((const unsigned*)((BASE) + (size_t)row_ * (LD) + (KOFF) + col_),  \
                                     (unsigned*)((DST) + (G) * 512), 16, 0, 0);                        \
  }
#define DMA_TILE(KOFF, STAGE)                                                                          \
  {                                                                                                    \
    u16* da_ = sa + (STAGE) * 8192;                                                                    \
    u16* db_ = sb + (STAGE) * 8192;                                                                    \
    DMA_PIECE(A, lda, wave * 4 + 0, KOFF, da_) DMA_PIECE(A, lda, wave * 4 + 1, KOFF, da_)              \
    DMA_PIECE(A, lda, wave * 4 + 2, KOFF, da_) DMA_PIECE(A, lda, wave * 4 + 3, KOFF, da_)              \
    if (NT == 4) {                                                                                     \
      DMA_PIECE(B, ldb, wave * 4 + 0, KOFF, db_) DMA_PIECE(B, ldb, wave * 4 + 1, KOFF, db_)            \
      DMA_PIECE(B, ldb, wave * 4 + 2, KOFF, db_) DMA_PIECE(B, ldb, wave * 4 + 3, KOFF, db_)            \
    } else {                                                                                           \
      DMA_PIECE(B, ldb, wave * 2 + 0, KOFF, db_) DMA_PIECE(B, ldb, wave * 2 + 1, KOFF, db_)            \
    }                                                                                                  \
  }
  __builtin_amdgcn_s_barrier();
  DMA_TILE(0, 0)
#pragma unroll 1
  for (int kt = 0; kt < nk; ++kt) {
    const int cur = kt & 1;
    asm volatile("s_waitcnt vmcnt(0)" ::: "memory");
    __builtin_amdgcn_s_barrier();
    asm volatile("" ::: "memory");
    const u16* ca = sa + cur * 8192;
    const u16* cb = sb + cur * 8192;
    if (SPLIT) {
      bf16x8 wf[NT], xf[4];
#pragma unroll
      for (int nt = 0; nt < NT; ++nt) wf[nt] = *(const bf16x8*)(cb + (wc * NT * 16 + nt * 16 + fr) * 64 + (((0 * 4 + fq) ^ swz) * 8));
#pragma unroll
      for (int mt = 0; mt < 4; ++mt) xf[mt] = *(const bf16x8*)(ca + (wr * 64 + mt * 16 + fr) * 64 + (((0 * 4 + fq) ^ swz) * 8));
#pragma unroll
      for (int mt = 0; mt < 4; ++mt)
#pragma unroll
        for (int nt = 0; nt < NT; ++nt) acc[mt][nt] = mfma16(wf[nt], xf[mt], acc[mt][nt]);
#pragma unroll
      for (int nt = 0; nt < NT; ++nt) wf[nt] = *(const bf16x8*)(cb + (wc * NT * 16 + nt * 16 + fr) * 64 + (((1 * 4 + fq) ^ swz) * 8));
#pragma unroll
      for (int mt = 0; mt < 4; ++mt) xf[mt] = *(const bf16x8*)(ca + (wr * 64 + mt * 16 + fr) * 64 + (((1 * 4 + fq) ^ swz) * 8));
      __builtin_amdgcn_sched_barrier(0);
      if (kt + 1 < nk) DMA_TILE((kt + 1) * 64, cur ^ 1)
      __builtin_amdgcn_sched_barrier(0);
#pragma unroll
      for (int mt = 0; mt < 4; ++mt)
#pragma unroll
        for (int nt = 0; nt < NT; ++nt) acc[mt][nt] = mfma16(wf[nt], xf[mt], acc[mt][nt]);
      continue;
    }
    bf16x8 wf[2][NT], xf[2][4];
#pragma unroll
    for (int kk = 0; kk < 2; ++kk) {
#pragma unroll
      for (int nt = 0; nt < NT; ++nt) wf[kk][nt] = *(const bf16x8*)(cb + (wc * NT * 16 + nt * 16 + fr) * 64 + (((kk * 4 + fq) ^ swz) * 8));
#pragma unroll
      for (int mt = 0; mt < 4; ++mt) xf[kk][mt] = *(const bf16x8*)(ca + (wr * 64 + mt * 16 + fr) * 64 + (((kk * 4 + fq) ^ swz) * 8));
    }
    __builtin_amdgcn_sched_barrier(0);
    if (kt + 1 < nk) DMA_TILE((kt + 1) * 64, cur ^ 1)
    __builtin_amdgcn_sched_barrier(0);
#pragma unroll
    for (int kk = 0; kk < 2; ++kk)
#pragma unroll
      for (int mt = 0; mt < 4; ++mt)
#pragma unroll
        for (int nt = 0; nt < NT; ++nt) acc[mt][nt] = mfma16(wf[kk][nt], xf[kk][mt], acc[mt][nt]);
  }
}
#else
template <int NT>
DI void gemm_kloop(const u16* __restrict__ A, size_t lda, const u16* __restrict__ B, size_t ldb, int nk,
                   f32x4 (&acc)[4][NT], u16* sm) {
  const int tid = my_tid(), lane = tid & 63, wave = tid >> 6;
  const int fr = lane & 15, fq = lane >> 4, wr = wave >> 1, wc = wave & 1;
  u16* sa = sm;
  u16* sb = sm + 2 * 128 * GP;
  uint4 ra0, ra1, ra2, ra3, rb0, rb1, rb2 = make_uint4(0, 0, 0, 0), rb3 = make_uint4(0, 0, 0, 0);
  uint4 rc0, rc1, rc2, rc3, rd0, rd1, rd2 = make_uint4(0, 0, 0, 0), rd3 = make_uint4(0, 0, 0, 0);
  const int lrow = tid >> 3, lseg = (tid & 7) * 8;
  const int sseg = ((tid & 7) ^ ((lrow >> 1) & 7)) * 8;
  const u16* Ap = A + (size_t)lrow * lda + lseg;
  const u16* Bp = B + (size_t)lrow * ldb + lseg;
#define KL_LOAD(KOFF, A0, A1, A2, A3, B0, B1, B2, B3)                    \
  A0 = *(const uint4*)(Ap + (KOFF));                                     \
  A1 = *(const uint4*)(Ap + 32 * lda + (KOFF));                          \
  A2 = *(const uint4*)(Ap + 64 * lda + (KOFF));                          \
  A3 = *(const uint4*)(Ap + 96 * lda + (KOFF));                          \
  B0 = *(const uint4*)(Bp + (KOFF));                                     \
  B1 = *(const uint4*)(Bp + 32 * ldb + (KOFF));                          \
  if (NT > 2) { B2 = *(const uint4*)(Bp + 64 * ldb + (KOFF)); B3 = *(const uint4*)(Bp + 96 * ldb + (KOFF)); }
#define KL_STORE(SA, SB, A0, A1, A2, A3, B0, B1, B2, B3)                 \
  *(uint4*)((SA) + (lrow + 0) * GP + sseg) = A0;                         \
  *(uint4*)((SA) + (lrow + 32) * GP + sseg) = A1;                        \
  *(uint4*)((SA) + (lrow + 64) * GP + sseg) = A2;                        \
  *(uint4*)((SA) + (lrow + 96) * GP + sseg) = A3;                        \
  *(uint4*)((SB) + (lrow + 0) * GP + sseg) = B0;                         \
  *(uint4*)((SB) + (lrow + 32) * GP + sseg) = B1;                        \
  if (NT > 2) { *(uint4*)((SB) + (lrow + 64) * GP + sseg) = B2; *(uint4*)((SB) + (lrow + 96) * GP + sseg) = B3; }
#define KL_COMPUTE(CA, CB)                                                                                     \
  _Pragma("unroll") for (int kk = 0; kk < 2; ++kk) {                                                           \
    bf16x8 wf[NT], xf[4];                                                                                      \
    _Pragma("unroll") for (int nt = 0; nt < NT; ++nt)                                                          \
      wf[nt] = *(const bf16x8*)((CB) + (wc * NT * 16 + nt * 16 + fr) * GP + (((kk * 4 + fq) ^ swz) * 8));       \
    _Pragma("unroll") for (int mt = 0; mt < 4; ++mt)                                                           \
      xf[mt] = *(const bf16x8*)((CA) + (wr * 64 + mt * 16 + fr) * GP + (((kk * 4 + fq) ^ swz) * 8));            \
    _Pragma("unroll") for (int mt = 0; mt < 4; ++mt)                                                           \
    _Pragma("unroll") for (int nt = 0; nt < NT; ++nt) acc[mt][nt] = mfma16(wf[nt], xf[mt], acc[mt][nt]);      \
  }
  const int swz = (fr >> 1) & 7;
  KL_LOAD(0, ra0, ra1, ra2, ra3, rb0, rb1, rb2, rb3)
  KL_LOAD(64, rc0, rc1, rc2, rc3, rd0, rd1, rd2, rd3)
  KL_STORE(sa, sb, ra0, ra1, ra2, ra3, rb0, rb1, rb2, rb3)
  __syncthreads();
  u16* sa1 = sa + 128 * GP;
  u16* sb1 = sb + 128 * GP;
#pragma unroll 1
  for (int kt = 0; kt < nk; kt += 2) {
    const int k2 = (kt + 2 < nk ? kt + 2 : kt) * 64, k3 = (kt + 3 < nk ? kt + 3 : kt + 1) * 64;
    KL_LOAD(k2, ra0, ra1, ra2, ra3, rb0, rb1, rb2, rb3)
    __builtin_amdgcn_sched_barrier(0);
    KL_COMPUTE(sa, sb)
    KL_STORE(sa1, sb1, rc0, rc1, rc2, rc3, rd0, rd1, rd2, rd3)
    __syncthreads();
    KL_LOAD(k3, rc0, rc1, rc2, rc3, rd0, rd1, rd2, rd3)
    __builtin_amdgcn_sched_barrier(0);
    KL_COMPUTE(sa1, sb1)
    KL_STORE(sa, sb, ra0, ra1, ra2, ra3, rb0, rb1, rb2, rb3)
    __syncthreads();
  }
}
#endif
template <int NT>
DI void zero_acc(f32x4 (&acc)[4][NT]) {
#pragma unroll
  for (int a = 0; a < 4; ++a)
#pragma unroll
    for (int b = 0; b < NT; ++b) acc[a][b] = (f32x4){0.f, 0.f, 0.f, 0.f};
}

struct TileIter {
  int step, nsteps, nrb, nct, x, li, lj, mode, idx, stride, L;
  DI void init(int nrt, int nct_, int b, int G) {
    nct = nct_;
    if (G == 512 && (nrt % 64) == 0) {
      mode = 1; x = b & 7;
      const int local = b >> 3;
      li = local >> 3; lj = local & 7;
      nrb = nrt / 64;
      nsteps = nrb * ((nct + 7) >> 3);
      step = 0;
      skip();
    } else {
      mode = 0; idx = b; stride = G; L = nrt * nct;
    }
  }
  DI int ctile() const { return (step / nrb) * 8 + lj; }
  DI void skip() { while (step < nsteps && ctile() >= nct) ++step; }
  DI bool valid() const { return mode ? step < nsteps : idx < L; }
  DI int rt() const { return mode ? x + 8 * ((step % nrb) * 8 + li) : idx / nct; }
  DI int ct() const { return mode ? ctile() : idx % nct; }
  DI void next() { if (mode) { ++step; skip(); } else idx += stride; }
};

#define EPI_COORDS                                                       \
  const int lane = my_tid() & 63, wave = my_tid() >> 6;           \
  const int fr = lane & 15, fq = lane >> 4, wr = wave >> 1, wc = wave & 1; \
  (void)fr; (void)fq; (void)wr; (void)wc;

DI void gemm_inproj(const Params& p, int layer, int b, int G, u16* sm) {
  const u16* H = (const u16*)(p.ws + OFF_H);
  const u16* W = (const u16*)(p.ws + OFF_W) + layer * W_LAYER + WO_IN;
  u16* proj = (u16*)(p.ws + OFF_PROJ);
  float* AB = (float*)(p.ws + OFF_AB);
  EPI_COORDS
  TileIter it; it.init(T / 128, 21, b, G);
  for (; it.valid(); it.next()) {
    const int row0 = it.rt() * 128, col0 = it.ct() * 128;
    f32x4 acc[4][4]; zero_acc<4>(acc);
    gemm_kloop<4>(H + (size_t)row0 * DM, DM, W + (size_t)col0 * DM, DM, 16, acc, sm);
#pragma unroll
    for (int mt = 0; mt < 4; ++mt) {
      const int row = row0 + wr * 64 + mt * 16 + fr;
#pragma unroll
      for (int nt = 0; nt < 4; ++nt) {
        const int col = col0 + wc * 64 + nt * 16 + fq * 4;
        if (col < INW) {
          uint2 o; o.x = pack2(acc[mt][nt][0], acc[mt][nt][1]); o.y = pack2(acc[mt][nt][2], acc[mt][nt][3]);
          *(uint2*)(proj + (size_t)row * INW + col) = o;
          if (col >= 1024 && col < 1040)
            *(float4*)(AB + (size_t)row * 16 + (col - 1024)) = make_float4(acc[mt][nt][0], acc[mt][nt][1], acc[mt][nt][2], acc[mt][nt][3]);
        }
      }
    }
  }
}

DI void gemm_glu(const Params& p, int layer, int b, int G, u16* sm) {
  const u16* Gb = (const u16*)(p.ws + OFF_G);
  const u16* W = (const u16*)(p.ws + OFF_W) + layer * W_LAYER + WO_GLU;
  u16* proj = (u16*)(p.ws + OFF_PROJ);
  EPI_COORDS
  TileIter it; it.init(T / 128, 4, b, G);
  for (; it.valid(); it.next()) {
    const int row0 = it.rt() * 128, ct = it.ct();
    f32x4 acc[4][4]; zero_acc<4>(acc);
    gemm_kloop<4>(Gb + (size_t)row0 * 256, 256, W + (size_t)ct * 128 * 256, 256, 4, acc, sm);
#pragma unroll
    for (int mt = 0; mt < 4; ++mt) {
      const int row = row0 + wr * 64 + mt * 16 + fr;
#pragma unroll
      for (int nt = 0; nt < 2; ++nt) {
        const int col = (ct * 2 + wc) * 32 + nt * 16 + fq * 4;
        float o[4];
#pragma unroll
        for (int j = 0; j < 4; ++j) o[j] = acc[mt][nt][j] * sigmoidf_(acc[mt][nt + 2][j]);
        uint2 ov; ov.x = pack2(o[0], o[1]); ov.y = pack2(o[2], o[3]);
        *(uint2*)(proj + (size_t)row * INW + C_CU + col) = ov;
      }
    }
  }
}

DI void gemm_merge(const Params& p, int layer, int b, int G, u16* sm) {
  const u16* H = (const u16*)(p.ws + OFF_H);
  const u16* Wg = (const u16*)(p.ws + OFF_W) + layer * W_LAYER + WO_GATE;
  const u16* Wb = (const u16*)(p.ws + OFF_W) + layer * W_LAYER + WO_BR;
  const u16* proj = (const u16*)(p.ws + OFF_PROJ);
  u16* merged = (u16*)(p.ws + OFF_MERGED);
  EPI_COORDS
  TileIter it; it.init(T / 128, 8, b, G);
  for (; it.valid(); it.next()) {
    const int row0 = it.rt() * 128, col0 = it.ct() * 128;
    uint2 mg[4][4];
#pragma unroll
    for (int a = 0; a < 4; ++a)
#pragma unroll
      for (int c = 0; c < 4; ++c) mg[a][c] = make_uint2(0u, 0u);
#pragma unroll 1
    for (int i = 0; i < 4; ++i) {
      const int ocol = (i == 0) ? C_AZ : (i == 1) ? C_BQ : (i == 2) ? C_CU : C_DQ;
      f32x4 acc[4][4]; zero_acc<4>(acc);
      gemm_kloop<4, true>(H + (size_t)row0 * DM, DM, Wg + (size_t)i * DM * DM + (size_t)col0 * DM, DM, 16, acc, sm);
      uint2 sg[4][4];
#pragma unroll
      for (int a = 0; a < 4; ++a)
#pragma unroll
        for (int c = 0; c < 4; ++c) {
          sg[a][c].x = pack2(sigmoidf_(acc[a][c][0]), sigmoidf_(acc[a][c][1]));
          sg[a][c].y = pack2(sigmoidf_(acc[a][c][2]), sigmoidf_(acc[a][c][3]));
        }
      zero_acc<4>(acc);
      gemm_kloop<4, true>(proj + (size_t)row0 * INW + ocol, INW, Wb + (size_t)i * DM * 256 + (size_t)col0 * 256, 256, 4, acc, sm);
#pragma unroll
      for (int a = 0; a < 4; ++a)
#pragma unroll
        for (int c = 0; c < 4; ++c) {
          const float m0 = bf2f((u16)(mg[a][c].x & 0xffff)) + bf2f((u16)(sg[a][c].x & 0xffff)) * acc[a][c][0];
          const float m1 = bf2f((u16)(mg[a][c].x >> 16)) + bf2f((u16)(sg[a][c].x >> 16)) * acc[a][c][1];
          const float m2 = bf2f((u16)(mg[a][c].y & 0xffff)) + bf2f((u16)(sg[a][c].y & 0xffff)) * acc[a][c][2];
          const float m3 = bf2f((u16)(mg[a][c].y >> 16)) + bf2f((u16)(sg[a][c].y >> 16)) * acc[a][c][3];
          mg[a][c].x = pack2(m0, m1); mg[a][c].y = pack2(m2, m3);
        }
    }
#pragma unroll
    for (int mt = 0; mt < 4; ++mt) {
      const int row = row0 + wr * 64 + mt * 16 + fr;
#pragma unroll
      for (int nt = 0; nt < 4; ++nt) {
        const int col = col0 + wc * 64 + nt * 16 + fq * 4;
        *(uint2*)(merged + (size_t)row * DM + col) = mg[mt][nt];
      }
    }
  }
}

DI void gemm_resid(const Params& p, int layer_src, const u16* A, int K, const u16* W, int b, int G, u16* sm) {
  EPI_COORDS
  TileIter it; it.init(T / 128, 8, b, G);
  for (; it.valid(); it.next()) {
    const int row0 = it.rt() * 128, col0 = it.ct() * 128;
    f32x4 acc[4][4]; zero_acc<4>(acc);
    gemm_kloop<4>(A + (size_t)row0 * K, K, W + (size_t)col0 * K, K, K / 64, acc, sm);
#pragma unroll
    for (int mt = 0; mt < 4; ++mt) {
      const int row = row0 + wr * 64 + mt * 16 + fr;
      const float* xs = xrow(p, layer_src, row);
      float* xd = p.xout + (size_t)row * DM;
#pragma unroll
      for (int nt = 0; nt < 4; ++nt) {
        const int col = col0 + wc * 64 + nt * 16 + fq * 4;
        float4 r = *(const float4*)(xs + col);
        r.x += acc[mt][nt][0]; r.y += acc[mt][nt][1]; r.z += acc[mt][nt][2]; r.w += acc[mt][nt][3];
        *(float4*)(xd + col) = r;
      }
    }
  }
}

DI void gemm_ffn1(const Params& p, int layer, int b, int G, u16* sm) {
  const u16* H = (const u16*)(p.ws + OFF_H2);
  const u16* W = (const u16*)(p.ws + OFF_W) + layer * W_LAYER + WO_GU;
  u16* act = (u16*)(p.ws + OFF_ACT);
  EPI_COORDS
  TileIter it; it.init(T / 128, 44, b, G);
  for (; it.valid(); it.next()) {
    const int row0 = it.rt() * 128, ct = it.ct();
    f32x4 acc[4][4]; zero_acc<4>(acc);
    gemm_kloop<4>(H + (size_t)row0 * DM, DM, W + (size_t)ct * 128 * DM, DM, 16, acc, sm);
#pragma unroll
    for (int mt = 0; mt < 4; ++mt) {
      const int row = row0 + wr * 64 + mt * 16 + fr;
#pragma unroll
      for (int nt = 0; nt < 2; ++nt) {
        const int col = (ct * 2 + wc) * 32 + nt * 16 + fq * 4;
        float o[4];
#pragma unroll
        for (int j = 0; j < 4; ++j) o[j] = siluf_(acc[mt][nt][j]) * acc[mt][nt + 2][j];
        uint2 ov; ov.x = pack2(o[0], o[1]); ov.y = pack2(o[2], o[3]);
        *(uint2*)(act + (size_t)row * FH + col) = ov;
      }
    }
  }
}

DI void gdn_pre(const Params& p, int layer, int task, char* smem) {
  const int tid = my_tid(), lane = tid & 63, wave = tid >> 6;
  const int n = task >> 2, h = task & 3, c0 = n * 64;
  const int lo = seq_lo(c0), hi = seq_hi(c0);
  float* ks = (float*)smem;
  float* vs = ks + 64 * 65;
  float* AmT = vs + 64 * 65;
  float* gcs = AmT + 2 * 64 * 64;
  float* bts = gcs + 128;
  const u16* proj = (const u16*)(p.ws + OFF_PROJ);
  u16* QN = (u16*)(p.ws + OFF_QN);
  u16* KN = (u16*)(p.ws + OFF_KN);
  float* GC = (float*)(p.ws + OFF_GC);
  const float* AB = (const float*)(p.ws + OFF_AB);
  u16* UW = (u16*)(p.ws + OFF_UW);
  __syncthreads();
#pragma unroll 1
  for (int mat = 0; mat < 3; ++mat) {
    const int ch = mat * 256 + h * 64 + lane;
    float w[5];
#pragma unroll
    for (int j = 0; j < 5; ++j) w[j] = p.conv_a[(size_t)(layer * 5 + j) * 768 + ch];
    float raw[20];
#pragma unroll
    for (int i = 0; i < 20; ++i) {
      const int tok = c0 + wave * 16 + i - 2;
      raw[i] = (tok >= lo && tok < hi) ? bf2f(proj[(size_t)tok * INW + ch]) : 0.f;
    }
#pragma unroll
    for (int i = 0; i < 16; ++i) {
      float v = 0.f;
#pragma unroll
      for (int j = 0; j < 5; ++j) v += raw[i + j] * w[j];
      v = siluf_(v);
      const int tl = wave * 16 + i;
      if (mat < 2) {
        const float ss = wave_sum(v * v);
        v *= rsqrtf(ss + EPS) * (mat == 0 ? 0.125f : 1.f);
      }
      if (mat == 0) QN[(size_t)(c0 + tl) * 256 + h * 64 + lane] = f2bf(v);
      else if (mat == 1) { KN[(size_t)(c0 + tl) * 256 + h * 64 + lane] = f2bf(v); ks[tl * 65 + lane] = v; }
      else vs[tl * 65 + lane] = v;
    }
  }
  if (wave < 2) {
    const int d = wave;
    const int tok = c0 + (d ? 63 - lane : lane);
    const float al = AB[(size_t)tok * 16 + d * 4 + h];
    const float br = AB[(size_t)tok * 16 + 8 + d * 4 + h];
    const float xx = al + p.dt_bias[(layer * 2 + d) * 4 + h];
    const float sp = fmaxf(xx, 0.f) + log1pf(__expf(-fabsf(xx)));
    float g = -__expf(p.a_log[(layer * 2 + d) * 4 + h]) * sp;
#pragma unroll
    for (int o = 1; o < 64; o <<= 1) {
      const float t = __shfl_up(g, o, 64);
      if (lane >= o) g += t;
    }
    gcs[d * 64 + lane] = g;
    bts[d * 64 + lane] = sigmoidf_(br);
    GC[(size_t)(task * 2 + d) * 64 + lane] = g;
  }
  __syncthreads();
#pragma unroll 1
  for (int m = 0; m < 16; ++m) {
    const int a = wave + 4 * m, b = lane;
    float dot = 0.f;
#pragma unroll 16
    for (int dd = 0; dd < 64; ++dd) dot += ks[a * 65 + dd] * ks[b * 65 + dd];
    if (a > b) {
      AmT[b * 64 + a] = bts[a] * dot * __expf(gcs[a] - gcs[b]);
      const int i1 = 63 - b, j1 = 63 - a;
      AmT[4096 + j1 * 64 + i1] = bts[64 + i1] * dot * __expf(gcs[64 + i1] - gcs[64 + j1]);
    }
  }
  __syncthreads();
  {
    int d = tid >> 7, c = tid & 127;
    asm volatile("" : "+v"(d), "+v"(c));
    float r[64];
    {
      const int stride = d ? -65 : 65;
      int off = (d ? 63 * 65 : 0) + (c & 63);
      const float* srcm = (c < 64) ? vs : ks;
      const bool isw = c >= 64;
#pragma unroll
      for (int i = 0; i < 64; ++i) {
        float v = srcm[off] * bts[d * 64 + i];
        if (isw) v *= __expf(gcs[d * 64 + i]);
        r[i] = v;
        off += stride;
        asm volatile("" : "+v"(off));
        if ((i & 7) == 7) __builtin_amdgcn_sched_barrier(0);
      }
    }
    const float* Ad = AmT + d * 4096;
#pragma unroll
    for (int j = 0; j < 63; ++j) {
      const float rj = r[j];
#pragma unroll
      for (int i = j + 1; i < 64; ++i) {
        r[i] = fmaf(-Ad[j * 64 + i], rj, r[i]);
        if ((i & 15) == 15) __builtin_amdgcn_sched_barrier(0);
      }
      __builtin_amdgcn_sched_barrier(0);
    }
    u16* base = UW + (size_t)(task * 2 + d) * 8192;
    if (c < 64) {
      uint4* dst = (uint4*)(base + c * 64);
#pragma unroll
      for (int q = 0; q < 8; ++q)
        dst[q] = make_uint4(pack2(r[8 * q], r[8 * q + 1]), pack2(r[8 * q + 2], r[8 * q + 3]), pack2(r[8 * q + 4], r[8 * q + 5]),
                            pack2(r[8 * q + 6], r[8 * q + 7]));
    } else {
      u16* dst = base + 4096 + (c - 64);
#pragma unroll
      for (int i = 0; i < 64; ++i) dst[i * 64] = f2bf(r[i]);
    }
  }
}

DI f32x4 mma_t(const u16* X, int xr, const u16* Y, int yr, f32x4 acc, int fr, int fq) {
#pragma unroll
  for (int kk = 0; kk < 2; ++kk) {
    const bf16x8 x = *(const bf16x8*)(X + (xr + fr) * 72 + kk * 32 + fq * 8);
    const bf16x8 y = *(const bf16x8*)(Y + (yr + fr) * 72 + kk * 32 + fq * 8);
    acc = mfma16(x, y, acc);
  }
  return acc;
}
DI f32x4 mma_t_swz(const u16* X, int xr, const u16* Y, int yr, f32x4 acc, int fr, int fq) {
  const int sw = ((xr + fr) >> 3) & 7;
#pragma unroll
  for (int kk = 0; kk < 2; ++kk) {
    const bf16x8 x = *(const bf16x8*)(X + (xr + fr) * 72 + (((kk * 4 + fq) ^ sw) * 8));
    const bf16x8 y = *(const bf16x8*)(Y + (yr + fr) * 72 + kk * 32 + fq * 8);
    acc = mfma16(x, y, acc);
  }
  return acc;
}

DI void gdn_scan(const Params& p, int item, char* smem) {
  const int tid = my_tid(), lane = tid & 63, w = tid >> 6;
  const int fr = lane & 15, fq = lane >> 4;
  const int chain = item >> 2, eq = item & 3;
  const int s = chain >> 3, h = (chain >> 1) & 3, d = chain & 1;
  const int sb = s == 0 ? 0 : TP + (s - 1) * 4096;
  const int nch = s == 0 ? 256 : 64;
  u16* St = (u16*)smem;
  u16* Vt = St + 16 * 72;
  u16* Vts = Vt + 16 * 72;
  u16* Wc = Vts + 16 * 72;
  u16* Qc = Wc + 64 * 72;
  u16* Kc = Qc + 64 * 72;
  u16* KcT = Kc + 64 * 72;
  u16* QKm = KcT + 64 * 72;
  float* gcs = (float*)(QKm + 64 * 72);
  u16* proj = (u16*)(p.ws + OFF_PROJ);
  const u16* QN = (const u16*)(p.ws + OFF_QN);
  const u16* KN = (const u16*)(p.ws + OFF_KN);
  const float* GC = (const float*)(p.ws + OFF_GC);
  const u16* UW = (const u16*)(p.ws + OFF_UW);
  __syncthreads();
  for (int i = tid; i < 16 * 72; i += 256) St[i] = 0;
  f32x4 S0 = (f32x4){0.f, 0.f, 0.f, 0.f};
  const int prow0 = tid >> 3, prow1 = (tid >> 3) + 32, pseg = (tid & 7) * 8;
  uint4 w0a, w1a, q0a, q1a, k0a, k1a, w0b, w1b, q0b, q1b, k0b, k1b;
  uint2 u0a, u0b;
  float ga, gb;
#define GDN_PREFETCH2(J, S)                                                                          \
  {                                                                                                  \
    const int jj_ = (J) < nch ? (J) : nch - 1;                                                       \
    const int n_ = sb / 64 + (d ? nch - 1 - jj_ : jj_);                                              \
    const int c0_ = n_ * 64;                                                                         \
    const size_t tb_ = (size_t)((n_ * 4 + h) * 2 + d);                                               \
    const u16* ub_ = UW + tb_ * 8192;                                                                \
    const int tok0_ = c0_ + (d ? 63 - prow0 : prow0), tok1_ = c0_ + (d ? 63 - prow1 : prow1);        \
    w0##S = *(const uint4*)(ub_ + 4096 + prow0 * 64 + pseg);                                         \
    w1##S = *(const uint4*)(ub_ + 4096 + prow1 * 64 + pseg);                                         \
    q0##S = *(const uint4*)(QN + (size_t)tok0_ * 256 + h * 64 + pseg);                               \
    q1##S = *(const uint4*)(QN + (size_t)tok1_ * 256 + h * 64 + pseg);                               \
    k0##S = *(const uint4*)(KN + (size_t)tok0_ * 256 + h * 64 + pseg);                               \
    k1##S = *(const uint4*)(KN + (size_t)tok1_ * 256 + h * 64 + pseg);                               \
    u0##S = *(const uint2*)(ub_ + (eq * 16 + fr) * 64 + w * 16 + fq * 4);                            \
    g##S = GC[tb_ * 64 + lane];                                                                      \
  }
#define GDN_STAGE2(ROW, PW, PQ, PK)                                                                  \
  {                                                                                                  \
    *(uint4*)(Wc + (ROW) * 72 + pseg) = PW;                                                          \
    *(uint4*)(Qc + (ROW) * 72 + pseg) = PQ;                                                          \
    *(uint4*)(Kc + (ROW) * 72 + pseg) = PK;                                                          \
    u16* kt_ = KcT + pseg * 72 + ((((ROW) >> 3) ^ (tid & 7)) * 8) + ((ROW) & 7);                     \
    kt_[0 * 72] = (u16)(PK.x & 0xffff); kt_[1 * 72] = (u16)(PK.x >> 16);                             \
    kt_[2 * 72] = (u16)(PK.y & 0xffff); kt_[3 * 72] = (u16)(PK.y >> 16);                             \
    kt_[4 * 72] = (u16)(PK.z & 0xffff); kt_[5 * 72] = (u16)(PK.z >> 16);                             \
    kt_[6 * 72] = (u16)(PK.w & 0xffff); kt_[7 * 72] = (u16)(PK.w >> 16);                             \
  }
#define GDN_STEP(JV, S)                                                                              \
  {                                                                                                  \
    const int j_ = (JV);                                                                             \
    const int n = sb / 64 + (d ? nch - 1 - j_ : j_);                                                 \
    const int c0 = n * 64;                                                                           \
    GDN_STAGE2(prow0, w0##S, q0##S, k0##S)                                                           \
    GDN_STAGE2(prow1, w1##S, q1##S, k1##S)                                                           \
    if (tid < 64) gcs[tid] = g##S;                                                                   \
    const uint2 cu0 = u0##S;                                                                         \
    __syncthreads();                                                                          \
    GDN_PREFETCH2(j_ + 2, S)                                                                         \
    const f32x4 z4 = (f32x4){0.f, 0.f, 0.f, 0.f};                                                    \
    const f32x4 P1a = mma_t(Wc, w * 16, St, 0, z4, fr, fq);                                          \
    const f32x4 P2a = mma_t(St, 0, Qc, w * 16, z4, fr, fq);                                          \
      \
    const float glog = gcs[63];                                                                      \
    const float gcc = gcs[w * 16 + fr];                                                              \
    const float4 gq0 = *(const float4*)(gcs + fq * 4), gq1 = *(const float4*)(gcs + 16 + fq * 4);    \
    const float4 gq2 = *(const float4*)(gcs + 32 + fq * 4), gq3 = *(const float4*)(gcs + 48 + fq * 4); \
    const float4 gw = *(const float4*)(gcs + w * 16 + fq * 4);                                       \
    {                                                                                                \
      const int c = w * 16 + fr;                                                                     \
      _Pragma("unroll") for (int t = 0; t < 4; ++t) {                                                \
        const f32x4 qk = mma_t(Kc, t * 16, Qc, w * 16, z4, fr, fq);                                  \
        const int s0 = t * 16 + fq * 4;                                                              \
        const float4 gs = t == 0 ? gq0 : t == 1 ? gq1 : t == 2 ? gq2 : gq3;                          \
        const float e0 = __expf(fminf(gcc - gs.x, 0.f)), e1 = __expf(fminf(gcc - gs.y, 0.f));       \
        const float e2 = __expf(fminf(gcc - gs.z, 0.f)), e3 = __expf(fminf(gcc - gs.w, 0.f));       \
        const float v0 = (c >= s0 + 0) ? qk[0] * e0 : 0.f;                                           \
        const float v1 = (c >= s0 + 1) ? qk[1] * e1 : 0.f;                                           \
        const float v2 = (c >= s0 + 2) ? qk[2] * e2 : 0.f;                                           \
        const float v3 = (c >= s0 + 3) ? qk[3] * e3 : 0.f;                                           \
        uint2 o; o.x = pack2(v0, v1); o.y = pack2(v2, v3);                                           \
        *(uint2*)(QKm + c * 72 + s0) = o;                                                            \
      }                                                                                              \
    }                                                                                                \
    {                                                                                                \
      const int cc0 = w * 16 + fq * 4;                                                               \
      const float v0 = bf2f((u16)(cu0.x & 0xffff)) - P1a[0], v1 = bf2f((u16)(cu0.x >> 16)) - P1a[1]; \
      const float v2 = bf2f((u16)(cu0.y & 0xffff)) - P1a[2], v3 = bf2f((u16)(cu0.y >> 16)) - P1a[3]; \
      uint2 o; o.x = pack2(v0, v1); o.y = pack2(v2, v3);                                             \
      *(uint2*)(Vt + fr * 72 + cc0) = o;                                                             \
      uint2 o2;                                                                                      \
      o2.x = pack2(v0 * __expf(glog - gw.x), v1 * __expf(glog - gw.y));                              \
      o2.y = pack2(v2 * __expf(glog - gw.z), v3 * __expf(glog - gw.w));                              \
      *(uint2*)(Vts + fr * 72 + cc0) = o2;                                                           \
    }                                                                                                \
    __syncthreads();                                                                          \
    {                                                                                                \
      const int c = w * 16 + fr;                                                                     \
      const float eg = __expf(gcc);                                                                  \
      const int tok = c0 + (d ? 63 - c : c);                                                         \
      u16* orow = proj + (size_t)tok * INW + d * 256 + h * 64 + eq * 16 + fq * 4;                    \
      f32x4 oa = P2a * eg;                                                                           \
      oa = mma_t(Vt, 0, QKm, w * 16, oa, fr, fq);                                                    \
      uint2 o; o.x = pack2(oa[0], oa[1]); o.y = pack2(oa[2], oa[3]);                                 \
      *(uint2*)(orow) = o;                                                                           \
    }                                                                                                \
    {                                                                                                \
      const float gl = __expf(glog);                                                                 \
      S0 *= gl;                                                                                      \
      S0 = mma_t_swz(KcT, w * 16, Vts, 0, S0, fr, fq);                                               \
      const int r0 = w * 16 + fq * 4;                                                                \
      uint2 o; o.x = pack2(S0[0], S0[1]); o.y = pack2(S0[2], S0[3]);                                 \
      *(uint2*)(St + fr * 72 + r0) = o;                                                              \
    }                                                                                                \
    __syncthreads();                                                                          \
  }
  GDN_PREFETCH2(0, a)
  GDN_PREFETCH2(1, b)
  for (int j = 0; j < nch; j += 2) {
    GDN_STEP(j, a)
    GDN_STEP(j + 1, b)
  }
}

DI void gdn_post_row(const Params& p, int layer, int t) {
  const int lane = my_tid() & 63;
  u16* row = (u16*)(p.ws + OFF_PROJ) + (size_t)t * INW;
  const uint2 f = *(const uint2*)(row + lane * 4);
  const uint2 bw = *(const uint2*)(row + 256 + lane * 4);
  const uint2 z = *(const uint2*)(row + C_AZ + lane * 4);
  float o[4], zz[4];
  o[0] = bf2f((u16)(f.x & 0xffff)) + bf2f((u16)(bw.x & 0xffff));
  o[1] = bf2f((u16)(f.x >> 16)) + bf2f((u16)(bw.x >> 16));
  o[2] = bf2f((u16)(f.y & 0xffff)) + bf2f((u16)(bw.y & 0xffff));
  o[3] = bf2f((u16)(f.y >> 16)) + bf2f((u16)(bw.y >> 16));
  zz[0] = bf2f((u16)(z.x & 0xffff)); zz[1] = bf2f((u16)(z.x >> 16)); zz[2] = bf2f((u16)(z.y & 0xffff)); zz[3] = bf2f((u16)(z.y >> 16));
  float ss = o[0] * o[0] + o[1] * o[1] + o[2] * o[2] + o[3] * o[3];
#pragma unroll
  for (int m = 1; m < 16; m <<= 1) ss += __shfl_xor(ss, m, 64);
  const float rs = rsqrtf(ss * (1.f / 64.f) + EPS);
  const int e0 = (lane & 15) * 4;
  float r[4];
#pragma unroll
  for (int j = 0; j < 4; ++j) r[j] = o[j] * rs * p.a_norm[layer * 64 + e0 + j] * siluf_(zz[j]);
  uint2 ov; ov.x = pack2(r[0], r[1]); ov.y = pack2(r[2], r[3]);
  *(uint2*)(row + C_AZ + lane * 4) = ov;
}

struct S5Const { float are, aim; float bpr[16], bpi[16]; };
DI void s5_consts(const Params& p, int layer, int d, int g, int lane, S5Const& k, float& lr, float& li, float& step) {
  const int gi = ((layer * 2 + d) * 16 + g);
  lr = p.lam_re[(size_t)gi * 64 + lane];
  li = p.lam_im[(size_t)gi * 64 + lane];
  step = expf(p.log_step[gi]);
  const float mag = expf(lr * step);
  float sn, cs; sincosf(li * step, &sn, &cs);
  k.are = mag * cs; k.aim = mag * sn;
  const float inv = 1.f / (lr * lr + li * li);
  const float ir = lr * inv, ii = -li * inv;
  const float cr = (k.are - 1.f) * ir - k.aim * ii;
  const float ci = (k.are - 1.f) * ii + k.aim * ir;
  const float* br = p.b_re + ((size_t)(layer * 16 + g) * 64 + lane) * 16;
  const float* bi = p.b_im + ((size_t)(layer * 16 + g) * 64 + lane) * 16;
#pragma unroll
  for (int c = 0; c < 16; ++c) {
    const float a = br[c], b = bi[c];
    k.bpr[c] = cr * a - ci * b;
    k.bpi[c] = cr * b + ci * a;
  }
}
DI void s5_stage_u(const Params& p, int c0, int gq, float* us) {
  const u16* proj = (const u16*)(p.ws + OFF_PROJ);
  const int tid = my_tid();
#pragma unroll
  for (int i = 0; i < 4; ++i) {
    const int idx = tid + 256 * i, tok = idx >> 4, c4 = (idx & 15) * 4;
    const uint2 v = *(const uint2*)(proj + (size_t)(c0 + tok) * INW + C_CU + gq * 64 + c4);
    us[tok * 64 + c4 + 0] = bf2f((u16)(v.x & 0xffff));
    us[tok * 64 + c4 + 1] = bf2f((u16)(v.x >> 16));
    us[tok * 64 + c4 + 2] = bf2f((u16)(v.y & 0xffff));
    us[tok * 64 + c4 + 3] = bf2f((u16)(v.y >> 16));
  }
}
DI void s5_step(const S5Const& k, const float* u, float& sr, float& si) {
  float xr = 0.f, xi = 0.f;
#pragma unroll
  for (int c4 = 0; c4 < 4; ++c4) {
    const float4 uu = *(const float4*)(u + c4 * 4);
    xr += k.bpr[c4 * 4 + 0] * uu.x + k.bpr[c4 * 4 + 1] * uu.y + k.bpr[c4 * 4 + 2] * uu.z + k.bpr[c4 * 4 + 3] * uu.w;
    xi += k.bpi[c4 * 4 + 0] * uu.x + k.bpi[c4 * 4 + 1] * uu.y + k.bpi[c4 * 4 + 2] * uu.z + k.bpi[c4 * 4 + 3] * uu.w;
  }
  const float nr = k.are * sr - k.aim * si + xr;
  const float ni = k.are * si + k.aim * sr + xi;
  sr = nr; si = ni;
}
DI void s5_pass1(const Params& p, int layer, int task, char* smem) {
  const int lane = my_tid() & 63, wave = my_tid() >> 6;
  const int n = task >> 2, gq = task & 3, g = gq * 4 + wave, c0 = n * 64;
  float* us = (float*)smem;
  float2* SEND = (float2*)(p.ws + OFF_SEND);
  __syncthreads();
  s5_stage_u(p, c0, gq, us);
  __syncthreads();
#pragma unroll 1
  for (int d = 0; d < 2; ++d) {
    S5Const k; float lr, li, step;
    s5_consts(p, layer, d, g, lane, k, lr, li, step);
    float sr = 0.f, si = 0.f;
#pragma unroll 4
    for (int i = 0; i < 64; ++i) {
      const int t = d ? 63 - i : i;
      s5_step(k, us + t * 64 + wave * 16, sr, si);
    }
    SEND[((size_t)(n * 2 + d) * 16 + g) * 64 + lane] = make_float2(sr, si);
  }
}
DI float gelu_tanh(float x) {
  const float u = 0.7978845608028654f * (x + 0.044715f * x * x * x);
  return 0.5f * x * (1.f + tanhf(u));
}
DI void s5_pass3(const Params& p, int layer, int task, char* smem) {
  const int lane = my_tid() & 63, wave = my_tid() >> 6;
  const int fr = lane & 15, fq = lane >> 4;
  const int n = task >> 2, gq = task & 3, g = gq * 4 + wave, c0 = n * 64;
  const int nlo = seq_lo(c0) / 64, nhi = seq_hi(c0) / 64;
  float* us = (float*)smem;
  u16* Sb = (u16*)(smem + 16384) + wave * 16 * 136;
  const float2* SEND = (const float2*)(p.ws + OFF_SEND);
  u16* Gb = (u16*)(p.ws + OFF_G);
  __syncthreads();
  s5_stage_u(p, c0, gq, us);
  __syncthreads();
  f32x4 yacc[4];
#pragma unroll
  for (int tb = 0; tb < 4; ++tb) yacc[tb] = (f32x4){0.f, 0.f, 0.f, 0.f};
#pragma unroll
  for (int d = 0; d < 2; ++d) {
    S5Const k; float lr, li, step;
    s5_consts(p, layer, d, g, lane, k, lr, li, step);
    const float m64 = expf(lr * step * 64.f);
    float s64, c64; sincosf(li * step * 64.f, &s64, &c64);
    const float a64r = m64 * c64, a64i = m64 * s64;
    float sr = 0.f, si = 0.f;
    {
      const int cnt = d == 0 ? n - nlo : nhi - 1 - n;
      const int first = d == 0 ? nlo : nhi - 1;
      const int sgn = d == 0 ? 1 : -1;
      const float2* sp = SEND + ((size_t)(first * 2 + d) * 16 + g) * 64 + lane;
      const long stride = (long)sgn * 2 * 16 * 64;
      int m = 0;
      for (; m + 8 <= cnt; m += 8) {
        float2 e0 = sp[0], e1 = sp[stride], e2 = sp[2 * stride], e3 = sp[3 * stride];
        float2 e4 = sp[4 * stride], e5 = sp[5 * stride], e6 = sp[6 * stride], e7 = sp[7 * stride];
        sp += 8 * stride;
#define HSTEP(E) { const float nr = a64r * sr - a64i * si + E.x, ni = a64r * si + a64i * sr + E.y; sr = nr; si = ni; }
        HSTEP(e0) HSTEP(e1) HSTEP(e2) HSTEP(e3) HSTEP(e4) HSTEP(e5) HSTEP(e6) HSTEP(e7)
      }
      for (; m < cnt; ++m) {
        const float2 e = sp[0];
        sp += stride;
        HSTEP(e)
      }
    }
    bf16x8 cf[4];
    {
      const float* cr = p.c_re + ((size_t)((layer * 2 + d) * 16 + g) * 16 + fr) * 64;
      const float* ci = p.c_im + ((size_t)((layer * 2 + d) * 16 + g) * 16 + fr) * 64;
#pragma unroll
      for (int kk = 0; kk < 4; ++kk)
#pragma unroll
        for (int e = 0; e < 8; ++e) {
          const int kx = (kk & 1) * 32 + fq * 8 + e;
          const float v = (kk < 2) ? cr[kx] : -ci[kx];
          cf[kk][e] = (short)f2bf(v);
        }
    }
#pragma unroll
    for (int blk = 0; blk < 4; ++blk) {
      const int tb = d ? 3 - blk : blk;
#pragma unroll 4
      for (int i = 0; i < 16; ++i) {
        const int r = d ? 15 - i : i;
        const int t = tb * 16 + r;
        s5_step(k, us + t * 64 + wave * 16, sr, si);
        Sb[r * 136 + lane] = f2bf(sr);
        Sb[r * 136 + 64 + lane] = f2bf(si);
      }
      __syncthreads();
#pragma unroll
      for (int kk = 0; kk < 4; ++kk) {
        const bf16x8 xf = *(const bf16x8*)(Sb + fr * 136 + kk * 32 + fq * 8);
        yacc[tb] = mfma16(xf, cf[kk], yacc[tb]);
      }
      __syncthreads();
    }
  }
  const float dsk = p.s5_d[layer * 256 + g * 16 + fr];
#pragma unroll
  for (int tb = 0; tb < 4; ++tb)
#pragma unroll
    for (int j = 0; j < 4; ++j) {
      const int t = tb * 16 + fq * 4 + j;
      const float y = yacc[tb][j] + us[t * 64 + wave * 16 + fr] * dsk;
      Gb[(size_t)(c0 + t) * 256 + g * 16 + fr] = f2bf(gelu_tanh(y));
    }
}

struct AttnState { float m, l; f32x4 o[4]; };
DI void attn_segment(const u16* proj, int kcol, int vcol, int tk0, int kstride, int npairs, int R, float slope, int tq,
                     int lo, int hi, const bf16x8 (&qf)[2], AttnState& st, u16* Vt, int lane) {
  const int fr = lane & 15, fq = lane >> 4;
#pragma unroll 1
  for (int pr = 0; pr < npairs; ++pr) {
    const int kbase = tk0 + pr * 32 * kstride;
    f32x4 sacc[2];
#pragma unroll
    for (int t = 0; t < 2; ++t) {
      int tk = kbase + (t * 16 + fr) * kstride;
      tk = min(max(tk, lo), hi - 1);
      const u16* kp = proj + (size_t)tk * INW + kcol + fq * 8;
      const bf16x8 k0 = *(const bf16x8*)(kp), k1 = *(const bf16x8*)(kp + 32);
      sacc[t] = mfma16(k0, qf[0], (f32x4){0.f, 0.f, 0.f, 0.f});
      sacc[t] = mfma16(k1, qf[1], sacc[t]);
    }
    uint4 vr[4];
#pragma unroll
    for (int i = 0; i < 4; ++i) {
      const int idx = lane + 64 * i, kl = idx >> 3, seg = (idx & 7) * 8;
      int tk = kbase + kl * kstride;
      tk = min(max(tk, lo), hi - 1);
      vr[i] = *(const uint4*)(proj + (size_t)tk * INW + vcol + seg);
    }
    float sc[2][4]; bool ok[2][4];
    float mx = -1e30f;
#pragma unroll
    for (int t = 0; t < 2; ++t)
#pragma unroll
      for (int j = 0; j < 4; ++j) {
        const int tk = kbase + (t * 16 + fq * 4 + j) * kstride;
        const int ad = abs(tk - tq);
        ok[t][j] = (ad <= R) && (tk >= lo) && (tk < hi);
        sc[t][j] = sacc[t][j] * 0.125f - slope * (float)ad;
        if (ok[t][j]) mx = fmaxf(mx, sc[t][j]);
      }
    mx = fmaxf(mx, __shfl_xor(mx, 16, 64));
    mx = fmaxf(mx, __shfl_xor(mx, 32, 64));
    const float mn = fmaxf(st.m, mx);
    const float alpha = __expf(st.m - mn);
    st.m = mn;
    float pv[2][4], ps = 0.f;
#pragma unroll
    for (int t = 0; t < 2; ++t)
#pragma unroll
      for (int j = 0; j < 4; ++j) { pv[t][j] = ok[t][j] ? __expf(sc[t][j] - mn) : 0.f; ps += pv[t][j]; }
    st.l = st.l * alpha + ps;
#pragma unroll
    for (int dt = 0; dt < 4; ++dt)
#pragma unroll
      for (int j = 0; j < 4; ++j) st.o[dt][j] *= alpha;
    bf16x8 pf;
    {
      const unsigned w0 = pack2(pv[0][0], pv[0][1]), w1 = pack2(pv[0][2], pv[0][3]), w2 = pack2(pv[1][0], pv[1][1]),
                     w3 = pack2(pv[1][2], pv[1][3]);
      uint4 t4 = make_uint4(w0, w1, w2, w3);
      pf = __builtin_bit_cast(bf16x8, t4);
    }
    __syncthreads();
#pragma unroll
    for (int i = 0; i < 4; ++i) {
      const int idx = lane + 64 * i, kl = idx >> 3, seg = (idx & 7) * 8;
      Vt[(seg + 0) * 36 + kl] = (u16)(vr[i].x & 0xffff); Vt[(seg + 1) * 36 + kl] = (u16)(vr[i].x >> 16);
      Vt[(seg + 2) * 36 + kl] = (u16)(vr[i].y & 0xffff); Vt[(seg + 3) * 36 + kl] = (u16)(vr[i].y >> 16);
      Vt[(seg + 4) * 36 + kl] = (u16)(vr[i].z & 0xffff); Vt[(seg + 5) * 36 + kl] = (u16)(vr[i].z >> 16);
      Vt[(seg + 6) * 36 + kl] = (u16)(vr[i].w & 0xffff); Vt[(seg + 7) * 36 + kl] = (u16)(vr[i].w >> 16);
    }
    __syncthreads();
#pragma unroll
    for (int dt = 0; dt < 4; ++dt) {
      const uint2 v0 = *(const uint2*)(Vt + (dt * 16 + fr) * 36 + fq * 4);
      const uint2 v1 = *(const uint2*)(Vt + (dt * 16 + fr) * 36 + 16 + fq * 4);
      uint4 t4 = make_uint4(v0.x, v0.y, v1.x, v1.y);
      const bf16x8 vf = __builtin_bit_cast(bf16x8, t4);
      st.o[dt] = mfma16(vf, pf, st.o[dt]);
    }
  }
}
DI void attn_task(const Params& p, int layer, int mode, int task, char* smem) {
  const int lane = my_tid() & 63, wave = my_tid() >> 6;
  const int fr = lane & 15, fq = lane >> 4;
  u16* proj = (u16*)(p.ws + OFF_PROJ);
  u16* Vt = (u16*)smem + wave * 64 * 36;
  int tq0, qstride, qcol, kcol, vcol; float slope;
  int hq;
  if (mode == 0) {
    const int blk = task >> 4, h = (task >> 2) & 3, rq = task & 3;
    hq = h; tq0 = blk * 256 + rq * 4 + wave; qstride = 16;
    qcol = C_BQ + h * 64; kcol = C_BK + h * 64; vcol = C_BV + h * 64;
    slope = exp2f(-(float)(5 + h));
  } else {
    const int blk = task >> 2, qh = task & 3;
    hq = qh; tq0 = blk * 64 + wave * 16; qstride = 1;
    qcol = C_DQ + qh * 64; kcol = C_DK + (qh >> 1) * 64; vcol = C_DV + (qh >> 1) * 64;
    slope = exp2f(-(float)(1 + qh));
  }
  const int lo = seq_lo(tq0), hi = seq_hi(tq0);
  const int tq = tq0 + fr * qstride;
  bf16x8 qf[2];
  {
    const u16* qp = proj + (size_t)tq * INW + qcol + fq * 8;
    qf[0] = *(const bf16x8*)(qp); qf[1] = *(const bf16x8*)(qp + 32);
  }
  AttnState st; st.m = -1e30f; st.l = 0.f;
#pragma unroll
  for (int dt = 0; dt < 4; ++dt) st.o[dt] = (f32x4){0.f, 0.f, 0.f, 0.f};
  __syncthreads();
  float scale;
  if (mode == 0) {
    attn_segment(proj, kcol, vcol, tq0 - 64, 1, 12, 64, slope, tq, lo, hi, qf, st, Vt, lane);
    attn_segment(proj, kcol, vcol, tq0 - 256, 4, 6, 256, slope, tq, lo, hi, qf, st, Vt, lane);
    attn_segment(proj, kcol, vcol, tq0 - 1024, 16, 5, 1024, slope, tq, lo, hi, qf, st, Vt, lane);
    float l = st.l; l += __shfl_xor(l, 16, 64); l += __shfl_xor(l, 32, 64);
    scale = 1.f / l;
  } else {
    attn_segment(proj, kcol, vcol, tq0 - 128, 1, 9, 128, slope, tq, lo, hi, qf, st, Vt, lane);
    float l = st.l; l += __shfl_xor(l, 16, 64); l += __shfl_xor(l, 32, 64);
    const float sink = p.attn_sink[layer * 4 + hq];
    const float mf = fmaxf(st.m, sink);
    const float sc = __expf(st.m - mf);
    scale = sc / (l * sc + __expf(sink - mf));
  }
#pragma unroll
  for (int dt = 0; dt < 4; ++dt) {
    uint2 o; o.x = pack2(st.o[dt][0] * scale, st.o[dt][1] * scale); o.y = pack2(st.o[dt][2] * scale, st.o[dt][3] * scale);
    *(uint2*)(proj + (size_t)tq * INW + qcol + dt * 16 + fq * 4) = o;
  }
}

DI void final_row(const Params& p, int t) {
  const int lane = my_tid() & 63;
  float* row = p.xout + (size_t)t * DM;
  float4 v[4]; float ss = 0.f;
#pragma unroll
  for (int i = 0; i < 4; ++i) {
    v[i] = *(const float4*)(row + i * 256 + lane * 4);
    ss += v[i].x * v[i].x + v[i].y * v[i].y + v[i].z * v[i].z + v[i].w * v[i].w;
  }
  ss = wave_sum(ss);
  const float rs = rsqrtf(ss * (1.f / DM) + EPS);
#pragma unroll
  for (int i = 0; i < 4; ++i) {
    const float4 g = *(const float4*)(p.final_norm + i * 256 + lane * 4);
    *(float4*)(row + i * 256 + lane * 4) = make_float4(v[i].x * rs * g.x, v[i].y * rs * g.y, v[i].z * rs * g.z, v[i].w * rs * g.w);
  }
}

#define XB_TMO      128
#define XB_XCNT(j)  (256  + 64 * (j))
#define XB_XSUB(j)  (1280 + 64 * (j))
#define XB_XGEN(j)  (2304 + 64 * (j))
#define XB_TOP      3328
#define XB_TOPGEN   3392
#define XB_SPIN_CAP (1u << 22)
#define LAS __attribute__((address_space(3)))
DI unsigned xb_ld(unsigned* p) { return __hip_atomic_load(p, __ATOMIC_RELAXED, __HIP_MEMORY_SCOPE_AGENT); }
DI unsigned xb_add(unsigned* p, unsigned v) { return __hip_atomic_fetch_add(p, v, __ATOMIC_RELAXED, __HIP_MEMORY_SCOPE_AGENT); }
DI unsigned xb_xcc_id() { return (unsigned)__builtin_amdgcn_s_getreg((3 << 11) | 20) & 0xFu; }
#define XB_SPIN(cond, bar) do { unsigned _sp = 0; while (cond) { __builtin_amdgcn_s_sleep(1); \
    if ((++_sp & 255u) == 0u) { if (xb_ld(&(bar)[XB_TMO])) break; if (_sp > XB_SPIN_CAP) { atomicAdd(&(bar)[XB_TMO], 1u); break; } } } } while (0)
struct XcdBarrier { unsigned* bar; unsigned x; volatile LAS unsigned* st; };
DI XcdBarrier xcd_barrier_post(unsigned* bar, volatile LAS unsigned* st) {
  XcdBarrier b; b.bar = bar; b.x = xb_xcc_id(); b.st = st;
  if (threadIdx.x == 0) (void)xb_add(&bar[XB_XCNT(b.x)], 1u);
  return b;
}
DI void xcd_barrier_complete(unsigned* bar, unsigned x, unsigned& nloc, unsigned& nx) {
  const unsigned G = gridDim.x * gridDim.y * gridDim.z;
  unsigned sum, cnt, mine, sp = 0u;
  for (;;) {
    sum = 0u; cnt = 0u; mine = 0u;
#pragma unroll
    for (unsigned j = 0; j < 16; ++j) { const unsigned c = xb_ld(&bar[XB_XCNT(j)]); sum += c; cnt += (c > 0u) ? 1u : 0u; mine = (j == x) ? c : mine; }
    if (sum == G) break;
    __builtin_amdgcn_s_sleep(1);
    if ((++sp & 255u) == 0u) { if (xb_ld(&bar[XB_TMO])) break; if (sp > XB_SPIN_CAP) { atomicAdd(&bar[XB_TMO], 1u); break; } }
  }
  nloc = mine > 0u ? mine : 1u; nx = cnt > 0u ? cnt : 1u;
}
DI void xcd_barrier(const XcdBarrier& b) {
  asm volatile("s_waitcnt vmcnt(0)" ::: "memory");
  __syncthreads();
  if (threadIdx.x == 0) {
    unsigned* bar = b.bar;
    __builtin_amdgcn_s_waitcnt(0);
    unsigned nloc = b.st[0], nx = b.st[1];
    if (nloc == 0u) { xcd_barrier_complete(bar, b.x, nloc, nx); b.st[0] = nloc; b.st[1] = nx; }
    const unsigned old = xb_add(&bar[XB_XSUB(b.x)], 1u);
    const unsigned gen = old / nloc;
    if (old + 1u == (gen + 1u) * nloc) {
      __builtin_amdgcn_fence(__ATOMIC_RELEASE, "agent");
      asm volatile("s_waitcnt vmcnt(0)" ::: "memory");
      const unsigned og = xb_add(&bar[XB_TOP], 1u);
      const unsigned tg = og / nx;
      if (og + 1u == (tg + 1u) * nx) xb_add(&bar[XB_TOPGEN], 1u);
      else XB_SPIN(xb_ld(&bar[XB_TOPGEN]) == tg, bar);
      __builtin_amdgcn_fence(__ATOMIC_ACQUIRE, "agent");
      xb_add(&bar[XB_XGEN(b.x)], 1u);
      asm volatile("s_waitcnt vmcnt(0)" ::: "memory");
    } else {
      XB_SPIN(xb_ld(&bar[XB_XGEN(b.x)]) == gen, bar);
      __builtin_amdgcn_fence(__ATOMIC_ACQUIRE, "agent");
      asm volatile("s_waitcnt vmcnt(0)" ::: "memory");
    }
  }
  __syncthreads();
}

enum { PH_NORM1 = 0, PH_INPROJ, PH_MIX1, PH_MIX2, PH_MIX3, PH_MERGE, PH_OUT, PH_NORM2, PH_FFN1, PH_FFN2, PH_PER_LAYER, PH_FINAL = 100 };

DI void run_phase(const Params& p, int ph, int layer, char* smem) {
  const int b = blockIdx.x, G = gridDim.x;
  const int wave = my_tid() >> 6;
  switch (ph) {
    case PH_NORM1: {
      if (layer == 0) {
        for (int t = b; t < 2 * CONV_TILES_LAYER; t += G) {
          ConvJob j;
          const int lt = conv_lookup(p, t, j);
          conv_tile(j, lt, (float*)smem);
        }
      }
      if (b == 0 && my_tid() == 0) *(unsigned*)(p.ws + OFF_CNT) = 0u;
      rms_phase(p, layer, p.norm1 + layer * DM, (u16*)(p.ws + OFF_H), b, G);
    } break;
    case PH_INPROJ: gemm_inproj(p, layer, b, G, (u16*)smem); break;
    case PH_MIX1: {
      for (int t = b; t < 2 * 3072; t += G) {
        const int kind = t / 3072, idx = t % 3072;
        if (kind == 0) gdn_pre(p, layer, idx, smem);
        else s5_pass1(p, layer, idx, smem);
      }
    } break;
    case PH_MIX2: {
      for (int c = b; c < 288; c += G) gdn_scan(p, c, smem);
      {
        unsigned* cnt = (unsigned*)(p.ws + OFF_CNT);
        int* slot = (int*)(smem + SMEM_BYTES - 16);
        for (;;) {
          __syncthreads();
          if (my_tid() == 0) *slot = (int)atomicAdd(cnt, 1u);
          __syncthreads();
          const int t = *slot;
          if (t >= 3 * 3072) break;
          if (t < 3072) s5_pass3(p, layer, t, smem);
          else if (t < 2 * 3072) attn_task(p, layer, 0, t - 3072, smem);
          else attn_task(p, layer, 1, t - 2 * 3072, smem);
        }
      }
    } break;
    case PH_MIX3: {
      gemm_glu(p, layer, b, G, (u16*)smem);
      for (int t = b * 4 + wave; t < T; t += G * 4) gdn_post_row(p, layer, t);
      rms_phase(p, layer, p.norm1 + layer * DM, (u16*)(p.ws + OFF_H), b, G);
    } break;
    case PH_MERGE: gemm_merge(p, layer, b, G, (u16*)smem); break;
    case PH_OUT:
      gemm_resid(p, layer, (const u16*)(p.ws + OFF_MERGED), DM, (const u16*)(p.ws + OFF_W) + layer * W_LAYER + WO_OUT, b, G, (u16*)smem);
      break;
    case PH_NORM2: rms_phase(p, 1, p.norm2 + layer * DM, (u16*)(p.ws + OFF_H2), b, G); break;
    case PH_FFN1: gemm_ffn1(p, layer, b, G, (u16*)smem); break;
    case PH_FFN2:
      gemm_resid(p, 1, (const u16*)(p.ws + OFF_ACT), FH, (const u16*)(p.ws + OFF_W) + layer * W_LAYER + WO_DN, b, G, (u16*)smem);
      break;
    case PH_FINAL:
      for (int t = b * 4 + wave; t < T; t += G * 4) final_row(p, t);
      break;
    default: break;
  }
}

#if !MEGA
__global__ void __launch_bounds__(256, 2) k_phase(Params p, int ph, int layer) {
  __shared__ __attribute__((aligned(16))) char smem[SMEM_BYTES];
  run_phase(p, ph, layer, smem);
}

#else
__global__ void __launch_bounds__(256, 2) k_mega(Params p) {
  __shared__ __attribute__((aligned(16))) char smem[SMEM_BYTES];
  __shared__ uint4 xb_words;
  cg::grid_group grid = cg::this_grid();
  if (threadIdx.x == 0) xb_words = make_uint4(0u, 0u, 0u, 0u);
  __syncthreads();
  const XcdBarrier xb = xcd_barrier_post((unsigned*)(p.ws + OFF_BAR), (volatile LAS unsigned*)&xb_words);
  for (int layer = 0; layer < 2; ++layer)
    for (int ph = 0; ph < PH_PER_LAYER; ++ph) {
      run_phase(p, ph, layer, smem);
      if (layer == 1 && ph == PH_PER_LAYER - 1) grid.sync(); else xcd_barrier(xb);
#ifdef PROBE_DUP
      if (ph == PROBE_DUP) { run_phase(p, ph, layer, smem); grid.sync(); }
#endif
    }
  run_phase(p, PH_FINAL, 0, smem);
}
#endif

extern "C" void kernel_launch(void* const* d_in, const int* in_sizes, int n_in, void* d_out, int out_size, void* d_ws,
                              size_t ws_size, hipStream_t stream) {
  (void)in_sizes; (void)n_in; (void)out_size;
  if (ws_size < WS_NEED) { fprintf(stderr, "workspace too small: %zu < %zu\n", ws_size, (size_t)WS_NEED); return; }
  Params p;
  memset(&p, 0, sizeof(p));
  const float* const* in = (const float* const*)d_in;
  p.x_prompt = in[0]; p.x_sample = in[1]; p.norm1 = in[2]; p.conv_a = in[4]; p.a_log = in[5]; p.dt_bias = in[6];
  p.a_norm = in[7]; p.lam_re = in[8]; p.lam_im = in[9]; p.log_step = in[10]; p.b_re = in[11]; p.b_im = in[12];
  p.c_re = in[13]; p.c_im = in[14]; p.s5_d = in[15]; p.attn_sink = in[17]; p.norm2 = in[21]; p.final_norm = in[25];
  p.xout = (float*)d_out;
  p.ws = (char*)d_ws;
  p.w_in = in[3]; p.w_glu = in[16]; p.w_gate = in[18]; p.w_branch = in[19]; p.w_out = in[20];
  p.w_ffn_gate = in[22]; p.w_ffn_up = in[23]; p.w_ffn_down = in[24];
  static int grid_blocks = 0;
  if (!grid_blocks) {
    int dev = 0, cus = 0, per_cu = 0;
    hipGetDevice(&dev);
    hipDeviceGetAttribute(&cus, hipDeviceAttributeMultiprocessorCount, dev);
#if MEGA
    hipOccupancyMaxActiveBlocksPerMultiprocessor(&per_cu, k_mega, 256, 0);
#else
    hipOccupancyMaxActiveBlocksPerMultiprocessor(&per_cu, k_phase, 256, 0);
#endif
    per_cu = 2;
    grid_blocks = cus * per_cu;
  }
#if MEGA
  hipMemsetAsync((char*)d_ws + OFF_BAR, 0, BAR_BYTES, stream);
  void* args[] = {&p};
  hipError_t e = hipLaunchCooperativeKernel((void*)k_mega, dim3(grid_blocks), dim3(256), args, 0, stream);
  if (e != hipSuccess) fprintf(stderr, "cooperative launch failed: %s (grid %d)\n", hipGetErrorString(e), grid_blocks);
#else
  for (int layer = 0; layer < 2; ++layer)
    for (int ph = 0; ph < PH_PER_LAYER; ++ph) hipLaunchKernelGGL(k_phase, dim3(grid_blocks), dim3(256), 0, stream, p, ph, layer);
  hipLaunchKernelGGL(k_phase, dim3(grid_blocks), dim3(256), 0, stream, p, (int)PH_FINAL, 0);
#endif
}
```

```cpp
#include <hip/hip_runtime.h>
#include <hip/hip_cooperative_groups.h>
#include <cstdio>
#include <cstring>
namespace cg = cooperative_groups;

#ifndef MEGA
#define MEGA 1
#endif

#define DI __device__ __forceinline__
typedef unsigned short u16;
typedef __attribute__((ext_vector_type(8))) short bf16x8;
typedef __attribute__((ext_vector_type(4))) float f32x4;

constexpr int T = 49152;
constexpr int TP = 16384;
constexpr int DM = 1024;
constexpr int INW = 2576;
constexpr int FH = 2816;
constexpr int NCH64 = T / 64;
constexpr float EPS = 1e-6f;

constexpr int C_AQ = 0, C_AK = 256, C_AV = 512, C_AZ = 768, C_BQ = 1040, C_BK = 1296, C_BV = 1552, C_CU = 1808,
              C_DQ = 2064, C_DK = 2320, C_DV = 2448;

constexpr size_t WO_IN = 0, WO_GATE = 2752512, WO_BR = 6946816, WO_OUT = 7995392, WO_GU = 9043968, WO_DN = 14811136,
                 WO_GLU = 17694720, W_LAYER = 17825792;
constexpr size_t OFF_W = 0;
constexpr size_t OFF_PROJ = 2 * W_LAYER * 2;
constexpr size_t SZ_PROJ = (size_t)T * INW * 2;
constexpr size_t OFF_R1 = OFF_PROJ + SZ_PROJ;
constexpr size_t SZ_H = (size_t)T * DM * 2;
constexpr size_t OFF_H = OFF_R1;
constexpr size_t OFF_UW = OFF_R1;
constexpr size_t OFF_QN = OFF_R1 + SZ_H;
constexpr size_t OFF_KN = OFF_QN + (size_t)T * 256 * 2;
constexpr size_t OFF_GC = OFF_KN + (size_t)T * 256 * 2;
constexpr size_t OFF_SEND = OFF_GC + (size_t)NCH64 * 8 * 64 * 4;
constexpr size_t OFF_G = OFF_SEND + (size_t)NCH64 * 2 * 1024 * 8;
constexpr size_t OFF_AB = OFF_G + (size_t)T * 256 * 2;
constexpr size_t OFF_CNT = OFF_AB + (size_t)T * 16 * 4;
constexpr size_t OFF_MERGED = OFF_R1 + SZ_H;
constexpr size_t OFF_H2 = OFF_PROJ;
constexpr size_t OFF_ACT = OFF_PROJ + SZ_H;
constexpr size_t OFF_BAR = OFF_MERGED + SZ_H;
constexpr size_t BAR_BYTES = 3456 * 4;
constexpr size_t OFF_SSQ = OFF_BAR + 16384;
constexpr size_t WS_NEED = OFF_SSQ + 5 * (size_t)T * 4;

constexpr int SMEM_BYTES = 75776;

struct ConvJob { const float* src; u16* dst; const float* kscale; int K, ncols, nrows_dst, src_ld, rs, off, ntn; };
struct Params;
DI float* ssq_buf(const Params& p, int i);
struct Params {
  const float *x_prompt, *x_sample, *norm1, *conv_a, *a_log, *dt_bias, *a_norm, *lam_re, *lam_im, *log_step, *b_re,
      *b_im, *c_re, *c_im, *s5_d, *attn_sink, *norm2, *final_norm;
  const float *w_in, *w_gate, *w_branch, *w_out, *w_ffn_gate, *w_ffn_up, *w_ffn_down, *w_glu;
  float* xout;
  char* ws;
};
constexpr int CONV_TILES_LAYER = 4352;

DI int my_tid() { int t = threadIdx.x; asm volatile("" : "+v"(t)); return t; }
DI u16 f2bf(float x) { unsigned u = __float_as_uint(x); u += 0x7fffu + ((u >> 16) & 1u); return (u16)(u >> 16); }
DI float bf2f(u16 v) { return __uint_as_float(((unsigned)v) << 16); }
DI unsigned pack2(float a, float b) { return (unsigned)f2bf(a) | ((unsigned)f2bf(b) << 16); }
DI float sigmoidf_(float x) { return 1.f / (1.f + __expf(-x)); }
DI float siluf_(float x) { return x / (1.f + __expf(-x)); }
DI float wave_sum(float v) {
#pragma unroll
  for (int o = 32; o > 0; o >>= 1) v += __shfl_xor(v, o, 64);
  return v;
}
DI int seq_lo(int t) { return t < TP ? 0 : (t & ~4095); }
DI int seq_hi(int t) { return t < TP ? TP : (t & ~4095) + 4096; }
DI const float* xrow(const Params& p, int layer, int t) {
  if (layer == 0) return t < TP ? p.x_prompt + (size_t)t * DM : p.x_sample + (size_t)(t - TP) * DM;
  return p.xout + (size_t)t * DM;
}
DI f32x4 mfma16(bf16x8 a, bf16x8 b, f32x4 c) { return __builtin_amdgcn_mfma_f32_16x16x32_bf16(a, b, c, 0, 0, 0); }

DI void mk_job(ConvJob& j, const float* src, u16* dst, int K, int ncols, int nrows_dst, int src_ld, int rs, int off,
                const float* kscale = nullptr) {
  j.kscale = kscale;
  j.src = src; j.dst = dst; j.K = K; j.ncols = ncols; j.nrows_dst = nrows_dst; j.src_ld = src_ld; j.rs = rs; j.off = off;
  j.ntn = (nrows_dst + 63) >> 6;
}
DI int conv_lookup(const Params& p, int t, ConvJob& j) {
  const int l = t / CONV_TILES_LAYER;
  int r = t % CONV_TILES_LAYER;
  u16* wl = (u16*)(p.ws + OFF_W) + (size_t)l * W_LAYER;
  if (r < 672) { mk_job(j, p.w_in + (size_t)l * DM * INW, wl + WO_IN, DM, INW, 2688, INW, 32, 0, p.norm1 + l * DM); return r; }
  r -= 672;
  if (r < 1024) { const int i = r >> 8; mk_job(j, p.w_gate + (size_t)(l * 4 + i) * DM * DM, wl + WO_GATE + (size_t)i * DM * DM, DM, DM, DM, DM, 32, 0, p.norm1 + l * DM); return r & 255; }
  r -= 1024;
  if (r < 256) { const int i = r >> 6; mk_job(j, p.w_branch + (size_t)(l * 4 + i) * 256 * DM, wl + WO_BR + (size_t)i * DM * 256, 256, DM, DM, DM, 32, 0); return r & 63; }
  r -= 256;
  if (r < 256) { mk_job(j, p.w_out + (size_t)l * DM * DM, wl + WO_OUT, DM, DM, DM, DM, 32, 0); return r; }
  r -= 256;
  if (r < 704) { mk_job(j, p.w_ffn_gate + (size_t)l * DM * FH, wl + WO_GU, DM, FH, FH, FH, 64, 0, p.norm2 + l * DM); return r; }
  r -= 704;
  if (r < 704) { mk_job(j, p.w_ffn_up + (size_t)l * DM * FH, wl + WO_GU, DM, FH, FH, FH, 64, 32, p.norm2 + l * DM); return r; }
  r -= 704;
  if (r < 704) { mk_job(j, p.w_ffn_down + (size_t)l * FH * DM, wl + WO_DN, FH, DM, DM, DM, 32, 0); return r; }
  r -= 704;
  if (r < 16) { mk_job(j, p.w_glu + (size_t)l * 256 * 512, wl + WO_GLU, 256, 256, 256, 512, 64, 0); return r; }
  r -= 16;
  mk_job(j, p.w_glu + (size_t)l * 256 * 512 + 256, wl + WO_GLU, 256, 256, 256, 512, 64, 32);
  return r;
}
DI void conv_tile(const ConvJob& j, int lt, float* tile) {
  const int tid = my_tid();
  const int tk = lt / j.ntn, tn = lt % j.ntn;
  __syncthreads();
#pragma unroll
  for (int i = 0; i < 4; ++i) {
    int r = (tid >> 4) + 16 * i, c4 = (tid & 15) * 4, n = tn * 64 + c4;
    float4 v = make_float4(0.f, 0.f, 0.f, 0.f);
    if (n < j.ncols) v = *(const float4*)(j.src + (size_t)(tk * 64 + r) * j.src_ld + n);
    if (j.kscale) { const float s = j.kscale[tk * 64 + r]; v.x *= s; v.y *= s; v.z *= s; v.w *= s; }
    tile[r * 65 + c4 + 0] = v.x; tile[r * 65 + c4 + 1] = v.y; tile[r * 65 + c4 + 2] = v.z; tile[r * 65 + c4 + 3] = v.w;
  }
  __syncthreads();
  const int cl = tid >> 2, ks = (tid & 3) * 16, n = tn * 64 + cl;
  if (n < j.nrows_dst) {
    unsigned w[8];
#pragma unroll
    for (int e = 0; e < 8; ++e) w[e] = pack2(tile[(ks + 2 * e) * 65 + cl], tile[(ks + 2 * e + 1) * 65 + cl]);
    const int nm = (n >> 5) * j.rs + (n & 31) + j.off;
    uint4* d = (uint4*)(j.dst + (size_t)nm * j.K + tk * 64 + ks);
    d[0] = make_uint4(w[0], w[1], w[2], w[3]);
    d[1] = make_uint4(w[4], w[5], w[6], w[7]);
  }
}

DI float* ssq_buf(const Params& p, int i) { return (float*)(p.ws + OFF_SSQ) + (size_t)i * T; }
DI float rstd_of(float ssq) { return rsqrtf(ssq * (1.f / DM) + EPS); }
DI void cvt_row_bf16(const float* src, u16* dst, float* ssq_out) {
  const int lane = my_tid() & 63;
  float ss = 0.f;
#pragma unroll
  for (int i = 0; i < 4; ++i) {
    const float4 v = *(const float4*)(src + i * 256 + lane * 4);
    ss += v.x * v.x + v.y * v.y + v.z * v.z + v.w * v.w;
    uint2 o; o.x = pack2(v.x, v.y); o.y = pack2(v.z, v.w);
    *(uint2*)(dst + i * 256 + lane * 4) = o;
  }
  if (ssq_out) { ss = wave_sum(ss); if (lane == 0) *ssq_out = ss; }
}
DI void cvt_phase(const Params& p, int layer, u16* dst, bool write_ssq, int b0, int nb) {
  const int wave = my_tid() >> 6;
  for (int r = b0 * 4 + wave; r < T; r += nb * 4)
    cvt_row_bf16(xrow(p, layer, r), dst + (size_t)r * DM, write_ssq ? ssq_buf(p, layer) + r : nullptr);
}

constexpr int GP = 64;
#ifndef GEMM_DMA
#define GEMM_DMA 1
#endif
#if GEMM_DMA
template <int NT, bool SPLIT = false>
DI void gemm_kloop(const u16* __restrict__ A, size_t lda, const u16* __restrict__ B, size_t ldb, int nk,
                   f32x4 (&acc)[4][NT], u16* sm) {
  const int tid = my_tid(), lane = tid & 63;
  const int wave = __builtin_amdgcn_readfirstlane(tid >> 6);
  const int fr = lane & 15, fq = lane >> 4, wr = wave >> 1, wc = wave & 1;
  u16* sa = sm;
  u16* sb = sm + 2 * 128 * 64;
  const int swz = (fr >> 1) & 7;
  const int lr = lane >> 3;
  const int lc = ((lane & 7) ^ ((lr >> 1) & 3)) * 8;
#define DMA_PIECE(BASE, LD, G, KOFF, DST)                                                              \
  {                                                                                                    \
    int lrl_ = lr;                                                                                     \
    asm volatile("" : "+v"(lrl_));   \
    const int row_ = (G) * 8 + lrl_;                                                                   \
    const int col_ = lc ^ ((((G) & 1) * 4) * 8);                                                       \
    __builtin_amdgcn_global_load_lds((const unsigned*)((BASE) + (size_t)row_ * (LD) + (KOFF) + col_),  \
                                     (unsigned*)((DST) + (G) * 512), 16, 0, 0);                        \
  }
#define DMA_TILE(KOFF, STAGE)                                                                          \
  {                                                                                                    \
    u16* da_ = sa + (STAGE) * 8192;                                                                    \
    u16* db_ = sb + (STAGE) * 8192;                                                                    \
    DMA_PIECE(A, lda, wave * 4 + 0, KOFF, da_) DMA_PIECE(A, lda, wave * 4 + 1, KOFF, da_)              \
    DMA_PIECE(A, lda, wave * 4 + 2, KOFF, da_) DMA_PIECE(A, lda, wave * 4 + 3, KOFF, da_)              \
    if (NT == 4) {                                                                                     \
      DMA_PIECE(B, ldb, wave * 4 + 0, KOFF, db_) DMA_PIECE(B, ldb, wave * 4 + 1, KOFF, db_)            \
      DMA_PIECE(B, ldb, wave * 4 + 2, KOFF, db_) DMA_PIECE(B, ldb, wave * 4 + 3, KOFF, db_)            \
    } else {                                                                                           \
      DMA_PIECE(B, ldb, wave * 2 + 0, KOFF, db_) DMA_PIECE(B, ldb, wave * 2 + 1, KOFF, db_)            \
    }                                                                                                  \
  }
  __builtin_amdgcn_s_barrier();
  DMA_TILE(0, 0)
#pragma unroll 1
  for (int kt = 0; kt < nk; ++kt) {
    const int cur = kt & 1;
    asm volatile("s_waitcnt vmcnt(0)" ::: "memory");
    __builtin_amdgcn_s_barrier();
    asm volatile("" ::: "memory");
    const u16* ca = sa + cur * 8192;
    const u16* cb = sb + cur * 8192;
    if (SPLIT) {
      bf16x8 wf[NT], xf[4];
#pragma unroll
      for (int nt = 0; nt < NT; ++nt) wf[nt] = *(const bf16x8*)(cb + (wc * NT * 16 + nt * 16 + fr) * 64 + (((0 * 4 + fq) ^ swz) * 8));
#pragma unroll
      for (int mt = 0; mt < 4; ++mt) xf[mt] = *(const bf16x8*)(ca + (wr * 64 + mt * 16 + fr) * 64 + (((0 * 4 + fq) ^ swz) * 8));
#pragma unroll
      for (int mt = 0; mt < 4; ++mt)
#pragma unroll
        for (int nt = 0; nt < NT; ++nt) acc[mt][nt] = mfma16(wf[nt], xf[mt], acc[mt][nt]);
#pragma unroll
      for (int nt = 0; nt < NT; ++nt) wf[nt] = *(const bf16x8*)(cb + (wc * NT * 16 + nt * 16 + fr) * 64 + (((1 * 4 + fq) ^ swz) * 8));
#pragma unroll
      for (int mt = 0; mt < 4; ++mt) xf[mt] = *(const bf16x8*)(ca + (wr * 64 + mt * 16 + fr) * 64 + (((1 * 4 + fq) ^ swz) * 8));
      __builtin_amdgcn_sched_barrier(0);
      if (kt + 1 < nk) DMA_TILE((kt + 1) * 64, cur ^ 1)
      __builtin_amdgcn_sched_barrier(0);
#pragma unroll
      for (int mt = 0; mt < 4; ++mt)
#pragma unroll
        for (int nt = 0; nt < NT; ++nt) acc[mt][nt] = mfma16(wf[nt], xf[mt], acc[mt][nt]);
      continue;
    }
    bf16x8 wf[2][NT], xf[2][4];
#pragma unroll
    for (int kk = 0; kk < 2; ++kk) {
#pragma unroll
      for (int nt = 0; nt < NT; ++nt) wf[kk][nt] = *(const bf16x8*)(cb + (wc * NT * 16 + nt * 16 + fr) * 64 + (((kk * 4 + fq) ^ swz) * 8));
#pragma unroll
      for (int mt = 0; mt < 4; ++mt) xf[kk][mt] = *(const bf16x8*)(ca + (wr * 64 + mt * 16 + fr) * 64 + (((kk * 4 + fq) ^ swz) * 8));
    }
    __builtin_amdgcn_sched_barrier(0);
    if (kt + 1 < nk) DMA_TILE((kt + 1) * 64, cur ^ 1)
    __builtin_amdgcn_sched_barrier(0);
#pragma unroll
    for (int kk = 0; kk < 2; ++kk)
#pragma unroll
      for (int mt = 0; mt < 4; ++mt)
#pragma unroll
        for (int nt = 0; nt < NT; ++nt) acc[mt][nt] = mfma16(wf[kk][nt], xf[kk][mt], acc[mt][nt]);
  }
}
#else
template <int NT>
DI void gemm_kloop(const u16* __restrict__ A, size_t lda, const u16* __restrict__ B, size_t ldb, int nk,
                   f32x4 (&acc)[4][NT], u16* sm) {
  const int tid = my_tid(), lane = tid & 63, wave = tid >> 6;
  const int fr = lane & 15, fq = lane >> 4, wr = wave >> 1, wc = wave & 1;
  u16* sa = sm;
  u16* sb = sm + 2 * 128 * GP;
  uint4 ra0, ra1, ra2, ra3, rb0, rb1, rb2 = make_uint4(0, 0, 0, 0), rb3 = make_uint4(0, 0, 0, 0);
  uint4 rc0, rc1, rc2, rc3, rd0, rd1, rd2 = make_uint4(0, 0, 0, 0), rd3 = make_uint4(0, 0, 0, 0);
  const int lrow = tid >> 3, lseg = (tid & 7) * 8;
  const int sseg = ((tid & 7) ^ ((lrow >> 1) & 7)) * 8;
  const u16* Ap = A + (size_t)lrow * lda + lseg;
  const u16* Bp = B + (size_t)lrow * ldb + lseg;
#define KL_LOAD(KOFF, A0, A1, A2, A3, B0, B1, B2, B3)                    \
  A0 = *(const uint4*)(Ap + (KOFF));                                     \
  A1 = *(const uint4*)(Ap + 32 * lda + (KOFF));                          \
  A2 = *(const uint4*)(Ap + 64 * lda + (KOFF));                          \
  A3 = *(const uint4*)(Ap + 96 * lda + (KOFF));                          \
  B0 = *(const uint4*)(Bp + (KOFF));                                     \
  B1 = *(const uint4*)(Bp + 32 * ldb + (KOFF));                          \
  if (NT > 2) { B2 = *(const uint4*)(Bp + 64 * ldb + (KOFF)); B3 = *(const uint4*)(Bp + 96 * ldb + (KOFF)); }
#define KL_STORE(SA, SB, A0, A1, A2, A3, B0, B1, B2, B3)                 \
  *(uint4*)((SA) + (lrow + 0) * GP + sseg) = A0;                         \
  *(uint4*)((SA) + (lrow + 32) * GP + sseg) = A1;                        \
  *(uint4*)((SA) + (lrow + 64) * GP + sseg) = A2;                        \
  *(uint4*)((SA) + (lrow + 96) * GP + sseg) = A3;                        \
  *(uint4*)((SB) + (lrow + 0) * GP + sseg) = B0;                         \
  *(uint4*)((SB) + (lrow + 32) * GP + sseg) = B1;                        \
  if (NT > 2) { *(uint4*)((SB) + (lrow + 64) * GP + sseg) = B2; *(uint4*)((SB) + (lrow + 96) * GP + sseg) = B3; }
#define KL_COMPUTE(CA, CB)                                                                                     \
  _Pragma("unroll") for (int kk = 0; kk < 2; ++kk) {                                                           \
    bf16x8 wf[NT], xf[4];                                                                                      \
    _Pragma("unroll") for (int nt = 0; nt < NT; ++nt)                                                          \
      wf[nt] = *(const bf16x8*)((CB) + (wc * NT * 16 + nt * 16 + fr) * GP + (((kk * 4 + fq) ^ swz) * 8));       \
    _Pragma("unroll") for (int mt = 0; mt < 4; ++mt)                                                           \
      xf[mt] = *(const bf16x8*)((CA) + (wr * 64 + mt * 16 + fr) * GP + (((kk * 4 + fq) ^ swz) * 8));            \
    _Pragma("unroll") for (int mt = 0; mt < 4; ++mt)                                                           \
    _Pragma("unroll") for (int nt = 0; nt < NT; ++nt) acc[mt][nt] = mfma16(wf[nt], xf[mt], acc[mt][nt]);      \
  }
  const int swz = (fr >> 1) & 7;
  KL_LOAD(0, ra0, ra1, ra2, ra3, rb0, rb1, rb2, rb3)
  KL_LOAD(64, rc0, rc1, rc2, rc3, rd0, rd1, rd2, rd3)
  KL_STORE(sa, sb, ra0, ra1, ra2, ra3, rb0, rb1, rb2, rb3)
  __syncthreads();
  u16* sa1 = sa + 128 * GP;
  u16* sb1 = sb + 128 * GP;
#pragma unroll 1
  for (int kt = 0; kt < nk; kt += 2) {
    const int k2 = (kt + 2 < nk ? kt + 2 : kt) * 64, k3 = (kt + 3 < nk ? kt + 3 : kt + 1) * 64;
    KL_LOAD(k2, ra0, ra1, ra2, ra3, rb0, rb1, rb2, rb3)
    __builtin_amdgcn_sched_barrier(0);
    KL_COMPUTE(sa, sb)
    KL_STORE(sa1, sb1, rc0, rc1, rc2, rc3, rd0, rd1, rd2, rd3)
    __syncthreads();
    KL_LOAD(k3, rc0, rc1, rc2, rc3, rd0, rd1, rd2, rd3)
    __builtin_amdgcn_sched_barrier(0);
    KL_COMPUTE(sa1, sb1)
    KL_STORE(sa, sb, ra0, ra1, ra2, ra3, rb0, rb1, rb2, rb3)
    __syncthreads();
  }
}
#endif
template <int NT>
DI void zero_acc(f32x4 (&acc)[4][NT]) {
#pragma unroll
  for (int a = 0; a < 4; ++a)
#pragma unroll
    for (int b = 0; b < NT; ++b) acc[a][b] = (f32x4){0.f, 0.f, 0.f, 0.f};
}

struct TileIter {
  int step, nsteps, nrb, nct, x, li, lj, mode, idx, stride, L;
  DI void init(int nrt, int nct_, int b, int G) {
    nct = nct_;
    if (G == 512 && (nrt % 64) == 0) {
      mode = 1; x = b & 7;
      const int local = b >> 3;
      li = local >> 3; lj = local & 7;
      nrb = nrt / 64;
      nsteps = nrb * ((nct + 7) >> 3);
      step = 0;
      skip();
    } else {
      mode = 0; idx = b; stride = G; L = nrt * nct;
    }
  }
  DI int ctile() const { return (step / nrb) * 8 + lj; }
  DI void skip() { while (step < nsteps && ctile() >= nct) ++step; }
  DI bool valid() const { return mode ? step < nsteps : idx < L; }
  DI int rt() const { return mode ? x + 8 * ((step % nrb) * 8 + li) : idx / nct; }
  DI int ct() const { return mode ? ctile() : idx % nct; }
  DI void next() { if (mode) { ++step; skip(); } else idx += stride; }
};

#define EPI_COORDS                                                       \
  const int lane = my_tid() & 63, wave = my_tid() >> 6;           \
  const int fr = lane & 15, fq = lane >> 4, wr = wave >> 1, wc = wave & 1; \
  (void)fr; (void)fq; (void)wr; (void)wc;

DI void gemm_inproj(const Params& p, int layer, int b, int G, u16* sm) {
  const u16* H = (const u16*)(p.ws + OFF_H);
  const u16* W = (const u16*)(p.ws + OFF_W) + layer * W_LAYER + WO_IN;
  u16* proj = (u16*)(p.ws + OFF_PROJ);
  float* AB = (float*)(p.ws + OFF_AB);
  EPI_COORDS
  TileIter it; it.init(T / 128, 21, b, G);
  for (; it.valid(); it.next()) {
    const int row0 = it.rt() * 128, col0 = it.ct() * 128;
    f32x4 acc[4][4]; zero_acc<4>(acc);
    gemm_kloop<4>(H + (size_t)row0 * DM, DM, W + (size_t)col0 * DM, DM, 16, acc, sm);
#pragma unroll
    for (int mt = 0; mt < 4; ++mt) {
      const int row = row0 + wr * 64 + mt * 16 + fr;
      const float rs = rstd_of(ssq_buf(p, layer)[row]);
#pragma unroll
      for (int nt = 0; nt < 4; ++nt) {
        const int col = col0 + wc * 64 + nt * 16 + fq * 4;
        acc[mt][nt] *= rs;
        if (col < INW) {
          uint2 o; o.x = pack2(acc[mt][nt][0], acc[mt][nt][1]); o.y = pack2(acc[mt][nt][2], acc[mt][nt][3]);
          *(uint2*)(proj + (size_t)row * INW + col) = o;
          if (col >= 1024 && col < 1040)
            *(float4*)(AB + (size_t)row * 16 + (col - 1024)) = make_float4(acc[mt][nt][0], acc[mt][nt][1], acc[mt][nt][2], acc[mt][nt][3]);
        }
      }
    }
  }
}

DI void gemm_glu(const Params& p, int layer, int b, int G, u16* sm) {
  const u16* Gb = (const u16*)(p.ws + OFF_G);
  const u16* W = (const u16*)(p.ws + OFF_W) + layer * W_LAYER + WO_GLU;
  u16* proj = (u16*)(p.ws + OFF_PROJ);
  EPI_COORDS
  TileIter it; it.init(T / 128, 4, b, G);
  for (; it.valid(); it.next()) {
    const int row0 = it.rt() * 128, ct = it.ct();
    f32x4 acc[4][4]; zero_acc<4>(acc);
    gemm_kloop<4>(Gb + (size_t)row0 * 256, 256, W + (size_t)ct * 128 * 256, 256, 4, acc, sm);
#pragma unroll
    for (int mt = 0; mt < 4; ++mt) {
      const int row = row0 + wr * 64 + mt * 16 + fr;
#pragma unroll
      for (int nt = 0; nt < 2; ++nt) {
        const int col = (ct * 2 + wc) * 32 + nt * 16 + fq * 4;
        float o[4];
#pragma unroll
        for (int j = 0; j < 4; ++j) o[j] = acc[mt][nt][j] * sigmoidf_(acc[mt][nt + 2][j]);
        uint2 ov; ov.x = pack2(o[0], o[1]); ov.y = pack2(o[2], o[3]);
        *(uint2*)(proj + (size_t)row * INW + C_CU + col) = ov;
      }
    }
  }
}

DI void gemm_merge(const Params& p, int layer, int b, int G, u16* sm) {
  const u16* H = (const u16*)(p.ws + OFF_H);
  const u16* Wg = (const u16*)(p.ws + OFF_W) + layer * W_LAYER + WO_GATE;
  const u16* Wb = (const u16*)(p.ws + OFF_W) + layer * W_LAYER + WO_BR;
  const u16* proj = (const u16*)(p.ws + OFF_PROJ);
  u16* merged = (u16*)(p.ws + OFF_MERGED);
  EPI_COORDS
  TileIter it; it.init(T / 128, 8, b, G);
  for (; it.valid(); it.next()) {
    const int row0 = it.rt() * 128, col0 = it.ct() * 128;
    uint2 mg[4][4];
#pragma unroll
    for (int a = 0; a < 4; ++a)
#pragma unroll
      for (int c = 0; c < 4; ++c) mg[a][c] = make_uint2(0u, 0u);
#pragma unroll 1
    for (int i = 0; i < 4; ++i) {
      const int ocol = (i == 0) ? C_AZ : (i == 1) ? C_BQ : (i == 2) ? C_CU : C_DQ;
      f32x4 acc[4][4]; zero_acc<4>(acc);
      gemm_kloop<4, true>(H + (size_t)row0 * DM, DM, Wg + (size_t)i * DM * DM + (size_t)col0 * DM, DM, 16, acc, sm);
      uint2 sg[4][4];
#pragma unroll
      for (int a = 0; a < 4; ++a) {
        const float rs = rstd_of(ssq_buf(p, layer)[row0 + wr * 64 + a * 16 + fr]);
#pragma unroll
        for (int c = 0; c < 4; ++c) {
          sg[a][c].x = pack2(sigmoidf_(rs * acc[a][c][0]), sigmoidf_(rs * acc[a][c][1]));
          sg[a][c].y = pack2(sigmoidf_(rs * acc[a][c][2]), sigmoidf_(rs * acc[a][c][3]));
        }
      }
      zero_acc<4>(acc);
      gemm_kloop<4, true>(proj + (size_t)row0 * INW + ocol, INW, Wb + (size_t)i * DM * 256 + (size_t)col0 * 256, 256, 4, acc, sm);
#pragma unroll
      for (int a = 0; a < 4; ++a)
#pragma unroll
        for (int c = 0; c < 4; ++c) {
          const float m0 = bf2f((u16)(mg[a][c].x & 0xffff)) + bf2f((u16)(sg[a][c].x & 0xffff)) * acc[a][c][0];
          const float m1 = bf2f((u16)(mg[a][c].x >> 16)) + bf2f((u16)(sg[a][c].x >> 16)) * acc[a][c][1];
          const float m2 = bf2f((u16)(mg[a][c].y & 0xffff)) + bf2f((u16)(sg[a][c].y & 0xffff)) * acc[a][c][2];
          const float m3 = bf2f((u16)(mg[a][c].y >> 16)) + bf2f((u16)(sg[a][c].y >> 16)) * acc[a][c][3];
          mg[a][c].x = pack2(m0, m1); mg[a][c].y = pack2(m2, m3);
        }
    }
#pragma unroll
    for (int mt = 0; mt < 4; ++mt) {
      const int row = row0 + wr * 64 + mt * 16 + fr;
#pragma unroll
      for (int nt = 0; nt < 4; ++nt) {
        const int col = col0 + wc * 64 + nt * 16 + fq * 4;
        *(uint2*)(merged + (size_t)row * DM + col) = mg[mt][nt];
      }
    }
  }
}

DI void gemm_resid(const Params& p, int layer_src, const u16* A, int K, const u16* W, int b, int G, u16* sm, u16* xb_out,
                   float* ssq_acc) {
  EPI_COORDS
  TileIter it; it.init(T / 128, 8, b, G);
  for (; it.valid(); it.next()) {
    const int row0 = it.rt() * 128, col0 = it.ct() * 128;
    f32x4 acc[4][4]; zero_acc<4>(acc);
    gemm_kloop<4>(A + (size_t)row0 * K, K, W + (size_t)col0 * K, K, K / 64, acc, sm);
#pragma unroll
    for (int mt = 0; mt < 4; ++mt) {
      const int row = row0 + wr * 64 + mt * 16 + fr;
      const float* xs = xrow(p, layer_src, row);
      float* xd = p.xout + (size_t)row * DM;
      float ss = 0.f;
#pragma unroll
      for (int nt = 0; nt < 4; ++nt) {
        const int col = col0 + wc * 64 + nt * 16 + fq * 4;
        float4 r = *(const float4*)(xs + col);
        r.x += acc[mt][nt][0]; r.y += acc[mt][nt][1]; r.z += acc[mt][nt][2]; r.w += acc[mt][nt][3];
        *(float4*)(xd + col) = r;
        ss += r.x * r.x + r.y * r.y + r.z * r.z + r.w * r.w;
        if (xb_out) { uint2 o; o.x = pack2(r.x, r.y); o.y = pack2(r.z, r.w); *(uint2*)(xb_out + (size_t)row * DM + col) = o; }
      }
      if (ssq_acc) {
        ss += __shfl_xor(ss, 16, 64);
        ss += __shfl_xor(ss, 32, 64);
        if (fq == 0) atomicAdd(ssq_acc + row, ss);
      }
    }
  }
}

DI void gemm_ffn1(const Params& p, int layer, int b, int G, u16* sm) {
  const u16* H = (const u16*)(p.ws + OFF_H2);
  const u16* W = (const u16*)(p.ws + OFF_W) + layer * W_LAYER + WO_GU;
  u16* act = (u16*)(p.ws + OFF_ACT);
  EPI_COORDS
  TileIter it; it.init(T / 128, 44, b, G);
  for (; it.valid(); it.next()) {
    const int row0 = it.rt() * 128, ct = it.ct();
    f32x4 acc[4][4]; zero_acc<4>(acc);
    gemm_kloop<4>(H + (size_t)row0 * DM, DM, W + (size_t)ct * 128 * DM, DM, 16, acc, sm);
#pragma unroll
    for (int mt = 0; mt < 4; ++mt) {
      const int row = row0 + wr * 64 + mt * 16 + fr;
      const float rs = rstd_of(ssq_buf(p, 2 + layer)[row]);
#pragma unroll
      for (int nt = 0; nt < 2; ++nt) {
        const int col = (ct * 2 + wc) * 32 + nt * 16 + fq * 4;
        float o[4];
#pragma unroll
        for (int j = 0; j < 4; ++j) o[j] = siluf_(rs * acc[mt][nt][j]) * (rs * acc[mt][nt + 2][j]);
        uint2 ov; ov.x = pack2(o[0], o[1]); ov.y = pack2(o[2], o[3]);
        *(uint2*)(act + (size_t)row * FH + col) = ov;
      }
    }
  }
}

DI void gdn_pre(const Params& p, int layer, int task, char* smem) {
  const int tid = my_tid(), lane = tid & 63, wave = tid >> 6;
  const int n = task >> 2, h = task & 3, c0 = n * 64;
  const int lo = seq_lo(c0), hi = seq_hi(c0);
  float* ks = (float*)smem;
  float* vs = ks + 64 * 65;
  float* AmT = vs + 64 * 65;
  float* gcs = AmT + 2 * 64 * 64;
  float* bts = gcs + 128;
  const u16* proj = (const u16*)(p.ws + OFF_PROJ);
  u16* QN = (u16*)(p.ws + OFF_QN);
  u16* KN = (u16*)(p.ws + OFF_KN);
  float* GC = (float*)(p.ws + OFF_GC);
  const float* AB = (const float*)(p.ws + OFF_AB);
  u16* UW = (u16*)(p.ws + OFF_UW);
  __syncthreads();
#pragma unroll 1
  for (int mat = 0; mat < 3; ++mat) {
    const int ch = mat * 256 + h * 64 + lane;
    float w[5];
#pragma unroll
    for (int j = 0; j < 5; ++j) w[j] = p.conv_a[(size_t)(layer * 5 + j) * 768 + ch];
    float raw[20];
#pragma unroll
    for (int i = 0; i < 20; ++i) {
      const int tok = c0 + wave * 16 + i - 2;
      raw[i] = (tok >= lo && tok < hi) ? bf2f(proj[(size_t)tok * INW + ch]) : 0.f;
    }
#pragma unroll
    for (int i = 0; i < 16; ++i) {
      float v = 0.f;
#pragma unroll
      for (int j = 0; j < 5; ++j) v += raw[i + j] * w[j];
      v = siluf_(v);
      const int tl = wave * 16 + i;
      if (mat < 2) {
        const float ss = wave_sum(v * v);
        v *= rsqrtf(ss + EPS) * (mat == 0 ? 0.125f : 1.f);
      }
      if (mat == 0) QN[(size_t)(c0 + tl) * 256 + h * 64 + lane] = f2bf(v);
      else if (mat == 1) { KN[(size_t)(c0 + tl) * 256 + h * 64 + lane] = f2bf(v); ks[tl * 65 + lane] = v; }
      else vs[tl * 65 + lane] = v;
    }
  }
  if (wave < 2) {
    const int d = wave;
    const int tok = c0 + (d ? 63 - lane : lane);
    const float al = AB[(size_t)tok * 16 + d * 4 + h];
    const float br = AB[(size_t)tok * 16 + 8 + d * 4 + h];
    const float xx = al + p.dt_bias[(layer * 2 + d) * 4 + h];
    const float sp = fmaxf(xx, 0.f) + log1pf(__expf(-fabsf(xx)));
    float g = -__expf(p.a_log[(layer * 2 + d) * 4 + h]) * sp;
#pragma unroll
    for (int o = 1; o < 64; o <<= 1) {
      const float t = __shfl_up(g, o, 64);
      if (lane >= o) g += t;
    }
    gcs[d * 64 + lane] = g;
    bts[d * 64 + lane] = sigmoidf_(br);
    GC[(size_t)(task * 2 + d) * 64 + lane] = g;
  }
  __syncthreads();
#pragma unroll 1
  for (int m = 0; m < 16; ++m) {
    const int a = wave + 4 * m, b = lane;
    float dot = 0.f;
#pragma unroll 16
    for (int dd = 0; dd < 64; ++dd) dot += ks[a * 65 + dd] * ks[b * 65 + dd];
    if (a > b) {
      AmT[b * 64 + a] = bts[a] * dot * __expf(gcs[a] - gcs[b]);
      const int i1 = 63 - b, j1 = 63 - a;
      AmT[4096 + j1 * 64 + i1] = bts[64 + i1] * dot * __expf(gcs[64 + i1] - gcs[64 + j1]);
    }
  }
  __syncthreads();
  {
    int d = tid >> 7, c = tid & 127;
    asm volatile("" : "+v"(d), "+v"(c));
    float r[64];
    {
      const int stride = d ? -65 : 65;
      int off = (d ? 63 * 65 : 0) + (c & 63);
      const float* srcm = (c < 64) ? vs : ks;
      const bool isw = c >= 64;
#pragma unroll
      for (int i = 0; i < 64; ++i) {
        float v = srcm[off] * bts[d * 64 + i];
        if (isw) v *= __expf(gcs[d * 64 + i]);
        r[i] = v;
        off += stride;
        asm volatile("" : "+v"(off));
        if ((i & 7) == 7) __builtin_amdgcn_sched_barrier(0);
      }
    }
    const float* Ad = AmT + d * 4096;
#pragma unroll
    for (int j = 0; j < 63; ++j) {
      const float rj = r[j];
#pragma unroll
      for (int i = j + 1; i < 64; ++i) {
        r[i] = fmaf(-Ad[j * 64 + i], rj, r[i]);
        if ((i & 15) == 15) __builtin_amdgcn_sched_barrier(0);
      }
      __builtin_amdgcn_sched_barrier(0);
    }
    u16* base = UW + (size_t)(task * 2 + d) * 8192;
    if (c < 64) {
      uint4* dst = (uint4*)(base + c * 64);
#pragma unroll
      for (int q = 0; q < 8; ++q)
        dst[q] = make_uint4(pack2(r[8 * q], r[8 * q + 1]), pack2(r[8 * q + 2], r[8 * q + 3]), pack2(r[8 * q + 4], r[8 * q + 5]),
                            pack2(r[8 * q + 6], r[8 * q + 7]));
    } else {
      u16* dst = base + 4096 + (c - 64);
#pragma unroll
      for (int i = 0; i < 64; ++i) dst[i * 64] = f2bf(r[i]);
    }
  }
}

DI f32x4 mma_t(const u16* X, int xr, const u16* Y, int yr, f32x4 acc, int fr, int fq) {
#pragma unroll
  for (int kk = 0; kk < 2; ++kk) {
    const bf16x8 x = *(const bf16x8*)(X + (xr + fr) * 72 + kk * 32 + fq * 8);
    const bf16x8 y = *(const bf16x8*)(Y + (yr + fr) * 72 + kk * 32 + fq * 8);
    acc = mfma16(x, y, acc);
  }
  return acc;
}
DI f32x4 mma_t_swz(const u16* X, int xr, const u16* Y, int yr, f32x4 acc, int fr, int fq) {
  const int sw = ((xr + fr) >> 3) & 7;
#pragma unroll
  for (int kk = 0; kk < 2; ++kk) {
    const bf16x8 x = *(const bf16x8*)(X + (xr + fr) * 72 + (((kk * 4 + fq) ^ sw) * 8));
    const bf16x8 y = *(const bf16x8*)(Y + (yr + fr) * 72 + kk * 32 + fq * 8);
    acc = mfma16(x, y, acc);
  }
  return acc;
}

DI void gdn_scan(const Params& p, int item, char* smem) {
  const int tid = my_tid(), lane = tid & 63, w = tid >> 6;
  const int fr = lane & 15, fq = lane >> 4;
  const int chain = item >> 2, eq = item & 3;
  const int s = chain >> 3, h = (chain >> 1) & 3, d = chain & 1;
  const int sb = s == 0 ? 0 : TP + (s - 1) * 4096;
  const int nch = s == 0 ? 256 : 64;
  u16* St = (u16*)smem;
  u16* Vt = St + 16 * 72;
  u16* Vts = Vt + 16 * 72;
  u16* Wc = Vts + 16 * 72;
  u16* Qc = Wc + 64 * 72;
  u16* Kc = Qc + 64 * 72;
  u16* KcT = Kc + 64 * 72;
  u16* QKm = KcT + 64 * 72;
  float* gcs = (float*)(QKm + 64 * 72);
  u16* proj = (u16*)(p.ws + OFF_PROJ);
  const u16* QN = (const u16*)(p.ws + OFF_QN);
  const u16* KN = (const u16*)(p.ws + OFF_KN);
  const float* GC = (const float*)(p.ws + OFF_GC);
  const u16* UW = (const u16*)(p.ws + OFF_UW);
  __syncthreads();
  for (int i = tid; i < 16 * 72; i += 256) St[i] = 0;
  f32x4 S0 = (f32x4){0.f, 0.f, 0.f, 0.f};
  const int prow0 = tid >> 3, prow1 = (tid >> 3) + 32, pseg = (tid & 7) * 8;
  uint4 w0a, w1a, q0a, q1a, k0a, k1a, w0b, w1b, q0b, q1b, k0b, k1b;
  uint2 u0a, u0b;
  float ga, gb;
#define GDN_PREFETCH2(J, S)                                                                          \
  {                                                                                                  \
    const int jj_ = (J) < nch ? (J) : nch - 1;                                                       \
    const int n_ = sb / 64 + (d ? nch - 1 - jj_ : jj_);                                              \
    const int c0_ = n_ * 64;                                                                         \
    const size_t tb_ = (size_t)((n_ * 4 + h) * 2 + d);                                               \
    const u16* ub_ = UW + tb_ * 8192;                                                                \
    const int tok0_ = c0_ + (d ? 63 - prow0 : prow0), tok1_ = c0_ + (d ? 63 - prow1 : prow1);        \
    w0##S = *(const uint4*)(ub_ + 4096 + prow0 * 64 + pseg);                                         \
    w1##S = *(const uint4*)(ub_ + 4096 + prow1 * 64 + pseg);                                         \
    q0##S = *(const uint4*)(QN + (size_t)tok0_ * 256 + h * 64 + pseg);                               \
    q1##S = *(const uint4*)(QN + (size_t)tok1_ * 256 + h * 64 + pseg);                               \
    k0##S = *(const uint4*)(KN + (size_t)tok0_ * 256 + h * 64 + pseg);                               \
    k1##S = *(const uint4*)(KN + (size_t)tok1_ * 256 + h * 64 + pseg);                               \
    u0##S = *(const uint2*)(ub_ + (eq * 16 + fr) * 64 + w * 16 + fq * 4);                            \
    g##S = GC[tb_ * 64 + lane];                                                                      \
  }
#define GDN_STAGE2(ROW, PW, PQ, PK)                                                                  \
  {                                                                                                  \
    *(uint4*)(Wc + (ROW) * 72 + pseg) = PW;                                                          \
    *(uint4*)(Qc + (ROW) * 72 + pseg) = PQ;                                                          \
    *(uint4*)(Kc + (ROW) * 72 + pseg) = PK;                                                          \
    u16* kt_ = KcT + pseg * 72 + ((((ROW) >> 3) ^ (tid & 7)) * 8) + ((ROW) & 7);                     \
    kt_[0 * 72] = (u16)(PK.x & 0xffff); kt_[1 * 72] = (u16)(PK.x >> 16);                             \
    kt_[2 * 72] = (u16)(PK.y & 0xffff); kt_[3 * 72] = (u16)(PK.y >> 16);                             \
    kt_[4 * 72] = (u16)(PK.z & 0xffff); kt_[5 * 72] = (u16)(PK.z >> 16);                             \
    kt_[6 * 72] = (u16)(PK.w & 0xffff); kt_[7 * 72] = (u16)(PK.w >> 16);                             \
  }
#define GDN_STEP(JV, S)                                                                              \
  {                                                                                                  \
    const int j_ = (JV);                                                                             \
    const int n = sb / 64 + (d ? nch - 1 - j_ : j_);                                                 \
    const int c0 = n * 64;                                                                           \
    GDN_STAGE2(prow0, w0##S, q0##S, k0##S)                                                           \
    GDN_STAGE2(prow1, w1##S, q1##S, k1##S)                                                           \
    if (tid < 64) gcs[tid] = g##S;                                                                   \
    const uint2 cu0 = u0##S;                                                                         \
    __syncthreads();                                                                          \
    GDN_PREFETCH2(j_ + 2, S)                                                                         \
    const f32x4 z4 = (f32x4){0.f, 0.f, 0.f, 0.f};                                                    \
    const f32x4 P1a = mma_t(Wc, w * 16, St, 0, z4, fr, fq);                                          \
    const f32x4 P2a = mma_t(St, 0, Qc, w * 16, z4, fr, fq);                                          \
      \
    const float glog = gcs[63];                                                                      \
    const float gcc = gcs[w * 16 + fr];                                                              \
    const float4 gq0 = *(const float4*)(gcs + fq * 4), gq1 = *(const float4*)(gcs + 16 + fq * 4);    \
    const float4 gq2 = *(const float4*)(gcs + 32 + fq * 4), gq3 = *(const float4*)(gcs + 48 + fq * 4); \
    const float4 gw = *(const float4*)(gcs + w * 16 + fq * 4);                                       \
    {                                                                                                \
      const int c = w * 16 + fr;                                                                     \
      _Pragma("unroll") for (int t = 0; t < 4; ++t) {                                                \
        const f32x4 qk = mma_t(Kc, t * 16, Qc, w * 16, z4, fr, fq);                                  \
        const int s0 = t * 16 + fq * 4;                                                              \
        const float4 gs = t == 0 ? gq0 : t == 1 ? gq1 : t == 2 ? gq2 : gq3;                          \
        const float e0 = __expf(fminf(gcc - gs.x, 0.f)), e1 = __expf(fminf(gcc - gs.y, 0.f));       \
        const float e2 = __expf(fminf(gcc - gs.z, 0.f)), e3 = __expf(fminf(gcc - gs.w, 0.f));       \
        const float v0 = (c >= s0 + 0) ? qk[0] * e0 : 0.f;                                           \
        const float v1 = (c >= s0 + 1) ? qk[1] * e1 : 0.f;                                           \
        const float v2 = (c >= s0 + 2) ? qk[2] * e2 : 0.f;                                           \
        const float v3 = (c >= s0 + 3) ? qk[3] * e3 : 0.f;                                           \
        uint2 o; o.x = pack2(v0, v1); o.y = pack2(v2, v3);                                           \
        *(uint2*)(QKm + c * 72 + s0) = o;                                                            \
      }                                                                                              \
    }                                                                                                \
    {                                                                                                \
      const int cc0 = w * 16 + fq * 4;                                                               \
      const float v0 = bf2f((u16)(cu0.x & 0xffff)) - P1a[0], v1 = bf2f((u16)(cu0.x >> 16)) - P1a[1]; \
      const float v2 = bf2f((u16)(cu0.y & 0xffff)) - P1a[2], v3 = bf2f((u16)(cu0.y >> 16)) - P1a[3]; \
      uint2 o; o.x = pack2(v0, v1); o.y = pack2(v2, v3);                                             \
      *(uint2*)(Vt + fr * 72 + cc0) = o;                                                             \
      uint2 o2;                                                                                      \
      o2.x = pack2(v0 * __expf(glog - gw.x), v1 * __expf(glog - gw.y));                              \
      o2.y = pack2(v2 * __expf(glog - gw.z), v3 * __expf(glog - gw.w));                              \
      *(uint2*)(Vts + fr * 72 + cc0) = o2;                                                           \
    }                                                                                                \
    __syncthreads();                                                                          \
    {                                                                                                \
      const int c = w * 16 + fr;                                                                     \
      const float eg = __expf(gcc);                                                                  \
      const int tok = c0 + (d ? 63 - c : c);                                                         \
      u16* orow = proj + (size_t)tok * INW + d * 256 + h * 64 + eq * 16 + fq * 4;                    \
      f32x4 oa = P2a * eg;                                                                           \
      oa = mma_t(Vt, 0, QKm, w * 16, oa, fr, fq);                                                    \
      uint2 o; o.x = pack2(oa[0], oa[1]); o.y = pack2(oa[2], oa[3]);                                 \
      *(uint2*)(orow) = o;                                                                           \
    }                                                                                                \
    {                                                                                                \
      const float gl = __expf(glog);                                                                 \
      S0 *= gl;                                                                                      \
      S0 = mma_t_swz(KcT, w * 16, Vts, 0, S0, fr, fq);                                               \
      const int r0 = w * 16 + fq * 4;                                                                \
      uint2 o; o.x = pack2(S0[0], S0[1]); o.y = pack2(S0[2], S0[3]);                                 \
      *(uint2*)(St + fr * 72 + r0) = o;                                                              \
    }                                                                                                \
    __syncthreads();                                                                          \
  }
  GDN_PREFETCH2(0, a)
  GDN_PREFETCH2(1, b)
  for (int j = 0; j < nch; j += 2) {
    GDN_STEP(j, a)
    GDN_STEP(j + 1, b)
  }
}

DI void gdn_post_row(const Params& p, int layer, int t) {
  const int lane = my_tid() & 63;
  u16* row = (u16*)(p.ws + OFF_PROJ) + (size_t)t * INW;
  const uint2 f = *(const uint2*)(row + lane * 4);
  const uint2 bw = *(const uint2*)(row + 256 + lane * 4);
  const uint2 z = *(const uint2*)(row + C_AZ + lane * 4);
  float o[4], zz[4];
  o[0] = bf2f((u16)(f.x & 0xffff)) + bf2f((u16)(bw.x & 0xffff));
  o[1] = bf2f((u16)(f.x >> 16)) + bf2f((u16)(bw.x >> 16));
  o[2] = bf2f((u16)(f.y & 0xffff)) + bf2f((u16)(bw.y & 0xffff));
  o[3] = bf2f((u16)(f.y >> 16)) + bf2f((u16)(bw.y >> 16));
  zz[0] = bf2f((u16)(z.x & 0xffff)); zz[1] = bf2f((u16)(z.x >> 16)); zz[2] = bf2f((u16)(z.y & 0xffff)); zz[3] = bf2f((u16)(z.y >> 16));
  float ss = o[0] * o[0] + o[1] * o[1] + o[2] * o[2] + o[3] * o[3];
#pragma unroll
  for (int m = 1; m < 16; m <<= 1) ss += __shfl_xor(ss, m, 64);
  const float rs = rsqrtf(ss * (1.f / 64.f) + EPS);
  const int e0 = (lane & 15) * 4;
  float r[4];
#pragma unroll
  for (int j = 0; j < 4; ++j) r[j] = o[j] * rs * p.a_norm[layer * 64 + e0 + j] * siluf_(zz[j]);
  uint2 ov; ov.x = pack2(r[0], r[1]); ov.y = pack2(r[2], r[3]);
  *(uint2*)(row + C_AZ + lane * 4) = ov;
}

struct S5Const { float are, aim; float bpr[16], bpi[16]; };
DI void s5_consts(const Params& p, int layer, int d, int g, int lane, S5Const& k, float& lr, float& li, float& step) {
  const int gi = ((layer * 2 + d) * 16 + g);
  lr = p.lam_re[(size_t)gi * 64 + lane];
  li = p.lam_im[(size_t)gi * 64 + lane];
  step = expf(p.log_step[gi]);
  const float mag = expf(lr * step);
  float sn, cs; sincosf(li * step, &sn, &cs);
  k.are = mag * cs; k.aim = mag * sn;
  const float inv = 1.f / (lr * lr + li * li);
  const float ir = lr * inv, ii = -li * inv;
  const float cr = (k.are - 1.f) * ir - k.aim * ii;
  const float ci = (k.are - 1.f) * ii + k.aim * ir;
  const float* br = p.b_re + ((size_t)(layer * 16 + g) * 64 + lane) * 16;
  const float* bi = p.b_im + ((size_t)(layer * 16 + g) * 64 + lane) * 16;
#pragma unroll
  for (int c = 0; c < 16; ++c) {
    const float a = br[c], b = bi[c];
    k.bpr[c] = cr * a - ci * b;
    k.bpi[c] = cr * b + ci * a;
  }
}
DI void s5_stage_u(const Params& p, int c0, int gq, float* us) {
  const u16* proj = (const u16*)(p.ws + OFF_PROJ);
  const int tid = my_tid();
#pragma unroll
  for (int i = 0; i < 4; ++i) {
    const int idx = tid + 256 * i, tok = idx >> 4, c4 = (idx & 15) * 4;
    const uint2 v = *(const uint2*)(proj + (size_t)(c0 + tok) * INW + C_CU + gq * 64 + c4);
    us[tok * 64 + c4 + 0] = bf2f((u16)(v.x & 0xffff));
    us[tok * 64 + c4 + 1] = bf2f((u16)(v.x >> 16));
    us[tok * 64 + c4 + 2] = bf2f((u16)(v.y & 0xffff));
    us[tok * 64 + c4 + 3] = bf2f((u16)(v.y >> 16));
  }
}
DI void s5_step(const S5Const& k, const float* u, float& sr, float& si) {
  float xr = 0.f, xi = 0.f;
#pragma unroll
  for (int c4 = 0; c4 < 4; ++c4) {
    const float4 uu = *(const float4*)(u + c4 * 4);
    xr += k.bpr[c4 * 4 + 0] * uu.x + k.bpr[c4 * 4 + 1] * uu.y + k.bpr[c4 * 4 + 2] * uu.z + k.bpr[c4 * 4 + 3] * uu.w;
    xi += k.bpi[c4 * 4 + 0] * uu.x + k.bpi[c4 * 4 + 1] * uu.y + k.bpi[c4 * 4 + 2] * uu.z + k.bpi[c4 * 4 + 3] * uu.w;
  }
  const float nr = k.are * sr - k.aim * si + xr;
  const float ni = k.are * si + k.aim * sr + xi;
  sr = nr; si = ni;
}
DI void s5_pass1(const Params& p, int layer, int task, char* smem) {
  const int lane = my_tid() & 63, wave = my_tid() >> 6;
  const int n = task >> 2, gq = task & 3, g = gq * 4 + wave, c0 = n * 64;
  float* us = (float*)smem;
  float2* SEND = (float2*)(p.ws + OFF_SEND);
  __syncthreads();
  s5_stage_u(p, c0, gq, us);
  __syncthreads();
#pragma unroll 1
  for (int d = 0; d < 2; ++d) {
    S5Const k; float lr, li, step;
    s5_consts(p, layer, d, g, lane, k, lr, li, step);
    float sr = 0.f, si = 0.f;
#pragma unroll 4
    for (int i = 0; i < 64; ++i) {
      const int t = d ? 63 - i : i;
      s5_step(k, us + t * 64 + wave * 16, sr, si);
    }
    SEND[((size_t)(n * 2 + d) * 16 + g) * 64 + lane] = make_float2(sr, si);
  }
}
DI float gelu_tanh(float x) {
  const float u = 0.7978845608028654f * (x + 0.044715f * x * x * x);
  return 0.5f * x * (1.f + tanhf(u));
}
DI void s5_pass3(const Params& p, int layer, int task, char* smem) {
  const int lane = my_tid() & 63, wave = my_tid() >> 6;
  const int fr = lane & 15, fq = lane >> 4;
  const int n = task >> 2, gq = task & 3, g = gq * 4 + wave, c0 = n * 64;
  const int nlo = seq_lo(c0) / 64, nhi = seq_hi(c0) / 64;
  float* us = (float*)smem;
  u16* Sb = (u16*)(smem + 16384) + wave * 16 * 136;
  const float2* SEND = (const float2*)(p.ws + OFF_SEND);
  u16* Gb = (u16*)(p.ws + OFF_G);
  __syncthreads();
  s5_stage_u(p, c0, gq, us);
  __syncthreads();
  f32x4 yacc[4];
#pragma unroll
  for (int tb = 0; tb < 4; ++tb) yacc[tb] = (f32x4){0.f, 0.f, 0.f, 0.f};
#pragma unroll
  for (int d = 0; d < 2; ++d) {
    S5Const k; float lr, li, step;
    s5_consts(p, layer, d, g, lane, k, lr, li, step);
    const float m64 = expf(lr * step * 64.f);
    float s64, c64; sincosf(li * step * 64.f, &s64, &c64);
    const float a64r = m64 * c64, a64i = m64 * s64;
    float sr = 0.f, si = 0.f;
    {
      const int cnt = d == 0 ? n - nlo : nhi - 1 - n;
      const int first = d == 0 ? nlo : nhi - 1;
      const int sgn = d == 0 ? 1 : -1;
      const float2* sp = SEND + ((size_t)(first * 2 + d) * 16 + g) * 64 + lane;
      const long stride = (long)sgn * 2 * 16 * 64;
      int m = 0;
      for (; m + 8 <= cnt; m += 8) {
        float2 e0 = sp[0], e1 = sp[stride], e2 = sp[2 * stride], e3 = sp[3 * stride];
        float2 e4 = sp[4 * stride], e5 = sp[5 * stride], e6 = sp[6 * stride], e7 = sp[7 * stride];
        sp += 8 * stride;
#define HSTEP(E) { const float nr = a64r * sr - a64i * si + E.x, ni = a64r * si + a64i * sr + E.y; sr = nr; si = ni; }
        HSTEP(e0) HSTEP(e1) HSTEP(e2) HSTEP(e3) HSTEP(e4) HSTEP(e5) HSTEP(e6) HSTEP(e7)
      }
      for (; m < cnt; ++m) {
        const float2 e = sp[0];
        sp += stride;
        HSTEP(e)
      }
    }
    bf16x8 cf[4];
    {
      const float* cr = p.c_re + ((size_t)((layer * 2 + d) * 16 + g) * 16 + fr) * 64;
      const float* ci = p.c_im + ((size_t)((layer * 2 + d) * 16 + g) * 16 + fr) * 64;
#pragma unroll
      for (int kk = 0; kk < 4; ++kk)
#pragma unroll
        for (int e = 0; e < 8; ++e) {
          const int kx = (kk & 1) * 32 + fq * 8 + e;
          const float v = (kk < 2) ? cr[kx] : -ci[kx];
          cf[kk][e] = (short)f2bf(v);
        }
    }
#pragma unroll
    for (int blk = 0; blk < 4; ++blk) {
      const int tb = d ? 3 - blk : blk;
#pragma unroll 4
      for (int i = 0; i < 16; ++i) {
        const int r = d ? 15 - i : i;
        const int t = tb * 16 + r;
        s5_step(k, us + t * 64 + wave * 16, sr, si);
        Sb[r * 136 + lane] = f2bf(sr);
        Sb[r * 136 + 64 + lane] = f2bf(si);
      }
      __syncthreads();
#pragma unroll
      for (int kk = 0; kk < 4; ++kk) {
        const bf16x8 xf = *(const bf16x8*)(Sb + fr * 136 + kk * 32 + fq * 8);
        yacc[tb] = mfma16(xf, cf[kk], yacc[tb]);
      }
      __syncthreads();
    }
  }
  const float dsk = p.s5_d[layer * 256 + g * 16 + fr];
#pragma unroll
  for (int tb = 0; tb < 4; ++tb)
#pragma unroll
    for (int j = 0; j < 4; ++j) {
      const int t = tb * 16 + fq * 4 + j;
      const float y = yacc[tb][j] + us[t * 64 + wave * 16 + fr] * dsk;
      Gb[(size_t)(c0 + t) * 256 + g * 16 + fr] = f2bf(gelu_tanh(y));
    }
}

struct AttnState { float m, l; f32x4 o[4]; };
DI void attn_segment(const u16* proj, int kcol, int vcol, int tk0, int kstride, int npairs, int R, float slope, int tq,
                     int lo, int hi, const bf16x8 (&qf)[2], AttnState& st, u16* Vt, int lane) {
  const int fr = lane & 15, fq = lane >> 4;
#pragma unroll 1
  for (int pr = 0; pr < npairs; ++pr) {
    const int kbase = tk0 + pr * 32 * kstride;
    f32x4 sacc[2];
#pragma unroll
    for (int t = 0; t < 2; ++t) {
      int tk = kbase + (t * 16 + fr) * kstride;
      tk = min(max(tk, lo), hi - 1);
      const u16* kp = proj + (size_t)tk * INW + kcol + fq * 8;
      const bf16x8 k0 = *(const bf16x8*)(kp), k1 = *(const bf16x8*)(kp + 32);
      sacc[t] = mfma16(k0, qf[0], (f32x4){0.f, 0.f, 0.f, 0.f});
      sacc[t] = mfma16(k1, qf[1], sacc[t]);
    }
    uint4 vr[4];
#pragma unroll
    for (int i = 0; i < 4; ++i) {
      const int idx = lane + 64 * i, kl = idx >> 3, seg = (idx & 7) * 8;
      int tk = kbase + kl * kstride;
      tk = min(max(tk, lo), hi - 1);
      vr[i] = *(const uint4*)(proj + (size_t)tk * INW + vcol + seg);
    }
    float sc[2][4]; bool ok[2][4];
    float mx = -1e30f;
#pragma unroll
    for (int t = 0; t < 2; ++t)
#pragma unroll
      for (int j = 0; j < 4; ++j) {
        const int tk = kbase + (t * 16 + fq * 4 + j) * kstride;
        const int ad = abs(tk - tq);
        ok[t][j] = (ad <= R) && (tk >= lo) && (tk < hi);
        sc[t][j] = sacc[t][j] * 0.125f - slope * (float)ad;
        if (ok[t][j]) mx = fmaxf(mx, sc[t][j]);
      }
    mx = fmaxf(mx, __shfl_xor(mx, 16, 64));
    mx = fmaxf(mx, __shfl_xor(mx, 32, 64));
    const float mn = fmaxf(st.m, mx);
    const float alpha = __expf(st.m - mn);
    st.m = mn;
    float pv[2][4], ps = 0.f;
#pragma unroll
    for (int t = 0; t < 2; ++t)
#pragma unroll
      for (int j = 0; j < 4; ++j) { pv[t][j] = ok[t][j] ? __expf(sc[t][j] - mn) : 0.f; ps += pv[t][j]; }
    st.l = st.l * alpha + ps;
#pragma unroll
    for (int dt = 0; dt < 4; ++dt)
#pragma unroll
      for (int j = 0; j < 4; ++j) st.o[dt][j] *= alpha;
    bf16x8 pf;
    {
      const unsigned w0 = pack2(pv[0][0], pv[0][1]), w1 = pack2(pv[0][2], pv[0][3]), w2 = pack2(pv[1][0], pv[1][1]),
                     w3 = pack2(pv[1][2], pv[1][3]);
      uint4 t4 = make_uint4(w0, w1, w2, w3);
      pf = __builtin_bit_cast(bf16x8, t4);
    }
    __syncthreads();
#pragma unroll
    for (int i = 0; i < 4; ++i) {
      const int idx = lane + 64 * i, kl = idx >> 3, seg = (idx & 7) * 8;
      Vt[(seg + 0) * 36 + kl] = (u16)(vr[i].x & 0xffff); Vt[(seg + 1) * 36 + kl] = (u16)(vr[i].x >> 16);
      Vt[(seg + 2) * 36 + kl] = (u16)(vr[i].y & 0xffff); Vt[(seg + 3) * 36 + kl] = (u16)(vr[i].y >> 16);
      Vt[(seg + 4) * 36 + kl] = (u16)(vr[i].z & 0xffff); Vt[(seg + 5) * 36 + kl] = (u16)(vr[i].z >> 16);
      Vt[(seg + 6) * 36 + kl] = (u16)(vr[i].w & 0xffff); Vt[(seg + 7) * 36 + kl] = (u16)(vr[i].w >> 16);
    }
    __syncthreads();
#pragma unroll
    for (int dt = 0; dt < 4; ++dt) {
      const uint2 v0 = *(const uint2*)(Vt + (dt * 16 + fr) * 36 + fq * 4);
      const uint2 v1 = *(const uint2*)(Vt + (dt * 16 + fr) * 36 + 16 + fq * 4);
      uint4 t4 = make_uint4(v0.x, v0.y, v1.x, v1.y);
      const bf16x8 vf = __builtin_bit_cast(bf16x8, t4);
      st.o[dt] = mfma16(vf, pf, st.o[dt]);
    }
  }
}
DI void attn_task(const Params& p, int layer, int mode, int task, char* smem) {
  const int lane = my_tid() & 63, wave = my_tid() >> 6;
  const int fr = lane & 15, fq = lane >> 4;
  u16* proj = (u16*)(p.ws + OFF_PROJ);
  u16* Vt = (u16*)smem + wave * 64 * 36;
  int tq0, qstride, qcol, kcol, vcol; float slope;
  int hq;
  if (mode == 0) {
    const int blk = task >> 4, h = (task >> 2) & 3, rq = task & 3;
    hq = h; tq0 = blk * 256 + rq * 4 + wave; qstride = 16;
    qcol = C_BQ + h * 64; kcol = C_BK + h * 64; vcol = C_BV + h * 64;
    slope = exp2f(-(float)(5 + h));
  } else {
    const int blk = task >> 2, qh = task & 3;
    hq = qh; tq0 = blk * 64 + wave * 16; qstride = 1;
    qcol = C_DQ + qh * 64; kcol = C_DK + (qh >> 1) * 64; vcol = C_DV + (qh >> 1) * 64;
    slope = exp2f(-(float)(1 + qh));
  }
  const int lo = seq_lo(tq0), hi = seq_hi(tq0);
  const int tq = tq0 + fr * qstride;
  bf16x8 qf[2];
  {
    const u16* qp = proj + (size_t)tq * INW + qcol + fq * 8;
    qf[0] = *(const bf16x8*)(qp); qf[1] = *(const bf16x8*)(qp + 32);
  }
  AttnState st; st.m = -1e30f; st.l = 0.f;
#pragma unroll
  for (int dt = 0; dt < 4; ++dt) st.o[dt] = (f32x4){0.f, 0.f, 0.f, 0.f};
  __syncthreads();
  float scale;
  if (mode == 0) {
    attn_segment(proj, kcol, vcol, tq0 - 64, 1, 12, 64, slope, tq, lo, hi, qf, st, Vt, lane);
    attn_segment(proj, kcol, vcol, tq0 - 256, 4, 6, 256, slope, tq, lo, hi, qf, st, Vt, lane);
    attn_segment(proj, kcol, vcol, tq0 - 1024, 16, 5, 1024, slope, tq, lo, hi, qf, st, Vt, lane);
    float l = st.l; l += __shfl_xor(l, 16, 64); l += __shfl_xor(l, 32, 64);
    scale = 1.f / l;
  } else {
    attn_segment(proj, kcol, vcol, tq0 - 128, 1, 9, 128, slope, tq, lo, hi, qf, st, Vt, lane);
    float l = st.l; l += __shfl_xor(l, 16, 64); l += __shfl_xor(l, 32, 64);
    const float sink = p.attn_sink[layer * 4 + hq];
    const float mf = fmaxf(st.m, sink);
    const float sc = __expf(st.m - mf);
    scale = sc / (l * sc + __expf(sink - mf));
  }
#pragma unroll
  for (int dt = 0; dt < 4; ++dt) {
    uint2 o; o.x = pack2(st.o[dt][0] * scale, st.o[dt][1] * scale); o.y = pack2(st.o[dt][2] * scale, st.o[dt][3] * scale);
    *(uint2*)(proj + (size_t)tq * INW + qcol + dt * 16 + fq * 4) = o;
  }
}

DI void final_row(const Params& p, int t) {
  const int lane = my_tid() & 63;
  float* row = p.xout + (size_t)t * DM;
  float4 v[4]; float ss = 0.f;
#pragma unroll
  for (int i = 0; i < 4; ++i) {
    v[i] = *(const float4*)(row + i * 256 + lane * 4);
    ss += v[i].x * v[i].x + v[i].y * v[i].y + v[i].z * v[i].z + v[i].w * v[i].w;
  }
  ss = wave_sum(ss);
  const float rs = rstd_of(ss);
#pragma unroll
  for (int i = 0; i < 4; ++i) {
    const float4 g = *(const float4*)(p.final_norm + i * 256 + lane * 4);
    *(float4*)(row + i * 256 + lane * 4) = make_float4(v[i].x * rs * g.x, v[i].y * rs * g.y, v[i].z * rs * g.z, v[i].w * rs * g.w);
  }
}

#define XB_TMO      128
#define XB_XCNT(j)  (256  + 64 * (j))
#define XB_XSUB(j)  (1280 + 64 * (j))
#define XB_XGEN(j)  (2304 + 64 * (j))
#define XB_TOP      3328
#define XB_TOPGEN   3392
#define XB_SPIN_CAP (1u << 22)
#define LAS __attribute__((address_space(3)))
DI unsigned xb_ld(unsigned* p) { return __hip_atomic_load(p, __ATOMIC_RELAXED, __HIP_MEMORY_SCOPE_AGENT); }
DI unsigned xb_add(unsigned* p, unsigned v) { return __hip_atomic_fetch_add(p, v, __ATOMIC_RELAXED, __HIP_MEMORY_SCOPE_AGENT); }
DI unsigned xb_xcc_id() { return (unsigned)__builtin_amdgcn_s_getreg((3 << 11) | 20) & 0xFu; }
#define XB_SPIN(cond, bar) do { unsigned _sp = 0; while (cond) { __builtin_amdgcn_s_sleep(1); \
    if ((++_sp & 255u) == 0u) { if (xb_ld(&(bar)[XB_TMO])) break; if (_sp > XB_SPIN_CAP) { atomicAdd(&(bar)[XB_TMO], 1u); break; } } } } while (0)
struct XcdBarrier { unsigned* bar; unsigned x; volatile LAS unsigned* st; };
DI XcdBarrier xcd_barrier_post(unsigned* bar, volatile LAS unsigned* st) {
  XcdBarrier b; b.bar = bar; b.x = xb_xcc_id(); b.st = st;
  if (threadIdx.x == 0) (void)xb_add(&bar[XB_XCNT(b.x)], 1u);
  return b;
}
DI void xcd_barrier_complete(unsigned* bar, unsigned x, unsigned& nloc, unsigned& nx) {
  const unsigned G = gridDim.x * gridDim.y * gridDim.z;
  unsigned sum, cnt, mine, sp = 0u;
  for (;;) {
    sum = 0u; cnt = 0u; mine = 0u;
#pragma unroll
    for (unsigned j = 0; j < 16; ++j) { const unsigned c = xb_ld(&bar[XB_XCNT(j)]); sum += c; cnt += (c > 0u) ? 1u : 0u; mine = (j == x) ? c : mine; }
    if (sum == G) break;
    __builtin_amdgcn_s_sleep(1);
    if ((++sp & 255u) == 0u) { if (xb_ld(&bar[XB_TMO])) break; if (sp > XB_SPIN_CAP) { atomicAdd(&bar[XB_TMO], 1u); break; } }
  }
  nloc = mine > 0u ? mine : 1u; nx = cnt > 0u ? cnt : 1u;
}
DI void xcd_barrier(const XcdBarrier& b) {
  asm volatile("s_waitcnt vmcnt(0)" ::: "memory");
  __syncthreads();
  if (threadIdx.x == 0) {
    unsigned* bar = b.bar;
    __builtin_amdgcn_s_waitcnt(0);
    unsigned nloc = b.st[0], nx = b.st[1];
    if (nloc == 0u) { xcd_barrier_complete(bar, b.x, nloc, nx); b.st[0] = nloc; b.st[1] = nx; }
    const unsigned old = xb_add(&bar[XB_XSUB(b.x)], 1u);
    const unsigned gen = old / nloc;
    if (old + 1u == (gen + 1u) * nloc) {
      __builtin_amdgcn_fence(__ATOMIC_RELEASE, "agent");
      asm volatile("s_waitcnt vmcnt(0)" ::: "memory");
      const unsigned og = xb_add(&bar[XB_TOP], 1u);
      const unsigned tg = og / nx;
      if (og + 1u == (tg + 1u) * nx) xb_add(&bar[XB_TOPGEN], 1u);
      else XB_SPIN(xb_ld(&bar[XB_TOPGEN]) == tg, bar);
      __builtin_amdgcn_fence(__ATOMIC_ACQUIRE, "agent");
      xb_add(&bar[XB_XGEN(b.x)], 1u);
      asm volatile("s_waitcnt vmcnt(0)" ::: "memory");
    } else {
      XB_SPIN(xb_ld(&bar[XB_XGEN(b.x)]) == gen, bar);
      __builtin_amdgcn_fence(__ATOMIC_ACQUIRE, "agent");
      asm volatile("s_waitcnt vmcnt(0)" ::: "memory");
    }
  }
  __syncthreads();
}

enum { PH_NORM1 = 0, PH_INPROJ, PH_MIX1, PH_MIX2, PH_MIX3, PH_MERGE, PH_OUT, PH_FFN1, PH_FFN2, PH_PER_LAYER, PH_FINAL = 100 };

DI void run_phase(const Params& p, int ph, int layer, char* smem) {
  const int b = blockIdx.x, G = gridDim.x;
  const int wave = my_tid() >> 6;
  switch (ph) {
    case PH_NORM1: {
      if (layer == 0) {
        for (int t = b; t < 2 * CONV_TILES_LAYER; t += G) {
          ConvJob j;
          const int lt = conv_lookup(p, t, j);
          conv_tile(j, lt, (float*)smem);
        }
      }
      if (b == 0 && my_tid() == 0) *(unsigned*)(p.ws + OFF_CNT) = 0u;
      if (layer == 0) {
        float* z = ssq_buf(p, 2);
        for (int i = b * 256 + my_tid(); i < 2 * T; i += G * 256) z[i] = 0.f;
      }
      cvt_phase(p, layer, (u16*)(p.ws + OFF_H), true, b, G);
    } break;
    case PH_INPROJ: gemm_inproj(p, layer, b, G, (u16*)smem); break;
    case PH_MIX1: {
      for (int t = b; t < 2 * 3072; t += G) {
        const int kind = t / 3072, idx = t % 3072;
        if (kind == 0) gdn_pre(p, layer, idx, smem);
        else s5_pass1(p, layer, idx, smem);
      }
    } break;
    case PH_MIX2: {
      for (int c = b; c < 288; c += G) gdn_scan(p, c, smem);
      {
        unsigned* cnt = (unsigned*)(p.ws + OFF_CNT);
        int* slot = (int*)(smem + SMEM_BYTES - 16);
        for (;;) {
          __syncthreads();
          if (my_tid() == 0) *slot = (int)atomicAdd(cnt, 1u);
          __syncthreads();
          const int t = *slot;
          if (t >= 3 * 3072) break;
          if (t < 3072) s5_pass3(p, layer, t, smem);
          else if (t < 2 * 3072) attn_task(p, layer, 0, t - 3072, smem);
          else attn_task(p, layer, 1, t - 2 * 3072, smem);
        }
      }
    } break;
    case PH_MIX3: {
      gemm_glu(p, layer, b, G, (u16*)smem);
      for (int t = b * 4 + wave; t < T; t += G * 4) gdn_post_row(p, layer, t);
      cvt_phase(p, layer, (u16*)(p.ws + OFF_H), false, b, G);
    } break;
    case PH_MERGE: gemm_merge(p, layer, b, G, (u16*)smem); break;
    case PH_OUT:
      gemm_resid(p, layer, (const u16*)(p.ws + OFF_MERGED), DM, (const u16*)(p.ws + OFF_W) + layer * W_LAYER + WO_OUT, b, G, (u16*)smem,
                 (u16*)(p.ws + OFF_H2), ssq_buf(p, 2 + layer));
      break;
    case PH_FFN1: gemm_ffn1(p, layer, b, G, (u16*)smem); break;
    case PH_FFN2:
      gemm_resid(p, 1, (const u16*)(p.ws + OFF_ACT), FH, (const u16*)(p.ws + OFF_W) + layer * W_LAYER + WO_DN, b, G, (u16*)smem,
                 nullptr, nullptr);
      break;
    case PH_FINAL:
      for (int t = b * 4 + wave; t < T; t += G * 4) final_row(p, t);
      break;
    default: break;
  }
}

#if !MEGA
__global__ void __launch_bounds__(256, 2) k_phase(Params p, int ph, int layer) {
  __shared__ __attribute__((aligned(16))) char smem[SMEM_BYTES];
  run_phase(p, ph, layer, smem);
}

#else
__global__ void __launch_bounds__(256, 2) k_mega(Params p) {
  __shared__ __attribute__((aligned(16))) char smem[SMEM_BYTES];
  __shared__ uint4 xb_words;
  cg::grid_group grid = cg::this_grid();
  if (threadIdx.x == 0) xb_words = make_uint4(0u, 0u, 0u, 0u);
  __syncthreads();
  const XcdBarrier xb = xcd_barrier_post((unsigned*)(p.ws + OFF_BAR), (volatile LAS unsigned*)&xb_words);
  for (int layer = 0; layer < 2; ++layer)
    for (int ph = 0; ph < PH_PER_LAYER; ++ph) {
      run_phase(p, ph, layer, smem);
      if (layer == 1 && ph == PH_PER_LAYER - 1) grid.sync(); else xcd_barrier(xb);
#ifdef PROBE_DUP
      if (ph == PROBE_DUP) { run_phase(p, ph, layer, smem); grid.sync(); }
#endif
    }
  run_phase(p, PH_FINAL, 0, smem);
}
#endif

extern "C" void kernel_launch(void* const* d_in, const int* in_sizes, int n_in, void* d_out, int out_size, void* d_ws,
                              size_t ws_size, hipStream_t stream) {
  (void)in_sizes; (void)n_in; (void)out_size;
  if (ws_size < WS_NEED) { fprintf(stderr, "workspace too small: %zu < %zu\n", ws_size, (size_t)WS_NEED); return; }
  Params p;
  memset(&p, 0, sizeof(p));
  const float* const* in = (const float* const*)d_in;
  p.x_prompt = in[0]; p.x_sample = in[1]; p.norm1 = in[2]; p.conv_a = in[4]; p.a_log = in[5]; p.dt_bias = in[6];
  p.a_norm = in[7]; p.lam_re = in[8]; p.lam_im = in[9]; p.log_step = in[10]; p.b_re = in[11]; p.b_im = in[12];
  p.c_re = in[13]; p.c_im = in[14]; p.s5_d = in[15]; p.attn_sink = in[17]; p.norm2 = in[21]; p.final_norm = in[25];
  p.xout = (float*)d_out;
  p.ws = (char*)d_ws;
  p.w_in = in[3]; p.w_glu = in[16]; p.w_gate = in[18]; p.w_branch = in[19]; p.w_out = in[20];
  p.w_ffn_gate = in[22]; p.w_ffn_up = in[23]; p.w_ffn_down = in[24];
  static int grid_blocks = 0;
  if (!grid_blocks) {
    int dev = 0, cus = 0, per_cu = 0;
    hipGetDevice(&dev);
    hipDeviceGetAttribute(&cus, hipDeviceAttributeMultiprocessorCount, dev);
#if MEGA
    hipOccupancyMaxActiveBlocksPerMultiprocessor(&per_cu, k_mega, 256, 0);
#else
    hipOccupancyMaxActiveBlocksPerMultiprocessor(&per_cu, k_phase, 256, 0);
#endif
    per_cu = 2;
    grid_blocks = cus * per_cu;
  }
#if MEGA
  hipMemsetAsync((char*)d_ws + OFF_BAR, 0, BAR_BYTES, stream);
  void* args[] = {&p};
  hipError_t e = hipLaunchCooperativeKernel((void*)k_mega, dim3(grid_blocks), dim3(256), args, 0, stream);
  if (e != hipSuccess) fprintf(stderr, "cooperative launch failed: %s (grid %d)\n", hipGetErrorString(e), grid_blocks);
#else
  for (int layer = 0; layer < 2; ++layer)
    for (int ph = 0; ph < PH_PER_LAYER; ++ph) hipLaunchKernelGGL(k_phase, dim3(grid_blocks), dim3(256), 0, stream, p, ph, layer);
  hipLaunchKernelGGL(k_phase, dim3(grid_blocks), dim3(256), 0, stream, p, (int)PH_FINAL, 0);
#endif
}
```

```cpp
#include <hip/hip_runtime.h>
#include <hip/hip_cooperative_groups.h>
#include <cstdio>
#include <cstring>
namespace cg = cooperative_groups;

#ifndef MEGA
#define MEGA 1
#endif

#define DI __device__ __forceinline__
typedef unsigned short u16;
typedef __attribute__((ext_vector_type(8))) short bf16x8;
typedef __attribute__((ext_vector_type(4))) float f32x4;

constexpr int T = 49152;
constexpr int TP = 16384;
constexpr int DM = 1024;
constexpr int INW = 2576;
constexpr int FH = 2816;
constexpr int NCH64 = T / 64;
constexpr float EPS = 1e-6f;

constexpr int C_AQ = 0, C_AK = 256, C_AV = 512, C_AZ = 768, C_BQ = 1040, C_BK = 1296, C_BV = 1552, C_CU = 1808,
              C_DQ = 2064, C_DK = 2320, C_DV = 2448;

constexpr size_t WO_IN = 0, WO_GATE = 2752512, WO_BR = 6946816, WO_OUT = 7995392, WO_GU = 9043968, WO_DN = 14811136,
                 WO_GLU = 17694720, W_LAYER = 17825792;
constexpr size_t OFF_W = 0;
constexpr size_t OFF_PROJ = 2 * W_LAYER * 2;
constexpr size_t SZ_PROJ = (size_t)T * INW * 2;
constexpr size_t OFF_R1 = OFF_PROJ + SZ_PROJ;
constexpr size_t SZ_H = (size_t)T * DM * 2;
constexpr size_t OFF_H = OFF_R1;
constexpr size_t OFF_UW = OFF_R1;
constexpr size_t OFF_QN = OFF_R1 + SZ_H;
constexpr size_t OFF_KN = OFF_QN + (size_t)T * 256 * 2;
constexpr size_t OFF_GC = OFF_KN + (size_t)T * 256 * 2;
constexpr size_t OFF_SEND = OFF_GC + (size_t)NCH64 * 8 * 64 * 4;
constexpr size_t OFF_G = OFF_SEND + (size_t)NCH64 * 2 * 1024 * 8;
constexpr size_t OFF_AB = OFF_G + (size_t)T * 256 * 2;
constexpr size_t OFF_CNT = OFF_AB + (size_t)T * 16 * 4;
constexpr size_t OFF_MERGED = OFF_R1 + SZ_H;
constexpr size_t OFF_H2 = OFF_PROJ;
constexpr size_t OFF_ACT = OFF_PROJ + SZ_H;
constexpr size_t OFF_BAR = OFF_MERGED + SZ_H;
constexpr size_t BAR_BYTES = 3456 * 4;
constexpr size_t OFF_SSQ = OFF_BAR + 16384;
constexpr size_t WS_NEED = OFF_SSQ + 5 * (size_t)T * 4;

constexpr int SMEM_BYTES = 75776;

struct ConvJob { const float* src; u16* dst; const float* kscale; int K, ncols, nrows_dst, src_ld, rs, off, ntn; };
struct Params;
DI float* ssq_buf(const Params& p, int i);
struct Params {
  const float *x_prompt, *x_sample, *norm1, *conv_a, *a_log, *dt_bias, *a_norm, *lam_re, *lam_im, *log_step, *b_re,
      *b_im, *c_re, *c_im, *s5_d, *attn_sink, *norm2, *final_norm;
  const float *w_in, *w_gate, *w_branch, *w_out, *w_ffn_gate, *w_ffn_up, *w_ffn_down, *w_glu;
  float* xout;
  char* ws;
};
constexpr int CONV_TILES_LAYER = 4352;

DI int my_tid() { int t = threadIdx.x; asm volatile("" : "+v"(t)); return t; }
DI u16 f2bf(float x) { unsigned u = __float_as_uint(x); u += 0x7fffu + ((u >> 16) & 1u); return (u16)(u >> 16); }
DI float bf2f(u16 v) { return __uint_as_float(((unsigned)v) << 16); }
DI unsigned pack2(float a, float b) { return (unsigned)f2bf(a) | ((unsigned)f2bf(b) << 16); }
DI float sigmoidf_(float x) { return 1.f / (1.f + __expf(-x)); }
DI float siluf_(float x) { return x / (1.f + __expf(-x)); }
DI float wave_sum(float v) {
#pragma unroll
  for (int o = 32; o > 0; o >>= 1) v += __shfl_xor(v, o, 64);
  return v;
}
DI int seq_lo(int t) { return t < TP ? 0 : (t & ~4095); }
DI int seq_hi(int t) { return t < TP ? TP : (t & ~4095) + 4096; }
DI const float* xrow(const Params& p, int layer, int t) {
  if (layer == 0) return t < TP ? p.x_prompt + (size_t)t * DM : p.x_sample + (size_t)(t - TP) * DM;
  return p.xout + (size_t)t * DM;
}
DI f32x4 mfma16(bf16x8 a, bf16x8 b, f32x4 c) { return __builtin_amdgcn_mfma_f32_16x16x32_bf16(a, b, c, 0, 0, 0); }

DI void mk_job(ConvJob& j, const float* src, u16* dst, int K, int ncols, int nrows_dst, int src_ld, int rs, int off,
                const float* kscale = nullptr) {
  j.kscale = kscale;
  j.src = src; j.dst = dst; j.K = K; j.ncols = ncols; j.nrows_dst = nrows_dst; j.src_ld = src_ld; j.rs = rs; j.off = off;
  j.ntn = (nrows_dst + 63) >> 6;
}
DI int conv_lookup(const Params& p, int t, ConvJob& j) {
  const int l = t / CONV_TILES_LAYER;
  int r = t % CONV_TILES_LAYER;
  u16* wl = (u16*)(p.ws + OFF_W) + (size_t)l * W_LAYER;
  if (r < 672) { mk_job(j, p.w_in + (size_t)l * DM * INW, wl + WO_IN, DM, INW, 2688, INW, 32, 0, p.norm1 + l * DM); return r; }
  r -= 672;
  if (r < 1024) { const int i = r >> 8; mk_job(j, p.w_gate + (size_t)(l * 4 + i) * DM * DM, wl + WO_GATE + (size_t)i * DM * DM, DM, DM, DM, DM, 32, 0, p.norm1 + l * DM); return r & 255; }
  r -= 1024;
  if (r < 256) { const int i = r >> 6; mk_job(j, p.w_branch + (size_t)(l * 4 + i) * 256 * DM, wl + WO_BR + (size_t)i * DM * 256, 256, DM, DM, DM, 32, 0); return r & 63; }
  r -= 256;
  if (r < 256) { mk_job(j, p.w_out + (size_t)l * DM * DM, wl + WO_OUT, DM, DM, DM, DM, 32, 0); return r; }
  r -= 256;
  if (r < 704) { mk_job(j, p.w_ffn_gate + (size_t)l * DM * FH, wl + WO_GU, DM, FH, FH, FH, 64, 0, p.norm2 + l * DM); return r; }
  r -= 704;
  if (r < 704) { mk_job(j, p.w_ffn_up + (size_t)l * DM * FH, wl + WO_GU, DM, FH, FH, FH, 64, 32, p.norm2 + l * DM); return r; }
  r -= 704;
  if (r < 704) { mk_job(j, p.w_ffn_down + (size_t)l * FH * DM, wl + WO_DN, FH, DM, DM, DM, 32, 0); return r; }
  r -= 704;
  if (r < 16) { mk_job(j, p.w_glu + (size_t)l * 256 * 512, wl + WO_GLU, 256, 256, 256, 512, 64, 0); return r; }
  r -= 16;
  mk_job(j, p.w_glu + (size_t)l * 256 * 512 + 256, wl + WO_GLU, 256, 256, 256, 512, 64, 32);
  return r;
}
DI void conv_tile(const ConvJob& j, int lt, float* tile) {
  const int tid = my_tid();
  const int tk = lt / j.ntn, tn = lt % j.ntn;
  __syncthreads();
#pragma unroll
  for (int i = 0; i < 4; ++i) {
    int r = (tid >> 4) + 16 * i, c4 = (tid & 15) * 4, n = tn * 64 + c4;
    float4 v = make_float4(0.f, 0.f, 0.f, 0.f);
    if (n < j.ncols) v = *(const float4*)(j.src + (size_t)(tk * 64 + r) * j.src_ld + n);
    if (j.kscale) { const float s = j.kscale[tk * 64 + r]; v.x *= s; v.y *= s; v.z *= s; v.w *= s; }
    tile[r * 65 + c4 + 0] = v.x; tile[r * 65 + c4 + 1] = v.y; tile[r * 65 + c4 + 2] = v.z; tile[r * 65 + c4 + 3] = v.w;
  }
  __syncthreads();
  const int cl = tid >> 2, ks = (tid & 3) * 16, n = tn * 64 + cl;
  if (n < j.nrows_dst) {
    unsigned w[8];
#pragma unroll
    for (int e = 0; e < 8; ++e) w[e] = pack2(tile[(ks + 2 * e) * 65 + cl], tile[(ks + 2 * e + 1) * 65 + cl]);
    const int nm = (n >> 5) * j.rs + (n & 31) + j.off;
    uint4* d = (uint4*)(j.dst + (size_t)nm * j.K + tk * 64 + ks);
    d[0] = make_uint4(w[0], w[1], w[2], w[3]);
    d[1] = make_uint4(w[4], w[5], w[6], w[7]);
  }
}

DI float* ssq_buf(const Params& p, int i) { return (float*)(p.ws + OFF_SSQ) + (size_t)i * T; }
DI float rstd_of(float ssq) { return rsqrtf(ssq * (1.f / DM) + EPS); }
DI void cvt_row_bf16(const float* src, u16* dst, float* ssq_out) {
  const int lane = my_tid() & 63;
  float ss = 0.f;
#pragma unroll
  for (int i = 0; i < 4; ++i) {
    const float4 v = *(const float4*)(src + i * 256 + lane * 4);
    ss += v.x * v.x + v.y * v.y + v.z * v.z + v.w * v.w;
    uint2 o; o.x = pack2(v.x, v.y); o.y = pack2(v.z, v.w);
    *(uint2*)(dst + i * 256 + lane * 4) = o;
  }
  if (ssq_out) { ss = wave_sum(ss); if (lane == 0) *ssq_out = ss; }
}
DI void cvt_phase(const Params& p, int layer, u16* dst, bool write_ssq, int b0, int nb) {
  const int wave = my_tid() >> 6;
  for (int r = b0 * 4 + wave; r < T; r += nb * 4)
    cvt_row_bf16(xrow(p, layer, r), dst + (size_t)r * DM, write_ssq ? ssq_buf(p, layer) + r : nullptr);
}

constexpr int GP = 64;
#ifndef GEMM_DMA
#define GEMM_DMA 1
#endif
#if GEMM_DMA
template <int NT, bool SPLIT = false>
DI void gemm_kloop(const u16* __restrict__ A, size_t lda, const u16* __restrict__ B, size_t ldb, int nk,
                   f32x4 (&acc)[4][NT], u16* sm) {
  const int tid = my_tid(), lane = tid & 63;
  const int wave = __builtin_amdgcn_readfirstlane(tid >> 6);
  const int fr = lane & 15, fq = lane >> 4, wr = wave >> 1, wc = wave & 1;
  u16* sa = sm;
  u16* sb = sm + 2 * 128 * 64;
  const int swz = (fr >> 1) & 7;
  const int lr = lane >> 3;
  const int lc = ((lane & 7) ^ ((lr >> 1) & 3)) * 8;
#define DMA_PIECE(BASE, LD, G, KOFF, DST)                                                              \
  {                                                                                                    \
    int lrl_ = lr;                                                                                     \
    asm volatile("" : "+v"(lrl_));   \
    const int row_ = (G) * 8 + lrl_;                                                                   \
    const int col_ = lc ^ ((((G) & 1) * 4) * 8);                                                       \
    __builtin_amdgcn_global_load_lds((const unsigned*)((BASE) + (size_t)row_ * (LD) + (KOFF) + col_),  \
                                     (unsigned*)((DST) + (G) * 512), 16, 0, 0);                        \
  }
#define DMA_TILE(KOFF, STAGE)                                                                          \
  {                                                                                                    \
    u16* da_ = sa + (STAGE) * 8192;                                                                    \
    u16* db_ = sb + (STAGE) * 8192;                                                                    \
    DMA_PIECE(A, lda, wave * 4 + 0, KOFF, da_) DMA_PIECE(A, lda, wave * 4 + 1, KOFF, da_)              \
    DMA_PIECE(A, lda, wave * 4 + 2, KOFF, da_) DMA_PIECE(A, lda, wave * 4 + 3, KOFF, da_)              \
    if (NT == 4) {                                                                                     \
      DMA_PIECE(B, ldb, wave * 4 + 0, KOFF, db_) DMA_PIECE(B, ldb, wave * 4 + 1, KOFF, db_)            \
      DMA_PIECE(B, ldb, wave * 4 + 2, KOFF, db_) DMA_PIECE(B, ldb, wave * 4 + 3, KOFF, db_)            \
    } else {                                                                                           \
      DMA_PIECE(B, ldb, wave * 2 + 0, KOFF, db_) DMA_PIECE(B, ldb, wave * 2 + 1, KOFF, db_)            \
    }                                                                                                  \
  }
  __builtin_amdgcn_s_barrier();
  DMA_TILE(0, 0)
#pragma unroll 1
  for (int kt = 0; kt < nk; ++kt) {
    const int cur = kt & 1;
    asm volatile("s_waitcnt vmcnt(0)" ::: "memory");
    __builtin_amdgcn_s_barrier();
    asm volatile("" ::: "memory");
    const u16* ca = sa + cur * 8192;
    const u16* cb = sb + cur * 8192;
    if (SPLIT) {
      bf16x8 wf[NT], xf[4];
#pragma unroll
      for (int nt = 0; nt < NT; ++nt) wf[nt] = *(const bf16x8*)(cb + (wc * NT * 16 + nt * 16 + fr) * 64 + (((0 * 4 + fq) ^ swz) * 8));
#pragma unroll
      for (int mt = 0; mt < 4; ++mt) xf[mt] = *(const bf16x8*)(ca + (wr * 64 + mt * 16 + fr) * 64 + (((0 * 4 + fq) ^ swz) * 8));
#pragma unroll
      for (int mt = 0; mt < 4; ++mt)
#pragma unroll
        for (int nt = 0; nt < NT; ++nt) acc[mt][nt] = mfma16(wf[nt], xf[mt], acc[mt][nt]);
#pragma unroll
      for (int nt = 0; nt < NT; ++nt) wf[nt] = *(const bf16x8*)(cb + (wc * NT * 16 + nt * 16 + fr) * 64 + (((1 * 4 + fq) ^ swz) * 8));
#pragma unroll
      for (int mt = 0; mt < 4; ++mt) xf[mt] = *(const bf16x8*)(ca + (wr * 64 + mt * 16 + fr) * 64 + (((1 * 4 + fq) ^ swz) * 8));
      __builtin_amdgcn_sched_barrier(0);
      if (kt + 1 < nk) DMA_TILE((kt + 1) * 64, cur ^ 1)
      __builtin_amdgcn_sched_barrier(0);
#pragma unroll
      for (int mt = 0; mt < 4; ++mt)
#pragma unroll
        for (int nt = 0; nt < NT; ++nt) acc[mt][nt] = mfma16(wf[nt], xf[mt], acc[mt][nt]);
      continue;
    }
    bf16x8 wf[2][NT], xf[2][4];
#pragma unroll
    for (int kk = 0; kk < 2; ++kk) {
#pragma unroll
      for (int nt = 0; nt < NT; ++nt) wf[kk][nt] = *(const bf16x8*)(cb + (wc * NT * 16 + nt * 16 + fr) * 64 + (((kk * 4 + fq) ^ swz) * 8));
#pragma unroll
      for (int mt = 0; mt < 4; ++mt) xf[kk][mt] = *(const bf16x8*)(ca + (wr * 64 + mt * 16 + fr) * 64 + (((kk * 4 + fq) ^ swz) * 8));
    }
    __builtin_amdgcn_sched_barrier(0);
    if (kt + 1 < nk) DMA_TILE((kt + 1) * 64, cur ^ 1)
    __builtin_amdgcn_sched_barrier(0);
#pragma unroll
    for (int kk = 0; kk < 2; ++kk)
#pragma unroll
      for (int mt = 0; mt < 4; ++mt)
#pragma unroll
        for (int nt = 0; nt < NT; ++nt) acc[mt][nt] = mfma16(wf[kk][nt], xf[kk][mt], acc[mt][nt]);
  }
}
#else
template <int NT>
DI void gemm_kloop(const u16* __restrict__ A, size_t lda, const u16* __restrict__ B, size_t ldb, int nk,
                   f32x4 (&acc)[4][NT], u16* sm) {
  const int tid = my_tid(), lane = tid & 63, wave = tid >> 6;
  const int fr = lane & 15, fq = lane >> 4, wr = wave >> 1, wc = wave & 1;
  u16* sa = sm;
  u16* sb = sm + 2 * 128 * GP;
  uint4 ra0, ra1, ra2, ra3, rb0, rb1, rb2 = make_uint4(0, 0, 0, 0), rb3 = make_uint4(0, 0, 0, 0);
  uint4 rc0, rc1, rc2, rc3, rd0, rd1, rd2 = make_uint4(0, 0, 0, 0), rd3 = make_uint4(0, 0, 0, 0);
  const int lrow = tid >> 3, lseg = (tid & 7) * 8;
  const int sseg = ((tid & 7) ^ ((lrow >> 1) & 7)) * 8;
  const u16* Ap = A + (size_t)lrow * lda + lseg;
  const u16* Bp = B + (size_t)lrow * ldb + lseg;
#define KL_LOAD(KOFF, A0, A1, A2, A3, B0, B1, B2, B3)                    \
  A0 = *(const uint4*)(Ap + (KOFF));                                     \
  A1 = *(const uint4*)(Ap + 32 * lda + (KOFF));                          \
  A2 = *(const uint4*)(Ap + 64 * lda + (KOFF));                          \
  A3 = *(const uint4*)(Ap + 96 * lda + (KOFF));                          \
  B0 = *(const uint4*)(Bp + (KOFF));                                     \
  B1 = *(const uint4*)(Bp + 32 * ldb + (KOFF));                          \
  if (NT > 2) { B2 = *(const uint4*)(Bp + 64 * ldb + (KOFF)); B3 = *(const uint4*)(Bp + 96 * ldb + (KOFF)); }
#define KL_STORE(SA, SB, A0, A1, A2, A3, B0, B1, B2, B3)                 \
  *(uint4*)((SA) + (lrow + 0) * GP + sseg) = A0;                         \
  *(uint4*)((SA) + (lrow + 32) * GP + sseg) = A1;                        \
  *(uint4*)((SA) + (lrow + 64) * GP + sseg) = A2;                        \
  *(uint4*)((SA) + (lrow + 96) * GP + sseg) = A3;                        \
  *(uint4*)((SB) + (lrow + 0) * GP + sseg) = B0;                         \
  *(uint4*)((SB) + (lrow + 32) * GP + sseg) = B1;                        \
  if (NT > 2) { *(uint4*)((SB) + (lrow + 64) * GP + sseg) = B2; *(uint4*)((SB) + (lrow + 96) * GP + sseg) = B3; }
#define KL_COMPUTE(CA, CB)                                                                                     \
  _Pragma("unroll") for (int kk = 0; kk < 2; ++kk) {                                                           \
    bf16x8 wf[NT], xf[4];                                                                                      \
    _Pragma("unroll") for (int nt = 0; nt < NT; ++nt)                                                          \
      wf[nt] = *(const bf16x8*)((CB) + (wc * NT * 16 + nt * 16 + fr) * GP + (((kk * 4 + fq) ^ swz) * 8));       \
    _Pragma("unroll") for (int mt = 0; mt < 4; ++mt)                                                           \
      xf[mt] = *(const bf16x8*)((CA) + (wr * 64 + mt * 16 + fr) * GP + (((kk * 4 + fq) ^ swz) * 8));            \
    _Pragma("unroll") for (int mt = 0; mt < 4; ++mt)                                                           \
    _Pragma("unroll") for (int nt = 0; nt < NT; ++nt) acc[mt][nt] = mfma16(wf[nt], xf[mt], acc[mt][nt]);      \
  }
  const int swz = (fr >> 1) & 7;
  KL_LOAD(0, ra0, ra1, ra2, ra3, rb0, rb1, rb2, rb3)
  KL_LOAD(64, rc0, rc1, rc2, rc3, rd0, rd1, rd2, rd3)
  KL_STORE(sa, sb, ra0, ra1, ra2, ra3, rb0, rb1, rb2, rb3)
  __syncthreads();
  u16* sa1 = sa + 128 * GP;
  u16* sb1 = sb + 128 * GP;
#pragma unroll 1
  for (int kt = 0; kt < nk; kt += 2) {
    const int k2 = (kt + 2 < nk ? kt + 2 : kt) * 64, k3 = (kt + 3 < nk ? kt + 3 : kt + 1) * 64;
    KL_LOAD(k2, ra0, ra1, ra2, ra3, rb0, rb1, rb2, rb3)
    __builtin_amdgcn_sched_barrier(0);
    KL_COMPUTE(sa, sb)
    KL_STORE(sa1, sb1, rc0, rc1, rc2, rc3, rd0, rd1, rd2, rd3)
    __syncthreads();
    KL_LOAD(k3, rc0, rc1, rc2, rc3, rd0, rd1, rd2, rd3)
    __builtin_amdgcn_sched_barrier(0);
    KL_COMPUTE(sa1, sb1)
    KL_STORE(sa, sb, ra0, ra1, ra2, ra3, rb0, rb1, rb2, rb3)
    __syncthreads();
  }
}
#endif
template <int NT>
DI void zero_acc(f32x4 (&acc)[4][NT]) {
#pragma unroll
  for (int a = 0; a < 4; ++a)
#pragma unroll
    for (int b = 0; b < NT; ++b) acc[a][b] = (f32x4){0.f, 0.f, 0.f, 0.f};
}

struct TileIter {
  int step, nsteps, nrb, nct, x, li, lj, mode, idx, stride, L;
  DI void init(int nrt, int nct_, int b, int G) {
    nct = nct_;
    if (G == 512 && (nrt % 64) == 0) {
      mode = 1; x = b & 7;
      const int local = b >> 3;
      li = local >> 3; lj = local & 7;
      nrb = nrt / 64;
      nsteps = nrb * ((nct + 7) >> 3);
      step = 0;
      skip();
    } else {
      mode = 0; idx = b; stride = G; L = nrt * nct;
    }
  }
  DI int ctile() const { return (step / nrb) * 8 + lj; }
  DI void skip() { while (step < nsteps && ctile() >= nct) ++step; }
  DI bool valid() const { return mode ? step < nsteps : idx < L; }
  DI int rt() const { return mode ? x + 8 * ((step % nrb) * 8 + li) : idx / nct; }
  DI int ct() const { return mode ? ctile() : idx % nct; }
  DI void next() { if (mode) { ++step; skip(); } else idx += stride; }
};

#define EPI_COORDS                                                       \
  const int lane = my_tid() & 63, wave = my_tid() >> 6;           \
  const int fr = lane & 15, fq = lane >> 4, wr = wave >> 1, wc = wave & 1; \
  (void)fr; (void)fq; (void)wr; (void)wc;

DI void gemm_inproj(const Params& p, int layer, int b, int G, u16* sm) {
  const u16* H = (const u16*)(p.ws + OFF_H);
  const u16* W = (const u16*)(p.ws + OFF_W) + layer * W_LAYER + WO_IN;
  u16* proj = (u16*)(p.ws + OFF_PROJ);
  float* AB = (float*)(p.ws + OFF_AB);
  EPI_COORDS
  TileIter it; it.init(T / 128, 21, b, G);
  for (; it.valid(); it.next()) {
    const int row0 = it.rt() * 128, col0 = it.ct() * 128;
    f32x4 acc[4][4]; zero_acc<4>(acc);
    gemm_kloop<4>(H + (size_t)row0 * DM, DM, W + (size_t)col0 * DM, DM, 16, acc, sm);
#pragma unroll
    for (int mt = 0; mt < 4; ++mt) {
      const int row = row0 + wr * 64 + mt * 16 + fr;
      const float rs = rstd_of(ssq_buf(p, layer)[row]);
#pragma unroll
      for (int nt = 0; nt < 4; ++nt) {
        const int col = col0 + wc * 64 + nt * 16 + fq * 4;
        acc[mt][nt] *= rs;
        if (col < INW) {
          uint2 o; o.x = pack2(acc[mt][nt][0], acc[mt][nt][1]); o.y = pack2(acc[mt][nt][2], acc[mt][nt][3]);
          *(uint2*)(proj + (size_t)row * INW + col) = o;
          if (col >= 1024 && col < 1040)
            *(float4*)(AB + (size_t)row * 16 + (col - 1024)) = make_float4(acc[mt][nt][0], acc[mt][nt][1], acc[mt][nt][2], acc[mt][nt][3]);
        }
      }
    }
  }
}

DI void gemm_glu(const Params& p, int layer, int b, int G, u16* sm) {
  const u16* Gb = (const u16*)(p.ws + OFF_G);
  const u16* W = (const u16*)(p.ws + OFF_W) + layer * W_LAYER + WO_GLU;
  u16* proj = (u16*)(p.ws + OFF_PROJ);
  EPI_COORDS
  TileIter it; it.init(T / 128, 4, b, G);
  for (; it.valid(); it.next()) {
    const int row0 = it.rt() * 128, ct = it.ct();
    f32x4 acc[4][4]; zero_acc<4>(acc);
    gemm_kloop<4>(Gb + (size_t)row0 * 256, 256, W + (size_t)ct * 128 * 256, 256, 4, acc, sm);
#pragma unroll
    for (int mt = 0; mt < 4; ++mt) {
      const int row = row0 + wr * 64 + mt * 16 + fr;
#pragma unroll
      for (int nt = 0; nt < 2; ++nt) {
        const int col = (ct * 2 + wc) * 32 + nt * 16 + fq * 4;
        float o[4];
#pragma unroll
        for (int j = 0; j < 4; ++j) o[j] = acc[mt][nt][j] * sigmoidf_(acc[mt][nt + 2][j]);
        uint2 ov; ov.x = pack2(o[0], o[1]); ov.y = pack2(o[2], o[3]);
        *(uint2*)(proj + (size_t)row * INW + C_CU + col) = ov;
      }
    }
  }
}

DI void gemm_merge(const Params& p, int layer, int b, int G, u16* sm) {
  const u16* H = (const u16*)(p.ws + OFF_H);
  const u16* Wg = (const u16*)(p.ws + OFF_W) + layer * W_LAYER + WO_GATE;
  const u16* Wb = (const u16*)(p.ws + OFF_W) + layer * W_LAYER + WO_BR;
  const u16* proj = (const u16*)(p.ws + OFF_PROJ);
  u16* merged = (u16*)(p.ws + OFF_MERGED);
  EPI_COORDS
  TileIter it; it.init(T / 128, 8, b, G);
  for (; it.valid(); it.next()) {
    const int row0 = it.rt() * 128, col0 = it.ct() * 128;
    uint2 mg[4][4];
#pragma unroll
    for (int a = 0; a < 4; ++a)
#pragma unroll
      for (int c = 0; c < 4; ++c) mg[a][c] = make_uint2(0u, 0u);
#pragma unroll 1
    for (int i = 0; i < 4; ++i) {
      const int ocol = (i == 0) ? C_AZ : (i == 1) ? C_BQ : (i == 2) ? C_CU : C_DQ;
      f32x4 acc[4][4]; zero_acc<4>(acc);
      gemm_kloop<4, true>(H + (size_t)row0 * DM, DM, Wg + (size_t)i * DM * DM + (size_t)col0 * DM, DM, 16, acc, sm);
      uint2 sg[4][4];
#pragma unroll
      for (int a = 0; a < 4; ++a) {
        const float rs = rstd_of(ssq_buf(p, layer)[row0 + wr * 64 + a * 16 + fr]);
#pragma unroll
        for (int c = 0; c < 4; ++c) {
          sg[a][c].x = pack2(sigmoidf_(rs * acc[a][c][0]), sigmoidf_(rs * acc[a][c][1]));
          sg[a][c].y = pack2(sigmoidf_(rs * acc[a][c][2]), sigmoidf_(rs * acc[a][c][3]));
        }
      }
      zero_acc<4>(acc);
      gemm_kloop<4, true>(proj + (size_t)row0 * INW + ocol, INW, Wb + (size_t)i * DM * 256 + (size_t)col0 * 256, 256, 4, acc, sm);
#pragma unroll
      for (int a = 0; a < 4; ++a)
#pragma unroll
        for (int c = 0; c < 4; ++c) {
          const float m0 = bf2f((u16)(mg[a][c].x & 0xffff)) + bf2f((u16)(sg[a][c].x & 0xffff)) * acc[a][c][0];
          const float m1 = bf2f((u16)(mg[a][c].x >> 16)) + bf2f((u16)(sg[a][c].x >> 16)) * acc[a][c][1];
          const float m2 = bf2f((u16)(mg[a][c].y & 0xffff)) + bf2f((u16)(sg[a][c].y & 0xffff)) * acc[a][c][2];
          const float m3 = bf2f((u16)(mg[a][c].y >> 16)) + bf2f((u16)(sg[a][c].y >> 16)) * acc[a][c][3];
          mg[a][c].x = pack2(m0, m1); mg[a][c].y = pack2(m2, m3);
        }
    }
#pragma unroll
    for (int mt = 0; mt < 4; ++mt) {
      const int row = row0 + wr * 64 + mt * 16 + fr;
#pragma unroll
      for (int nt = 0; nt < 4; ++nt) {
        const int col = col0 + wc * 64 + nt * 16 + fq * 4;
        *(uint2*)(merged + (size_t)row * DM + col) = mg[mt][nt];
      }
    }
  }
}

DI void gemm_resid(const Params& p, int layer_src, const u16* A, int K, const u16* W, int b, int G, u16* sm, u16* xb_out,
                   float* ssq_acc) {
  EPI_COORDS
  TileIter it; it.init(T / 128, 8, b, G);
  for (; it.valid(); it.next()) {
    const int row0 = it.rt() * 128, col0 = it.ct() * 128;
    f32x4 acc[4][4]; zero_acc<4>(acc);
    gemm_kloop<4>(A + (size_t)row0 * K, K, W + (size_t)col0 * K, K, K / 64, acc, sm);
#pragma unroll
    for (int mt = 0; mt < 4; ++mt) {
      const int row = row0 + wr * 64 + mt * 16 + fr;
      const float* xs = xrow(p, layer_src, row);
      float* xd = p.xout + (size_t)row * DM;
      float ss = 0.f;
#pragma unroll
      for (int nt = 0; nt < 4; ++nt) {
        const int col = col0 + wc * 64 + nt * 16 + fq * 4;
        float4 r = *(const float4*)(xs + col);
        r.x += acc[mt][nt][0]; r.y += acc[mt][nt][1]; r.z += acc[mt][nt][2]; r.w += acc[mt][nt][3];
        *(float4*)(xd + col) = r;
        ss += r.x * r.x + r.y * r.y + r.z * r.z + r.w * r.w;
        if (xb_out) { uint2 o; o.x = pack2(r.x, r.y); o.y = pack2(r.z, r.w); *(uint2*)(xb_out + (size_t)row * DM + col) = o; }
      }
      if (ssq_acc) {
        ss += __shfl_xor(ss, 16, 64);
        ss += __shfl_xor(ss, 32, 64);
        if (fq == 0) atomicAdd(ssq_acc + row, ss);
      }
    }
  }
}

DI void gemm_ffn1(const Params& p, int layer, int b, int G, u16* sm) {
  const u16* H = (const u16*)(p.ws + OFF_H2);
  const u16* W = (const u16*)(p.ws + OFF_W) + layer * W_LAYER + WO_GU;
  u16* act = (u16*)(p.ws + OFF_ACT);
  EPI_COORDS
  TileIter it; it.init(T / 128, 44, b, G);
  for (; it.valid(); it.next()) {
    const int row0 = it.rt() * 128, ct = it.ct();
    f32x4 acc[4][4]; zero_acc<4>(acc);
    gemm_kloop<4>(H + (size_t)row0 * DM, DM, W + (size_t)ct * 128 * DM, DM, 16, acc, sm);
#pragma unroll
    for (int mt = 0; mt < 4; ++mt) {
      const int row = row0 + wr * 64 + mt * 16 + fr;
      const float rs = rstd_of(ssq_buf(p, 2 + layer)[row]);
#pragma unroll
      for (int nt = 0; nt < 2; ++nt) {
        const int col = (ct * 2 + wc) * 32 + nt * 16 + fq * 4;
        float o[4];
#pragma unroll
        for (int j = 0; j < 4; ++j) o[j] = siluf_(rs * acc[mt][nt][j]) * (rs * acc[mt][nt + 2][j]);
        uint2 ov; ov.x = pack2(o[0], o[1]); ov.y = pack2(o[2], o[3]);
        *(uint2*)(act + (size_t)row * FH + col) = ov;
      }
    }
  }
}

DI f32x4 mma_t(const u16* X, int xr, const u16* Y, int yr, f32x4 acc, int fr, int fq);
DI void gdn_pre(const Params& p, int layer, int task, char* smem) {
  const int tid = my_tid(), lane = tid & 63, wave = tid >> 6;
  const int fr = lane & 15, fq = lane >> 4;
  const int n = task >> 2, h = task & 3, c0 = n * 64;
  const int lo = seq_lo(c0), hi = seq_hi(c0);
  float* ks = (float*)smem;
  float* vs = ks + 64 * 65;
  u16* Kb = (u16*)vs;
  float* AmT = vs + 64 * 65;
  float* gcs = AmT + 2 * 64 * 68;
  float* bts = gcs + 128;
  const u16* proj = (const u16*)(p.ws + OFF_PROJ);
  u16* QN = (u16*)(p.ws + OFF_QN);
  u16* KN = (u16*)(p.ws + OFF_KN);
  float* GC = (float*)(p.ws + OFF_GC);
  const float* AB = (const float*)(p.ws + OFF_AB);
  u16* UW = (u16*)(p.ws + OFF_UW);
  __syncthreads();
#define GDN_CONV(MAT)                                                                                \
  {                                                                                                  \
    const int ch = (MAT) * 256 + h * 64 + lane;                                                      \
    float w[5];                                                                                      \
    _Pragma("unroll") for (int j = 0; j < 5; ++j) w[j] = p.conv_a[(size_t)(layer * 5 + j) * 768 + ch]; \
    float raw[20];                                                                                   \
    _Pragma("unroll") for (int i = 0; i < 20; ++i) {                                                 \
      const int tok = c0 + wave * 16 + i - 2;                                                        \
      raw[i] = (tok >= lo && tok < hi) ? bf2f(proj[(size_t)tok * INW + ch]) : 0.f;                   \
    }                                                                                                \
    _Pragma("unroll") for (int i = 0; i < 16; ++i) {                                                 \
      float v = 0.f;                                                                                 \
      _Pragma("unroll") for (int j = 0; j < 5; ++j) v += raw[i + j] * w[j];                          \
      v = siluf_(v);                                                                                 \
      const int tl = wave * 16 + i;                                                                  \
      if ((MAT) < 2) {                                                                               \
        const float ss = wave_sum(v * v);                                                            \
        v *= rsqrtf(ss + EPS) * ((MAT) == 0 ? 0.125f : 1.f);                                         \
      }                                                                                              \
      if ((MAT) == 0) QN[(size_t)(c0 + tl) * 256 + h * 64 + lane] = f2bf(v);                         \
      else if ((MAT) == 1) {                                                                         \
        const u16 kb = f2bf(v);                                                                      \
        KN[(size_t)(c0 + tl) * 256 + h * 64 + lane] = kb; ks[tl * 65 + lane] = v; Kb[tl * 72 + lane] = kb; \
      } else vs[tl * 65 + lane] = v;                                                                 \
    }                                                                                                \
  }
  GDN_CONV(0)
  GDN_CONV(1)
  if (wave < 2) {
    const int d = wave;
    const int tok = c0 + (d ? 63 - lane : lane);
    const float al = AB[(size_t)tok * 16 + d * 4 + h];
    const float br = AB[(size_t)tok * 16 + 8 + d * 4 + h];
    const float xx = al + p.dt_bias[(layer * 2 + d) * 4 + h];
    const float sp = fmaxf(xx, 0.f) + log1pf(__expf(-fabsf(xx)));
    float g = -__expf(p.a_log[(layer * 2 + d) * 4 + h]) * sp;
#pragma unroll
    for (int o = 1; o < 64; o <<= 1) {
      const float t = __shfl_up(g, o, 64);
      if (lane >= o) g += t;
    }
    gcs[d * 64 + lane] = g;
    bts[d * 64 + lane] = sigmoidf_(br);
    GC[(size_t)(task * 2 + d) * 64 + lane] = g;
  }
  __syncthreads();
#pragma unroll
  for (int t = 0; t < 4; ++t) {
    if (t <= wave) {
      const f32x4 kk = mma_t(Kb, wave * 16, Kb, t * 16, (f32x4){0.f, 0.f, 0.f, 0.f}, fr, fq);
      const int b = t * 16 + fr;
      const float gb0 = gcs[b], gb1 = gcs[64 + 63 - b], bt1 = bts[64 + 63 - b];
#pragma unroll
      for (int j = 0; j < 4; ++j) {
        const int a = wave * 16 + fq * 4 + j;
        if (a > b) {
          AmT[b * 68 + a] = bts[a] * kk[j] * __expf(gcs[a] - gb0);
          const int i1 = 63 - b, j1 = 63 - a;
          AmT[64 * 68 + j1 * 68 + i1] = bt1 * kk[j] * __expf(gb1 - gcs[64 + j1]);
        }
      }
    }
  }
  __syncthreads();
  GDN_CONV(2)
  __syncthreads();
  {
    int d = tid >> 7, c = tid & 127;
    asm volatile("" : "+v"(d), "+v"(c));
    float r[64];
    {
      const int stride = d ? -65 : 65;
      int off = (d ? 63 * 65 : 0) + (c & 63);
      const float* srcm = (c < 64) ? vs : ks;
      const bool isw = c >= 64;
#pragma unroll
      for (int i = 0; i < 64; ++i) {
        float v = srcm[off] * bts[d * 64 + i];
        if (isw) v *= __expf(gcs[d * 64 + i]);
        r[i] = v;
        off += stride;
        asm volatile("" : "+v"(off));
        if ((i & 7) == 7) __builtin_amdgcn_sched_barrier(0);
      }
    }
    const float* Ad = AmT + d * 64 * 68;
#pragma unroll
    for (int j = 0; j < 63; ++j) {
      const float rj = r[j];
#pragma unroll
      for (int i = j + 1; i < 64; ++i) {
        r[i] = fmaf(-Ad[j * 68 + i], rj, r[i]);
        if ((i & 15) == 15) __builtin_amdgcn_sched_barrier(0);
      }
      __builtin_amdgcn_sched_barrier(0);
    }
    u16* base = UW + (size_t)(task * 2 + d) * 8192;
    if (c < 64) {
      uint4* dst = (uint4*)(base + c * 64);
#pragma unroll
      for (int q = 0; q < 8; ++q)
        dst[q] = make_uint4(pack2(r[8 * q], r[8 * q + 1]), pack2(r[8 * q + 2], r[8 * q + 3]), pack2(r[8 * q + 4], r[8 * q + 5]),
                            pack2(r[8 * q + 6], r[8 * q + 7]));
    } else {
      u16* dst = base + 4096 + (c - 64);
#pragma unroll
      for (int i = 0; i < 64; ++i) dst[i * 64] = f2bf(r[i]);
    }
  }
}

DI f32x4 mma_t(const u16* X, int xr, const u16* Y, int yr, f32x4 acc, int fr, int fq) {
#pragma unroll
  for (int kk = 0; kk < 2; ++kk) {
    const bf16x8 x = *(const bf16x8*)(X + (xr + fr) * 72 + kk * 32 + fq * 8);
    const bf16x8 y = *(const bf16x8*)(Y + (yr + fr) * 72 + kk * 32 + fq * 8);
    acc = mfma16(x, y, acc);
  }
  return acc;
}
DI f32x4 mma_t_swz(const u16* X, int xr, const u16* Y, int yr, f32x4 acc, int fr, int fq) {
  const int sw = ((xr + fr) >> 3) & 7;
#pragma unroll
  for (int kk = 0; kk < 2; ++kk) {
    const bf16x8 x = *(const bf16x8*)(X + (xr + fr) * 72 + (((kk * 4 + fq) ^ sw) * 8));
    const bf16x8 y = *(const bf16x8*)(Y + (yr + fr) * 72 + kk * 32 + fq * 8);
    acc = mfma16(x, y, acc);
  }
  return acc;
}

DI void gdn_scan(const Params& p, int item, char* smem) {
  const int tid = my_tid(), lane = tid & 63, w = tid >> 6;
  const int fr = lane & 15, fq = lane >> 4;
  const int chain = item >> 2, eq = item & 3;
  const int s = chain >> 3, h = (chain >> 1) & 3, d = chain & 1;
  const int sb = s == 0 ? 0 : TP + (s - 1) * 4096;
  const int nch = s == 0 ? 256 : 64;
  u16* St = (u16*)smem;
  u16* Vt = St + 16 * 72;
  u16* Vts = Vt + 16 * 72;
  u16* Wc = Vts + 16 * 72;
  u16* Qc = Wc + 64 * 72;
  u16* Kc = Qc + 64 * 72;
  u16* KcT = Kc + 64 * 72;
  u16* QKm = KcT + 64 * 72;
  float* gcs = (float*)(QKm + 64 * 72);
  u16* proj = (u16*)(p.ws + OFF_PROJ);
  const u16* QN = (const u16*)(p.ws + OFF_QN);
  const u16* KN = (const u16*)(p.ws + OFF_KN);
  const float* GC = (const float*)(p.ws + OFF_GC);
  const u16* UW = (const u16*)(p.ws + OFF_UW);
  __syncthreads();
  for (int i = tid; i < 16 * 72; i += 256) St[i] = 0;
  f32x4 S0 = (f32x4){0.f, 0.f, 0.f, 0.f};
  const int prow0 = tid >> 3, prow1 = (tid >> 3) + 32, pseg = (tid & 7) * 8;
  uint4 w0a, w1a, q0a, q1a, k0a, k1a, w0b, w1b, q0b, q1b, k0b, k1b;
  uint2 u0a, u0b;
  float ga, gb;
#define GDN_PREFETCH2(J, S)                                                                          \
  {                                                                                                  \
    const int jj_ = (J) < nch ? (J) : nch - 1;                                                       \
    const int n_ = sb / 64 + (d ? nch - 1 - jj_ : jj_);                                              \
    const int c0_ = n_ * 64;                                                                         \
    const size_t tb_ = (size_t)((n_ * 4 + h) * 2 + d);                                               \
    const u16* ub_ = UW + tb_ * 8192;                                                                \
    const int tok0_ = c0_ + (d ? 63 - prow0 : prow0), tok1_ = c0_ + (d ? 63 - prow1 : prow1);        \
    w0##S = *(const uint4*)(ub_ + 4096 + prow0 * 64 + pseg);                                         \
    w1##S = *(const uint4*)(ub_ + 4096 + prow1 * 64 + pseg);                                         \
    q0##S = *(const uint4*)(QN + (size_t)tok0_ * 256 + h * 64 + pseg);                               \
    q1##S = *(const uint4*)(QN + (size_t)tok1_ * 256 + h * 64 + pseg);                               \
    k0##S = *(const uint4*)(KN + (size_t)tok0_ * 256 + h * 64 + pseg);                               \
    k1##S = *(const uint4*)(KN + (size_t)tok1_ * 256 + h * 64 + pseg);                               \
    u0##S = *(const uint2*)(ub_ + (eq * 16 + fr) * 64 + w * 16 + fq * 4);                            \
    g##S = GC[tb_ * 64 + lane];                                                                      \
  }
#define GDN_STAGE2(ROW, PW, PQ, PK)                                                                  \
  {                                                                                                  \
    *(uint4*)(Wc + (ROW) * 72 + pseg) = PW;                                                          \
    *(uint4*)(Qc + (ROW) * 72 + pseg) = PQ;                                                          \
    *(uint4*)(Kc + (ROW) * 72 + pseg) = PK;                                                          \
    u16* kt_ = KcT + pseg * 72 + ((((ROW) >> 3) ^ (tid & 7)) * 8) + ((ROW) & 7);                     \
    kt_[0 * 72] = (u16)(PK.x & 0xffff); kt_[1 * 72] = (u16)(PK.x >> 16);                             \
    kt_[2 * 72] = (u16)(PK.y & 0xffff); kt_[3 * 72] = (u16)(PK.y >> 16);                             \
    kt_[4 * 72] = (u16)(PK.z & 0xffff); kt_[5 * 72] = (u16)(PK.z >> 16);                             \
    kt_[6 * 72] = (u16)(PK.w & 0xffff); kt_[7 * 72] = (u16)(PK.w >> 16);                             \
  }
#define GDN_STEP(JV, S)                                                                              \
  {                                                                                                  \
    const int j_ = (JV);                                                                             \
    const int n = sb / 64 + (d ? nch - 1 - j_ : j_);                                                 \
    const int c0 = n * 64;                                                                           \
    GDN_STAGE2(prow0, w0##S, q0##S, k0##S)                                                           \
    GDN_STAGE2(prow1, w1##S, q1##S, k1##S)                                                           \
    if (tid < 64) gcs[tid] = g##S;                                                                   \
    const uint2 cu0 = u0##S;                                                                         \
    __syncthreads();                                                                          \
    GDN_PREFETCH2(j_ + 2, S)                                                                         \
    const f32x4 z4 = (f32x4){0.f, 0.f, 0.f, 0.f};                                                    \
    const f32x4 P1a = mma_t(Wc, w * 16, St, 0, z4, fr, fq);                                          \
    const f32x4 P2a = mma_t(St, 0, Qc, w * 16, z4, fr, fq);                                          \
      \
    const float glog = gcs[63];                                                                      \
    const float gcc = gcs[w * 16 + fr];                                                              \
    const float4 gq0 = *(const float4*)(gcs + fq * 4), gq1 = *(const float4*)(gcs + 16 + fq * 4);    \
    const float4 gq2 = *(const float4*)(gcs + 32 + fq * 4), gq3 = *(const float4*)(gcs + 48 + fq * 4); \
    const float4 gw = *(const float4*)(gcs + w * 16 + fq * 4);                                       \
    {                                                                                                \
      const int c = w * 16 + fr;                                                                     \
      _Pragma("unroll") for (int t = 0; t < 4; ++t) {                                                \
        const f32x4 qk = mma_t(Kc, t * 16, Qc, w * 16, z4, fr, fq);                                  \
        const int s0 = t * 16 + fq * 4;                                                              \
        const float4 gs = t == 0 ? gq0 : t == 1 ? gq1 : t == 2 ? gq2 : gq3;                          \
        const float e0 = __expf(fminf(gcc - gs.x, 0.f)), e1 = __expf(fminf(gcc - gs.y, 0.f));       \
        const float e2 = __expf(fminf(gcc - gs.z, 0.f)), e3 = __expf(fminf(gcc - gs.w, 0.f));       \
        const float v0 = (c >= s0 + 0) ? qk[0] * e0 : 0.f;                                           \
        const float v1 = (c >= s0 + 1) ? qk[1] * e1 : 0.f;                                           \
        const float v2 = (c >= s0 + 2) ? qk[2] * e2 : 0.f;                                           \
        const float v3 = (c >= s0 + 3) ? qk[3] * e3 : 0.f;                                           \
        uint2 o; o.x = pack2(v0, v1); o.y = pack2(v2, v3);                                           \
        *(uint2*)(QKm + c * 72 + s0) = o;                                                            \
      }                                                                                              \
    }                                                                                                \
    {                                                                                                \
      const int cc0 = w * 16 + fq * 4;                                                               \
      const float v0 = bf2f((u16)(cu0.x & 0xffff)) - P1a[0], v1 = bf2f((u16)(cu0.x >> 16)) - P1a[1]; \
      const float v2 = bf2f((u16)(cu0.y & 0xffff)) - P1a[2], v3 = bf2f((u16)(cu0.y >> 16)) - P1a[3]; \
      uint2 o; o.x = pack2(v0, v1); o.y = pack2(v2, v3);                                             \
      *(uint2*)(Vt + fr * 72 + cc0) = o;                                                             \
      uint2 o2;                                                                                      \
      o2.x = pack2(v0 * __expf(glog - gw.x), v1 * __expf(glog - gw.y));                              \
      o2.y = pack2(v2 * __expf(glog - gw.z), v3 * __expf(glog - gw.w));                              \
      *(uint2*)(Vts + fr * 72 + cc0) = o2;                                                           \
    }                                                                                                \
    __syncthreads();                                                                          \
    {                                                                                                \
      const int c = w * 16 + fr;                                                                     \
      const float eg = __expf(gcc);                                                                  \
      const int tok = c0 + (d ? 63 - c : c);                                                         \
      u16* orow = proj + (size_t)tok * INW + d * 256 + h * 64 + eq * 16 + fq * 4;                    \
      f32x4 oa = P2a * eg;                                                                           \
      oa = mma_t(Vt, 0, QKm, w * 16, oa, fr, fq);                                                    \
      uint2 o; o.x = pack2(oa[0], oa[1]); o.y = pack2(oa[2], oa[3]);                                 \
      *(uint2*)(orow) = o;                                                                           \
    }                                                                                                \
    {                                                                                                \
      const float gl = __expf(glog);                                                                 \
      S0 *= gl;                                                                                      \
      S0 = mma_t_swz(KcT, w * 16, Vts, 0, S0, fr, fq);                                               \
      const int r0 = w * 16 + fq * 4;                                                                \
      uint2 o; o.x = pack2(S0[0], S0[1]); o.y = pack2(S0[2], S0[3]);                                 \
      *(uint2*)(St + fr * 72 + r0) = o;                                                              \
    }                                                                                                \
    __syncthreads();                                                                          \
  }
  GDN_PREFETCH2(0, a)
  GDN_PREFETCH2(1, b)
  for (int j = 0; j < nch; j += 2) {
    GDN_STEP(j, a)
    GDN_STEP(j + 1, b)
  }
}

DI void gdn_post_row(const Params& p, int layer, int t) {
  const int lane = my_tid() & 63;
  u16* row = (u16*)(p.ws + OFF_PROJ) + (size_t)t * INW;
  const uint2 f = *(const uint2*)(row + lane * 4);
  const uint2 bw = *(const uint2*)(row + 256 + lane * 4);
  const uint2 z = *(const uint2*)(row + C_AZ + lane * 4);
  float o[4], zz[4];
  o[0] = bf2f((u16)(f.x & 0xffff)) + bf2f((u16)(bw.x & 0xffff));
  o[1] = bf2f((u16)(f.x >> 16)) + bf2f((u16)(bw.x >> 16));
  o[2] = bf2f((u16)(f.y & 0xffff)) + bf2f((u16)(bw.y & 0xffff));
  o[3] = bf2f((u16)(f.y >> 16)) + bf2f((u16)(bw.y >> 16));
  zz[0] = bf2f((u16)(z.x & 0xffff)); zz[1] = bf2f((u16)(z.x >> 16)); zz[2] = bf2f((u16)(z.y & 0xffff)); zz[3] = bf2f((u16)(z.y >> 16));
  float ss = o[0] * o[0] + o[1] * o[1] + o[2] * o[2] + o[3] * o[3];
#pragma unroll
  for (int m = 1; m < 16; m <<= 1) ss += __shfl_xor(ss, m, 64);
  const float rs = rsqrtf(ss * (1.f / 64.f) + EPS);
  const int e0 = (lane & 15) * 4;
  float r[4];
#pragma unroll
  for (int j = 0; j < 4; ++j) r[j] = o[j] * rs * p.a_norm[layer * 64 + e0 + j] * siluf_(zz[j]);
  uint2 ov; ov.x = pack2(r[0], r[1]); ov.y = pack2(r[2], r[3]);
  *(uint2*)(row + C_AZ + lane * 4) = ov;
}

struct S5Const { float are, aim; float bpr[16], bpi[16]; };
DI void s5_consts(const Params& p, int layer, int d, int g, int lane, S5Const& k, float& lr, float& li, float& step) {
  const int gi = ((layer * 2 + d) * 16 + g);
  lr = p.lam_re[(size_t)gi * 64 + lane];
  li = p.lam_im[(size_t)gi * 64 + lane];
  step = expf(p.log_step[gi]);
  const float mag = expf(lr * step);
  float sn, cs; sincosf(li * step, &sn, &cs);
  k.are = mag * cs; k.aim = mag * sn;
  const float inv = 1.f / (lr * lr + li * li);
  const float ir = lr * inv, ii = -li * inv;
  const float cr = (k.are - 1.f) * ir - k.aim * ii;
  const float ci = (k.are - 1.f) * ii + k.aim * ir;
  const float* br = p.b_re + ((size_t)(layer * 16 + g) * 64 + lane) * 16;
  const float* bi = p.b_im + ((size_t)(layer * 16 + g) * 64 + lane) * 16;
#pragma unroll
  for (int c = 0; c < 16; ++c) {
    const float a = br[c], b = bi[c];
    k.bpr[c] = cr * a - ci * b;
    k.bpi[c] = cr * b + ci * a;
  }
}
DI void s5_stage_u(const Params& p, int c0, int gq, float* us) {
  const u16* proj = (const u16*)(p.ws + OFF_PROJ);
  const int tid = my_tid();
#pragma unroll
  for (int i = 0; i < 4; ++i) {
    const int idx = tid + 256 * i, tok = idx >> 4, c4 = (idx & 15) * 4;
    const uint2 v = *(const uint2*)(proj + (size_t)(c0 + tok) * INW + C_CU + gq * 64 + c4);
    us[tok * 64 + c4 + 0] = bf2f((u16)(v.x & 0xffff));
    us[tok * 64 + c4 + 1] = bf2f((u16)(v.x >> 16));
    us[tok * 64 + c4 + 2] = bf2f((u16)(v.y & 0xffff));
    us[tok * 64 + c4 + 3] = bf2f((u16)(v.y >> 16));
  }
}
DI void s5_step(const S5Const& k, const float* u, float& sr, float& si) {
  float xr = 0.f, xi = 0.f;
#pragma unroll
  for (int c4 = 0; c4 < 4; ++c4) {
    const float4 uu = *(const float4*)(u + c4 * 4);
    xr += k.bpr[c4 * 4 + 0] * uu.x + k.bpr[c4 * 4 + 1] * uu.y + k.bpr[c4 * 4 + 2] * uu.z + k.bpr[c4 * 4 + 3] * uu.w;
    xi += k.bpi[c4 * 4 + 0] * uu.x + k.bpi[c4 * 4 + 1] * uu.y + k.bpi[c4 * 4 + 2] * uu.z + k.bpi[c4 * 4 + 3] * uu.w;
  }
  const float nr = k.are * sr - k.aim * si + xr;
  const float ni = k.are * si + k.aim * sr + xi;
  sr = nr; si = ni;
}
DI void s5_pass1(const Params& p, int layer, int task, char* smem) {
  const int lane = my_tid() & 63, wave = my_tid() >> 6;
  const int n = task >> 2, gq = task & 3, g = gq * 4 + wave, c0 = n * 64;
  float* us = (float*)smem;
  float2* SEND = (float2*)(p.ws + OFF_SEND);
  __syncthreads();
  s5_stage_u(p, c0, gq, us);
  __syncthreads();
#pragma unroll 1
  for (int d = 0; d < 2; ++d) {
    S5Const k; float lr, li, step;
    s5_consts(p, layer, d, g, lane, k, lr, li, step);
    float sr = 0.f, si = 0.f;
#pragma unroll 4
    for (int i = 0; i < 64; ++i) {
      const int t = d ? 63 - i : i;
      s5_step(k, us + t * 64 + wave * 16, sr, si);
    }
    SEND[((size_t)(n * 2 + d) * 16 + g) * 64 + lane] = make_float2(sr, si);
  }
}
DI float gelu_tanh(float x) {
  const float u = 0.7978845608028654f * (x + 0.044715f * x * x * x);
  return 0.5f * x * (1.f + tanhf(u));
}
DI void s5_pass3(const Params& p, int layer, int task, char* smem) {
  const int lane = my_tid() & 63, wave = my_tid() >> 6;
  const int fr = lane & 15, fq = lane >> 4;
  const int n = task >> 2, gq = task & 3, g = gq * 4 + wave, c0 = n * 64;
  const int nlo = seq_lo(c0) / 64, nhi = seq_hi(c0) / 64;
  float* us = (float*)smem;
  u16* Sb = (u16*)(smem + 16384) + wave * 16 * 136;
  const float2* SEND = (const float2*)(p.ws + OFF_SEND);
  u16* Gb = (u16*)(p.ws + OFF_G);
  __syncthreads();
  s5_stage_u(p, c0, gq, us);
  __syncthreads();
  f32x4 yacc[4];
#pragma unroll
  for (int tb = 0; tb < 4; ++tb) yacc[tb] = (f32x4){0.f, 0.f, 0.f, 0.f};
#pragma unroll
  for (int d = 0; d < 2; ++d) {
    S5Const k; float lr, li, step;
    s5_consts(p, layer, d, g, lane, k, lr, li, step);
    const float m64 = expf(lr * step * 64.f);
    float s64, c64; sincosf(li * step * 64.f, &s64, &c64);
    const float a64r = m64 * c64, a64i = m64 * s64;
    float sr = 0.f, si = 0.f;
    {
      const int cnt = d == 0 ? n - nlo : nhi - 1 - n;
      const int first = d == 0 ? nlo : nhi - 1;
      const int sgn = d == 0 ? 1 : -1;
      const float2* sp = SEND + ((size_t)(first * 2 + d) * 16 + g) * 64 + lane;
      const long stride = (long)sgn * 2 * 16 * 64;
      int m = 0;
      for (; m + 8 <= cnt; m += 8) {
        float2 e0 = sp[0], e1 = sp[stride], e2 = sp[2 * stride], e3 = sp[3 * stride];
        float2 e4 = sp[4 * stride], e5 = sp[5 * stride], e6 = sp[6 * stride], e7 = sp[7 * stride];
        sp += 8 * stride;
#define HSTEP(E) { const float nr = a64r * sr - a64i * si + E.x, ni = a64r * si + a64i * sr + E.y; sr = nr; si = ni; }
        HSTEP(e0) HSTEP(e1) HSTEP(e2) HSTEP(e3) HSTEP(e4) HSTEP(e5) HSTEP(e6) HSTEP(e7)
      }
      for (; m < cnt; ++m) {
        const float2 e = sp[0];
        sp += stride;
        HSTEP(e)
      }
    }
    bf16x8 cf[4];
    {
      const float* cr = p.c_re + ((size_t)((layer * 2 + d) * 16 + g) * 16 + fr) * 64;
      const float* ci = p.c_im + ((size_t)((layer * 2 + d) * 16 + g) * 16 + fr) * 64;
#pragma unroll
      for (int kk = 0; kk < 4; ++kk)
#pragma unroll
        for (int e = 0; e < 8; ++e) {
          const int kx = (kk & 1) * 32 + fq * 8 + e;
          const float v = (kk < 2) ? cr[kx] : -ci[kx];
          cf[kk][e] = (short)f2bf(v);
        }
    }
#pragma unroll
    for (int blk = 0; blk < 4; ++blk) {
      const int tb = d ? 3 - blk : blk;
#pragma unroll 4
      for (int i = 0; i < 16; ++i) {
        const int r = d ? 15 - i : i;
        const int t = tb * 16 + r;
        s5_step(k, us + t * 64 + wave * 16, sr, si);
        Sb[r * 136 + lane] = f2bf(sr);
        Sb[r * 136 + 64 + lane] = f2bf(si);
      }
      asm volatile("s_waitcnt lgkmcnt(0)" ::: "memory");
#pragma unroll
      for (int kk = 0; kk < 4; ++kk) {
        const bf16x8 xf = *(const bf16x8*)(Sb + fr * 136 + kk * 32 + fq * 8);
        yacc[tb] = mfma16(xf, cf[kk], yacc[tb]);
      }
      asm volatile("s_waitcnt lgkmcnt(0)" ::: "memory");
    }
  }
  const float dsk = p.s5_d[layer * 256 + g * 16 + fr];
#pragma unroll
  for (int tb = 0; tb < 4; ++tb)
#pragma unroll
    for (int j = 0; j < 4; ++j) {
      const int t = tb * 16 + fq * 4 + j;
      const float y = yacc[tb][j] + us[t * 64 + wave * 16 + fr] * dsk;
      Gb[(size_t)(c0 + t) * 256 + g * 16 + fr] = f2bf(gelu_tanh(y));
    }
}

struct AttnState { float m, l; f32x4 o[4]; };
DI void attn_segment(const u16* proj, int kcol, int vcol, int tk0, int kstride, int npairs, int R, float slope, int tq,
                     int lo, int hi, const bf16x8 (&qf)[2], AttnState& st, u16* Vt, int lane) {
  const int fr = lane & 15, fq = lane >> 4;
#pragma unroll 1
  for (int pr = 0; pr < npairs; ++pr) {
    const int kbase = tk0 + pr * 32 * kstride;
    f32x4 sacc[2];
#pragma unroll
    for (int t = 0; t < 2; ++t) {
      int tk = kbase + (t * 16 + fr) * kstride;
      tk = min(max(tk, lo), hi - 1);
      const u16* kp = proj + (size_t)tk * INW + kcol + fq * 8;
      const bf16x8 k0 = *(const bf16x8*)(kp), k1 = *(const bf16x8*)(kp + 32);
      sacc[t] = mfma16(k0, qf[0], (f32x4){0.f, 0.f, 0.f, 0.f});
      sacc[t] = mfma16(k1, qf[1], sacc[t]);
    }
    uint4 vr[4];
#pragma unroll
    for (int i = 0; i < 4; ++i) {
      const int idx = lane + 64 * i, kl = idx >> 3, seg = (idx & 7) * 8;
      int tk = kbase + kl * kstride;
      tk = min(max(tk, lo), hi - 1);
      vr[i] = *(const uint4*)(proj + (size_t)tk * INW + vcol + seg);
    }
    float sc[2][4]; bool ok[2][4];
    float mx = -1e30f;
#pragma unroll
    for (int t = 0; t < 2; ++t)
#pragma unroll
      for (int j = 0; j < 4; ++j) {
        const int tk = kbase + (t * 16 + fq * 4 + j) * kstride;
        const int ad = abs(tk - tq);
        ok[t][j] = (ad <= R) && (tk >= lo) && (tk < hi);
        sc[t][j] = sacc[t][j] * 0.125f - slope * (float)ad;
        if (ok[t][j]) mx = fmaxf(mx, sc[t][j]);
      }
    mx = fmaxf(mx, __shfl_xor(mx, 16, 64));
    mx = fmaxf(mx, __shfl_xor(mx, 32, 64));
    const float mn = fmaxf(st.m, mx);
    const float alpha = __expf(st.m - mn);
    st.m = mn;
    float pv[2][4], ps = 0.f;
#pragma unroll
    for (int t = 0; t < 2; ++t)
#pragma unroll
      for (int j = 0; j < 4; ++j) { pv[t][j] = ok[t][j] ? __expf(sc[t][j] - mn) : 0.f; ps += pv[t][j]; }
    st.l = st.l * alpha + ps;
#pragma unroll
    for (int dt = 0; dt < 4; ++dt)
#pragma unroll
      for (int j = 0; j < 4; ++j) st.o[dt][j] *= alpha;
    bf16x8 pf;
    {
      const unsigned w0 = pack2(pv[0][0], pv[0][1]), w1 = pack2(pv[0][2], pv[0][3]), w2 = pack2(pv[1][0], pv[1][1]),
                     w3 = pack2(pv[1][2], pv[1][3]);
      uint4 t4 = make_uint4(w0, w1, w2, w3);
      pf = __builtin_bit_cast(bf16x8, t4);
    }
    asm volatile("s_waitcnt lgkmcnt(0)" ::: "memory");
#pragma unroll
    for (int i = 0; i < 4; ++i) {
      const int idx = lane + 64 * i, kl = idx >> 3, seg = (idx & 7) * 8;
      Vt[(seg + 0) * 36 + kl] = (u16)(vr[i].x & 0xffff); Vt[(seg + 1) * 36 + kl] = (u16)(vr[i].x >> 16);
      Vt[(seg + 2) * 36 + kl] = (u16)(vr[i].y & 0xffff); Vt[(seg + 3) * 36 + kl] = (u16)(vr[i].y >> 16);
      Vt[(seg + 4) * 36 + kl] = (u16)(vr[i].z & 0xffff); Vt[(seg + 5) * 36 + kl] = (u16)(vr[i].z >> 16);
      Vt[(seg + 6) * 36 + kl] = (u16)(vr[i].w & 0xffff); Vt[(seg + 7) * 36 + kl] = (u16)(vr[i].w >> 16);
    }
    asm volatile("s_waitcnt lgkmcnt(0)" ::: "memory");
#pragma unroll
    for (int dt = 0; dt < 4; ++dt) {
      const uint2 v0 = *(const uint2*)(Vt + (dt * 16 + fr) * 36 + fq * 4);
      const uint2 v1 = *(const uint2*)(Vt + (dt * 16 + fr) * 36 + 16 + fq * 4);
      uint4 t4 = make_uint4(v0.x, v0.y, v1.x, v1.y);
      const bf16x8 vf = __builtin_bit_cast(bf16x8, t4);
      st.o[dt] = mfma16(vf, pf, st.o[dt]);
    }
  }
}
DI void attn_task(const Params& p, int layer, int mode, int task, char* smem) {
  const int lane = my_tid() & 63, wave = my_tid() >> 6;
  const int fr = lane & 15, fq = lane >> 4;
  u16* proj = (u16*)(p.ws + OFF_PROJ);
  u16* Vt = (u16*)smem + wave * 64 * 36;
  int tq0, qstride, qcol, kcol, vcol; float slope;
  int hq;
  if (mode == 0) {
    const int blk = task >> 4, h = (task >> 2) & 3, rq = task & 3;
    hq = h; tq0 = blk * 256 + rq * 4 + wave; qstride = 16;
    qcol = C_BQ + h * 64; kcol = C_BK + h * 64; vcol = C_BV + h * 64;
    slope = exp2f(-(float)(5 + h));
  } else {
    const int blk = task >> 2, qh = task & 3;
    hq = qh; tq0 = blk * 64 + wave * 16; qstride = 1;
    qcol = C_DQ + qh * 64; kcol = C_DK + (qh >> 1) * 64; vcol = C_DV + (qh >> 1) * 64;
    slope = exp2f(-(float)(1 + qh));
  }
  const int lo = seq_lo(tq0), hi = seq_hi(tq0);
  const int tq = tq0 + fr * qstride;
  bf16x8 qf[2];
  {
    const u16* qp = proj + (size_t)tq * INW + qcol + fq * 8;
    qf[0] = *(const bf16x8*)(qp); qf[1] = *(const bf16x8*)(qp + 32);
  }
  AttnState st; st.m = -1e30f; st.l = 0.f;
#pragma unroll
  for (int dt = 0; dt < 4; ++dt) st.o[dt] = (f32x4){0.f, 0.f, 0.f, 0.f};
  __syncthreads();
  float scale;
  if (mode == 0) {
    attn_segment(proj, kcol, vcol, tq0 - 64, 1, 12, 64, slope, tq, lo, hi, qf, st, Vt, lane);
    attn_segment(proj, kcol, vcol, tq0 - 256, 4, 6, 256, slope, tq, lo, hi, qf, st, Vt, lane);
    attn_segment(proj, kcol, vcol, tq0 - 1024, 16, 5, 1024, slope, tq, lo, hi, qf, st, Vt, lane);
    float l = st.l; l += __shfl_xor(l, 16, 64); l += __shfl_xor(l, 32, 64);
    scale = 1.f / l;
  } else {
    attn_segment(proj, kcol, vcol, tq0 - 128, 1, 9, 128, slope, tq, lo, hi, qf, st, Vt, lane);
    float l = st.l; l += __shfl_xor(l, 16, 64); l += __shfl_xor(l, 32, 64);
    const float sink = p.attn_sink[layer * 4 + hq];
    const float mf = fmaxf(st.m, sink);
    const float sc = __expf(st.m - mf);
    scale = sc / (l * sc + __expf(sink - mf));
  }
#pragma unroll
  for (int dt = 0; dt < 4; ++dt) {
    uint2 o; o.x = pack2(st.o[dt][0] * scale, st.o[dt][1] * scale); o.y = pack2(st.o[dt][2] * scale, st.o[dt][3] * scale);
    *(uint2*)(proj + (size_t)tq * INW + qcol + dt * 16 + fq * 4) = o;
  }
}

DI void final_row(const Params& p, int t) {
  const int lane = my_tid() & 63;
  float* row = p.xout + (size_t)t * DM;
  float4 v[4]; float ss = 0.f;
#pragma unroll
  for (int i = 0; i < 4; ++i) {
    v[i] = *(const float4*)(row + i * 256 + lane * 4);
    ss += v[i].x * v[i].x + v[i].y * v[i].y + v[i].z * v[i].z + v[i].w * v[i].w;
  }
  ss = wave_sum(ss);
  const float rs = rstd_of(ss);
#pragma unroll
  for (int i = 0; i < 4; ++i) {
    const float4 g = *(const float4*)(p.final_norm + i * 256 + lane * 4);
    *(float4*)(row + i * 256 + lane * 4) = make_float4(v[i].x * rs * g.x, v[i].y * rs * g.y, v[i].z * rs * g.z, v[i].w * rs * g.w);
  }
}

#define XB_TMO      128
#define XB_XCNT(j)  (256  + 64 * (j))
#define XB_XSUB(j)  (1280 + 64 * (j))
#define XB_XGEN(j)  (2304 + 64 * (j))
#define XB_TOP      3328
#define XB_TOPGEN   3392
#define XB_SPIN_CAP (1u << 22)
#define LAS __attribute__((address_space(3)))
DI unsigned xb_ld(unsigned* p) { return __hip_atomic_load(p, __ATOMIC_RELAXED, __HIP_MEMORY_SCOPE_AGENT); }
DI unsigned xb_add(unsigned* p, unsigned v) { return __hip_atomic_fetch_add(p, v, __ATOMIC_RELAXED, __HIP_MEMORY_SCOPE_AGENT); }
DI unsigned xb_xcc_id() { return (unsigned)__builtin_amdgcn_s_getreg((3 << 11) | 20) & 0xFu; }
#define XB_SPIN(cond, bar) do { unsigned _sp = 0; while (cond) { __builtin_amdgcn_s_sleep(1); \
    if ((++_sp & 255u) == 0u) { if (xb_ld(&(bar)[XB_TMO])) break; if (_sp > XB_SPIN_CAP) { atomicAdd(&(bar)[XB_TMO], 1u); break; } } } } while (0)
struct XcdBarrier { unsigned* bar; unsigned x; volatile LAS unsigned* st; };
DI XcdBarrier xcd_barrier_post(unsigned* bar, volatile LAS unsigned* st) {
  XcdBarrier b; b.bar = bar; b.x = xb_xcc_id(); b.st = st;
  if (threadIdx.x == 0) (void)xb_add(&bar[XB_XCNT(b.x)], 1u);
  return b;
}
DI void xcd_barrier_complete(unsigned* bar, unsigned x, unsigned& nloc, unsigned& nx) {
  const unsigned G = gridDim.x * gridDim.y * gridDim.z;
  unsigned sum, cnt, mine, sp = 0u;
  for (;;) {
    sum = 0u; cnt = 0u; mine = 0u;
#pragma unroll
    for (unsigned j = 0; j < 16; ++j) { const unsigned c = xb_ld(&bar[XB_XCNT(j)]); sum += c; cnt += (c > 0u) ? 1u : 0u; mine = (j == x) ? c : mine; }
    if (sum == G) break;
    __builtin_amdgcn_s_sleep(1);
    if ((++sp & 255u) == 0u) { if (xb_ld(&bar[XB_TMO])) break; if (sp > XB_SPIN_CAP) { atomicAdd(&bar[XB_TMO], 1u); break; } }
  }
  nloc = mine > 0u ? mine : 1u; nx = cnt > 0u ? cnt : 1u;
}
DI void xcd_barrier(const XcdBarrier& b) {
  asm volatile("s_waitcnt vmcnt(0)" ::: "memory");
  __syncthreads();
  if (threadIdx.x == 0) {
    unsigned* bar = b.bar;
    __builtin_amdgcn_s_waitcnt(0);
    unsigned nloc = b.st[0], nx = b.st[1];
    if (nloc == 0u) { xcd_barrier_complete(bar, b.x, nloc, nx); b.st[0] = nloc; b.st[1] = nx; }
    const unsigned old = xb_add(&bar[XB_XSUB(b.x)], 1u);
    const unsigned gen = old / nloc;
    if (old + 1u == (gen + 1u) * nloc) {
      __builtin_amdgcn_fence(__ATOMIC_RELEASE, "agent");
      asm volatile("s_waitcnt vmcnt(0)" ::: "memory");
      const unsigned og = xb_add(&bar[XB_TOP], 1u);
      const unsigned tg = og / nx;
      if (og + 1u == (tg + 1u) * nx) xb_add(&bar[XB_TOPGEN], 1u);
      else XB_SPIN(xb_ld(&bar[XB_TOPGEN]) == tg, bar);
      __builtin_amdgcn_fence(__ATOMIC_ACQUIRE, "agent");
      xb_add(&bar[XB_XGEN(b.x)], 1u);
      asm volatile("s_waitcnt vmcnt(0)" ::: "memory");
    } else {
      XB_SPIN(xb_ld(&bar[XB_XGEN(b.x)]) == gen, bar);
      __builtin_amdgcn_fence(__ATOMIC_ACQUIRE, "agent");
      asm volatile("s_waitcnt vmcnt(0)" ::: "memory");
    }
  }
  __syncthreads();
}

enum { PH_NORM1 = 0, PH_INPROJ, PH_MIX1, PH_MIX2, PH_MIX3, PH_MERGE, PH_OUT, PH_FFN1, PH_FFN2, PH_PER_LAYER, PH_FINAL = 100 };

DI void run_phase(const Params& p, int ph, int layer, char* smem) {
  const int b = blockIdx.x, G = gridDim.x;
  const int wave = my_tid() >> 6;
  switch (ph) {
    case PH_NORM1: {
      if (layer == 0) {
        for (int t = b; t < 2 * CONV_TILES_LAYER; t += G) {
          ConvJob j;
          const int lt = conv_lookup(p, t, j);
          conv_tile(j, lt, (float*)smem);
        }
      }
      if (b == 0 && my_tid() == 0) *(unsigned*)(p.ws + OFF_CNT) = 0u;
      if (layer == 0) {
        float* z = ssq_buf(p, 2);
        for (int i = b * 256 + my_tid(); i < 2 * T; i += G * 256) z[i] = 0.f;
      }
      cvt_phase(p, layer, (u16*)(p.ws + OFF_H), true, b, G);
    } break;
    case PH_INPROJ: gemm_inproj(p, layer, b, G, (u16*)smem); break;
    case PH_MIX1: {
      for (int t = b; t < 2 * 3072; t += G) {
        const int kind = t / 3072, idx = t % 3072;
        if (kind == 0) gdn_pre(p, layer, idx, smem);
        else s5_pass1(p, layer, idx, smem);
      }
    } break;
    case PH_MIX2: {
      for (int c = b; c < 288; c += G) gdn_scan(p, c, smem);
      {
        unsigned* cnt = (unsigned*)(p.ws + OFF_CNT);
        int* slot = (int*)(smem + SMEM_BYTES - 16);
        for (;;) {
          __syncthreads();
          if (my_tid() == 0) *slot = (int)atomicAdd(cnt, 1u);
          __syncthreads();
          const int t = *slot;
          if (t >= 3 * 3072) break;
          if (t < 3072) s5_pass3(p, layer, t, smem);
          else if (t < 2 * 3072) attn_task(p, layer, 0, t - 3072, smem);
          else attn_task(p, layer, 1, t - 2 * 3072, smem);
        }
      }
    } break;
    case PH_MIX3: {
      gemm_glu(p, layer, b, G, (u16*)smem);
      for (int t = b * 4 + wave; t < T; t += G * 4) gdn_post_row(p, layer, t);
      cvt_phase(p, layer, (u16*)(p.ws + OFF_H), false, b, G);
    } break;
    case PH_MERGE: gemm_merge(p, layer, b, G, (u16*)smem); break;
    case PH_OUT:
      gemm_resid(p, layer, (const u16*)(p.ws + OFF_MERGED), DM, (const u16*)(p.ws + OFF_W) + layer * W_LAYER + WO_OUT, b, G, (u16*)smem,
                 (u16*)(p.ws + OFF_H2), ssq_buf(p, 2 + layer));
      break;
    case PH_FFN1: gemm_ffn1(p, layer, b, G, (u16*)smem); break;
    case PH_FFN2:
      gemm_resid(p, 1, (const u16*)(p.ws + OFF_ACT), FH, (const u16*)(p.ws + OFF_W) + layer * W_LAYER + WO_DN, b, G, (u16*)smem,
                 nullptr, nullptr);
      break;
    case PH_FINAL:
      for (int t = b * 4 + wave; t < T; t += G * 4) final_row(p, t);
      break;
    default: break;
  }
}

#if !MEGA
__global__ void __launch_bounds__(256, 2) k_phase(Params p, int ph, int layer) {
  __shared__ __attribute__((aligned(16))) char smem[SMEM_BYTES];
  run_phase(p, ph, layer, smem);
}

#else
__global__ void __launch_bounds__(256, 2) k_mega(Params p) {
  __shared__ __attribute__((aligned(16))) char smem[SMEM_BYTES];
  __shared__ uint4 xb_words;
  cg::grid_group grid = cg::this_grid();
  if (threadIdx.x == 0) xb_words = make_uint4(0u, 0u, 0u, 0u);
  __syncthreads();
  const XcdBarrier xb = xcd_barrier_post((unsigned*)(p.ws + OFF_BAR), (volatile LAS unsigned*)&xb_words);
  for (int layer = 0; layer < 2; ++layer)
    for (int ph = 0; ph < PH_PER_LAYER; ++ph) {
      run_phase(p, ph, layer, smem);
      if (layer == 1 && ph == PH_PER_LAYER - 1) grid.sync(); else xcd_barrier(xb);
#ifdef PROBE_DUP
      if (ph == PROBE_DUP) { run_phase(p, ph, layer, smem); grid.sync(); }
#endif
    }
  run_phase(p, PH_FINAL, 0, smem);
}
#endif

extern "C" void kernel_launch(void* const* d_in, const int* in_sizes, int n_in, void* d_out, int out_size, void* d_ws,
                              size_t ws_size, hipStream_t stream) {
  (void)in_sizes; (void)n_in; (void)out_size;
  if (ws_size < WS_NEED) { fprintf(stderr, "workspace too small: %zu < %zu\n", ws_size, (size_t)WS_NEED); return; }
  Params p;
  memset(&p, 0, sizeof(p));
  const float* const* in = (const float* const*)d_in;
  p.x_prompt = in[0]; p.x_sample = in[1]; p.norm1 = in[2]; p.conv_a = in[4]; p.a_log = in[5]; p.dt_bias = in[6];
  p.a_norm = in[7]; p.lam_re = in[8]; p.lam_im = in[9]; p.log_step = in[10]; p.b_re = in[11]; p.b_im = in[12];
  p.c_re = in[13]; p.c_im = in[14]; p.s5_d = in[15]; p.attn_sink = in[17]; p.norm2 = in[21]; p.final_norm = in[25];
  p.xout = (float*)d_out;
  p.ws = (char*)d_ws;
  p.w_in = in[3]; p.w_glu = in[16]; p.w_gate = in[18]; p.w_branch = in[19]; p.w_out = in[20];
  p.w_ffn_gate = in[22]; p.w_ffn_up = in[23]; p.w_ffn_down = in[24];
  static int grid_blocks = 0;
  if (!grid_blocks) {
    int dev = 0, cus = 0, per_cu = 0;
    hipGetDevice(&dev);
    hipDeviceGetAttribute(&cus, hipDeviceAttributeMultiprocessorCount, dev);
#if MEGA
    hipOccupancyMaxActiveBlocksPerMultiprocessor(&per_cu, k_mega, 256, 0);
#else
    hipOccupancyMaxActiveBlocksPerMultiprocessor(&per_cu, k_phase, 256, 0);
#endif
    per_cu = 2;
    grid_blocks = cus * per_cu;
  }
#if MEGA
  hipMemsetAsync((char*)d_ws + OFF_BAR, 0, BAR_BYTES, stream);
  void* args[] = {&p};
  hipError_t e = hipLaunchCooperativeKernel((void*)k_mega, dim3(grid_blocks), dim3(256), args, 0, stream);
  if (e != hipSuccess) fprintf(stderr, "cooperative launch failed: %s (grid %d)\n", hipGetErrorString(e), grid_blocks);
#else
  for (int layer = 0; layer < 2; ++layer)
    for (int ph = 0; ph < PH_PER_LAYER; ++ph) hipLaunchKernelGGL(k_phase, dim3(grid_blocks), dim3(256), 0, stream, p, ph, layer);
  hipLaunchKernelGGL(k_phase, dim3(grid_blocks), dim3(256), 0, stream, p, (int)PH_FINAL, 0);
#endif
}
```

```cpp
#include <hip/hip_runtime.h>
#include <hip/hip_cooperative_groups.h>
#include <cstdio>
#include <cstring>
namespace cg = cooperative_groups;

#ifndef MEGA
#define MEGA 1
#endif

#define DI __device__ __forceinline__
typedef unsigned short u16;
typedef __attribute__((ext_vector_type(8))) short bf16x8;
typedef __attribute__((ext_vector_type(4))) float f32x4;

constexpr int T = 49152;
constexpr int TP = 16384;
constexpr int DM = 1024;
constexpr int INW = 2576;
constexpr int FH = 2816;
constexpr int NCH64 = T / 64;
constexpr float EPS = 1e-6f;

constexpr int C_AQ = 0, C_AK = 256, C_AV = 512, C_AZ = 768, C_BQ = 1040, C_BK = 1296, C_BV = 1552, C_CU = 1808,
              C_DQ = 2064, C_DK = 2320, C_DV = 2448;

constexpr size_t WO_IN = 0, WO_GATE = 2752512, WO_BR = 6946816, WO_OUT = 7995392, WO_GU = 9043968, WO_DN = 14811136,
                 WO_GLU = 17694720, W_LAYER = 17825792;
constexpr size_t OFF_W = 0;
constexpr size_t OFF_PROJ = 2 * W_LAYER * 2;
constexpr size_t SZ_PROJ = (size_t)T * INW * 2;
constexpr size_t OFF_R1 = OFF_PROJ + SZ_PROJ;
constexpr size_t SZ_H = (size_t)T * DM * 2;
constexpr size_t OFF_H = OFF_R1;
constexpr size_t OFF_UW = OFF_R1;
constexpr size_t OFF_QN = OFF_R1 + SZ_H;
constexpr size_t OFF_KN = OFF_QN + (size_t)T * 256 * 2;
constexpr size_t OFF_GC = OFF_KN + (size_t)T * 256 * 2;
constexpr size_t OFF_SEND = OFF_GC + (size_t)NCH64 * 8 * 64 * 4;
constexpr size_t OFF_G = OFF_SEND + (size_t)NCH64 * 2 * 1024 * 8;
constexpr size_t OFF_AB = OFF_G + (size_t)T * 256 * 2;
constexpr size_t OFF_CNT = OFF_AB + (size_t)T * 16 * 4;
constexpr size_t OFF_MERGED = OFF_R1 + SZ_H;
constexpr size_t OFF_H2 = OFF_PROJ;
constexpr size_t OFF_ACT = OFF_PROJ + SZ_H;
constexpr size_t OFF_BAR = OFF_MERGED + SZ_H;
constexpr size_t BAR_BYTES = 3456 * 4;
constexpr size_t OFF_SSQ = OFF_BAR + 16384;
constexpr size_t WS_NEED = OFF_SSQ + 5 * (size_t)T * 4;

constexpr int SMEM_BYTES = 75776;

struct ConvJob { const float* src; u16* dst; const float* kscale; int K, ncols, nrows_dst, src_ld, rs, off, ntn; };
struct Params;
DI float* ssq_buf(const Params& p, int i);
struct Params {
  const float *x_prompt, *x_sample, *norm1, *conv_a, *a_log, *dt_bias, *a_norm, *lam_re, *lam_im, *log_step, *b_re,
      *b_im, *c_re, *c_im, *s5_d, *attn_sink, *norm2, *final_norm;
  const float *w_in, *w_gate, *w_branch, *w_out, *w_ffn_gate, *w_ffn_up, *w_ffn_down, *w_glu;
  float* xout;
  char* ws;
};
constexpr int CONV_TILES_LAYER = 4352;

DI int my_tid() { int t = threadIdx.x; asm volatile("" : "+v"(t)); return t; }
DI u16 f2bf(float x) { unsigned u = __float_as_uint(x); u += 0x7fffu + ((u >> 16) & 1u); return (u16)(u >> 16); }
DI float bf2f(u16 v) { return __uint_as_float(((unsigned)v) << 16); }
DI unsigned pack2(float a, float b) { return (unsigned)f2bf(a) | ((unsigned)f2bf(b) << 16); }
DI float sigmoidf_(float x) { return 1.f / (1.f + __expf(-x)); }
DI float siluf_(float x) { return x / (1.f + __expf(-x)); }
DI float wave_sum(float v) {
#pragma unroll
  for (int o = 32; o > 0; o >>= 1) v += __shfl_xor(v, o, 64);
  return v;
}
DI int seq_lo(int t) { return t < TP ? 0 : (t & ~4095); }
DI int seq_hi(int t) { return t < TP ? TP : (t & ~4095) + 4096; }
DI const float* xrow(const Params& p, int layer, int t) {
  if (layer == 0) return t < TP ? p.x_prompt + (size_t)t * DM : p.x_sample + (size_t)(t - TP) * DM;
  return p.xout + (size_t)t * DM;
}
DI f32x4 mfma16(bf16x8 a, bf16x8 b, f32x4 c) { return __builtin_amdgcn_mfma_f32_16x16x32_bf16(a, b, c, 0, 0, 0); }

DI void mk_job(ConvJob& j, const float* src, u16* dst, int K, int ncols, int nrows_dst, int src_ld, int rs, int off,
                const float* kscale = nullptr) {
  j.kscale = kscale;
  j.src = src; j.dst = dst; j.K = K; j.ncols = ncols; j.nrows_dst = nrows_dst; j.src_ld = src_ld; j.rs = rs; j.off = off;
  j.ntn = (nrows_dst + 63) >> 6;
}
DI int conv_lookup(const Params& p, int t, ConvJob& j) {
  const int l = t / CONV_TILES_LAYER;
  int r = t % CONV_TILES_LAYER;
  u16* wl = (u16*)(p.ws + OFF_W) + (size_t)l * W_LAYER;
  if (r < 672) { mk_job(j, p.w_in + (size_t)l * DM * INW, wl + WO_IN, DM, INW, 2688, INW, 32, 0, p.norm1 + l * DM); return r; }
  r -= 672;
  if (r < 1024) { const int i = r >> 8; mk_job(j, p.w_gate + (size_t)(l * 4 + i) * DM * DM, wl + WO_GATE + (size_t)i * DM * DM, DM, DM, DM, DM, 32, 0, p.norm1 + l * DM); return r & 255; }
  r -= 1024;
  if (r < 256) { const int i = r >> 6; mk_job(j, p.w_branch + (size_t)(l * 4 + i) * 256 * DM, wl + WO_BR + (size_t)i * DM * 256, 256, DM, DM, DM, 32, 0); return r & 63; }
  r -= 256;
  if (r < 256) { mk_job(j, p.w_out + (size_t)l * DM * DM, wl + WO_OUT, DM, DM, DM, DM, 32, 0); return r; }
  r -= 256;
  if (r < 704) { mk_job(j, p.w_ffn_gate + (size_t)l * DM * FH, wl + WO_GU, DM, FH, FH, FH, 64, 0, p.norm2 + l * DM); return r; }
  r -= 704;
  if (r < 704) { mk_job(j, p.w_ffn_up + (size_t)l * DM * FH, wl + WO_GU, DM, FH, FH, FH, 64, 32, p.norm2 + l * DM); return r; }
  r -= 704;
  if (r < 704) { mk_job(j, p.w_ffn_down + (size_t)l * FH * DM, wl + WO_DN, FH, DM, DM, DM, 32, 0); return r; }
  r -= 704;
  if (r < 16) { mk_job(j, p.w_glu + (size_t)l * 256 * 512, wl + WO_GLU, 256, 256, 256, 512, 64, 0); return r; }
  r -= 16;
  mk_job(j, p.w_glu + (size_t)l * 256 * 512 + 256, wl + WO_GLU, 256, 256, 256, 512, 64, 32);
  return r;
}
DI void conv_tile(const ConvJob& j, int lt, float* tile) {
  const int tid = my_tid();
  const int tk = lt / j.ntn, tn = lt % j.ntn;
  __syncthreads();
#pragma unroll
  for (int i = 0; i < 4; ++i) {
    int r = (tid >> 4) + 16 * i, c4 = (tid & 15) * 4, n = tn * 64 + c4;
    float4 v = make_float4(0.f, 0.f, 0.f, 0.f);
    if (n < j.ncols) v = *(const float4*)(j.src + (size_t)(tk * 64 + r) * j.src_ld + n);
    if (j.kscale) { const float s = j.kscale[tk * 64 + r]; v.x *= s; v.y *= s; v.z *= s; v.w *= s; }
    tile[r * 65 + c4 + 0] = v.x; tile[r * 65 + c4 + 1] = v.y; tile[r * 65 + c4 + 2] = v.z; tile[r * 65 + c4 + 3] = v.w;
  }
  __syncthreads();
  const int cl = tid >> 2, ks = (tid & 3) * 16, n = tn * 64 + cl;
  if (n < j.nrows_dst) {
    unsigned w[8];
#pragma unroll
    for (int e = 0; e < 8; ++e) w[e] = pack2(tile[(ks + 2 * e) * 65 + cl], tile[(ks + 2 * e + 1) * 65 + cl]);
    const int nm = (n >> 5) * j.rs + (n & 31) + j.off;
    uint4* d = (uint4*)(j.dst + (size_t)nm * j.K + tk * 64 + ks);
    d[0] = make_uint4(w[0], w[1], w[2], w[3]);
    d[1] = make_uint4(w[4], w[5], w[6], w[7]);
  }
}

DI float* ssq_buf(const Params& p, int i) { return (float*)(p.ws + OFF_SSQ) + (size_t)i * T; }
DI float rstd_of(float ssq) { return rsqrtf(ssq * (1.f / DM) + EPS); }
DI void cvt_row_bf16(const float* src, u16* dst, float* ssq_out) {
  const int lane = my_tid() & 63;
  float ss = 0.f;
#pragma unroll
  for (int i = 0; i < 4; ++i) {
    const float4 v = *(const float4*)(src + i * 256 + lane * 4);
    ss += v.x * v.x + v.y * v.y + v.z * v.z + v.w * v.w;
    uint2 o; o.x = pack2(v.x, v.y); o.y = pack2(v.z, v.w);
    *(uint2*)(dst + i * 256 + lane * 4) = o;
  }
  if (ssq_out) { ss = wave_sum(ss); if (lane == 0) *ssq_out = ss; }
}
DI void cvt_phase(const Params& p, int layer, u16* dst, bool write_ssq, int b0, int nb) {
  const int wave = my_tid() >> 6;
  for (int r = b0 * 4 + wave; r < T; r += nb * 4)
    cvt_row_bf16(xrow(p, layer, r), dst + (size_t)r * DM, write_ssq ? ssq_buf(p, layer) + r : nullptr);
}

constexpr int GP = 64;
#ifndef GEMM_DMA
#define GEMM_DMA 1
#endif
#if GEMM_DMA
template <int NT, bool SPLIT = false>
DI void gemm_kloop(const u16* __restrict__ A, size_t lda, const u16* __restrict__ B, size_t ldb, int nk,
                   f32x4 (&acc)[4][NT], u16* sm) {
  const int tid = my_tid(), lane = tid & 63;
  const int wave = __builtin_amdgcn_readfirstlane(tid >> 6);
  const int fr = lane & 15, fq = lane >> 4, wr = wave >> 1, wc = wave & 1;
  u16* sa = sm;
  u16* sb = sm + 2 * 128 * 64;
  const int swz = (fr >> 1) & 7;
  const int lr = lane >> 3;
  const int lc = ((lane & 7) ^ ((lr >> 1) & 3)) * 8;
#define DMA_PIECE(BASE, LD, G, KOFF, DST)                                                              \
  {                                                                                                    \
    int lrl_ = lr;                                                                                     \
    asm volatile("" : "+v"(lrl_));   \
    const int row_ = (G) * 8 + lrl_;                                                                   \
    const int col_ = lc ^ ((((G) & 1) * 4) * 8);                                                       \
    __builtin_amdgcn_global_load_lds((const unsigned*)((BASE) + (size_t)row_ * (LD) + (KOFF) + col_),  \
                                     (unsigned*)((DST) + (G) * 512), 16, 0, 0);                        \
  }
#define DMA_TILE(KOFF, STAGE)                                                                          \
  {                                                                                                    \
    u16* da_ = sa + (STAGE) * 8192;                                                                    \
    u16* db_ = sb + (STAGE) * 8192;                                                                    \
    DMA_PIECE(A, lda, wave * 4 + 0, KOFF, da_) DMA_PIECE(A, lda, wave * 4 + 1, KOFF, da_)              \
    DMA_PIECE(A, lda, wave * 4 + 2, KOFF, da_) DMA_PIECE(A, lda, wave * 4 + 3, KOFF, da_)              \
    if (NT == 4) {                                                                                     \
      DMA_PIECE(B, ldb, wave * 4 + 0, KOFF, db_) DMA_PIECE(B, ldb, wave * 4 + 1, KOFF, db_)            \
      DMA_PIECE(B, ldb, wave * 4 + 2, KOFF, db_) DMA_PIECE(B, ldb, wave * 4 + 3, KOFF, db_)            \
    } else {                                                                                           \
      DMA_PIECE(B, ldb, wave * 2 + 0, KOFF, db_) DMA_PIECE(B, ldb, wave * 2 + 1, KOFF, db_)            \
    }                                                                                                  \
  }
  __builtin_amdgcn_s_barrier();
  DMA_TILE(0, 0)
#pragma unroll 1
  for (int kt = 0; kt < nk; ++kt) {
    const int cur = kt & 1;
    asm volatile("s_waitcnt vmcnt(0)" ::: "memory");
    __builtin_amdgcn_s_barrier();
    asm volatile("" ::: "memory");
    const u16* ca = sa + cur * 8192;
    const u16* cb = sb + cur * 8192;
    if (SPLIT) {
      bf16x8 wf[NT], xf[4];
#pragma unroll
      for (int nt = 0; nt < NT; ++nt) wf[nt] = *(const bf16x8*)(cb + (wc * NT * 16 + nt * 16 + fr) * 64 + (((0 * 4 + fq) ^ swz) * 8));
#pragma unroll
      for (int mt = 0; mt < 4; ++mt) xf[mt] = *(const bf16x8*)(ca + (wr * 64 + mt * 16 + fr) * 64 + (((0 * 4 + fq) ^ swz) * 8));
#pragma unroll
      for (int mt = 0; mt < 4; ++mt)
#pragma unroll
        for (int nt = 0; nt < NT; ++nt) acc[mt][nt] = mfma16(wf[nt], xf[mt], acc[mt][nt]);
#pragma unroll
      for (int nt = 0; nt < NT; ++nt) wf[nt] = *(const bf16x8*)(cb + (wc * NT * 16 + nt * 16 + fr) * 64 + (((1 * 4 + fq) ^ swz) * 8));
#pragma unroll
      for (int mt = 0; mt < 4; ++mt) xf[mt] = *(const bf16x8*)(ca + (wr * 64 + mt * 16 + fr) * 64 + (((1 * 4 + fq) ^ swz) * 8));
      __builtin_amdgcn_sched_barrier(0);
      if (kt + 1 < nk) DMA_TILE((kt + 1) * 64, cur ^ 1)
      __builtin_amdgcn_sched_barrier(0);
#pragma unroll
      for (int mt = 0; mt < 4; ++mt)
#pragma unroll
        for (int nt = 0; nt < NT; ++nt) acc[mt][nt] = mfma16(wf[nt], xf[mt], acc[mt][nt]);
      continue;
    }
    bf16x8 wf[2][NT], xf[2][4];
#pragma unroll
    for (int kk = 0; kk < 2; ++kk) {
#pragma unroll
      for (int nt = 0; nt < NT; ++nt) wf[kk][nt] = *(const bf16x8*)(cb + (wc * NT * 16 + nt * 16 + fr) * 64 + (((kk * 4 + fq) ^ swz) * 8));
#pragma unroll
      for (int mt = 0; mt < 4; ++mt) xf[kk][mt] = *(const bf16x8*)(ca + (wr * 64 + mt * 16 + fr) * 64 + (((kk * 4 + fq) ^ swz) * 8));
    }
    __builtin_amdgcn_sched_barrier(0);
    if (kt + 1 < nk) DMA_TILE((kt + 1) * 64, cur ^ 1)
    __builtin_amdgcn_sched_barrier(0);
    __builtin_amdgcn_s_setprio(1);
#pragma unroll
    for (int kk = 0; kk < 2; ++kk)
#pragma unroll
      for (int mt = 0; mt < 4; ++mt)
#pragma unroll
        for (int nt = 0; nt < NT; ++nt) acc[mt][nt] = mfma16(wf[kk][nt], xf[kk][mt], acc[mt][nt]);
    __builtin_amdgcn_s_setprio(0);
  }
}
#else
template <int NT>
DI void gemm_kloop(const u16* __restrict__ A, size_t lda, const u16* __restrict__ B, size_t ldb, int nk,
                   f32x4 (&acc)[4][NT], u16* sm) {
  const int tid = my_tid(), lane = tid & 63, wave = tid >> 6;
  const int fr = lane & 15, fq = lane >> 4, wr = wave >> 1, wc = wave & 1;
  u16* sa = sm;
  u16* sb = sm + 2 * 128 * GP;
  uint4 ra0, ra1, ra2, ra3, rb0, rb1, rb2 = make_uint4(0, 0, 0, 0), rb3 = make_uint4(0, 0, 0, 0);
  uint4 rc0, rc1, rc2, rc3, rd0, rd1, rd2 = make_uint4(0, 0, 0, 0), rd3 = make_uint4(0, 0, 0, 0);
  const int lrow = tid >> 3, lseg = (tid & 7) * 8;
  const int sseg = ((tid & 7) ^ ((lrow >> 1) & 7)) * 8;
  const u16* Ap = A + (size_t)lrow * lda + lseg;
  const u16* Bp = B + (size_t)lrow * ldb + lseg;
#define KL_LOAD(KOFF, A0, A1, A2, A3, B0, B1, B2, B3)                    \
  A0 = *(const uint4*)(Ap + (KOFF));                                     \
  A1 = *(const uint4*)(Ap + 32 * lda + (KOFF));                          \
  A2 = *(const uint4*)(Ap + 64 * lda + (KOFF));                          \
  A3 = *(const uint4*)(Ap + 96 * lda + (KOFF));                          \
  B0 = *(const uint4*)(Bp + (KOFF));                                     \
  B1 = *(const uint4*)(Bp + 32 * ldb + (KOFF));                          \
  if (NT > 2) { B2 = *(const uint4*)(Bp + 64 * ldb + (KOFF)); B3 = *(const uint4*)(Bp + 96 * ldb + (KOFF)); }
#define KL_STORE(SA, SB, A0, A1, A2, A3, B0, B1, B2, B3)                 \
  *(uint4*)((SA) + (lrow + 0) * GP + sseg) = A0;                         \
  *(uint4*)((SA) + (lrow + 32) * GP + sseg) = A1;                        \
  *(uint4*)((SA) + (lrow + 64) * GP + sseg) = A2;                        \
  *(uint4*)((SA) + (lrow + 96) * GP + sseg) = A3;                        \
  *(uint4*)((SB) + (lrow + 0) * GP + sseg) = B0;                         \
  *(uint4*)((SB) + (lrow + 32) * GP + sseg) = B1;                        \
  if (NT > 2) { *(uint4*)((SB) + (lrow + 64) * GP + sseg) = B2; *(uint4*)((SB) + (lrow + 96) * GP + sseg) = B3; }
#define KL_COMPUTE(CA, CB)                                                                                     \
  _Pragma("unroll") for (int kk = 0; kk < 2; ++kk) {                                                           \
    bf16x8 wf[NT], xf[4];                                                                                      \
    _Pragma("unroll") for (int nt = 0; nt < NT; ++nt)                                                          \
      wf[nt] = *(const bf16x8*)((CB) + (wc * NT * 16 + nt * 16 + fr) * GP + (((kk * 4 + fq) ^ swz) * 8));       \
    _Pragma("unroll") for (int mt = 0; mt < 4; ++mt)                                                           \
      xf[mt] = *(const bf16x8*)((CA) + (wr * 64 + mt * 16 + fr) * GP + (((kk * 4 + fq) ^ swz) * 8));            \
    _Pragma("unroll") for (int mt = 0; mt < 4; ++mt)                                                           \
    _Pragma("unroll") for (int nt = 0; nt < NT; ++nt) acc[mt][nt] = mfma16(wf[nt], xf[mt], acc[mt][nt]);      \
  }
  const int swz = (fr >> 1) & 7;
  KL_LOAD(0, ra0, ra1, ra2, ra3, rb0, rb1, rb2, rb3)
  KL_LOAD(64, rc0, rc1, rc2, rc3, rd0, rd1, rd2, rd3)
  KL_STORE(sa, sb, ra0, ra1, ra2, ra3, rb0, rb1, rb2, rb3)
  __syncthreads();
  u16* sa1 = sa + 128 * GP;
  u16* sb1 = sb + 128 * GP;
#pragma unroll 1
  for (int kt = 0; kt < nk; kt += 2) {
    const int k2 = (kt + 2 < nk ? kt + 2 : kt) * 64, k3 = (kt + 3 < nk ? kt + 3 : kt + 1) * 64;
    KL_LOAD(k2, ra0, ra1, ra2, ra3, rb0, rb1, rb2, rb3)
    __builtin_amdgcn_sched_barrier(0);
    KL_COMPUTE(sa, sb)
    KL_STORE(sa1, sb1, rc0, rc1, rc2, rc3, rd0, rd1, rd2, rd3)
    __syncthreads();
    KL_LOAD(k3, rc0, rc1, rc2, rc3, rd0, rd1, rd2, rd3)
    __builtin_amdgcn_sched_barrier(0);
    KL_COMPUTE(sa1, sb1)
    KL_STORE(sa, sb, ra0, ra1, ra2, ra3, rb0, rb1, rb2, rb3)
    __syncthreads();
  }
}
#endif
template <int NT>
DI void zero_acc(f32x4 (&acc)[4][NT]) {
#pragma unroll
  for (int a = 0; a < 4; ++a)
#pragma unroll
    for (int b = 0; b < NT; ++b) acc[a][b] = (f32x4){0.f, 0.f, 0.f, 0.f};
}

struct TileIter {
  int step, nsteps, nfull, nrx, nct, pwl, x, local, mode, idx, stride, L;
  DI void init(int nrt, int nct_, int b, int G) {
    nct = nct_;
    if (G == 512 && (nrt % 64) == 0) {
      mode = 1; x = b & 7; local = b >> 3;
      nrx = nrt / 8;
      const int fullp = nct >> 3;
      pwl = nct & 7;
      nfull = fullp * (nrx / 8);
      nsteps = nfull + (pwl ? (nrx * pwl + 63) / 64 : 0);
      step = 0;
      skip();
    } else {
      mode = 0; idx = b; stride = G; L = nrt * nct;
    }
  }
  DI bool in_range() const { return step < nfull || (step - nfull) * 64 + local < nrx * pwl; }
  DI void skip() { while (step < nsteps && !in_range()) ++step; }
  DI bool valid() const { return mode ? step < nsteps : idx < L; }
  DI int rt() const {
    if (!mode) return idx / nct;
    const int nrb = nrx / 8;
    const int ri = step < nfull ? (step % nrb) * 8 + (local >> 3) : ((step - nfull) * 64 + local) / pwl;
    return x + 8 * ri;
  }
  DI int ct() const {
    if (!mode) return idx % nct;
    const int nrb = nrx / 8;
    return step < nfull ? (step / nrb) * 8 + (local & 7) : (nct & ~7) + ((step - nfull) * 64 + local) % pwl;
  }
  DI void next() { if (mode) { ++step; skip(); } else idx += stride; }
};

#define EPI_COORDS                                                       \
  const int lane = my_tid() & 63, wave = my_tid() >> 6;           \
  const int fr = lane & 15, fq = lane >> 4, wr = wave >> 1, wc = wave & 1; \
  (void)fr; (void)fq; (void)wr; (void)wc;

DI void gemm_inproj(const Params& p, int layer, int b, int G, u16* sm) {
  const u16* H = (const u16*)(p.ws + OFF_H);
  const u16* W = (const u16*)(p.ws + OFF_W) + layer * W_LAYER + WO_IN;
  u16* proj = (u16*)(p.ws + OFF_PROJ);
  float* AB = (float*)(p.ws + OFF_AB);
  EPI_COORDS
  TileIter it; it.init(T / 128, 21, b, G);
  for (; it.valid(); it.next()) {
    const int row0 = it.rt() * 128, col0 = it.ct() * 128;
    f32x4 acc[4][4]; zero_acc<4>(acc);
    gemm_kloop<4>(H + (size_t)row0 * DM, DM, W + (size_t)col0 * DM, DM, 16, acc, sm);
#pragma unroll
    for (int mt = 0; mt < 4; ++mt) {
      const int row = row0 + wr * 64 + mt * 16 + fr;
      const float rs = rstd_of(ssq_buf(p, layer)[row]);
#pragma unroll
      for (int nt = 0; nt < 4; ++nt) {
        const int col = col0 + wc * 64 + nt * 16 + fq * 4;
        acc[mt][nt] *= rs;
        if (col < INW) {
          uint2 o; o.x = pack2(acc[mt][nt][0], acc[mt][nt][1]); o.y = pack2(acc[mt][nt][2], acc[mt][nt][3]);
          *(uint2*)(proj + (size_t)row * INW + col) = o;
          if (col >= 1024 && col < 1040)
            *(float4*)(AB + (size_t)row * 16 + (col - 1024)) = make_float4(acc[mt][nt][0], acc[mt][nt][1], acc[mt][nt][2], acc[mt][nt][3]);
        }
      }
    }
  }
}

DI void gemm_glu(const Params& p, int layer, int b, int G, u16* sm) {
  const u16* Gb = (const u16*)(p.ws + OFF_G);
  const u16* W = (const u16*)(p.ws + OFF_W) + layer * W_LAYER + WO_GLU;
  u16* proj = (u16*)(p.ws + OFF_PROJ);
  EPI_COORDS
  TileIter it; it.init(T / 128, 4, b, G);
  for (; it.valid(); it.next()) {
    const int row0 = it.rt() * 128, ct = it.ct();
    f32x4 acc[4][4]; zero_acc<4>(acc);
    gemm_kloop<4>(Gb + (size_t)row0 * 256, 256, W + (size_t)ct * 128 * 256, 256, 4, acc, sm);
#pragma unroll
    for (int mt = 0; mt < 4; ++mt) {
      const int row = row0 + wr * 64 + mt * 16 + fr;
#pragma unroll
      for (int nt = 0; nt < 2; ++nt) {
        const int col = (ct * 2 + wc) * 32 + nt * 16 + fq * 4;
        float o[4];
#pragma unroll
        for (int j = 0; j < 4; ++j) o[j] = acc[mt][nt][j] * sigmoidf_(acc[mt][nt + 2][j]);
        uint2 ov; ov.x = pack2(o[0], o[1]); ov.y = pack2(o[2], o[3]);
        *(uint2*)(proj + (size_t)row * INW + C_CU + col) = ov;
      }
    }
  }
}

DI void gemm_merge(const Params& p, int layer, int b, int G, u16* sm) {
  const u16* H = (const u16*)(p.ws + OFF_H);
  const u16* Wg = (const u16*)(p.ws + OFF_W) + layer * W_LAYER + WO_GATE;
  const u16* Wb = (const u16*)(p.ws + OFF_W) + layer * W_LAYER + WO_BR;
  const u16* proj = (const u16*)(p.ws + OFF_PROJ);
  u16* merged = (u16*)(p.ws + OFF_MERGED);
  EPI_COORDS
  TileIter it; it.init(T / 128, 8, b, G);
  for (; it.valid(); it.next()) {
    const int row0 = it.rt() * 128, col0 = it.ct() * 128;
    uint2 mg[4][4];
#pragma unroll
    for (int a = 0; a < 4; ++a)
#pragma unroll
      for (int c = 0; c < 4; ++c) mg[a][c] = make_uint2(0u, 0u);
#pragma unroll 1
    for (int i = 0; i < 4; ++i) {
      const int ocol = (i == 0) ? C_AZ : (i == 1) ? C_BQ : (i == 2) ? C_CU : C_DQ;
      f32x4 acc[4][4]; zero_acc<4>(acc);
      gemm_kloop<4, true>(H + (size_t)row0 * DM, DM, Wg + (size_t)i * DM * DM + (size_t)col0 * DM, DM, 16, acc, sm);
      uint2 sg[4][4];
#pragma unroll
      for (int a = 0; a < 4; ++a) {
        const float rs = rstd_of(ssq_buf(p, layer)[row0 + wr * 64 + a * 16 + fr]);
#pragma unroll
        for (int c = 0; c < 4; ++c) {
          sg[a][c].x = pack2(sigmoidf_(rs * acc[a][c][0]), sigmoidf_(rs * acc[a][c][1]));
          sg[a][c].y = pack2(sigmoidf_(rs * acc[a][c][2]), sigmoidf_(rs * acc[a][c][3]));
        }
      }
      zero_acc<4>(acc);
      gemm_kloop<4, true>(proj + (size_t)row0 * INW + ocol, INW, Wb + (size_t)i * DM * 256 + (size_t)col0 * 256, 256, 4, acc, sm);
#pragma unroll
      for (int a = 0; a < 4; ++a)
#pragma unroll
        for (int c = 0; c < 4; ++c) {
          const float m0 = bf2f((u16)(mg[a][c].x & 0xffff)) + bf2f((u16)(sg[a][c].x & 0xffff)) * acc[a][c][0];
          const float m1 = bf2f((u16)(mg[a][c].x >> 16)) + bf2f((u16)(sg[a][c].x >> 16)) * acc[a][c][1];
          const float m2 = bf2f((u16)(mg[a][c].y & 0xffff)) + bf2f((u16)(sg[a][c].y & 0xffff)) * acc[a][c][2];
          const float m3 = bf2f((u16)(mg[a][c].y >> 16)) + bf2f((u16)(sg[a][c].y >> 16)) * acc[a][c][3];
          mg[a][c].x = pack2(m0, m1); mg[a][c].y = pack2(m2, m3);
        }
    }
#pragma unroll
    for (int mt = 0; mt < 4; ++mt) {
      const int row = row0 + wr * 64 + mt * 16 + fr;
#pragma unroll
      for (int nt = 0; nt < 4; ++nt) {
        const int col = col0 + wc * 64 + nt * 16 + fq * 4;
        *(uint2*)(merged + (size_t)row * DM + col) = mg[mt][nt];
      }
    }
  }
}

DI void gemm_resid(const Params& p, int layer_src, const u16* A, int K, const u16* W, int b, int G, u16* sm, u16* xb_out,
                   float* ssq_acc) {
  EPI_COORDS
  TileIter it; it.init(T / 128, 8, b, G);
  for (; it.valid(); it.next()) {
    const int row0 = it.rt() * 128, col0 = it.ct() * 128;
    f32x4 acc[4][4]; zero_acc<4>(acc);
    gemm_kloop<4>(A + (size_t)row0 * K, K, W + (size_t)col0 * K, K, K / 64, acc, sm);
#pragma unroll
    for (int mt = 0; mt < 4; ++mt) {
      const int row = row0 + wr * 64 + mt * 16 + fr;
      const float* xs = xrow(p, layer_src, row);
      float* xd = p.xout + (size_t)row * DM;
      float ss = 0.f;
#pragma unroll
      for (int nt = 0; nt < 4; ++nt) {
        const int col = col0 + wc * 64 + nt * 16 + fq * 4;
        float4 r = *(const float4*)(xs + col);
        r.x += acc[mt][nt][0]; r.y += acc[mt][nt][1]; r.z += acc[mt][nt][2]; r.w += acc[mt][nt][3];
        *(float4*)(xd + col) = r;
        ss += r.x * r.x + r.y * r.y + r.z * r.z + r.w * r.w;
        if (xb_out) { uint2 o; o.x = pack2(r.x, r.y); o.y = pack2(r.z, r.w); *(uint2*)(xb_out + (size_t)row * DM + col) = o; }
      }
      if (ssq_acc) {
        ss += __shfl_xor(ss, 16, 64);
        ss += __shfl_xor(ss, 32, 64);
        if (fq == 0) atomicAdd(ssq_acc + row, ss);
      }
    }
  }
}

DI void gemm_ffn1(const Params& p, int layer, int b, int G, u16* sm) {
  const u16* H = (const u16*)(p.ws + OFF_H2);
  const u16* W = (const u16*)(p.ws + OFF_W) + layer * W_LAYER + WO_GU;
  u16* act = (u16*)(p.ws + OFF_ACT);
  EPI_COORDS
  TileIter it; it.init(T / 128, 44, b, G);
  for (; it.valid(); it.next()) {
    const int row0 = it.rt() * 128, ct = it.ct();
    f32x4 acc[4][4]; zero_acc<4>(acc);
    gemm_kloop<4>(H + (size_t)row0 * DM, DM, W + (size_t)ct * 128 * DM, DM, 16, acc, sm);
#pragma unroll
    for (int mt = 0; mt < 4; ++mt) {
      const int row = row0 + wr * 64 + mt * 16 + fr;
      const float rs = rstd_of(ssq_buf(p, 2 + layer)[row]);
#pragma unroll
      for (int nt = 0; nt < 2; ++nt) {
        const int col = (ct * 2 + wc) * 32 + nt * 16 + fq * 4;
        float o[4];
#pragma unroll
        for (int j = 0; j < 4; ++j) o[j] = siluf_(rs * acc[mt][nt][j]) * (rs * acc[mt][nt + 2][j]);
        uint2 ov; ov.x = pack2(o[0], o[1]); ov.y = pack2(o[2], o[3]);
        *(uint2*)(act + (size_t)row * FH + col) = ov;
      }
    }
  }
}

DI f32x4 mma_t(const u16* X, int xr, const u16* Y, int yr, f32x4 acc, int fr, int fq);
DI void gdn_pre(const Params& p, int layer, int task, char* smem) {
  const int tid = my_tid(), lane = tid & 63, wave = tid >> 6;
  const int fr = lane & 15, fq = lane >> 4;
  const int n = task >> 2, h = task & 3, c0 = n * 64;
  const int lo = seq_lo(c0), hi = seq_hi(c0);
  float* ks = (float*)smem;
  float* vs = ks + 64 * 65;
  u16* Kb = (u16*)vs;
  float* AmT = vs + 64 * 65;
  float* gcs = AmT + 2 * 64 * 68;
  float* bts = gcs + 128;
  const u16* proj = (const u16*)(p.ws + OFF_PROJ);
  u16* QN = (u16*)(p.ws + OFF_QN);
  u16* KN = (u16*)(p.ws + OFF_KN);
  float* GC = (float*)(p.ws + OFF_GC);
  const float* AB = (const float*)(p.ws + OFF_AB);
  u16* UW = (u16*)(p.ws + OFF_UW);
  __syncthreads();
#define GDN_CONV(MAT)                                                                                \
  {                                                                                                  \
    const int ch = (MAT) * 256 + h * 64 + lane;                                                      \
    float w[5];                                                                                      \
    _Pragma("unroll") for (int j = 0; j < 5; ++j) w[j] = p.conv_a[(size_t)(layer * 5 + j) * 768 + ch]; \
    float raw[20];                                                                                   \
    _Pragma("unroll") for (int i = 0; i < 20; ++i) {                                                 \
      const int tok = c0 + wave * 16 + i - 2;                                                        \
      raw[i] = (tok >= lo && tok < hi) ? bf2f(proj[(size_t)tok * INW + ch]) : 0.f;                   \
    }                                                                                                \
    _Pragma("unroll") for (int i = 0; i < 16; ++i) {                                                 \
      float v = 0.f;                                                                                 \
      _Pragma("unroll") for (int j = 0; j < 5; ++j) v += raw[i + j] * w[j];                          \
      v = siluf_(v);                                                                                 \
      const int tl = wave * 16 + i;                                                                  \
      if ((MAT) < 2) {                                                                               \
        const float ss = wave_sum(v * v);                                                            \
        v *= rsqrtf(ss + EPS) * ((MAT) == 0 ? 0.125f : 1.f);                                         \
      }                                                                                              \
      if ((MAT) == 0) QN[(size_t)(c0 + tl) * 256 + h * 64 + lane] = f2bf(v);                         \
      else if ((MAT) == 1) {                                                                         \
        const u16 kb = f2bf(v);                                                                      \
        KN[(size_t)(c0 + tl) * 256 + h * 64 + lane] = kb; ks[tl * 65 + lane] = v; Kb[tl * 72 + lane] = kb; \
      } else vs[tl * 65 + lane] = v;                                                                 \
    }                                                                                                \
  }
  GDN_CONV(0)
  GDN_CONV(1)
  if (wave < 2) {
    const int d = wave;
    const int tok = c0 + (d ? 63 - lane : lane);
    const float al = AB[(size_t)tok * 16 + d * 4 + h];
    const float br = AB[(size_t)tok * 16 + 8 + d * 4 + h];
    const float xx = al + p.dt_bias[(layer * 2 + d) * 4 + h];
    const float sp = fmaxf(xx, 0.f) + log1pf(__expf(-fabsf(xx)));
    float g = -__expf(p.a_log[(layer * 2 + d) * 4 + h]) * sp;
#pragma unroll
    for (int o = 1; o < 64; o <<= 1) {
      const float t = __shfl_up(g, o, 64);
      if (lane >= o) g += t;
    }
    gcs[d * 64 + lane] = g;
    bts[d * 64 + lane] = sigmoidf_(br);
    GC[(size_t)(task * 2 + d) * 64 + lane] = g;
  }
  __syncthreads();
#pragma unroll
  for (int t = 0; t < 4; ++t) {
    if (t <= wave) {
      const f32x4 kk = mma_t(Kb, wave * 16, Kb, t * 16, (f32x4){0.f, 0.f, 0.f, 0.f}, fr, fq);
      const int b = t * 16 + fr;
      const float gb0 = gcs[b], gb1 = gcs[64 + 63 - b], bt1 = bts[64 + 63 - b];
#pragma unroll
      for (int j = 0; j < 4; ++j) {
        const int a = wave * 16 + fq * 4 + j;
        if (a > b) {
          AmT[b * 68 + a] = bts[a] * kk[j] * __expf(gcs[a] - gb0);
          const int i1 = 63 - b, j1 = 63 - a;
          AmT[64 * 68 + j1 * 68 + i1] = bt1 * kk[j] * __expf(gb1 - gcs[64 + j1]);
        }
      }
    }
  }
  __syncthreads();
  GDN_CONV(2)
  __syncthreads();
  {
    int d = tid >> 7, c = tid & 127;
    asm volatile("" : "+v"(d), "+v"(c));
    float r[64];
    {
      const int stride = d ? -65 : 65;
      int off = (d ? 63 * 65 : 0) + (c & 63);
      const float* srcm = (c < 64) ? vs : ks;
      const bool isw = c >= 64;
#pragma unroll
      for (int i = 0; i < 64; ++i) {
        float v = srcm[off] * bts[d * 64 + i];
        if (isw) v *= __expf(gcs[d * 64 + i]);
        r[i] = v;
        off += stride;
        asm volatile("" : "+v"(off));
        if ((i & 7) == 7) __builtin_amdgcn_sched_barrier(0);
      }
    }
    const float* Ad = AmT + d * 64 * 68;
#pragma unroll
    for (int j = 0; j < 63; ++j) {
      const float rj = r[j];
#pragma unroll
      for (int i = j + 1; i < 64; ++i) {
        r[i] = fmaf(-Ad[j * 68 + i], rj, r[i]);
        if ((i & 15) == 15) __builtin_amdgcn_sched_barrier(0);
      }
      __builtin_amdgcn_sched_barrier(0);
    }
    u16* base = UW + (size_t)(task * 2 + d) * 8192;
    if (c < 64) {
      uint4* dst = (uint4*)(base + c * 64);
#pragma unroll
      for (int q = 0; q < 8; ++q)
        dst[q] = make_uint4(pack2(r[8 * q], r[8 * q + 1]), pack2(r[8 * q + 2], r[8 * q + 3]), pack2(r[8 * q + 4], r[8 * q + 5]),
                            pack2(r[8 * q + 6], r[8 * q + 7]));
    } else {
      u16* dst = base + 4096 + (c - 64);
#pragma unroll
      for (int i = 0; i < 64; ++i) dst[i * 64] = f2bf(r[i]);
    }
  }
}

DI f32x4 mma_t(const u16* X, int xr, const u16* Y, int yr, f32x4 acc, int fr, int fq) {
#pragma unroll
  for (int kk = 0; kk < 2; ++kk) {
    const bf16x8 x = *(const bf16x8*)(X + (xr + fr) * 72 + kk * 32 + fq * 8);
    const bf16x8 y = *(const bf16x8*)(Y + (yr + fr) * 72 + kk * 32 + fq * 8);
    acc = mfma16(x, y, acc);
  }
  return acc;
}
DI f32x4 mma_t_swz(const u16* X, int xr, const u16* Y, int yr, f32x4 acc, int fr, int fq) {
  const int sw = ((xr + fr) >> 3) & 7;
#pragma unroll
  for (int kk = 0; kk < 2; ++kk) {
    const bf16x8 x = *(const bf16x8*)(X + (xr + fr) * 72 + (((kk * 4 + fq) ^ sw) * 8));
    const bf16x8 y = *(const bf16x8*)(Y + (yr + fr) * 72 + kk * 32 + fq * 8);
    acc = mfma16(x, y, acc);
  }
  return acc;
}

DI void gdn_scan(const Params& p, int item, char* smem) {
  const int tid = my_tid(), lane = tid & 63, w = tid >> 6;
  const int fr = lane & 15, fq = lane >> 4;
  const int chain = item >> 2, eq = item & 3;
  const int s = chain >> 3, h = (chain >> 1) & 3, d = chain & 1;
  const int sb = s == 0 ? 0 : TP + (s - 1) * 4096;
  const int nch = s == 0 ? 256 : 64;
  u16* St = (u16*)smem;
  u16* Vt = St + 16 * 72;
  u16* Vts = Vt + 16 * 72;
  u16* Wc = Vts + 16 * 72;
  u16* Qc = Wc + 64 * 72;
  u16* Kc = Qc + 64 * 72;
  u16* KcT = Kc + 64 * 72;
  u16* QKm = KcT + 64 * 72;
  float* gcs = (float*)(QKm + 64 * 72);
  u16* proj = (u16*)(p.ws + OFF_PROJ);
  const u16* QN = (const u16*)(p.ws + OFF_QN);
  const u16* KN = (const u16*)(p.ws + OFF_KN);
  const float* GC = (const float*)(p.ws + OFF_GC);
  const u16* UW = (const u16*)(p.ws + OFF_UW);
  __syncthreads();
  for (int i = tid; i < 16 * 72; i += 256) St[i] = 0;
  f32x4 S0 = (f32x4){0.f, 0.f, 0.f, 0.f};
  const int prow0 = tid >> 3, prow1 = (tid >> 3) + 32, pseg = (tid & 7) * 8;
  uint4 w0a, w1a, q0a, q1a, k0a, k1a, w0b, w1b, q0b, q1b, k0b, k1b;
  uint2 u0a, u0b;
  float ga, gb;
#define GDN_PREFETCH2(J, S)                                                                          \
  {                                                                                                  \
    const int jj_ = (J) < nch ? (J) : nch - 1;                                                       \
    const int n_ = sb / 64 + (d ? nch - 1 - jj_ : jj_);                                              \
    const int c0_ = n_ * 64;                                                                         \
    const size_t tb_ = (size_t)((n_ * 4 + h) * 2 + d);                                               \
    const u16* ub_ = UW + tb_ * 8192;                                                                \
    const int tok0_ = c0_ + (d ? 63 - prow0 : prow0), tok1_ = c0_ + (d ? 63 - prow1 : prow1);        \
    w0##S = *(const uint4*)(ub_ + 4096 + prow0 * 64 + pseg);                                         \
    w1##S = *(const uint4*)(ub_ + 4096 + prow1 * 64 + pseg);                                         \
    q0##S = *(const uint4*)(QN + (size_t)tok0_ * 256 + h * 64 + pseg);                               \
    q1##S = *(const uint4*)(QN + (size_t)tok1_ * 256 + h * 64 + pseg);                               \
    k0##S = *(const uint4*)(KN + (size_t)tok0_ * 256 + h * 64 + pseg);                               \
    k1##S = *(const uint4*)(KN + (size_t)tok1_ * 256 + h * 64 + pseg);                               \
    u0##S = *(const uint2*)(ub_ + (eq * 16 + fr) * 64 + w * 16 + fq * 4);                            \
    g##S = GC[tb_ * 64 + lane];                                                                      \
  }
#define GDN_STAGE2(ROW, PW, PQ, PK)                                                                  \
  {                                                                                                  \
    *(uint4*)(Wc + (ROW) * 72 + pseg) = PW;                                                          \
    *(uint4*)(Qc + (ROW) * 72 + pseg) = PQ;                                                          \
    *(uint4*)(Kc + (ROW) * 72 + pseg) = PK;                                                          \
    u16* kt_ = KcT + pseg * 72 + ((((ROW) >> 3) ^ (tid & 7)) * 8) + ((ROW) & 7);                     \
    kt_[0 * 72] = (u16)(PK.x & 0xffff); kt_[1 * 72] = (u16)(PK.x >> 16);                             \
    kt_[2 * 72] = (u16)(PK.y & 0xffff); kt_[3 * 72] = (u16)(PK.y >> 16);                             \
    kt_[4 * 72] = (u16)(PK.z & 0xffff); kt_[5 * 72] = (u16)(PK.z >> 16);                             \
    kt_[6 * 72] = (u16)(PK.w & 0xffff); kt_[7 * 72] = (u16)(PK.w >> 16);                             \
  }
#define GDN_STEP(JV, S)                                                                              \
  {                                                                                                  \
    const int j_ = (JV);                                                                             \
    const int n = sb / 64 + (d ? nch - 1 - j_ : j_);                                                 \
    const int c0 = n * 64;                                                                           \
    GDN_STAGE2(prow0, w0##S, q0##S, k0##S)                                                           \
    GDN_STAGE2(prow1, w1##S, q1##S, k1##S)                                                           \
    if (tid < 64) gcs[tid] = g##S;                                                                   \
    const uint2 cu0 = u0##S;                                                                         \
    __syncthreads();                                                                          \
    GDN_PREFETCH2(j_ + 2, S)                                                                         \
    const f32x4 z4 = (f32x4){0.f, 0.f, 0.f, 0.f};                                                    \
    const f32x4 P1a = mma_t(Wc, w * 16, St, 0, z4, fr, fq);                                          \
    const f32x4 P2a = mma_t(St, 0, Qc, w * 16, z4, fr, fq);                                          \
      \
    const float glog = gcs[63];                                                                      \
    const float gcc = gcs[w * 16 + fr];                                                              \
    const float4 gq0 = *(const float4*)(gcs + fq * 4), gq1 = *(const float4*)(gcs + 16 + fq * 4);    \
    const float4 gq2 = *(const float4*)(gcs + 32 + fq * 4), gq3 = *(const float4*)(gcs + 48 + fq * 4); \
    const float4 gw = *(const float4*)(gcs + w * 16 + fq * 4);                                       \
    {                                                                                                \
      const int c = w * 16 + fr;                                                                     \
      _Pragma("unroll") for (int t = 0; t < 4; ++t) {                                                \
        const f32x4 qk = mma_t(Kc, t * 16, Qc, w * 16, z4, fr, fq);                                  \
        const int s0 = t * 16 + fq * 4;                                                              \
        const float4 gs = t == 0 ? gq0 : t == 1 ? gq1 : t == 2 ? gq2 : gq3;                          \
        const float e0 = __expf(fminf(gcc - gs.x, 0.f)), e1 = __expf(fminf(gcc - gs.y, 0.f));       \
        const float e2 = __expf(fminf(gcc - gs.z, 0.f)), e3 = __expf(fminf(gcc - gs.w, 0.f));       \
        const float v0 = (c >= s0 + 0) ? qk[0] * e0 : 0.f;                                           \
        const float v1 = (c >= s0 + 1) ? qk[1] * e1 : 0.f;                                           \
        const float v2 = (c >= s0 + 2) ? qk[2] * e2 : 0.f;                                           \
        const float v3 = (c >= s0 + 3) ? qk[3] * e3 : 0.f;                                           \
        uint2 o; o.x = pack2(v0, v1); o.y = pack2(v2, v3);                                           \
        *(uint2*)(QKm + c * 72 + s0) = o;                                                            \
      }                                                                                              \
    }                                                                                                \
    {                                                                                                \
      const int cc0 = w * 16 + fq * 4;                                                               \
      const float v0 = bf2f((u16)(cu0.x & 0xffff)) - P1a[0], v1 = bf2f((u16)(cu0.x >> 16)) - P1a[1]; \
      const float v2 = bf2f((u16)(cu0.y & 0xffff)) - P1a[2], v3 = bf2f((u16)(cu0.y >> 16)) - P1a[3]; \
      uint2 o; o.x = pack2(v0, v1); o.y = pack2(v2, v3);                                             \
      *(uint2*)(Vt + fr * 72 + cc0) = o;                                                             \
      uint2 o2;                                                                                      \
      o2.x = pack2(v0 * __expf(glog - gw.x), v1 * __expf(glog - gw.y));                              \
      o2.y = pack2(v2 * __expf(glog - gw.z), v3 * __expf(glog - gw.w));                              \
      *(uint2*)(Vts + fr * 72 + cc0) = o2;                                                           \
    }                                                                                                \
    __syncthreads();                                                                          \
    {                                                                                                \
      const int c = w * 16 + fr;                                                                     \
      const float eg = __expf(gcc);                                                                  \
      const int tok = c0 + (d ? 63 - c : c);                                                         \
      u16* orow = proj + (size_t)tok * INW + d * 256 + h * 64 + eq * 16 + fq * 4;                    \
      f32x4 oa = P2a * eg;                                                                           \
      oa = mma_t(Vt, 0, QKm, w * 16, oa, fr, fq);                                                    \
      uint2 o; o.x = pack2(oa[0], oa[1]); o.y = pack2(oa[2], oa[3]);                                 \
      *(uint2*)(orow) = o;                                                                           \
    }                                                                                                \
    {                                                                                                \
      const float gl = __expf(glog);                                                                 \
      S0 *= gl;                                                                                      \
      S0 = mma_t_swz(KcT, w * 16, Vts, 0, S0, fr, fq);                                               \
      const int r0 = w * 16 + fq * 4;                                                                \
      uint2 o; o.x = pack2(S0[0], S0[1]); o.y = pack2(S0[2], S0[3]);                                 \
      *(uint2*)(St + fr * 72 + r0) = o;                                                              \
    }                                                                                                \
    __syncthreads();                                                                          \
  }
  GDN_PREFETCH2(0, a)
  GDN_PREFETCH2(1, b)
  for (int j = 0; j < nch; j += 2) {
    GDN_STEP(j, a)
    GDN_STEP(j + 1, b)
  }
}

DI void gdn_post_row(const Params& p, int layer, int t) {
  const int lane = my_tid() & 63;
  u16* row = (u16*)(p.ws + OFF_PROJ) + (size_t)t * INW;
  const uint2 f = *(const uint2*)(row + lane * 4);
  const uint2 bw = *(const uint2*)(row + 256 + lane * 4);
  const uint2 z = *(const uint2*)(row + C_AZ + lane * 4);
  float o[4], zz[4];
  o[0] = bf2f((u16)(f.x & 0xffff)) + bf2f((u16)(bw.x & 0xffff));
  o[1] = bf2f((u16)(f.x >> 16)) + bf2f((u16)(bw.x >> 16));
  o[2] = bf2f((u16)(f.y & 0xffff)) + bf2f((u16)(bw.y & 0xffff));
  o[3] = bf2f((u16)(f.y >> 16)) + bf2f((u16)(bw.y >> 16));
  zz[0] = bf2f((u16)(z.x & 0xffff)); zz[1] = bf2f((u16)(z.x >> 16)); zz[2] = bf2f((u16)(z.y & 0xffff)); zz[3] = bf2f((u16)(z.y >> 16));
  float ss = o[0] * o[0] + o[1] * o[1] + o[2] * o[2] + o[3] * o[3];
#pragma unroll
  for (int m = 1; m < 16; m <<= 1) ss += __shfl_xor(ss, m, 64);
  const float rs = rsqrtf(ss * (1.f / 64.f) + EPS);
  const int e0 = (lane & 15) * 4;
  float r[4];
#pragma unroll
  for (int j = 0; j < 4; ++j) r[j] = o[j] * rs * p.a_norm[layer * 64 + e0 + j] * siluf_(zz[j]);
  uint2 ov; ov.x = pack2(r[0], r[1]); ov.y = pack2(r[2], r[3]);
  *(uint2*)(row + C_AZ + lane * 4) = ov;
}

struct S5Const { float are, aim; float bpr[16], bpi[16]; };
DI void s5_consts(const Params& p, int layer, int d, int g, int lane, S5Const& k, float& lr, float& li, float& step) {
  const int gi = ((layer * 2 + d) * 16 + g);
  lr = p.lam_re[(size_t)gi * 64 + lane];
  li = p.lam_im[(size_t)gi * 64 + lane];
  step = expf(p.log_step[gi]);
  const float mag = expf(lr * step);
  float sn, cs; sincosf(li * step, &sn, &cs);
  k.are = mag * cs; k.aim = mag * sn;
  const float inv = 1.f / (lr * lr + li * li);
  const float ir = lr * inv, ii = -li * inv;
  const float cr = (k.are - 1.f) * ir - k.aim * ii;
  const float ci = (k.are - 1.f) * ii + k.aim * ir;
  const float* br = p.b_re + ((size_t)(layer * 16 + g) * 64 + lane) * 16;
  const float* bi = p.b_im + ((size_t)(layer * 16 + g) * 64 + lane) * 16;
#pragma unroll
  for (int c = 0; c < 16; ++c) {
    const float a = br[c], b = bi[c];
    k.bpr[c] = cr * a - ci * b;
    k.bpi[c] = cr * b + ci * a;
  }
}
DI void s5_stage_u(const Params& p, int c0, int gq, float* us) {
  const u16* proj = (const u16*)(p.ws + OFF_PROJ);
  const int tid = my_tid();
#pragma unroll
  for (int i = 0; i < 4; ++i) {
    const int idx = tid + 256 * i, tok = idx >> 4, c4 = (idx & 15) * 4;
    const uint2 v = *(const uint2*)(proj + (size_t)(c0 + tok) * INW + C_CU + gq * 64 + c4);
    us[tok * 64 + c4 + 0] = bf2f((u16)(v.x & 0xffff));
    us[tok * 64 + c4 + 1] = bf2f((u16)(v.x >> 16));
    us[tok * 64 + c4 + 2] = bf2f((u16)(v.y & 0xffff));
    us[tok * 64 + c4 + 3] = bf2f((u16)(v.y >> 16));
  }
}
DI void s5_step(const S5Const& k, const float* u, float& sr, float& si) {
  float xr = 0.f, xi = 0.f;
#pragma unroll
  for (int c4 = 0; c4 < 4; ++c4) {
    const float4 uu = *(const float4*)(u + c4 * 4);
    xr += k.bpr[c4 * 4 + 0] * uu.x + k.bpr[c4 * 4 + 1] * uu.y + k.bpr[c4 * 4 + 2] * uu.z + k.bpr[c4 * 4 + 3] * uu.w;
    xi += k.bpi[c4 * 4 + 0] * uu.x + k.bpi[c4 * 4 + 1] * uu.y + k.bpi[c4 * 4 + 2] * uu.z + k.bpi[c4 * 4 + 3] * uu.w;
  }
  const float nr = k.are * sr - k.aim * si + xr;
  const float ni = k.are * si + k.aim * sr + xi;
  sr = nr; si = ni;
}
DI void s5_pass1(const Params& p, int layer, int task, char* smem) {
  const int lane = my_tid() & 63, wave = my_tid() >> 6;
  const int n = task >> 2, gq = task & 3, g = gq * 4 + wave, c0 = n * 64;
  float* us = (float*)smem;
  float2* SEND = (float2*)(p.ws + OFF_SEND);
  __syncthreads();
  s5_stage_u(p, c0, gq, us);
  __syncthreads();
#pragma unroll 1
  for (int d = 0; d < 2; ++d) {
    S5Const k; float lr, li, step;
    s5_consts(p, layer, d, g, lane, k, lr, li, step);
    float sr = 0.f, si = 0.f;
#pragma unroll 4
    for (int i = 0; i < 64; ++i) {
      const int t = d ? 63 - i : i;
      s5_step(k, us + t * 64 + wave * 16, sr, si);
    }
    SEND[((size_t)(n * 2 + d) * 16 + g) * 64 + lane] = make_float2(sr, si);
  }
}
DI float gelu_tanh(float x) {
  const float u = 0.7978845608028654f * (x + 0.044715f * x * x * x);
  return 0.5f * x * (1.f + tanhf(u));
}
DI void s5_pass3(const Params& p, int layer, int task, char* smem) {
  const int lane = my_tid() & 63, wave = my_tid() >> 6;
  const int fr = lane & 15, fq = lane >> 4;
  const int n = task >> 2, gq = task & 3, g = gq * 4 + wave, c0 = n * 64;
  const int nlo = seq_lo(c0) / 64, nhi = seq_hi(c0) / 64;
  float* us = (float*)smem;
  u16* Sb = (u16*)(smem + 16384) + wave * 16 * 136;
  const float2* SEND = (const float2*)(p.ws + OFF_SEND);
  u16* Gb = (u16*)(p.ws + OFF_G);
  __syncthreads();
  s5_stage_u(p, c0, gq, us);
  __syncthreads();
  f32x4 yacc[4];
#pragma unroll
  for (int tb = 0; tb < 4; ++tb) yacc[tb] = (f32x4){0.f, 0.f, 0.f, 0.f};
#pragma unroll
  for (int d = 0; d < 2; ++d) {
    S5Const k; float lr, li, step;
    s5_consts(p, layer, d, g, lane, k, lr, li, step);
    const float m64 = expf(lr * step * 64.f);
    float s64, c64; sincosf(li * step * 64.f, &s64, &c64);
    const float a64r = m64 * c64, a64i = m64 * s64;
    float sr = 0.f, si = 0.f;
    {
      const int cnt = d == 0 ? n - nlo : nhi - 1 - n;
      const int first = d == 0 ? nlo : nhi - 1;
      const int sgn = d == 0 ? 1 : -1;
      const float2* sp = SEND + ((size_t)(first * 2 + d) * 16 + g) * 64 + lane;
      const long stride = (long)sgn * 2 * 16 * 64;
      int m = 0;
      for (; m + 8 <= cnt; m += 8) {
        float2 e0 = sp[0], e1 = sp[stride], e2 = sp[2 * stride], e3 = sp[3 * stride];
        float2 e4 = sp[4 * stride], e5 = sp[5 * stride], e6 = sp[6 * stride], e7 = sp[7 * stride];
        sp += 8 * stride;
#define HSTEP(E) { const float nr = a64r * sr - a64i * si + E.x, ni = a64r * si + a64i * sr + E.y; sr = nr; si = ni; }
        HSTEP(e0) HSTEP(e1) HSTEP(e2) HSTEP(e3) HSTEP(e4) HSTEP(e5) HSTEP(e6) HSTEP(e7)
      }
      for (; m < cnt; ++m) {
        const float2 e = sp[0];
        sp += stride;
        HSTEP(e)
      }
    }
    bf16x8 cf[4];
    {
      const float* cr = p.c_re + ((size_t)((layer * 2 + d) * 16 + g) * 16 + fr) * 64;
      const float* ci = p.c_im + ((size_t)((layer * 2 + d) * 16 + g) * 16 + fr) * 64;
#pragma unroll
      for (int kk = 0; kk < 4; ++kk)
#pragma unroll
        for (int e = 0; e < 8; ++e) {
          const int kx = (kk & 1) * 32 + fq * 8 + e;
          const float v = (kk < 2) ? cr[kx] : -ci[kx];
          cf[kk][e] = (short)f2bf(v);
        }
    }
#pragma unroll
    for (int blk = 0; blk < 4; ++blk) {
      const int tb = d ? 3 - blk : blk;
#pragma unroll 4
      for (int i = 0; i < 16; ++i) {
        const int r = d ? 15 - i : i;
        const int t = tb * 16 + r;
        s5_step(k, us + t * 64 + wave * 16, sr, si);
        Sb[r * 136 + lane] = f2bf(sr);
        Sb[r * 136 + 64 + lane] = f2bf(si);
      }
      asm volatile("s_waitcnt lgkmcnt(0)" ::: "memory");
#pragma unroll
      for (int kk = 0; kk < 4; ++kk) {
        const bf16x8 xf = *(const bf16x8*)(Sb + fr * 136 + kk * 32 + fq * 8);
        yacc[tb] = mfma16(xf, cf[kk], yacc[tb]);
      }
      asm volatile("s_waitcnt lgkmcnt(0)" ::: "memory");
    }
  }
  const float dsk = p.s5_d[layer * 256 + g * 16 + fr];
#pragma unroll
  for (int tb = 0; tb < 4; ++tb)
#pragma unroll
    for (int j = 0; j < 4; ++j) {
      const int t = tb * 16 + fq * 4 + j;
      const float y = yacc[tb][j] + us[t * 64 + wave * 16 + fr] * dsk;
      Gb[(size_t)(c0 + t) * 256 + g * 16 + fr] = f2bf(gelu_tanh(y));
    }
}

struct AttnState { float m, l; f32x4 o[4]; };
DI void attn_segment(const u16* proj, int kcol, int vcol, int tk0, int kstride, int npairs, int R, float slope, int tq,
                     int lo, int hi, const bf16x8 (&qf)[2], AttnState& st, u16* Vt, int lane) {
  const int fr = lane & 15, fq = lane >> 4;
#pragma unroll 1
  for (int pr = 0; pr < npairs; ++pr) {
    const int kbase = tk0 + pr * 32 * kstride;
    f32x4 sacc[2];
#pragma unroll
    for (int t = 0; t < 2; ++t) {
      int tk = kbase + (t * 16 + fr) * kstride;
      tk = min(max(tk, lo), hi - 1);
      const u16* kp = proj + (size_t)tk * INW + kcol + fq * 8;
      const bf16x8 k0 = *(const bf16x8*)(kp), k1 = *(const bf16x8*)(kp + 32);
      sacc[t] = mfma16(k0, qf[0], (f32x4){0.f, 0.f, 0.f, 0.f});
      sacc[t] = mfma16(k1, qf[1], sacc[t]);
    }
    uint4 vr0, vr1, vr2, vr3;
    {
      const int seg = (lane & 7) * 8, kl0 = lane >> 3;
      const int t0 = min(max(kbase + (kl0 + 0) * kstride, lo), hi - 1), t1 = min(max(kbase + (kl0 + 8) * kstride, lo), hi - 1);
      const int t2 = min(max(kbase + (kl0 + 16) * kstride, lo), hi - 1), t3 = min(max(kbase + (kl0 + 24) * kstride, lo), hi - 1);
      vr0 = *(const uint4*)(proj + (size_t)t0 * INW + vcol + seg);
      vr1 = *(const uint4*)(proj + (size_t)t1 * INW + vcol + seg);
      vr2 = *(const uint4*)(proj + (size_t)t2 * INW + vcol + seg);
      vr3 = *(const uint4*)(proj + (size_t)t3 * INW + vcol + seg);
    }
    float sc[2][4]; bool ok[2][4];
    float mx = -1e30f;
#pragma unroll
    for (int t = 0; t < 2; ++t)
#pragma unroll
      for (int j = 0; j < 4; ++j) {
        const int tk = kbase + (t * 16 + fq * 4 + j) * kstride;
        const int ad = abs(tk - tq);
        ok[t][j] = (ad <= R) && (tk >= lo) && (tk < hi);
        sc[t][j] = sacc[t][j] * 0.125f - slope * (float)ad;
        if (ok[t][j]) mx = fmaxf(mx, sc[t][j]);
      }
    mx = fmaxf(mx, __shfl_xor(mx, 16, 64));
    mx = fmaxf(mx, __shfl_xor(mx, 32, 64));
    const float mn = fmaxf(st.m, mx);
    const float alpha = __expf(st.m - mn);
    st.m = mn;
    float pv[2][4], ps = 0.f;
#pragma unroll
    for (int t = 0; t < 2; ++t)
#pragma unroll
      for (int j = 0; j < 4; ++j) { pv[t][j] = ok[t][j] ? __expf(sc[t][j] - mn) : 0.f; ps += pv[t][j]; }
    st.l = st.l * alpha + ps;
#pragma unroll
    for (int dt = 0; dt < 4; ++dt)
#pragma unroll
      for (int j = 0; j < 4; ++j) st.o[dt][j] *= alpha;
    bf16x8 pf;
    {
      const unsigned w0 = pack2(pv[0][0], pv[0][1]), w1 = pack2(pv[0][2], pv[0][3]), w2 = pack2(pv[1][0], pv[1][1]),
                     w3 = pack2(pv[1][2], pv[1][3]);
      uint4 t4 = make_uint4(w0, w1, w2, w3);
      pf = __builtin_bit_cast(bf16x8, t4);
    }
    asm volatile("s_waitcnt lgkmcnt(0)" ::: "memory");
    {
      u16* vdst = Vt + (lane >> 3) * 72 + (lane & 7) * 8;
      *(uint4*)(vdst) = vr0; *(uint4*)(vdst + 8 * 72) = vr1; *(uint4*)(vdst + 16 * 72) = vr2; *(uint4*)(vdst + 24 * 72) = vr3;
    }
    {
      const int q = fr >> 2, pp = fr & 3;
      const unsigned a0 = (unsigned)(size_t)Vt + (unsigned)(((fq * 4 + q) * 72 + 4 * pp) * 2);
      {
        uint2 x0, x1, y0, y1;
        asm volatile(
            "s_waitcnt lgkmcnt(0)\n\t"
            "ds_read_b64_tr_b16 %0, %4\n\t"
            "ds_read_b64_tr_b16 %1, %4 offset:32\n\t"
            "ds_read_b64_tr_b16 %2, %4 offset:2304\n\t"
            "ds_read_b64_tr_b16 %3, %4 offset:2336\n\t"
            "s_waitcnt lgkmcnt(0)"
            : "=&v"(x0), "=&v"(x1), "=&v"(y0), "=&v"(y1) : "v"(a0) : "memory");
        st.o[0] = mfma16(__builtin_bit_cast(bf16x8, make_uint4(x0.x, x0.y, y0.x, y0.y)), pf, st.o[0]);
        st.o[1] = mfma16(__builtin_bit_cast(bf16x8, make_uint4(x1.x, x1.y, y1.x, y1.y)), pf, st.o[1]);
      }
      {
        uint2 x0, x1, y0, y1;
        asm volatile(
            "ds_read_b64_tr_b16 %0, %4 offset:64\n\t"
            "ds_read_b64_tr_b16 %1, %4 offset:96\n\t"
            "ds_read_b64_tr_b16 %2, %4 offset:2368\n\t"
            "ds_read_b64_tr_b16 %3, %4 offset:2400\n\t"
            "s_waitcnt lgkmcnt(0)"
            : "=&v"(x0), "=&v"(x1), "=&v"(y0), "=&v"(y1) : "v"(a0) : "memory");
        st.o[2] = mfma16(__builtin_bit_cast(bf16x8, make_uint4(x0.x, x0.y, y0.x, y0.y)), pf, st.o[2]);
        st.o[3] = mfma16(__builtin_bit_cast(bf16x8, make_uint4(x1.x, x1.y, y1.x, y1.y)), pf, st.o[3]);
      }
    }
  }
}
DI void attn_task(const Params& p, int layer, int mode, int task, char* smem) {
  const int lane = my_tid() & 63, wave = my_tid() >> 6;
  const int fr = lane & 15, fq = lane >> 4;
  u16* proj = (u16*)(p.ws + OFF_PROJ);
  u16* Vt = (u16*)smem + wave * 32 * 72;
  int tq0, qstride, qcol, kcol, vcol; float slope;
  int hq;
  if (mode == 0) {
    const int blk = task >> 4, h = (task >> 2) & 3, rq = task & 3;
    hq = h; tq0 = blk * 256 + rq * 4 + wave; qstride = 16;
    qcol = C_BQ + h * 64; kcol = C_BK + h * 64; vcol = C_BV + h * 64;
    slope = exp2f(-(float)(5 + h));
  } else {
    const int blk = task >> 2, qh = task & 3;
    hq = qh; tq0 = blk * 64 + wave * 16; qstride = 1;
    qcol = C_DQ + qh * 64; kcol = C_DK + (qh >> 1) * 64; vcol = C_DV + (qh >> 1) * 64;
    slope = exp2f(-(float)(1 + qh));
  }
  const int lo = seq_lo(tq0), hi = seq_hi(tq0);
  const int tq = tq0 + fr * qstride;
  bf16x8 qf[2];
  {
    const u16* qp = proj + (size_t)tq * INW + qcol + fq * 8;
    qf[0] = *(const bf16x8*)(qp); qf[1] = *(const bf16x8*)(qp + 32);
  }
  AttnState st; st.m = -1e30f; st.l = 0.f;
#pragma unroll
  for (int dt = 0; dt < 4; ++dt) st.o[dt] = (f32x4){0.f, 0.f, 0.f, 0.f};
  __syncthreads();
  float scale;
  if (mode == 0) {
    attn_segment(proj, kcol, vcol, tq0 - 64, 1, 12, 64, slope, tq, lo, hi, qf, st, Vt, lane);
    attn_segment(proj, kcol, vcol, tq0 - 256, 4, 6, 256, slope, tq, lo, hi, qf, st, Vt, lane);
    attn_segment(proj, kcol, vcol, tq0 - 1024, 16, 5, 1024, slope, tq, lo, hi, qf, st, Vt, lane);
    float l = st.l; l += __shfl_xor(l, 16, 64); l += __shfl_xor(l, 32, 64);
    scale = 1.f / l;
  } else {
    attn_segment(proj, kcol, vcol, tq0 - 128, 1, 9, 128, slope, tq, lo, hi, qf, st, Vt, lane);
    float l = st.l; l += __shfl_xor(l, 16, 64); l += __shfl_xor(l, 32, 64);
    const float sink = p.attn_sink[layer * 4 + hq];
    const float mf = fmaxf(st.m, sink);
    const float sc = __expf(st.m - mf);
    scale = sc / (l * sc + __expf(sink - mf));
  }
#pragma unroll
  for (int dt = 0; dt < 4; ++dt) {
    uint2 o; o.x = pack2(st.o[dt][0] * scale, st.o[dt][1] * scale); o.y = pack2(st.o[dt][2] * scale, st.o[dt][3] * scale);
    *(uint2*)(proj + (size_t)tq * INW + qcol + dt * 16 + fq * 4) = o;
  }
}

DI void final_row(const Params& p, int t) {
  const int lane = my_tid() & 63;
  float* row = p.xout + (size_t)t * DM;
  float4 v[4]; float ss = 0.f;
#pragma unroll
  for (int i = 0; i < 4; ++i) {
    v[i] = *(const float4*)(row + i * 256 + lane * 4);
    ss += v[i].x * v[i].x + v[i].y * v[i].y + v[i].z * v[i].z + v[i].w * v[i].w;
  }
  ss = wave_sum(ss);
  const float rs = rstd_of(ss);
#pragma unroll
  for (int i = 0; i < 4; ++i) {
    const float4 g = *(const float4*)(p.final_norm + i * 256 + lane * 4);
    *(float4*)(row + i * 256 + lane * 4) = make_float4(v[i].x * rs * g.x, v[i].y * rs * g.y, v[i].z * rs * g.z, v[i].w * rs * g.w);
  }
}

#define XB_TMO      128
#define XB_XCNT(j)  (256  + 64 * (j))
#define XB_XSUB(j)  (1280 + 64 * (j))
#define XB_XGEN(j)  (2304 + 64 * (j))
#define XB_TOP      3328
#define XB_TOPGEN   3392
#define XB_SPIN_CAP (1u << 22)
#define LAS __attribute__((address_space(3)))
DI unsigned xb_ld(unsigned* p) { return __hip_atomic_load(p, __ATOMIC_RELAXED, __HIP_MEMORY_SCOPE_AGENT); }
DI unsigned xb_add(unsigned* p, unsigned v) { return __hip_atomic_fetch_add(p, v, __ATOMIC_RELAXED, __HIP_MEMORY_SCOPE_AGENT); }
DI unsigned xb_xcc_id() { return (unsigned)__builtin_amdgcn_s_getreg((3 << 11) | 20) & 0xFu; }
#define XB_SPIN(cond, bar) do { unsigned _sp = 0; while (cond) { __builtin_amdgcn_s_sleep(1); \
    if ((++_sp & 255u) == 0u) { if (xb_ld(&(bar)[XB_TMO])) break; if (_sp > XB_SPIN_CAP) { atomicAdd(&(bar)[XB_TMO], 1u); break; } } } } while (0)
struct XcdBarrier { unsigned* bar; unsigned x; volatile LAS unsigned* st; };
DI XcdBarrier xcd_barrier_post(unsigned* bar, volatile LAS unsigned* st) {
  XcdBarrier b; b.bar = bar; b.x = xb_xcc_id(); b.st = st;
  if (threadIdx.x == 0) (void)xb_add(&bar[XB_XCNT(b.x)], 1u);
  return b;
}
DI void xcd_barrier_complete(unsigned* bar, unsigned x, unsigned& nloc, unsigned& nx) {
  const unsigned G = gridDim.x * gridDim.y * gridDim.z;
  unsigned sum, cnt, mine, sp = 0u;
  for (;;) {
    sum = 0u; cnt = 0u; mine = 0u;
#pragma unroll
    for (unsigned j = 0; j < 16; ++j) { const unsigned c = xb_ld(&bar[XB_XCNT(j)]); sum += c; cnt += (c > 0u) ? 1u : 0u; mine = (j == x) ? c : mine; }
    if (sum == G) break;
    __builtin_amdgcn_s_sleep(1);
    if ((++sp & 255u) == 0u) { if (xb_ld(&bar[XB_TMO])) break; if (sp > XB_SPIN_CAP) { atomicAdd(&bar[XB_TMO], 1u); break; } }
  }
  nloc = mine > 0u ? mine : 1u; nx = cnt > 0u ? cnt : 1u;
}
DI void xcd_barrier(const XcdBarrier& b) {
  asm volatile("s_waitcnt vmcnt(0)" ::: "memory");
  __syncthreads();
  if (threadIdx.x == 0) {
    unsigned* bar = b.bar;
    __builtin_amdgcn_s_waitcnt(0);
    unsigned nloc = b.st[0], nx = b.st[1];
    if (nloc == 0u) { xcd_barrier_complete(bar, b.x, nloc, nx); b.st[0] = nloc; b.st[1] = nx; }
    const unsigned old = xb_add(&bar[XB_XSUB(b.x)], 1u);
    const unsigned gen = old / nloc;
    if (old + 1u == (gen + 1u) * nloc) {
      __builtin_amdgcn_fence(__ATOMIC_RELEASE, "agent");
      asm volatile("s_waitcnt vmcnt(0)" ::: "memory");
      const unsigned og = xb_add(&bar[XB_TOP], 1u);
      const unsigned tg = og / nx;
      if (og + 1u == (tg + 1u) * nx) xb_add(&bar[XB_TOPGEN], 1u);
      else XB_SPIN(xb_ld(&bar[XB_TOPGEN]) == tg, bar);
      __builtin_amdgcn_fence(__ATOMIC_ACQUIRE, "agent");
      xb_add(&bar[XB_XGEN(b.x)], 1u);
      asm volatile("s_waitcnt vmcnt(0)" ::: "memory");
    } else {
      XB_SPIN(xb_ld(&bar[XB_XGEN(b.x)]) == gen, bar);
      __builtin_amdgcn_fence(__ATOMIC_ACQUIRE, "agent");
      asm volatile("s_waitcnt vmcnt(0)" ::: "memory");
    }
  }
  __syncthreads();
}

enum { PH_NORM1 = 0, PH_INPROJ, PH_MIX1, PH_MIX2, PH_MIX3, PH_MERGE, PH_OUT, PH_FFN1, PH_FFN2, PH_PER_LAYER, PH_FINAL = 100 };

DI void run_phase(const Params& p, int ph, int layer, char* smem) {
  const int b = blockIdx.x, G = gridDim.x;
  const int wave = my_tid() >> 6;
  switch (ph) {
    case PH_NORM1: {
      if (layer == 0) {
        for (int t = b; t < 2 * CONV_TILES_LAYER; t += G) {
          ConvJob j;
          const int lt = conv_lookup(p, t, j);
          conv_tile(j, lt, (float*)smem);
        }
      }
      if (b == 0 && my_tid() == 0) *(unsigned*)(p.ws + OFF_CNT) = 0u;
      if (layer == 0) {
        float* z = ssq_buf(p, 2);
        for (int i = b * 256 + my_tid(); i < 2 * T; i += G * 256) z[i] = 0.f;
      }
      cvt_phase(p, layer, (u16*)(p.ws + OFF_H), true, b, G);
    } break;
    case PH_INPROJ: gemm_inproj(p, layer, b, G, (u16*)smem); break;
    case PH_MIX1: {
      for (int t = b; t < 2 * 3072; t += G) {
        const int kind = t / 3072, idx = t % 3072;
        if (kind == 0) gdn_pre(p, layer, idx, smem);
        else s5_pass1(p, layer, idx, smem);
      }
    } break;
    case PH_MIX2: {
      for (int c = b; c < 288; c += G) gdn_scan(p, c, smem);
      {
        unsigned* cnt = (unsigned*)(p.ws + OFF_CNT);
        int* slot = (int*)(smem + SMEM_BYTES - 16);
        for (;;) {
          __syncthreads();
          if (my_tid() == 0) *slot = (int)atomicAdd(cnt, 1u);
          __syncthreads();
          const int t = *slot;
          if (t >= 3 * 3072) break;
          if (t < 3072) s5_pass3(p, layer, t, smem);
          else if (t < 2 * 3072) attn_task(p, layer, 0, t - 3072, smem);
          else attn_task(p, layer, 1, t - 2 * 3072, smem);
        }
      }
    } break;
    case PH_MIX3: {
      gemm_glu(p, layer, b, G, (u16*)smem);
      for (int t = b * 4 + wave; t < T; t += G * 4) gdn_post_row(p, layer, t);
      cvt_phase(p, layer, (u16*)(p.ws + OFF_H), false, b, G);
    } break;
    case PH_MERGE: gemm_merge(p, layer, b, G, (u16*)smem); break;
    case PH_OUT:
      gemm_resid(p, layer, (const u16*)(p.ws + OFF_MERGED), DM, (const u16*)(p.ws + OFF_W) + layer * W_LAYER + WO_OUT, b, G, (u16*)smem,
                 (u16*)(p.ws + OFF_H2), ssq_buf(p, 2 + layer));
      break;
    case PH_FFN1: gemm_ffn1(p, layer, b, G, (u16*)smem); break;
    case PH_FFN2:
      gemm_resid(p, 1, (const u16*)(p.ws + OFF_ACT), FH, (const u16*)(p.ws + OFF_W) + layer * W_LAYER + WO_DN, b, G, (u16*)smem,
                 nullptr, nullptr);
      break;
    case PH_FINAL:
      for (int t = b * 4 + wave; t < T; t += G * 4) final_row(p, t);
      break;
    default: break;
  }
}

#if !MEGA
__global__ void __launch_bounds__(256, 2) k_phase(Params p, int ph, int layer) {
  __shared__ __attribute__((aligned(16))) char smem[SMEM_BYTES];
  run_phase(p, ph, layer, smem);
}

#else
__global__ void __launch_bounds__(256, 2) k_mega(Params p) {
  __shared__ __attribute__((aligned(16))) char smem[SMEM_BYTES];
  __shared__ uint4 xb_words;
  cg::grid_group grid = cg::this_grid();
  if (threadIdx.x == 0) xb_words = make_uint4(0u, 0u, 0u, 0u);
  __syncthreads();
  const XcdBarrier xb = xcd_barrier_post((unsigned*)(p.ws + OFF_BAR), (volatile LAS unsigned*)&xb_words);
  for (int layer = 0; layer < 2; ++layer)
    for (int ph = 0; ph < PH_PER_LAYER; ++ph) {
      run_phase(p, ph, layer, smem);
      if (layer == 1 && ph == PH_PER_LAYER - 1) grid.sync(); else xcd_barrier(xb);
#ifdef PROBE_DUP
      if (ph == PROBE_DUP) { run_phase(p, ph, layer, smem); grid.sync(); }
#endif
    }
  run_phase(p, PH_FINAL, 0, smem);
}
#endif

extern "C" void kernel_launch(void* const* d_in, const int* in_sizes, int n_in, void* d_out, int out_size, void* d_ws,
                              size_t ws_size, hipStream_t stream) {
  (void)in_sizes; (void)n_in; (void)out_size;
  if (ws_size < WS_NEED) { fprintf(stderr, "workspace too small: %zu < %zu\n", ws_size, (size_t)WS_NEED); return; }
  Params p;
  memset(&p, 0, sizeof(p));
  const float* const* in = (const float* const*)d_in;
  p.x_prompt = in[0]; p.x_sample = in[1]; p.norm1 = in[2]; p.conv_a = in[4]; p.a_log = in[5]; p.dt_bias = in[6];
  p.a_norm = in[7]; p.lam_re = in[8]; p.lam_im = in[9]; p.log_step = in[10]; p.b_re = in[11]; p.b_im = in[12];
  p.c_re = in[13]; p.c_im = in[14]; p.s5_d = in[15]; p.attn_sink = in[17]; p.norm2 = in[21]; p.final_norm = in[25];
  p.xout = (float*)d_out;
  p.ws = (char*)d_ws;
  p.w_in = in[3]; p.w_glu = in[16]; p.w_gate = in[18]; p.w_branch = in[19]; p.w_out = in[20];
  p.w_ffn_gate = in[22]; p.w_ffn_up = in[23]; p.w_ffn_down = in[24];
  static int grid_blocks = 0;
  if (!grid_blocks) {
    int dev = 0, cus = 0, per_cu = 0;
    hipGetDevice(&dev);
    hipDeviceGetAttribute(&cus, hipDeviceAttributeMultiprocessorCount, dev);
#if MEGA
    hipOccupancyMaxActiveBlocksPerMultiprocessor(&per_cu, k_mega, 256, 0);
#else
    hipOccupancyMaxActiveBlocksPerMultiprocessor(&per_cu, k_phase, 256, 0);
#endif
    per_cu = 2;
    grid_blocks = cus * per_cu;
  }
#if MEGA
  hipMemsetAsync((char*)d_ws + OFF_BAR, 0, BAR_BYTES, stream);
  void* args[] = {&p};
  hipError_t e = hipLaunchCooperativeKernel((void*)k_mega, dim3(grid_blocks), dim3(256), args, 0, stream);
  if (e != hipSuccess) fprintf(stderr, "cooperative launch failed: %s (grid %d)\n", hipGetErrorString(e), grid_blocks);
#else
  for (int layer = 0; layer < 2; ++layer)
    for (int ph = 0; ph < PH_PER_LAYER; ++ph) hipLaunchKernelGGL(k_phase, dim3(grid_blocks), dim3(256), 0, stream, p, ph, layer);
  hipLaunchKernelGGL(k_phase, dim3(grid_blocks), dim3(256), 0, stream, p, (int)PH_FINAL, 0);
#endif
}
```

```cpp
#include <hip/hip_runtime.h>
#include <hip/hip_cooperative_groups.h>
#include <cstdio>
#include <cstring>
namespace cg = cooperative_groups;

#ifndef MEGA
#define MEGA 1
#endif

#define DI __device__ __forceinline__
typedef unsigned short u16;
typedef __attribute__((ext_vector_type(8))) short bf16x8;
typedef __attribute__((ext_vector_type(4))) float f32x4;

constexpr int T = 49152;
constexpr int TP = 16384;
constexpr int DM = 1024;
constexpr int INW = 2576;
constexpr int FH = 2816;
constexpr int NCH64 = T / 64;
constexpr float EPS = 1e-6f;

constexpr int C_AQ = 0, C_AK = 256, C_AV = 512, C_AZ = 768, C_BQ = 1040, C_BK = 1296, C_BV = 1552, C_CU = 1808,
              C_DQ = 2064, C_DK = 2320, C_DV = 2448;

constexpr size_t WO_IN = 0, WO_GATE = 2752512, WO_BR = 6946816, WO_OUT = 7995392, WO_GU = 9043968, WO_DN = 14811136,
                 WO_GLU = 17694720, W_LAYER = 17825792;
constexpr size_t OFF_W = 0;
constexpr size_t OFF_PROJ = 2 * W_LAYER * 2;
constexpr size_t SZ_PROJ = (size_t)T * INW * 2;
constexpr size_t OFF_R1 = OFF_PROJ + SZ_PROJ;
constexpr size_t SZ_H = (size_t)T * DM * 2;
constexpr size_t OFF_H = OFF_R1;
constexpr size_t OFF_UW = OFF_R1;
constexpr size_t OFF_QN = OFF_R1 + SZ_H;
constexpr size_t OFF_KN = OFF_QN + (size_t)T * 256 * 2;
constexpr size_t OFF_GC = OFF_KN + (size_t)T * 256 * 2;
constexpr size_t OFF_SEND = OFF_GC + (size_t)NCH64 * 8 * 64 * 4;
constexpr size_t OFF_G = OFF_SEND + (size_t)NCH64 * 2 * 1024 * 8;
constexpr size_t OFF_AB = OFF_G + (size_t)T * 256 * 2;
constexpr size_t OFF_CNT = OFF_AB + (size_t)T * 16 * 4;
constexpr size_t OFF_MERGED = OFF_R1 + SZ_H;
constexpr size_t OFF_H2 = OFF_PROJ;
constexpr size_t OFF_ACT = OFF_PROJ + SZ_H;
constexpr size_t OFF_BAR = OFF_MERGED + SZ_H;
constexpr size_t BAR_BYTES = 3456 * 4;
constexpr size_t OFF_SSQ = OFF_BAR + 16384;
constexpr size_t OFF_S5TAB = OFF_SSQ + 5 * (size_t)T * 4;
constexpr size_t S5TAB_STRIDE = 13 * 1024;
constexpr size_t WS_NEED = OFF_S5TAB + 32 * S5TAB_STRIDE;

constexpr int SMEM_BYTES = 75776;

struct ConvJob { const float* src; u16* dst; const float* kscale; int K, ncols, nrows_dst, src_ld, rs, off, ntn; };
struct Params;
DI float* ssq_buf(const Params& p, int i);
struct Params {
  const float *x_prompt, *x_sample, *norm1, *conv_a, *a_log, *dt_bias, *a_norm, *lam_re, *lam_im, *log_step, *b_re,
      *b_im, *c_re, *c_im, *s5_d, *attn_sink, *norm2, *final_norm;
  const float *w_in, *w_gate, *w_branch, *w_out, *w_ffn_gate, *w_ffn_up, *w_ffn_down, *w_glu;
  float* xout;
  char* ws;
};
constexpr int CONV_TILES_LAYER = 4352;

DI int my_tid() { int t = threadIdx.x; asm volatile("" : "+v"(t)); return t; }
DI u16 f2bf(float x) { unsigned u = __float_as_uint(x); u += 0x7fffu + ((u >> 16) & 1u); return (u16)(u >> 16); }
DI float bf2f(u16 v) { return __uint_as_float(((unsigned)v) << 16); }
DI unsigned pack2(float a, float b) { return (unsigned)f2bf(a) | ((unsigned)f2bf(b) << 16); }
DI float sigmoidf_(float x) { return 1.f / (1.f + __expf(-x)); }
DI float siluf_(float x) { return x / (1.f + __expf(-x)); }
DI float wave_sum(float v) {
#pragma unroll
  for (int o = 32; o > 0; o >>= 1) v += __shfl_xor(v, o, 64);
  return v;
}
DI int seq_lo(int t) { return t < TP ? 0 : (t & ~4095); }
DI int seq_hi(int t) { return t < TP ? TP : (t & ~4095) + 4096; }
DI const float* xrow(const Params& p, int layer, int t) {
  if (layer == 0) return t < TP ? p.x_prompt + (size_t)t * DM : p.x_sample + (size_t)(t - TP) * DM;
  return p.xout + (size_t)t * DM;
}
DI f32x4 mfma16(bf16x8 a, bf16x8 b, f32x4 c) { return __builtin_amdgcn_mfma_f32_16x16x32_bf16(a, b, c, 0, 0, 0); }

DI void mk_job(ConvJob& j, const float* src, u16* dst, int K, int ncols, int nrows_dst, int src_ld, int rs, int off,
                const float* kscale = nullptr) {
  j.kscale = kscale;
  j.src = src; j.dst = dst; j.K = K; j.ncols = ncols; j.nrows_dst = nrows_dst; j.src_ld = src_ld; j.rs = rs; j.off = off;
  j.ntn = (nrows_dst + 63) >> 6;
}
DI int conv_lookup(const Params& p, int t, ConvJob& j) {
  const int l = t / CONV_TILES_LAYER;
  int r = t % CONV_TILES_LAYER;
  u16* wl = (u16*)(p.ws + OFF_W) + (size_t)l * W_LAYER;
  if (r < 672) { mk_job(j, p.w_in + (size_t)l * DM * INW, wl + WO_IN, DM, INW, 2688, INW, 32, 0, p.norm1 + l * DM); return r; }
  r -= 672;
  if (r < 1024) { const int i = r >> 8; mk_job(j, p.w_gate + (size_t)(l * 4 + i) * DM * DM, wl + WO_GATE + (size_t)i * DM * DM, DM, DM, DM, DM, 32, 0, p.norm1 + l * DM); return r & 255; }
  r -= 1024;
  if (r < 256) { const int i = r >> 6; mk_job(j, p.w_branch + (size_t)(l * 4 + i) * 256 * DM, wl + WO_BR + (size_t)i * DM * 256, 256, DM, DM, DM, 32, 0); return r & 63; }
  r -= 256;
  if (r < 256) { mk_job(j, p.w_out + (size_t)l * DM * DM, wl + WO_OUT, DM, DM, DM, DM, 32, 0); return r; }
  r -= 256;
  if (r < 704) { mk_job(j, p.w_ffn_gate + (size_t)l * DM * FH, wl + WO_GU, DM, FH, FH, FH, 64, 0, p.norm2 + l * DM); return r; }
  r -= 704;
  if (r < 704) { mk_job(j, p.w_ffn_up + (size_t)l * DM * FH, wl + WO_GU, DM, FH, FH, FH, 64, 32, p.norm2 + l * DM); return r; }
  r -= 704;
  if (r < 704) { mk_job(j, p.w_ffn_down + (size_t)l * FH * DM, wl + WO_DN, FH, DM, DM, DM, 32, 0); return r; }
  r -= 704;
  if (r < 16) { mk_job(j, p.w_glu + (size_t)l * 256 * 512, wl + WO_GLU, 256, 256, 256, 512, 64, 0); return r; }
  r -= 16;
  mk_job(j, p.w_glu + (size_t)l * 256 * 512 + 256, wl + WO_GLU, 256, 256, 256, 512, 64, 32);
  return r;
}
DI void conv_tile(const ConvJob& j, int lt, float* tile) {
  const int tid = my_tid();
  const int tk = lt / j.ntn, tn = lt % j.ntn;
  __syncthreads();
#pragma unroll
  for (int i = 0; i < 4; ++i) {
    int r = (tid >> 4) + 16 * i, c4 = (tid & 15) * 4, n = tn * 64 + c4;
    float4 v = make_float4(0.f, 0.f, 0.f, 0.f);
    if (n < j.ncols) v = *(const float4*)(j.src + (size_t)(tk * 64 + r) * j.src_ld + n);
    if (j.kscale) { const float s = j.kscale[tk * 64 + r]; v.x *= s; v.y *= s; v.z *= s; v.w *= s; }
    tile[r * 65 + c4 + 0] = v.x; tile[r * 65 + c4 + 1] = v.y; tile[r * 65 + c4 + 2] = v.z; tile[r * 65 + c4 + 3] = v.w;
  }
  __syncthreads();
  const int cl = tid >> 2, ks = (tid & 3) * 16, n = tn * 64 + cl;
  if (n < j.nrows_dst) {
    unsigned w[8];
#pragma unroll
    for (int e = 0; e < 8; ++e) w[e] = pack2(tile[(ks + 2 * e) * 65 + cl], tile[(ks + 2 * e + 1) * 65 + cl]);
    const int nm = (n >> 5) * j.rs + (n & 31) + j.off;
    uint4* d = (uint4*)(j.dst + (size_t)nm * j.K + tk * 64 + ks);
    d[0] = make_uint4(w[0], w[1], w[2], w[3]);
    d[1] = make_uint4(w[4], w[5], w[6], w[7]);
  }
}

DI float* ssq_buf(const Params& p, int i) { return (float*)(p.ws + OFF_SSQ) + (size_t)i * T; }
DI float rstd_of(float ssq) { return rsqrtf(ssq * (1.f / DM) + EPS); }
DI void cvt_row_bf16(const float* src, u16* dst, float* ssq_out) {
  const int lane = my_tid() & 63;
  float ss = 0.f;
#pragma unroll
  for (int i = 0; i < 4; ++i) {
    const float4 v = *(const float4*)(src + i * 256 + lane * 4);
    ss += v.x * v.x + v.y * v.y + v.z * v.z + v.w * v.w;
    uint2 o; o.x = pack2(v.x, v.y); o.y = pack2(v.z, v.w);
    *(uint2*)(dst + i * 256 + lane * 4) = o;
  }
  if (ssq_out) { ss = wave_sum(ss); if (lane == 0) *ssq_out = ss; }
}
DI void cvt_phase(const Params& p, int layer, u16* dst, bool write_ssq, int b0, int nb) {
  const int wave = my_tid() >> 6;
  for (int r = b0 * 4 + wave; r < T; r += nb * 4)
    cvt_row_bf16(xrow(p, layer, r), dst + (size_t)r * DM, write_ssq ? ssq_buf(p, layer) + r : nullptr);
}

constexpr int GP = 64;
#ifndef GEMM_DMA
#define GEMM_DMA 1
#endif
#if GEMM_DMA
template <int NT, bool SPLIT = false>
DI void gemm_kloop(const u16* __restrict__ A, size_t lda, const u16* __restrict__ B, size_t ldb, int nk,
                   f32x4 (&acc)[4][NT], u16* sm) {
  const int tid = my_tid(), lane = tid & 63;
  const int wave = __builtin_amdgcn_readfirstlane(tid >> 6);
  const int fr = lane & 15, fq = lane >> 4, wr = wave >> 1, wc = wave & 1;
  u16* sa = sm;
  u16* sb = sm + 2 * 128 * 64;
  const int swz = (fr >> 1) & 7;
  const int lr = lane >> 3;
  const int lc = ((lane & 7) ^ ((lr >> 1) & 3)) * 8;
#define DMA_PIECE(BASE, LD, G, KOFF, DST)                                                              \
  {                                                                                                    \
    int lrl_ = lr;                                                                                     \
    asm volatile("" : "+v"(lrl_));   \
    const int row_ = (G) * 8 + lrl_;                                                                   \
    const int col_ = lc ^ ((((G) & 1) * 4) * 8);                                                       \
    __builtin_amdgcn_global_load_lds((const unsigned*)((BASE) + (size_t)row_ * (LD) + (KOFF) + col_),  \
                                     (unsigned*)((DST) + (G) * 512), 16, 0, 0);                        \
  }
#define DMA_TILE(KOFF, STAGE)                                                                          \
  {                                                                                                    \
    u16* da_ = sa + (STAGE) * 8192;                                                                    \
    u16* db_ = sb + (STAGE) * 8192;                                                                    \
    DMA_PIECE(A, lda, wave * 4 + 0, KOFF, da_) DMA_PIECE(A, lda, wave * 4 + 1, KOFF, da_)              \
    DMA_PIECE(A, lda, wave * 4 + 2, KOFF, da_) DMA_PIECE(A, lda, wave * 4 + 3, KOFF, da_)              \
    if (NT == 4) {                                                                                     \
      DMA_PIECE(B, ldb, wave * 4 + 0, KOFF, db_) DMA_PIECE(B, ldb, wave * 4 + 1, KOFF, db_)            \
      DMA_PIECE(B, ldb, wave * 4 + 2, KOFF, db_) DMA_PIECE(B, ldb, wave * 4 + 3, KOFF, db_)            \
    } else {                                                                                           \
      DMA_PIECE(B, ldb, wave * 2 + 0, KOFF, db_) DMA_PIECE(B, ldb, wave * 2 + 1, KOFF, db_)            \
    }                                                                                                  \
  }
  __builtin_amdgcn_s_barrier();
  DMA_TILE(0, 0)
#pragma unroll 1
  for (int kt = 0; kt < nk; ++kt) {
    const int cur = kt & 1;
    asm volatile("s_waitcnt vmcnt(0)" ::: "memory");
    __builtin_amdgcn_s_barrier();
    asm volatile("" ::: "memory");
    const u16* ca = sa + cur * 8192;
    const u16* cb = sb + cur * 8192;
    if (SPLIT) {
      bf16x8 wf[NT], xf[4];
#pragma unroll
      for (int nt = 0; nt < NT; ++nt) wf[nt] = *(const bf16x8*)(cb + (wc * NT * 16 + nt * 16 + fr) * 64 + (((0 * 4 + fq) ^ swz) * 8));
#pragma unroll
      for (int mt = 0; mt < 4; ++mt) xf[mt] = *(const bf16x8*)(ca + (wr * 64 + mt * 16 + fr) * 64 + (((0 * 4 + fq) ^ swz) * 8));
#pragma unroll
      for (int mt = 0; mt < 4; ++mt)
#pragma unroll
        for (int nt = 0; nt < NT; ++nt) acc[mt][nt] = mfma16(wf[nt], xf[mt], acc[mt][nt]);
#pragma unroll
      for (int nt = 0; nt < NT; ++nt) wf[nt] = *(const bf16x8*)(cb + (wc * NT * 16 + nt * 16 + fr) * 64 + (((1 * 4 + fq) ^ swz) * 8));
#pragma unroll
      for (int mt = 0; mt < 4; ++mt) xf[mt] = *(const bf16x8*)(ca + (wr * 64 + mt * 16 + fr) * 64 + (((1 * 4 + fq) ^ swz) * 8));
      __builtin_amdgcn_sched_barrier(0);
      if (kt + 1 < nk) DMA_TILE((kt + 1) * 64, cur ^ 1)
      __builtin_amdgcn_sched_barrier(0);
#pragma unroll
      for (int mt = 0; mt < 4; ++mt)
#pragma unroll
        for (int nt = 0; nt < NT; ++nt) acc[mt][nt] = mfma16(wf[nt], xf[mt], acc[mt][nt]);
      continue;
    }
    bf16x8 wf[2][NT], xf[2][4];
#pragma unroll
    for (int kk = 0; kk < 2; ++kk) {
#pragma unroll
      for (int nt = 0; nt < NT; ++nt) wf[kk][nt] = *(const bf16x8*)(cb + (wc * NT * 16 + nt * 16 + fr) * 64 + (((kk * 4 + fq) ^ swz) * 8));
#pragma unroll
      for (int mt = 0; mt < 4; ++mt) xf[kk][mt] = *(const bf16x8*)(ca + (wr * 64 + mt * 16 + fr) * 64 + (((kk * 4 + fq) ^ swz) * 8));
    }
    __builtin_amdgcn_sched_barrier(0);
    if (kt + 1 < nk) DMA_TILE((kt + 1) * 64, cur ^ 1)
    __builtin_amdgcn_sched_barrier(0);
    __builtin_amdgcn_s_setprio(1);
#pragma unroll
    for (int kk = 0; kk < 2; ++kk)
#pragma unroll
      for (int mt = 0; mt < 4; ++mt)
#pragma unroll
        for (int nt = 0; nt < NT; ++nt) acc[mt][nt] = mfma16(wf[kk][nt], xf[kk][mt], acc[mt][nt]);
    __builtin_amdgcn_s_setprio(0);
  }
}
#else
template <int NT>
DI void gemm_kloop(const u16* __restrict__ A, size_t lda, const u16* __restrict__ B, size_t ldb, int nk,
                   f32x4 (&acc)[4][NT], u16* sm) {
  const int tid = my_tid(), lane = tid & 63, wave = tid >> 6;
  const int fr = lane & 15, fq = lane >> 4, wr = wave >> 1, wc = wave & 1;
  u16* sa = sm;
  u16* sb = sm + 2 * 128 * GP;
  uint4 ra0, ra1, ra2, ra3, rb0, rb1, rb2 = make_uint4(0, 0, 0, 0), rb3 = make_uint4(0, 0, 0, 0);
  uint4 rc0, rc1, rc2, rc3, rd0, rd1, rd2 = make_uint4(0, 0, 0, 0), rd3 = make_uint4(0, 0, 0, 0);
  const int lrow = tid >> 3, lseg = (tid & 7) * 8;
  const int sseg = ((tid & 7) ^ ((lrow >> 1) & 7)) * 8;
  const u16* Ap = A + (size_t)lrow * lda + lseg;
  const u16* Bp = B + (size_t)lrow * ldb + lseg;
#define KL_LOAD(KOFF, A0, A1, A2, A3, B0, B1, B2, B3)                    \
  A0 = *(const uint4*)(Ap + (KOFF));                                     \
  A1 = *(const uint4*)(Ap + 32 * lda + (KOFF));                          \
  A2 = *(const uint4*)(Ap + 64 * lda + (KOFF));                          \
  A3 = *(const uint4*)(Ap + 96 * lda + (KOFF));                          \
  B0 = *(const uint4*)(Bp + (KOFF));                                     \
  B1 = *(const uint4*)(Bp + 32 * ldb + (KOFF));                          \
  if (NT > 2) { B2 = *(const uint4*)(Bp + 64 * ldb + (KOFF)); B3 = *(const uint4*)(Bp + 96 * ldb + (KOFF)); }
#define KL_STORE(SA, SB, A0, A1, A2, A3, B0, B1, B2, B3)                 \
  *(uint4*)((SA) + (lrow + 0) * GP + sseg) = A0;                         \
  *(uint4*)((SA) + (lrow + 32) * GP + sseg) = A1;                        \
  *(uint4*)((SA) + (lrow + 64) * GP + sseg) = A2;                        \
  *(uint4*)((SA) + (lrow + 96) * GP + sseg) = A3;                        \
  *(uint4*)((SB) + (lrow + 0) * GP + sseg) = B0;                         \
  *(uint4*)((SB) + (lrow + 32) * GP + sseg) = B1;                        \
  if (NT > 2) { *(uint4*)((SB) + (lrow + 64) * GP + sseg) = B2; *(uint4*)((SB) + (lrow + 96) * GP + sseg) = B3; }
#define KL_COMPUTE(CA, CB)                                                                                     \
  _Pragma("unroll") for (int kk = 0; kk < 2; ++kk) {                                                           \
    bf16x8 wf[NT], xf[4];                                                                                      \
    _Pragma("unroll") for (int nt = 0; nt < NT; ++nt)                                                          \
      wf[nt] = *(const bf16x8*)((CB) + (wc * NT * 16 + nt * 16 + fr) * GP + (((kk * 4 + fq) ^ swz) * 8));       \
    _Pragma("unroll") for (int mt = 0; mt < 4; ++mt)                                                           \
      xf[mt] = *(const bf16x8*)((CA) + (wr * 64 + mt * 16 + fr) * GP + (((kk * 4 + fq) ^ swz) * 8));            \
    _Pragma("unroll") for (int mt = 0; mt < 4; ++mt)                                                           \
    _Pragma("unroll") for (int nt = 0; nt < NT; ++nt) acc[mt][nt] = mfma16(wf[nt], xf[mt], acc[mt][nt]);      \
  }
  const int swz = (fr >> 1) & 7;
  KL_LOAD(0, ra0, ra1, ra2, ra3, rb0, rb1, rb2, rb3)
  KL_LOAD(64, rc0, rc1, rc2, rc3, rd0, rd1, rd2, rd3)
  KL_STORE(sa, sb, ra0, ra1, ra2, ra3, rb0, rb1, rb2, rb3)
  __syncthreads();
  u16* sa1 = sa + 128 * GP;
  u16* sb1 = sb + 128 * GP;
#pragma unroll 1
  for (int kt = 0; kt < nk; kt += 2) {
    const int k2 = (kt + 2 < nk ? kt + 2 : kt) * 64, k3 = (kt + 3 < nk ? kt + 3 : kt + 1) * 64;
    KL_LOAD(k2, ra0, ra1, ra2, ra3, rb0, rb1, rb2, rb3)
    __builtin_amdgcn_sched_barrier(0);
    KL_COMPUTE(sa, sb)
    KL_STORE(sa1, sb1, rc0, rc1, rc2, rc3, rd0, rd1, rd2, rd3)
    __syncthreads();
    KL_LOAD(k3, rc0, rc1, rc2, rc3, rd0, rd1, rd2, rd3)
    __builtin_amdgcn_sched_barrier(0);
    KL_COMPUTE(sa1, sb1)
    KL_STORE(sa, sb, ra0, ra1, ra2, ra3, rb0, rb1, rb2, rb3)
    __syncthreads();
  }
}
#endif
template <int NT>
DI void zero_acc(f32x4 (&acc)[4][NT]) {
#pragma unroll
  for (int a = 0; a < 4; ++a)
#pragma unroll
    for (int b = 0; b < NT; ++b) acc[a][b] = (f32x4){0.f, 0.f, 0.f, 0.f};
}

struct TileIter {
  int step, nsteps, nfull, nrx, nct, pwl, x, local, mode, idx, stride, L;
  DI void init(int nrt, int nct_, int b, int G) {
    nct = nct_;
    if (G == 512 && (nrt % 64) == 0) {
      mode = 1; x = b & 7; local = b >> 3;
      nrx = nrt / 8;
      const int fullp = nct >> 3;
      pwl = nct & 7;
      nfull = fullp * (nrx / 8);
      nsteps = nfull + (pwl ? (nrx * pwl + 63) / 64 : 0);
      step = 0;
      skip();
    } else {
      mode = 0; idx = b; stride = G; L = nrt * nct;
    }
  }
  DI bool in_range() const { return step < nfull || (step - nfull) * 64 + local < nrx * pwl; }
  DI void skip() { while (step < nsteps && !in_range()) ++step; }
  DI bool valid() const { return mode ? step < nsteps : idx < L; }
  DI int rt() const {
    if (!mode) return idx / nct;
    const int nrb = nrx / 8;
    const int ri = step < nfull ? (step % nrb) * 8 + (local >> 3) : ((step - nfull) * 64 + local) / pwl;
    return x + 8 * ri;
  }
  DI int ct() const {
    if (!mode) return idx % nct;
    const int nrb = nrx / 8;
    return step < nfull ? (step / nrb) * 8 + (local & 7) : (nct & ~7) + ((step - nfull) * 64 + local) % pwl;
  }
  DI void next() { if (mode) { ++step; skip(); } else idx += stride; }
};

#define EPI_COORDS                                                       \
  const int lane = my_tid() & 63, wave = my_tid() >> 6;           \
  const int fr = lane & 15, fq = lane >> 4, wr = wave >> 1, wc = wave & 1; \
  (void)fr; (void)fq; (void)wr; (void)wc;

DI void gemm_inproj(const Params& p, int layer, int b, int G, u16* sm) {
  const u16* H = (const u16*)(p.ws + OFF_H);
  const u16* W = (const u16*)(p.ws + OFF_W) + layer * W_LAYER + WO_IN;
  u16* proj = (u16*)(p.ws + OFF_PROJ);
  float* AB = (float*)(p.ws + OFF_AB);
  EPI_COORDS
  TileIter it; it.init(T / 128, 21, b, G);
  for (; it.valid(); it.next()) {
    const int row0 = it.rt() * 128, col0 = it.ct() * 128;
    f32x4 acc[4][4]; zero_acc<4>(acc);
    gemm_kloop<4>(H + (size_t)row0 * DM, DM, W + (size_t)col0 * DM, DM, 16, acc, sm);
#pragma unroll
    for (int mt = 0; mt < 4; ++mt) {
      const int row = row0 + wr * 64 + mt * 16 + fr;
      const float rs = rstd_of(ssq_buf(p, layer)[row]);
#pragma unroll
      for (int nt = 0; nt < 4; ++nt) {
        const int col = col0 + wc * 64 + nt * 16 + fq * 4;
        acc[mt][nt] *= rs;
        if (col < INW) {
          uint2 o; o.x = pack2(acc[mt][nt][0], acc[mt][nt][1]); o.y = pack2(acc[mt][nt][2], acc[mt][nt][3]);
          *(uint2*)(proj + (size_t)row * INW + col) = o;
          if (col >= 1024 && col < 1040)
            *(float4*)(AB + (size_t)row * 16 + (col - 1024)) = make_float4(acc[mt][nt][0], acc[mt][nt][1], acc[mt][nt][2], acc[mt][nt][3]);
        }
      }
    }
  }
}

DI void gemm_glu(const Params& p, int layer, int b, int G, u16* sm) {
  const u16* Gb = (const u16*)(p.ws + OFF_G);
  const u16* W = (const u16*)(p.ws + OFF_W) + layer * W_LAYER + WO_GLU;
  u16* proj = (u16*)(p.ws + OFF_PROJ);
  EPI_COORDS
  TileIter it; it.init(T / 128, 4, b, G);
  for (; it.valid(); it.next()) {
    const int row0 = it.rt() * 128, ct = it.ct();
    f32x4 acc[4][4]; zero_acc<4>(acc);
    gemm_kloop<4>(Gb + (size_t)row0 * 256, 256, W + (size_t)ct * 128 * 256, 256, 4, acc, sm);
#pragma unroll
    for (int mt = 0; mt < 4; ++mt) {
      const int row = row0 + wr * 64 + mt * 16 + fr;
#pragma unroll
      for (int nt = 0; nt < 2; ++nt) {
        const int col = (ct * 2 + wc) * 32 + nt * 16 + fq * 4;
        float o[4];
#pragma unroll
        for (int j = 0; j < 4; ++j) o[j] = acc[mt][nt][j] * sigmoidf_(acc[mt][nt + 2][j]);
        uint2 ov; ov.x = pack2(o[0], o[1]); ov.y = pack2(o[2], o[3]);
        *(uint2*)(proj + (size_t)row * INW + C_CU + col) = ov;
      }
    }
  }
}

DI void gemm_merge(const Params& p, int layer, int b, int G, u16* sm) {
  const u16* H = (const u16*)(p.ws + OFF_H);
  const u16* Wg = (const u16*)(p.ws + OFF_W) + layer * W_LAYER + WO_GATE;
  const u16* Wb = (const u16*)(p.ws + OFF_W) + layer * W_LAYER + WO_BR;
  const u16* proj = (const u16*)(p.ws + OFF_PROJ);
  u16* merged = (u16*)(p.ws + OFF_MERGED);
  EPI_COORDS
  TileIter it; it.init(T / 128, 8, b, G);
  for (; it.valid(); it.next()) {
    const int row0 = it.rt() * 128, col0 = it.ct() * 128;
    uint2 mg[4][4];
#pragma unroll
    for (int a = 0; a < 4; ++a)
#pragma unroll
      for (int c = 0; c < 4; ++c) mg[a][c] = make_uint2(0u, 0u);
#pragma unroll 1
    for (int i = 0; i < 4; ++i) {
      const int ocol = (i == 0) ? C_AZ : (i == 1) ? C_BQ : (i == 2) ? C_CU : C_DQ;
      f32x4 acc[4][4]; zero_acc<4>(acc);
      gemm_kloop<4, true>(H + (size_t)row0 * DM, DM, Wg + (size_t)i * DM * DM + (size_t)col0 * DM, DM, 16, acc, sm);
      uint2 sg[4][4];
#pragma unroll
      for (int a = 0; a < 4; ++a) {
        const float rs = rstd_of(ssq_buf(p, layer)[row0 + wr * 64 + a * 16 + fr]);
#pragma unroll
        for (int c = 0; c < 4; ++c) {
          sg[a][c].x = pack2(sigmoidf_(rs * acc[a][c][0]), sigmoidf_(rs * acc[a][c][1]));
          sg[a][c].y = pack2(sigmoidf_(rs * acc[a][c][2]), sigmoidf_(rs * acc[a][c][3]));
        }
      }
      zero_acc<4>(acc);
      gemm_kloop<4, true>(proj + (size_t)row0 * INW + ocol, INW, Wb + (size_t)i * DM * 256 + (size_t)col0 * 256, 256, 4, acc, sm);
#pragma unroll
      for (int a = 0; a < 4; ++a)
#pragma unroll
        for (int c = 0; c < 4; ++c) {
          const float m0 = bf2f((u16)(mg[a][c].x & 0xffff)) + bf2f((u16)(sg[a][c].x & 0xffff)) * acc[a][c][0];
          const float m1 = bf2f((u16)(mg[a][c].x >> 16)) + bf2f((u16)(sg[a][c].x >> 16)) * acc[a][c][1];
          const float m2 = bf2f((u16)(mg[a][c].y & 0xffff)) + bf2f((u16)(sg[a][c].y & 0xffff)) * acc[a][c][2];
          const float m3 = bf2f((u16)(mg[a][c].y >> 16)) + bf2f((u16)(sg[a][c].y >> 16)) * acc[a][c][3];
          mg[a][c].x = pack2(m0, m1); mg[a][c].y = pack2(m2, m3);
        }
    }
#pragma unroll
    for (int mt = 0; mt < 4; ++mt) {
      const int row = row0 + wr * 64 + mt * 16 + fr;
#pragma unroll
      for (int nt = 0; nt < 4; ++nt) {
        const int col = col0 + wc * 64 + nt * 16 + fq * 4;
        *(uint2*)(merged + (size_t)row * DM + col) = mg[mt][nt];
      }
    }
  }
}

DI void gemm_resid(const Params& p, int layer_src, const u16* A, int K, const u16* W, int b, int G, u16* sm, u16* xb_out,
                   float* ssq_acc) {
  EPI_COORDS
  TileIter it; it.init(T / 128, 8, b, G);
  for (; it.valid(); it.next()) {
    const int row0 = it.rt() * 128, col0 = it.ct() * 128;
    f32x4 acc[4][4]; zero_acc<4>(acc);
    gemm_kloop<4>(A + (size_t)row0 * K, K, W + (size_t)col0 * K, K, K / 64, acc, sm);
#pragma unroll
    for (int mt = 0; mt < 4; ++mt) {
      const int row = row0 + wr * 64 + mt * 16 + fr;
      const float* xs = xrow(p, layer_src, row);
      float* xd = p.xout + (size_t)row * DM;
      float ss = 0.f;
#pragma unroll
      for (int nt = 0; nt < 4; ++nt) {
        const int col = col0 + wc * 64 + nt * 16 + fq * 4;
        float4 r = *(const float4*)(xs + col);
        r.x += acc[mt][nt][0]; r.y += acc[mt][nt][1]; r.z += acc[mt][nt][2]; r.w += acc[mt][nt][3];
        *(float4*)(xd + col) = r;
        ss += r.x * r.x + r.y * r.y + r.z * r.z + r.w * r.w;
        if (xb_out) { uint2 o; o.x = pack2(r.x, r.y); o.y = pack2(r.z, r.w); *(uint2*)(xb_out + (size_t)row * DM + col) = o; }
      }
      if (ssq_acc) {
        ss += __shfl_xor(ss, 16, 64);
        ss += __shfl_xor(ss, 32, 64);
        if (fq == 0) atomicAdd(ssq_acc + row, ss);
      }
    }
  }
}

DI void gemm_ffn1(const Params& p, int layer, int b, int G, u16* sm) {
  const u16* H = (const u16*)(p.ws + OFF_H2);
  const u16* W = (const u16*)(p.ws + OFF_W) + layer * W_LAYER + WO_GU;
  u16* act = (u16*)(p.ws + OFF_ACT);
  EPI_COORDS
  TileIter it; it.init(T / 128, 44, b, G);
  for (; it.valid(); it.next()) {
    const int row0 = it.rt() * 128, ct = it.ct();
    f32x4 acc[4][4]; zero_acc<4>(acc);
    gemm_kloop<4>(H + (size_t)row0 * DM, DM, W + (size_t)ct * 128 * DM, DM, 16, acc, sm);
#pragma unroll
    for (int mt = 0; mt < 4; ++mt) {
      const int row = row0 + wr * 64 + mt * 16 + fr;
      const float rs = rstd_of(ssq_buf(p, 2 + layer)[row]);
#pragma unroll
      for (int nt = 0; nt < 2; ++nt) {
        const int col = (ct * 2 + wc) * 32 + nt * 16 + fq * 4;
        float o[4];
#pragma unroll
        for (int j = 0; j < 4; ++j) o[j] = siluf_(rs * acc[mt][nt][j]) * (rs * acc[mt][nt + 2][j]);
        uint2 ov; ov.x = pack2(o[0], o[1]); ov.y = pack2(o[2], o[3]);
        *(uint2*)(act + (size_t)row * FH + col) = ov;
      }
    }
  }
}

DI f32x4 mma_t(const u16* X, int xr, const u16* Y, int yr, f32x4 acc, int fr, int fq);
DI void gdn_pre(const Params& p, int layer, int task, char* smem) {
  const int tid = my_tid(), lane = tid & 63, wave = tid >> 6;
  const int fr = lane & 15, fq = lane >> 4;
  const int n = task >> 2, h = task & 3, c0 = n * 64;
  const int lo = seq_lo(c0), hi = seq_hi(c0);
  float* ks = (float*)smem;
  float* vs = ks + 64 * 65;
  u16* Kb = (u16*)vs;
  float* AmT = vs + 64 * 65;
  float* gcs = AmT + 2 * 64 * 68;
  float* bts = gcs + 128;
  const u16* proj = (const u16*)(p.ws + OFF_PROJ);
  u16* QN = (u16*)(p.ws + OFF_QN);
  u16* KN = (u16*)(p.ws + OFF_KN);
  float* GC = (float*)(p.ws + OFF_GC);
  const float* AB = (const float*)(p.ws + OFF_AB);
  u16* UW = (u16*)(p.ws + OFF_UW);
  __syncthreads();
#define GDN_CONV(MAT)                                                                                \
  {                                                                                                  \
    const int ch = (MAT) * 256 + h * 64 + lane;                                                      \
    float w[5];                                                                                      \
    _Pragma("unroll") for (int j = 0; j < 5; ++j) w[j] = p.conv_a[(size_t)(layer * 5 + j) * 768 + ch]; \
    float raw[20];                                                                                   \
    _Pragma("unroll") for (int i = 0; i < 20; ++i) {                                                 \
      const int tok = c0 + wave * 16 + i - 2;                                                        \
      raw[i] = (tok >= lo && tok < hi) ? bf2f(proj[(size_t)tok * INW + ch]) : 0.f;                   \
    }                                                                                                \
    _Pragma("unroll") for (int i = 0; i < 16; ++i) {                                                 \
      float v = 0.f;                                                                                 \
      _Pragma("unroll") for (int j = 0; j < 5; ++j) v += raw[i + j] * w[j];                          \
      v = siluf_(v);                                                                                 \
      const int tl = wave * 16 + i;                                                                  \
      if ((MAT) < 2) {                                                                               \
        const float ss = wave_sum(v * v);                                                            \
        v *= rsqrtf(ss + EPS) * ((MAT) == 0 ? 0.125f : 1.f);                                         \
      }                                                                                              \
      if ((MAT) == 0) QN[(size_t)(c0 + tl) * 256 + h * 64 + lane] = f2bf(v);                         \
      else if ((MAT) == 1) {                                                                         \
        const u16 kb = f2bf(v);                                                                      \
        KN[(size_t)(c0 + tl) * 256 + h * 64 + lane] = kb; ks[tl * 65 + lane] = v; Kb[tl * 72 + lane] = kb; \
      } else vs[tl * 65 + lane] = v;                                                                 \
    }                                                                                                \
  }
  GDN_CONV(0)
  GDN_CONV(1)
  if (wave < 2) {
    const int d = wave;
    const int tok = c0 + (d ? 63 - lane : lane);
    const float al = AB[(size_t)tok * 16 + d * 4 + h];
    const float br = AB[(size_t)tok * 16 + 8 + d * 4 + h];
    const float xx = al + p.dt_bias[(layer * 2 + d) * 4 + h];
    const float sp = fmaxf(xx, 0.f) + log1pf(__expf(-fabsf(xx)));
    float g = -__expf(p.a_log[(layer * 2 + d) * 4 + h]) * sp;
#pragma unroll
    for (int o = 1; o < 64; o <<= 1) {
      const float t = __shfl_up(g, o, 64);
      if (lane >= o) g += t;
    }
    gcs[d * 64 + lane] = g;
    bts[d * 64 + lane] = sigmoidf_(br);
    GC[(size_t)(task * 2 + d) * 64 + lane] = g;
  }
  __syncthreads();
#pragma unroll
  for (int t = 0; t < 4; ++t) {
    if (t <= wave) {
      const f32x4 kk = mma_t(Kb, wave * 16, Kb, t * 16, (f32x4){0.f, 0.f, 0.f, 0.f}, fr, fq);
      const int b = t * 16 + fr;
      const float gb0 = gcs[b], gb1 = gcs[64 + 63 - b], bt1 = bts[64 + 63 - b];
#pragma unroll
      for (int j = 0; j < 4; ++j) {
        const int a = wave * 16 + fq * 4 + j;
        if (a > b) {
          AmT[b * 68 + a] = bts[a] * kk[j] * __expf(gcs[a] - gb0);
          const int i1 = 63 - b, j1 = 63 - a;
          AmT[64 * 68 + j1 * 68 + i1] = bt1 * kk[j] * __expf(gb1 - gcs[64 + j1]);
        }
      }
    }
  }
  __syncthreads();
  GDN_CONV(2)
  __syncthreads();
  {
    int d = tid >> 7, c = tid & 127;
    asm volatile("" : "+v"(d), "+v"(c));
    float r[64];
    {
      const int stride = d ? -65 : 65;
      int off = (d ? 63 * 65 : 0) + (c & 63);
      const float* srcm = (c < 64) ? vs : ks;
      const bool isw = c >= 64;
#pragma unroll
      for (int i = 0; i < 64; ++i) {
        float v = srcm[off] * bts[d * 64 + i];
        if (isw) v *= __expf(gcs[d * 64 + i]);
        r[i] = v;
        off += stride;
        asm volatile("" : "+v"(off));
        if ((i & 7) == 7) __builtin_amdgcn_sched_barrier(0);
      }
    }
    const float* Ad = AmT + d * 64 * 68;
#pragma unroll
    for (int j = 0; j < 63; ++j) {
      const float rj = r[j];
#pragma unroll
      for (int i = j + 1; i < 64; ++i) {
        r[i] = fmaf(-Ad[j * 68 + i], rj, r[i]);
        if ((i & 15) == 15) __builtin_amdgcn_sched_barrier(0);
      }
      __builtin_amdgcn_sched_barrier(0);
    }
    u16* base = UW + (size_t)(task * 2 + d) * 8192;
    if (c < 64) {
      uint4* dst = (uint4*)(base + c * 64);
#pragma unroll
      for (int q = 0; q < 8; ++q)
        dst[q] = make_uint4(pack2(r[8 * q], r[8 * q + 1]), pack2(r[8 * q + 2], r[8 * q + 3]), pack2(r[8 * q + 4], r[8 * q + 5]),
                            pack2(r[8 * q + 6], r[8 * q + 7]));
    } else {
      u16* dst = base + 4096 + (c - 64);
#pragma unroll
      for (int i = 0; i < 64; ++i) dst[i * 64] = f2bf(r[i]);
    }
  }
}

DI f32x4 mma_t(const u16* X, int xr, const u16* Y, int yr, f32x4 acc, int fr, int fq) {
#pragma unroll
  for (int kk = 0; kk < 2; ++kk) {
    const bf16x8 x = *(const bf16x8*)(X + (xr + fr) * 72 + kk * 32 + fq * 8);
    const bf16x8 y = *(const bf16x8*)(Y + (yr + fr) * 72 + kk * 32 + fq * 8);
    acc = mfma16(x, y, acc);
  }
  return acc;
}
DI f32x4 mma_t_swz(const u16* X, int xr, const u16* Y, int yr, f32x4 acc, int fr, int fq) {
  const int sw = ((xr + fr) >> 3) & 7;
#pragma unroll
  for (int kk = 0; kk < 2; ++kk) {
    const bf16x8 x = *(const bf16x8*)(X + (xr + fr) * 72 + (((kk * 4 + fq) ^ sw) * 8));
    const bf16x8 y = *(const bf16x8*)(Y + (yr + fr) * 72 + kk * 32 + fq * 8);
    acc = mfma16(x, y, acc);
  }
  return acc;
}

DI void gdn_scan(const Params& p, int item, char* smem) {
  const int tid = my_tid(), lane = tid & 63, w = tid >> 6;
  const int fr = lane & 15, fq = lane >> 4;
  const int chain = item >> 2, eq = item & 3;
  const int s = chain >> 3, h = (chain >> 1) & 3, d = chain & 1;
  const int sb = s == 0 ? 0 : TP + (s - 1) * 4096;
  const int nch = s == 0 ? 256 : 64;
  u16* St = (u16*)smem;
  u16* Vt = St + 16 * 72;
  u16* Vts = Vt + 16 * 72;
  u16* Wc = Vts + 16 * 72;
  u16* Qc = Wc + 64 * 72;
  u16* Kc = Qc + 64 * 72;
  u16* KcT = Kc + 64 * 72;
  u16* QKm = KcT + 64 * 72;
  float* gcs = (float*)(QKm + 64 * 72);
  u16* proj = (u16*)(p.ws + OFF_PROJ);
  const u16* QN = (const u16*)(p.ws + OFF_QN);
  const u16* KN = (const u16*)(p.ws + OFF_KN);
  const float* GC = (const float*)(p.ws + OFF_GC);
  const u16* UW = (const u16*)(p.ws + OFF_UW);
  __syncthreads();
  for (int i = tid; i < 16 * 72; i += 256) St[i] = 0;
  f32x4 S0 = (f32x4){0.f, 0.f, 0.f, 0.f};
  const int prow0 = tid >> 3, prow1 = (tid >> 3) + 32, pseg = (tid & 7) * 8;
  uint4 w0a, w1a, q0a, q1a, k0a, k1a, w0b, w1b, q0b, q1b, k0b, k1b;
  uint2 u0a, u0b;
  float ga, gb;
#define GDN_PREFETCH2(J, S)                                                                          \
  {                                                                                                  \
    const int jj_ = (J) < nch ? (J) : nch - 1;                                                       \
    const int n_ = sb / 64 + (d ? nch - 1 - jj_ : jj_);                                              \
    const int c0_ = n_ * 64;                                                                         \
    const size_t tb_ = (size_t)((n_ * 4 + h) * 2 + d);                                               \
    const u16* ub_ = UW + tb_ * 8192;                                                                \
    const int tok0_ = c0_ + (d ? 63 - prow0 : prow0), tok1_ = c0_ + (d ? 63 - prow1 : prow1);        \
    w0##S = *(const uint4*)(ub_ + 4096 + prow0 * 64 + pseg);                                         \
    w1##S = *(const uint4*)(ub_ + 4096 + prow1 * 64 + pseg);                                         \
    q0##S = *(const uint4*)(QN + (size_t)tok0_ * 256 + h * 64 + pseg);                               \
    q1##S = *(const uint4*)(QN + (size_t)tok1_ * 256 + h * 64 + pseg);                               \
    k0##S = *(const uint4*)(KN + (size_t)tok0_ * 256 + h * 64 + pseg);                               \
    k1##S = *(const uint4*)(KN + (size_t)tok1_ * 256 + h * 64 + pseg);                               \
    u0##S = *(const uint2*)(ub_ + (eq * 16 + fr) * 64 + w * 16 + fq * 4);                            \
    g##S = GC[tb_ * 64 + lane];                                                                      \
  }
#define GDN_STAGE2(ROW, PW, PQ, PK)                                                                  \
  {                                                                                                  \
    *(uint4*)(Wc + (ROW) * 72 + pseg) = PW;                                                          \
    *(uint4*)(Qc + (ROW) * 72 + pseg) = PQ;                                                          \
    *(uint4*)(Kc + (ROW) * 72 + pseg) = PK;                                                          \
    u16* kt_ = KcT + pseg * 72 + ((((ROW) >> 3) ^ (tid & 7)) * 8) + ((ROW) & 7);                     \
    kt_[0 * 72] = (u16)(PK.x & 0xffff); kt_[1 * 72] = (u16)(PK.x >> 16);                             \
    kt_[2 * 72] = (u16)(PK.y & 0xffff); kt_[3 * 72] = (u16)(PK.y >> 16);                             \
    kt_[4 * 72] = (u16)(PK.z & 0xffff); kt_[5 * 72] = (u16)(PK.z >> 16);                             \
    kt_[6 * 72] = (u16)(PK.w & 0xffff); kt_[7 * 72] = (u16)(PK.w >> 16);                             \
  }
#define GDN_STEP(JV, S)                                                                              \
  {                                                                                                  \
    const int j_ = (JV);                                                                             \
    const int n = sb / 64 + (d ? nch - 1 - j_ : j_);                                                 \
    const int c0 = n * 64;                                                                           \
    GDN_STAGE2(prow0, w0##S, q0##S, k0##S)                                                           \
    GDN_STAGE2(prow1, w1##S, q1##S, k1##S)                                                           \
    if (tid < 64) gcs[tid] = g##S;                                                                   \
    const uint2 cu0 = u0##S;                                                                         \
    __syncthreads();                                                                          \
    GDN_PREFETCH2(j_ + 2, S)                                                                         \
    const f32x4 z4 = (f32x4){0.f, 0.f, 0.f, 0.f};                                                    \
    const f32x4 P1a = mma_t(Wc, w * 16, St, 0, z4, fr, fq);                                          \
    const f32x4 P2a = mma_t(St, 0, Qc, w * 16, z4, fr, fq);                                          \
      \
    const float glog = gcs[63];                                                                      \
    const float gcc = gcs[w * 16 + fr];                                                              \
    const float4 gq0 = *(const float4*)(gcs + fq * 4), gq1 = *(const float4*)(gcs + 16 + fq * 4);    \
    const float4 gq2 = *(const float4*)(gcs + 32 + fq * 4), gq3 = *(const float4*)(gcs + 48 + fq * 4); \
    const float4 gw = *(const float4*)(gcs + w * 16 + fq * 4);                                       \
    {                                                                                                \
      const int c = w * 16 + fr;                                                                     \
      _Pragma("unroll") for (int t = 0; t < 4; ++t) {                                                \
        const f32x4 qk = mma_t(Kc, t * 16, Qc, w * 16, z4, fr, fq);                                  \
        const int s0 = t * 16 + fq * 4;                                                              \
        const float4 gs = t == 0 ? gq0 : t == 1 ? gq1 : t == 2 ? gq2 : gq3;                          \
        const float e0 = __expf(fminf(gcc - gs.x, 0.f)), e1 = __expf(fminf(gcc - gs.y, 0.f));       \
        const float e2 = __expf(fminf(gcc - gs.z, 0.f)), e3 = __expf(fminf(gcc - gs.w, 0.f));       \
        const float v0 = (c >= s0 + 0) ? qk[0] * e0 : 0.f;                                           \
        const float v1 = (c >= s0 + 1) ? qk[1] * e1 : 0.f;                                           \
        const float v2 = (c >= s0 + 2) ? qk[2] * e2 : 0.f;                                           \
        const float v3 = (c >= s0 + 3) ? qk[3] * e3 : 0.f;                                           \
        uint2 o; o.x = pack2(v0, v1); o.y = pack2(v2, v3);                                           \
        *(uint2*)(QKm + c * 72 + s0) = o;                                                            \
      }                                                                                              \
    }                                                                                                \
    {                                                                                                \
      const int cc0 = w * 16 + fq * 4;                                                               \
      const float v0 = bf2f((u16)(cu0.x & 0xffff)) - P1a[0], v1 = bf2f((u16)(cu0.x >> 16)) - P1a[1]; \
      const float v2 = bf2f((u16)(cu0.y & 0xffff)) - P1a[2], v3 = bf2f((u16)(cu0.y >> 16)) - P1a[3]; \
      uint2 o; o.x = pack2(v0, v1); o.y = pack2(v2, v3);                                             \
      *(uint2*)(Vt + fr * 72 + cc0) = o;                                                             \
      uint2 o2;                                                                                      \
      o2.x = pack2(v0 * __expf(glog - gw.x), v1 * __expf(glog - gw.y));                              \
      o2.y = pack2(v2 * __expf(glog - gw.z), v3 * __expf(glog - gw.w));                              \
      *(uint2*)(Vts + fr * 72 + cc0) = o2;                                                           \
    }                                                                                                \
    __syncthreads();                                                                          \
    {                                                                                                \
      const int c = w * 16 + fr;                                                                     \
      const float eg = __expf(gcc);                                                                  \
      const int tok = c0 + (d ? 63 - c : c);                                                         \
      u16* orow = proj + (size_t)tok * INW + d * 256 + h * 64 + eq * 16 + fq * 4;                    \
      f32x4 oa = P2a * eg;                                                                           \
      oa = mma_t(Vt, 0, QKm, w * 16, oa, fr, fq);                                                    \
      uint2 o; o.x = pack2(oa[0], oa[1]); o.y = pack2(oa[2], oa[3]);                                 \
      *(uint2*)(orow) = o;                                                                           \
    }                                                                                                \
    {                                                                                                \
      const float gl = __expf(glog);                                                                 \
      S0 *= gl;                                                                                      \
      S0 = mma_t_swz(KcT, w * 16, Vts, 0, S0, fr, fq);                                               \
      const int r0 = w * 16 + fq * 4;                                                                \
      uint2 o; o.x = pack2(S0[0], S0[1]); o.y = pack2(S0[2], S0[3]);                                 \
      *(uint2*)(St + fr * 72 + r0) = o;                                                              \
    }                                                                                                \
    __syncthreads();                                                                          \
  }
  GDN_PREFETCH2(0, a)
  GDN_PREFETCH2(1, b)
  for (int j = 0; j < nch; j += 2) {
    GDN_STEP(j, a)
    GDN_STEP(j + 1, b)
  }
}

DI void gdn_post_row(const Params& p, int layer, int t) {
  const int lane = my_tid() & 63;
  u16* row = (u16*)(p.ws + OFF_PROJ) + (size_t)t * INW;
  const uint2 f = *(const uint2*)(row + lane * 4);
  const uint2 bw = *(const uint2*)(row + 256 + lane * 4);
  const uint2 z = *(const uint2*)(row + C_AZ + lane * 4);
  float o[4], zz[4];
  o[0] = bf2f((u16)(f.x & 0xffff)) + bf2f((u16)(bw.x & 0xffff));
  o[1] = bf2f((u16)(f.x >> 16)) + bf2f((u16)(bw.x >> 16));
  o[2] = bf2f((u16)(f.y & 0xffff)) + bf2f((u16)(bw.y & 0xffff));
  o[3] = bf2f((u16)(f.y >> 16)) + bf2f((u16)(bw.y >> 16));
  zz[0] = bf2f((u16)(z.x & 0xffff)); zz[1] = bf2f((u16)(z.x >> 16)); zz[2] = bf2f((u16)(z.y & 0xffff)); zz[3] = bf2f((u16)(z.y >> 16));
  float ss = o[0] * o[0] + o[1] * o[1] + o[2] * o[2] + o[3] * o[3];
#pragma unroll
  for (int m = 1; m < 16; m <<= 1) ss += __shfl_xor(ss, m, 64);
  const float rs = rsqrtf(ss * (1.f / 64.f) + EPS);
  const int e0 = (lane & 15) * 4;
  float r[4];
#pragma unroll
  for (int j = 0; j < 4; ++j) r[j] = o[j] * rs * p.a_norm[layer * 64 + e0 + j] * siluf_(zz[j]);
  uint2 ov; ov.x = pack2(r[0], r[1]); ov.y = pack2(r[2], r[3]);
  *(uint2*)(row + C_AZ + lane * 4) = ov;
}

constexpr int XP = 20;
struct S5Rec { float are, aim, lr, li, step; };
DI void s5_rec_consts(const Params& p, int layer, int d, int g, int lane, S5Rec& k) {
  const int gi = ((layer * 2 + d) * 16 + g);
  k.lr = p.lam_re[(size_t)gi * 64 + lane];
  k.li = p.lam_im[(size_t)gi * 64 + lane];
  k.step = expf(p.log_step[gi]);
  const float mag = expf(k.lr * k.step);
  float sn, cs; sincosf(k.li * k.step, &sn, &cs);
  k.are = mag * cs; k.aim = mag * sn;
}
DI void s5_bq(const Params& p, int layer, int d, int g, int fr, int fq, bf16x8 (&bq)[8]) {
  const int gi = ((layer * 2 + d) * 16 + g);
  const float step = expf(p.log_step[gi]);
#pragma unroll
  for (int n4 = 0; n4 < 4; ++n4) {
    const int pp = n4 * 16 + fr;
    const float lr = p.lam_re[(size_t)gi * 64 + pp], li = p.lam_im[(size_t)gi * 64 + pp];
    const float mag = expf(lr * step);
    float sn, cs; sincosf(li * step, &sn, &cs);
    const float are = mag * cs, aim = mag * sn;
    const float inv = 1.f / (lr * lr + li * li);
    const float ir = lr * inv, ii = -li * inv;
    const float cr = (are - 1.f) * ir - aim * ii;
    const float ci = (are - 1.f) * ii + aim * ir;
    const float* br = p.b_re + ((size_t)(layer * 16 + g) * 64 + pp) * 16 + (fq & 1) * 8;
    const float* bi = p.b_im + ((size_t)(layer * 16 + g) * 64 + pp) * 16 + (fq & 1) * 8;
    bf16x8 vr, vi;
#pragma unroll
    for (int e = 0; e < 8; ++e) {
      const float a = br[e], b = bi[e];
      vr[e] = (fq < 2) ? (short)f2bf(cr * a - ci * b) : (short)0;
      vi[e] = (fq < 2) ? (short)f2bf(cr * b + ci * a) : (short)0;
    }
    bq[n4] = vr;
    bq[4 + n4] = vi;
  }
}
DI bf16x8 s5_uf(const u16* proj, int tok0, int g, int fr, int fq) {
  const uint4 v = *(const uint4*)(proj + (size_t)(tok0 + fr) * INW + C_CU + g * 16 + (fq & 1) * 8);
  const uint4 z = make_uint4(0u, 0u, 0u, 0u);
  return __builtin_bit_cast(bf16x8, fq < 2 ? v : z);
}
#define S5_BLOCK_X(UF, XS, XR, XI)                                                                   \
  {                                                                                                  \
    asm volatile("s_waitcnt lgkmcnt(0)" ::: "memory");    \
    _Pragma("unroll") for (int n = 0; n < 8; ++n) {                                                  \
      const f32x4 xx = mfma16(bq[n], UF, (f32x4){0.f, 0.f, 0.f, 0.f});   \
      _Pragma("unroll") for (int j = 0; j < 4; ++j) (XS)[(n * 16 + fq * 4 + j) * XP + fr] = xx[j];   \
    }                                                                                                \
    asm volatile("s_waitcnt lgkmcnt(0)" ::: "memory");                                               \
    _Pragma("unroll") for (int q = 0; q < 4; ++q) {                                                  \
      const float4 a = *(const float4*)((XS) + lane * XP + q * 4);                                   \
      const float4 b = *(const float4*)((XS) + (64 + lane) * XP + q * 4);                            \
      XR[q * 4 + 0] = a.x; XR[q * 4 + 1] = a.y; XR[q * 4 + 2] = a.z; XR[q * 4 + 3] = a.w;            \
      XI[q * 4 + 0] = b.x; XI[q * 4 + 1] = b.y; XI[q * 4 + 2] = b.z; XI[q * 4 + 3] = b.w;            \
    }                                                                                                \
  }
DI void s5_build_table(const Params& p, int layer, int dg) {
  const int lane = my_tid() & 63, fr = lane & 15, fq = lane >> 4;
  const int d = dg >> 4, g = dg & 15;
  char* tab = p.ws + OFF_S5TAB + (size_t)dg * S5TAB_STRIDE;
  bf16x8 bq[8]; s5_bq(p, layer, d, g, fr, fq, bq);
#pragma unroll
  for (int n = 0; n < 8; ++n) ((uint4*)tab)[n * 64 + lane] = __builtin_bit_cast(uint4, bq[n]);
  const float* cr = p.c_re + ((size_t)((layer * 2 + d) * 16 + g) * 16 + fr) * 64;
  const float* ci = p.c_im + ((size_t)((layer * 2 + d) * 16 + g) * 16 + fr) * 64;
#pragma unroll
  for (int kk = 0; kk < 4; ++kk) {
    bf16x8 cf;
#pragma unroll
    for (int e = 0; e < 8; ++e) {
      const int kx = (kk & 1) * 32 + fq * 8 + e;
      cf[e] = (short)f2bf((kk < 2) ? cr[kx] : -ci[kx]);
    }
    ((uint4*)(tab + 8192))[kk * 64 + lane] = __builtin_bit_cast(uint4, cf);
  }
  S5Rec k; s5_rec_consts(p, layer, d, g, lane, k);
  const float m64 = expf(k.lr * k.step * 64.f);
  float s64, c64; sincosf(k.li * k.step * 64.f, &s64, &c64);
  ((float4*)(tab + 12288))[lane] = make_float4(k.are, k.aim, m64 * c64, m64 * s64);
}
DI void s5_pass1(const Params& p, int layer, int task, char* smem) {
  const int lane = my_tid() & 63, wave = my_tid() >> 6;
  const int fr = lane & 15, fq = lane >> 4;
  const int n = task >> 2, gq = task & 3, g = gq * 4 + wave, c0 = n * 64;
  float* Xs = (float*)smem + wave * 128 * XP;
  const u16* proj = (const u16*)(p.ws + OFF_PROJ);
  float2* SEND = (float2*)(p.ws + OFF_SEND);
  __syncthreads();
  bf16x8 uf[4];
#pragma unroll
  for (int tb = 0; tb < 4; ++tb) uf[tb] = s5_uf(proj, c0 + tb * 16, g, fr, fq);
#pragma unroll 1
  for (int d = 0; d < 2; ++d) {
    const char* tab = p.ws + OFF_S5TAB + (size_t)(d * 16 + g) * S5TAB_STRIDE;
    bf16x8 bq[8];
#pragma unroll
    for (int n8 = 0; n8 < 8; ++n8) bq[n8] = __builtin_bit_cast(bf16x8, ((const uint4*)tab)[n8 * 64 + lane]);
    const float4 rc = ((const float4*)(tab + 12288))[lane];
    S5Rec k; k.are = rc.x; k.aim = rc.y;
    float sr = 0.f, si = 0.f;
#pragma unroll
    for (int blk = 0; blk < 4; ++blk) {
      const int tb = d ? 3 - blk : blk;
      float xr[16], xi[16];
      S5_BLOCK_X(uf[tb], Xs, xr, xi)
#pragma unroll
      for (int i = 0; i < 16; ++i) {
        const int r = d ? 15 - i : i;
        const float nr = k.are * sr - k.aim * si + xr[r], ni = k.are * si + k.aim * sr + xi[r];
        sr = nr; si = ni;
      }
    }
    SEND[((size_t)(n * 2 + d) * 16 + g) * 64 + lane] = make_float2(sr, si);
  }
}
DI float gelu_tanh(float x) {
  const float u = 0.7978845608028654f * (x + 0.044715f * x * x * x);
  return 0.5f * x * (1.f + tanhf(u));
}
DI void s5_pass3(const Params& p, int layer, int task, char* smem) {
  const int lane = my_tid() & 63, wave = my_tid() >> 6;
  const int fr = lane & 15, fq = lane >> 4;
  const int n = task >> 2, gq = task & 3, g = gq * 4 + wave, c0 = n * 64;
  const int nlo = seq_lo(c0) / 64, nhi = seq_hi(c0) / 64;
  float* Xs = (float*)smem + wave * 128 * XP;
  u16* Sb = (u16*)(smem + 4 * 128 * XP * 4) + wave * 16 * 136;
  const u16* proj = (const u16*)(p.ws + OFF_PROJ);
  const float2* SEND = (const float2*)(p.ws + OFF_SEND);
  u16* Gb = (u16*)(p.ws + OFF_G);
  __syncthreads();
  bf16x8 uf[4];
#pragma unroll
  for (int tb = 0; tb < 4; ++tb) uf[tb] = s5_uf(proj, c0 + tb * 16, g, fr, fq);
  f32x4 yacc[4];
#pragma unroll
  for (int tb = 0; tb < 4; ++tb) yacc[tb] = (f32x4){0.f, 0.f, 0.f, 0.f};
#pragma unroll 1
  for (int d = 0; d < 2; ++d) {
    const char* tab = p.ws + OFF_S5TAB + (size_t)(d * 16 + g) * S5TAB_STRIDE;
    bf16x8 bq[8];
#pragma unroll
    for (int n8 = 0; n8 < 8; ++n8) bq[n8] = __builtin_bit_cast(bf16x8, ((const uint4*)tab)[n8 * 64 + lane]);
    const float4 rc = ((const float4*)(tab + 12288))[lane];
    S5Rec k; k.are = rc.x; k.aim = rc.y;
    const float a64r = rc.z, a64i = rc.w;
    float sr = 0.f, si = 0.f;
    {
      const int cnt = d == 0 ? n - nlo : nhi - 1 - n;
      const int first = d == 0 ? nlo : nhi - 1;
      const int sgn = d == 0 ? 1 : -1;
      const float2* sp = SEND + ((size_t)(first * 2 + d) * 16 + g) * 64 + lane;
      const long stride = (long)sgn * 2 * 16 * 64;
      int m = 0;
      for (; m + 8 <= cnt; m += 8) {
        float2 e0 = sp[0], e1 = sp[stride], e2 = sp[2 * stride], e3 = sp[3 * stride];
        float2 e4 = sp[4 * stride], e5 = sp[5 * stride], e6 = sp[6 * stride], e7 = sp[7 * stride];
        sp += 8 * stride;
#define HSTEP(E) { const float nr = a64r * sr - a64i * si + E.x, ni = a64r * si + a64i * sr + E.y; sr = nr; si = ni; }
        HSTEP(e0) HSTEP(e1) HSTEP(e2) HSTEP(e3) HSTEP(e4) HSTEP(e5) HSTEP(e6) HSTEP(e7)
      }
      for (; m < cnt; ++m) {
        const float2 e = sp[0];
        sp += stride;
        HSTEP(e)
      }
    }
    bf16x8 cf[4];
#pragma unroll
    for (int kk = 0; kk < 4; ++kk) cf[kk] = __builtin_bit_cast(bf16x8, ((const uint4*)(tab + 8192))[kk * 64 + lane]);
#pragma unroll
    for (int blk = 0; blk < 4; ++blk) {
      const int tb = d ? 3 - blk : blk;
      float xr[16], xi[16];
      S5_BLOCK_X(uf[tb], Xs, xr, xi)
#pragma unroll
      for (int i = 0; i < 16; ++i) {
        const int r = d ? 15 - i : i;
        const float nr = k.are * sr - k.aim * si + xr[r], ni = k.are * si + k.aim * sr + xi[r];
        sr = nr; si = ni;
        Sb[r * 136 + lane] = f2bf(sr);
        Sb[r * 136 + 64 + lane] = f2bf(si);
      }
      asm volatile("s_waitcnt lgkmcnt(0)" ::: "memory");
#pragma unroll
      for (int kk = 0; kk < 4; ++kk) {
        const bf16x8 xf = *(const bf16x8*)(Sb + fr * 136 + kk * 32 + fq * 8);
        yacc[tb] = mfma16(xf, cf[kk], yacc[tb]);
      }
      asm volatile("s_waitcnt lgkmcnt(0)" ::: "memory");
    }
  }
  const float dsk = p.s5_d[layer * 256 + g * 16 + fr];
#pragma unroll
  for (int tb = 0; tb < 4; ++tb)
#pragma unroll
    for (int j = 0; j < 4; ++j) {
      const int t = tb * 16 + fq * 4 + j;
      const float u = bf2f(proj[(size_t)(c0 + t) * INW + C_CU + g * 16 + fr]);
      const float y = yacc[tb][j] + u * dsk;
      Gb[(size_t)(c0 + t) * 256 + g * 16 + fr] = f2bf(gelu_tanh(y));
    }
}

struct AttnState { float m, l; f32x4 o[4]; };
DI void attn_segment(const u16* proj, int kcol, int vcol, int tk0, int kstride, int npairs, int R, float slope, int tq,
                     int lo, int hi, const bf16x8 (&qf)[2], AttnState& st, u16* Vt, int lane) {
  const int fr = lane & 15, fq = lane >> 4;
#pragma unroll 1
  for (int pr = 0; pr < npairs; ++pr) {
    const int kbase = tk0 + pr * 32 * kstride;
    f32x4 sacc[2];
#pragma unroll
    for (int t = 0; t < 2; ++t) {
      int tk = kbase + (t * 16 + fr) * kstride;
      tk = min(max(tk, lo), hi - 1);
      const u16* kp = proj + (size_t)tk * INW + kcol + fq * 8;
      const bf16x8 k0 = *(const bf16x8*)(kp), k1 = *(const bf16x8*)(kp + 32);
      sacc[t] = mfma16(k0, qf[0], (f32x4){0.f, 0.f, 0.f, 0.f});
      sacc[t] = mfma16(k1, qf[1], sacc[t]);
    }
    uint4 vr0, vr1, vr2, vr3;
    {
      const int seg = (lane & 7) * 8, kl0 = lane >> 3;
      const int t0 = min(max(kbase + (kl0 + 0) * kstride, lo), hi - 1), t1 = min(max(kbase + (kl0 + 8) * kstride, lo), hi - 1);
      const int t2 = min(max(kbase + (kl0 + 16) * kstride, lo), hi - 1), t3 = min(max(kbase + (kl0 + 24) * kstride, lo), hi - 1);
      vr0 = *(const uint4*)(proj + (size_t)t0 * INW + vcol + seg);
      vr1 = *(const uint4*)(proj + (size_t)t1 * INW + vcol + seg);
      vr2 = *(const uint4*)(proj + (size_t)t2 * INW + vcol + seg);
      vr3 = *(const uint4*)(proj + (size_t)t3 * INW + vcol + seg);
    }
    float sc[2][4]; bool ok[2][4];
    float mx = -1e30f;
#pragma unroll
    for (int t = 0; t < 2; ++t)
#pragma unroll
      for (int j = 0; j < 4; ++j) {
        const int tk = kbase + (t * 16 + fq * 4 + j) * kstride;
        const int ad = abs(tk - tq);
        ok[t][j] = (ad <= R) && (tk >= lo) && (tk < hi);
        sc[t][j] = sacc[t][j] * 0.125f - slope * (float)ad;
        if (ok[t][j]) mx = fmaxf(mx, sc[t][j]);
      }
    mx = fmaxf(mx, __shfl_xor(mx, 16, 64));
    mx = fmaxf(mx, __shfl_xor(mx, 32, 64));
    const float mn = fmaxf(st.m, mx);
    const float alpha = __expf(st.m - mn);
    st.m = mn;
    float pv[2][4], ps = 0.f;
#pragma unroll
    for (int t = 0; t < 2; ++t)
#pragma unroll
      for (int j = 0; j < 4; ++j) { pv[t][j] = ok[t][j] ? __expf(sc[t][j] - mn) : 0.f; ps += pv[t][j]; }
    st.l = st.l * alpha + ps;
#pragma unroll
    for (int dt = 0; dt < 4; ++dt)
#pragma unroll
      for (int j = 0; j < 4; ++j) st.o[dt][j] *= alpha;
    bf16x8 pf;
    {
      const unsigned w0 = pack2(pv[0][0], pv[0][1]), w1 = pack2(pv[0][2], pv[0][3]), w2 = pack2(pv[1][0], pv[1][1]),
                     w3 = pack2(pv[1][2], pv[1][3]);
      uint4 t4 = make_uint4(w0, w1, w2, w3);
      pf = __builtin_bit_cast(bf16x8, t4);
    }
    asm volatile("s_waitcnt lgkmcnt(0)" ::: "memory");
    {
      u16* vdst = Vt + (lane >> 3) * 72 + (lane & 7) * 8;
      *(uint4*)(vdst) = vr0; *(uint4*)(vdst + 8 * 72) = vr1; *(uint4*)(vdst + 16 * 72) = vr2; *(uint4*)(vdst + 24 * 72) = vr3;
    }
    {
      const int q = fr >> 2, pp = fr & 3;
      const unsigned a0 = (unsigned)(size_t)Vt + (unsigned)(((fq * 4 + q) * 72 + 4 * pp) * 2);
      {
        uint2 x0, x1, y0, y1;
        asm volatile(
            "s_waitcnt lgkmcnt(0)\n\t"
            "ds_read_b64_tr_b16 %0, %4\n\t"
            "ds_read_b64_tr_b16 %1, %4 offset:32\n\t"
            "ds_read_b64_tr_b16 %2, %4 offset:2304\n\t"
            "ds_read_b64_tr_b16 %3, %4 offset:2336\n\t"
            "s_waitcnt lgkmcnt(0)"
            : "=&v"(x0), "=&v"(x1), "=&v"(y0), "=&v"(y1) : "v"(a0) : "memory");
        st.o[0] = mfma16(__builtin_bit_cast(bf16x8, make_uint4(x0.x, x0.y, y0.x, y0.y)), pf, st.o[0]);
        st.o[1] = mfma16(__builtin_bit_cast(bf16x8, make_uint4(x1.x, x1.y, y1.x, y1.y)), pf, st.o[1]);
      }
      {
        uint2 x0, x1, y0, y1;
        asm volatile(
            "ds_read_b64_tr_b16 %0, %4 offset:64\n\t"
            "ds_read_b64_tr_b16 %1, %4 offset:96\n\t"
            "ds_read_b64_tr_b16 %2, %4 offset:2368\n\t"
            "ds_read_b64_tr_b16 %3, %4 offset:2400\n\t"
            "s_waitcnt lgkmcnt(0)"
            : "=&v"(x0), "=&v"(x1), "=&v"(y0), "=&v"(y1) : "v"(a0) : "memory");
        st.o[2] = mfma16(__builtin_bit_cast(bf16x8, make_uint4(x0.x, x0.y, y0.x, y0.y)), pf, st.o[2]);
        st.o[3] = mfma16(__builtin_bit_cast(bf16x8, make_uint4(x1.x, x1.y, y1.x, y1.y)), pf, st.o[3]);
      }
    }
  }
}
DI void attn_task(const Params& p, int layer, int mode, int task, char* smem) {
  const int lane = my_tid() & 63, wave = my_tid() >> 6;
  const int fr = lane & 15, fq = lane >> 4;
  u16* proj = (u16*)(p.ws + OFF_PROJ);
  u16* Vt = (u16*)smem + wave * 32 * 72;
  int tq0, qstride, qcol, kcol, vcol; float slope;
  int hq;
  if (mode == 0) {
    const int blk = task >> 4, h = (task >> 2) & 3, rq = task & 3;
    hq = h; tq0 = blk * 256 + rq * 4 + wave; qstride = 16;
    qcol = C_BQ + h * 64; kcol = C_BK + h * 64; vcol = C_BV + h * 64;
    slope = exp2f(-(float)(5 + h));
  } else {
    const int blk = task >> 2, qh = task & 3;
    hq = qh; tq0 = blk * 64 + wave * 16; qstride = 1;
    qcol = C_DQ + qh * 64; kcol = C_DK + (qh >> 1) * 64; vcol = C_DV + (qh >> 1) * 64;
    slope = exp2f(-(float)(1 + qh));
  }
  const int lo = seq_lo(tq0), hi = seq_hi(tq0);
  const int tq = tq0 + fr * qstride;
  bf16x8 qf[2];
  {
    const u16* qp = proj + (size_t)tq * INW + qcol + fq * 8;
    qf[0] = *(const bf16x8*)(qp); qf[1] = *(const bf16x8*)(qp + 32);
  }
  AttnState st; st.m = -1e30f; st.l = 0.f;
#pragma unroll
  for (int dt = 0; dt < 4; ++dt) st.o[dt] = (f32x4){0.f, 0.f, 0.f, 0.f};
  __syncthreads();
  float scale;
  if (mode == 0) {
    attn_segment(proj, kcol, vcol, tq0 - 64, 1, 12, 64, slope, tq, lo, hi, qf, st, Vt, lane);
    attn_segment(proj, kcol, vcol, tq0 - 256, 4, 6, 256, slope, tq, lo, hi, qf, st, Vt, lane);
    attn_segment(proj, kcol, vcol, tq0 - 1024, 16, 5, 1024, slope, tq, lo, hi, qf, st, Vt, lane);
    float l = st.l; l += __shfl_xor(l, 16, 64); l += __shfl_xor(l, 32, 64);
    scale = 1.f / l;
  } else {
    attn_segment(proj, kcol, vcol, tq0 - 128, 1, 9, 128, slope, tq, lo, hi, qf, st, Vt, lane);
    float l = st.l; l += __shfl_xor(l, 16, 64); l += __shfl_xor(l, 32, 64);
    const float sink = p.attn_sink[layer * 4 + hq];
    const float mf = fmaxf(st.m, sink);
    const float sc = __expf(st.m - mf);
    scale = sc / (l * sc + __expf(sink - mf));
  }
#pragma unroll
  for (int dt = 0; dt < 4; ++dt) {
    uint2 o; o.x = pack2(st.o[dt][0] * scale, st.o[dt][1] * scale); o.y = pack2(st.o[dt][2] * scale, st.o[dt][3] * scale);
    *(uint2*)(proj + (size_t)tq * INW + qcol + dt * 16 + fq * 4) = o;
  }
}

DI void final_row(const Params& p, int t) {
  const int lane = my_tid() & 63;
  float* row = p.xout + (size_t)t * DM;
  float4 v[4]; float ss = 0.f;
#pragma unroll
  for (int i = 0; i < 4; ++i) {
    v[i] = *(const float4*)(row + i * 256 + lane * 4);
    ss += v[i].x * v[i].x + v[i].y * v[i].y + v[i].z * v[i].z + v[i].w * v[i].w;
  }
  ss = wave_sum(ss);
  const float rs = rstd_of(ss);
#pragma unroll
  for (int i = 0; i < 4; ++i) {
    const float4 g = *(const float4*)(p.final_norm + i * 256 + lane * 4);
    *(float4*)(row + i * 256 + lane * 4) = make_float4(v[i].x * rs * g.x, v[i].y * rs * g.y, v[i].z * rs * g.z, v[i].w * rs * g.w);
  }
}

#define XB_TMO      128
#define XB_XCNT(j)  (256  + 64 * (j))
#define XB_XSUB(j)  (1280 + 64 * (j))
#define XB_XGEN(j)  (2304 + 64 * (j))
#define XB_TOP      3328
#define XB_TOPGEN   3392
#define XB_SPIN_CAP (1u << 22)
#define LAS __attribute__((address_space(3)))
DI unsigned xb_ld(unsigned* p) { return __hip_atomic_load(p, __ATOMIC_RELAXED, __HIP_MEMORY_SCOPE_AGENT); }
DI unsigned xb_add(unsigned* p, unsigned v) { return __hip_atomic_fetch_add(p, v, __ATOMIC_RELAXED, __HIP_MEMORY_SCOPE_AGENT); }
DI unsigned xb_xcc_id() { return (unsigned)__builtin_amdgcn_s_getreg((3 << 11) | 20) & 0xFu; }
#define XB_SPIN(cond, bar) do { unsigned _sp = 0; while (cond) { __builtin_amdgcn_s_sleep(1); \
    if ((++_sp & 255u) == 0u) { if (xb_ld(&(bar)[XB_TMO])) break; if (_sp > XB_SPIN_CAP) { atomicAdd(&(bar)[XB_TMO], 1u); break; } } } } while (0)
struct XcdBarrier { unsigned* bar; unsigned x; volatile LAS unsigned* st; };
DI XcdBarrier xcd_barrier_post(unsigned* bar, volatile LAS unsigned* st) {
  XcdBarrier b; b.bar = bar; b.x = xb_xcc_id(); b.st = st;
  if (threadIdx.x == 0) (void)xb_add(&bar[XB_XCNT(b.x)], 1u);
  return b;
}
DI void xcd_barrier_complete(unsigned* bar, unsigned x, unsigned& nloc, unsigned& nx) {
  const unsigned G = gridDim.x * gridDim.y * gridDim.z;
  unsigned sum, cnt, mine, sp = 0u;
  for (;;) {
    sum = 0u; cnt = 0u; mine = 0u;
#pragma unroll
    for (unsigned j = 0; j < 16; ++j) { const unsigned c = xb_ld(&bar[XB_XCNT(j)]); sum += c; cnt += (c > 0u) ? 1u : 0u; mine = (j == x) ? c : mine; }
    if (sum == G) break;
    __builtin_amdgcn_s_sleep(1);
    if ((++sp & 255u) == 0u) { if (xb_ld(&bar[XB_TMO])) break; if (sp > XB_SPIN_CAP) { atomicAdd(&bar[XB_TMO], 1u); break; } }
  }
  nloc = mine > 0u ? mine : 1u; nx = cnt > 0u ? cnt : 1u;
}
DI void xcd_barrier(const XcdBarrier& b) {
  asm volatile("s_waitcnt vmcnt(0)" ::: "memory");
  __syncthreads();
  if (threadIdx.x == 0) {
    unsigned* bar = b.bar;
    __builtin_amdgcn_s_waitcnt(0);
    unsigned nloc = b.st[0], nx = b.st[1];
    if (nloc == 0u) { xcd_barrier_complete(bar, b.x, nloc, nx); b.st[0] = nloc; b.st[1] = nx; }
    const unsigned old = xb_add(&bar[XB_XSUB(b.x)], 1u);
    const unsigned gen = old / nloc;
    if (old + 1u == (gen + 1u) * nloc) {
      __builtin_amdgcn_fence(__ATOMIC_RELEASE, "agent");
      asm volatile("s_waitcnt vmcnt(0)" ::: "memory");
      const unsigned og = xb_add(&bar[XB_TOP], 1u);
      const unsigned tg = og / nx;
      if (og + 1u == (tg + 1u) * nx) xb_add(&bar[XB_TOPGEN], 1u);
      else XB_SPIN(xb_ld(&bar[XB_TOPGEN]) == tg, bar);
      __builtin_amdgcn_fence(__ATOMIC_ACQUIRE, "agent");
      xb_add(&bar[XB_XGEN(b.x)], 1u);
      asm volatile("s_waitcnt vmcnt(0)" ::: "memory");
    } else {
      XB_SPIN(xb_ld(&bar[XB_XGEN(b.x)]) == gen, bar);
      __builtin_amdgcn_fence(__ATOMIC_ACQUIRE, "agent");
      asm volatile("s_waitcnt vmcnt(0)" ::: "memory");
    }
  }
  __syncthreads();
}

enum { PH_NORM1 = 0, PH_INPROJ, PH_MIX1, PH_MIX2, PH_MIX3, PH_MERGE, PH_OUT, PH_FFN1, PH_FFN2, PH_PER_LAYER, PH_FINAL = 100 };

DI void run_phase(const Params& p, int ph, int layer, char* smem) {
  const int b = blockIdx.x, G = gridDim.x;
  const int wave = my_tid() >> 6;
  switch (ph) {
    case PH_NORM1: {
      if (layer == 0) {
        for (int t = b; t < 2 * CONV_TILES_LAYER; t += G) {
          ConvJob j;
          const int lt = conv_lookup(p, t, j);
          conv_tile(j, lt, (float*)smem);
        }
      }
      if (b == 0 && my_tid() == 0) *(unsigned*)(p.ws + OFF_CNT) = 0u;
      if (layer == 0) {
        float* z = ssq_buf(p, 2);
        for (int i = b * 256 + my_tid(); i < 2 * T; i += G * 256) z[i] = 0.f;
      }
      if (b < 8) s5_build_table(p, layer, b * 4 + wave);
      cvt_phase(p, layer, (u16*)(p.ws + OFF_H), true, b, G);
    } break;
    case PH_INPROJ: gemm_inproj(p, layer, b, G, (u16*)smem); break;
    case PH_MIX1: {
      for (int t = b; t < 2 * 3072; t += G) {
        const int kind = t / 3072, idx = t % 3072;
        if (kind == 0) gdn_pre(p, layer, idx, smem);
        else s5_pass1(p, layer, idx, smem);
      }
    } break;
    case PH_MIX2: {
      for (int c = b; c < 288; c += G) gdn_scan(p, c, smem);
      {
        unsigned* cnt = (unsigned*)(p.ws + OFF_CNT);
        int* slot = (int*)(smem + SMEM_BYTES - 16);
        for (;;) {
          __syncthreads();
          if (my_tid() == 0) *slot = (int)atomicAdd(cnt, 1u);
          __syncthreads();
          const int t = *slot;
          if (t >= 3 * 3072) break;
          if (t < 3072) s5_pass3(p, layer, t, smem);
          else if (t < 2 * 3072) attn_task(p, layer, 0, t - 3072, smem);
          else attn_task(p, layer, 1, t - 2 * 3072, smem);
        }
      }
    } break;
    case PH_MIX3: {
      gemm_glu(p, layer, b, G, (u16*)smem);
      for (int t = b * 4 + wave; t < T; t += G * 4) gdn_post_row(p, layer, t);
      cvt_phase(p, layer, (u16*)(p.ws + OFF_H), false, b, G);
    } break;
    case PH_MERGE: gemm_merge(p, layer, b, G, (u16*)smem); break;
    case PH_OUT:
      gemm_resid(p, layer, (const u16*)(p.ws + OFF_MERGED), DM, (const u16*)(p.ws + OFF_W) + layer * W_LAYER + WO_OUT, b, G, (u16*)smem,
                 (u16*)(p.ws + OFF_H2), ssq_buf(p, 2 + layer));
      break;
    case PH_FFN1: gemm_ffn1(p, layer, b, G, (u16*)smem); break;
    case PH_FFN2:
      gemm_resid(p, 1, (const u16*)(p.ws + OFF_ACT), FH, (const u16*)(p.ws + OFF_W) + layer * W_LAYER + WO_DN, b, G, (u16*)smem,
                 nullptr, nullptr);
      break;
    case PH_FINAL:
      for (int t = b * 4 + wave; t < T; t += G * 4) final_row(p, t);
      break;
    default: break;
  }
}

#if !MEGA
__global__ void __launch_bounds__(256, 2) k_phase(Params p, int ph, int layer) {
  __shared__ __attribute__((aligned(16))) char smem[SMEM_BYTES];
  run_phase(p, ph, layer, smem);
}

#else
__global__ void __launch_bounds__(256, 2) k_mega(Params p) {
  __shared__ __attribute__((aligned(16))) char smem[SMEM_BYTES];
  __shared__ uint4 xb_words;
  cg::grid_group grid = cg::this_grid();
  if (threadIdx.x == 0) xb_words = make_uint4(0u, 0u, 0u, 0u);
  __syncthreads();
  const XcdBarrier xb = xcd_barrier_post((unsigned*)(p.ws + OFF_BAR), (volatile LAS unsigned*)&xb_words);
  for (int layer = 0; layer < 2; ++layer)
    for (int ph = 0; ph < PH_PER_LAYER; ++ph) {
      run_phase(p, ph, layer, smem);
      if (layer == 1 && ph == PH_PER_LAYER - 1) grid.sync(); else xcd_barrier(xb);
#ifdef PROBE_DUP
      if (ph == PROBE_DUP) { run_phase(p, ph, layer, smem); grid.sync(); }
#endif
    }
  run_phase(p, PH_FINAL, 0, smem);
}
#endif

extern "C" void kernel_launch(void* const* d_in, const int* in_sizes, int n_in, void* d_out, int out_size, void* d_ws,
                              size_t ws_size, hipStream_t stream) {
  (void)in_sizes; (void)n_in; (void)out_size;
  if (ws_size < WS_NEED) { fprintf(stderr, "workspace too small: %zu < %zu\n", ws_size, (size_t)WS_NEED); return; }
  Params p;
  memset(&p, 0, sizeof(p));
  const float* const* in = (const float* const*)d_in;
  p.x_prompt = in[0]; p.x_sample = in[1]; p.norm1 = in[2]; p.conv_a = in[4]; p.a_log = in[5]; p.dt_bias = in[6];
  p.a_norm = in[7]; p.lam_re = in[8]; p.lam_im = in[9]; p.log_step = in[10]; p.b_re = in[11]; p.b_im = in[12];
  p.c_re = in[13]; p.c_im = in[14]; p.s5_d = in[15]; p.attn_sink = in[17]; p.norm2 = in[21]; p.final_norm = in[25];
  p.xout = (float*)d_out;
  p.ws = (char*)d_ws;
  p.w_in = in[3]; p.w_glu = in[16]; p.w_gate = in[18]; p.w_branch = in[19]; p.w_out = in[20];
  p.w_ffn_gate = in[22]; p.w_ffn_up = in[23]; p.w_ffn_down = in[24];
  static int grid_blocks = 0;
  if (!grid_blocks) {
    int dev = 0, cus = 0, per_cu = 0;
    hipGetDevice(&dev);
    hipDeviceGetAttribute(&cus, hipDeviceAttributeMultiprocessorCount, dev);
#if MEGA
    hipOccupancyMaxActiveBlocksPerMultiprocessor(&per_cu, k_mega, 256, 0);
#else
    hipOccupancyMaxActiveBlocksPerMultiprocessor(&per_cu, k_phase, 256, 0);
#endif
    per_cu = 2;
    grid_blocks = cus * per_cu;
  }
#if MEGA
  hipMemsetAsync((char*)d_ws + OFF_BAR, 0, BAR_BYTES, stream);
  void* args[] = {&p};
  hipError_t e = hipLaunchCooperativeKernel((void*)k_mega, dim3(grid_blocks), dim3(256), args, 0, stream);
  if (e != hipSuccess) fprintf(stderr, "cooperative launch failed: %s (grid %d)\n", hipGetErrorString(e), grid_blocks);
#else
  for (int layer = 0; layer < 2; ++layer)
    for (int ph = 0; ph < PH_PER_LAYER; ++ph) hipLaunchKernelGGL(k_phase, dim3(grid_blocks), dim3(256), 0, stream, p, ph, layer);
  hipLaunchKernelGGL(k_phase, dim3(grid_blocks), dim3(256), 0, stream, p, (int)PH_FINAL, 0);
#endif
}
```

```cpp
#include <hip/hip_runtime.h>
#include <hip/hip_cooperative_groups.h>
#include <cstdio>
#include <cstring>
namespace cg = cooperative_groups;

#ifndef MEGA
#define MEGA 1
#endif

#define DI __device__ __forceinline__
typedef unsigned short u16;
typedef __attribute__((ext_vector_type(8))) short bf16x8;
typedef __attribute__((ext_vector_type(4))) float f32x4;

constexpr int T = 49152;
constexpr int TP = 16384;
constexpr int DM = 1024;
constexpr int INW = 2576;
constexpr int FH = 2816;
constexpr int NCH64 = T / 64;
constexpr float EPS = 1e-6f;

constexpr int C_AQ = 0, C_AK = 256, C_AV = 512, C_AZ = 768, C_BQ = 1040, C_BK = 1296, C_BV = 1552, C_CU = 1808,
              C_DQ = 2064, C_DK = 2320, C_DV = 2448;

constexpr size_t WO_IN = 0, WO_GATE = 2752512, WO_BR = 6946816, WO_OUT = 7995392, WO_GU = 9043968, WO_DN = 14811136,
                 WO_GLU = 17694720, W_LAYER = 17825792;
constexpr size_t OFF_W = 0;
constexpr size_t OFF_PROJ = 2 * W_LAYER * 2;
constexpr size_t SZ_PROJ = (size_t)T * INW * 2;
constexpr size_t OFF_R1 = OFF_PROJ + SZ_PROJ;
constexpr size_t SZ_H = (size_t)T * DM * 2;
constexpr size_t OFF_H = OFF_R1;
constexpr size_t OFF_UW = OFF_R1;
constexpr size_t OFF_QN = OFF_R1 + SZ_H;
constexpr size_t OFF_KN = OFF_QN + (size_t)T * 256 * 2;
constexpr size_t OFF_GC = OFF_KN + (size_t)T * 256 * 2;
constexpr size_t OFF_SEND = OFF_GC + (size_t)NCH64 * 8 * 64 * 4;
constexpr size_t OFF_G = OFF_SEND + (size_t)NCH64 * 2 * 1024 * 8;
constexpr size_t OFF_AB = OFF_G + (size_t)T * 256 * 2;
constexpr size_t OFF_CNT = OFF_AB + (size_t)T * 16 * 4;
constexpr size_t OFF_MERGED = OFF_R1 + SZ_H;
constexpr size_t OFF_H2 = OFF_PROJ;
constexpr size_t OFF_ACT = OFF_PROJ + SZ_H;
constexpr size_t OFF_BAR = OFF_MERGED + SZ_H;
constexpr size_t BAR_BYTES = 3456 * 4;
constexpr size_t OFF_SSQ = OFF_BAR + 16384;
constexpr size_t OFF_S5TAB = OFF_SSQ + 5 * (size_t)T * 4;
constexpr size_t S5TAB_STRIDE = 13 * 1024;
constexpr size_t WS_NEED = OFF_S5TAB + 32 * S5TAB_STRIDE;

constexpr int SMEM_BYTES = 75776;

struct ConvJob { const float* src; u16* dst; const float* kscale; int K, ncols, nrows_dst, src_ld, rs, off, ntn; };
struct Params;
DI float* ssq_buf(const Params& p, int i);
struct Params {
  const float *x_prompt, *x_sample, *norm1, *conv_a, *a_log, *dt_bias, *a_norm, *lam_re, *lam_im, *log_step, *b_re,
      *b_im, *c_re, *c_im, *s5_d, *attn_sink, *norm2, *final_norm;
  const float *w_in, *w_gate, *w_branch, *w_out, *w_ffn_gate, *w_ffn_up, *w_ffn_down, *w_glu;
  float* xout;
  char* ws;
};
constexpr int CONV_TILES_LAYER = 4352;

DI int my_tid() { int t = threadIdx.x; asm volatile("" : "+v"(t)); return t; }
DI u16 f2bf(float x) { unsigned u = __float_as_uint(x); u += 0x7fffu + ((u >> 16) & 1u); return (u16)(u >> 16); }
DI float bf2f(u16 v) { return __uint_as_float(((unsigned)v) << 16); }
DI unsigned pack2(float a, float b) { return (unsigned)f2bf(a) | ((unsigned)f2bf(b) << 16); }
DI float sigmoidf_(float x) { return 1.f / (1.f + __expf(-x)); }
DI float siluf_(float x) { return x / (1.f + __expf(-x)); }
DI float wave_sum(float v) {
#pragma unroll
  for (int o = 32; o > 0; o >>= 1) v += __shfl_xor(v, o, 64);
  return v;
}
DI int seq_lo(int t) { return t < TP ? 0 : (t & ~4095); }
DI int seq_hi(int t) { return t < TP ? TP : (t & ~4095) + 4096; }
DI const float* xrow(const Params& p, int layer, int t) {
  if (layer == 0) return t < TP ? p.x_prompt + (size_t)t * DM : p.x_sample + (size_t)(t - TP) * DM;
  return p.xout + (size_t)t * DM;
}
DI f32x4 mfma16(bf16x8 a, bf16x8 b, f32x4 c) { return __builtin_amdgcn_mfma_f32_16x16x32_bf16(a, b, c, 0, 0, 0); }

DI void mk_job(ConvJob& j, const float* src, u16* dst, int K, int ncols, int nrows_dst, int src_ld, int rs, int off,
                const float* kscale = nullptr) {
  j.kscale = kscale;
  j.src = src; j.dst = dst; j.K = K; j.ncols = ncols; j.nrows_dst = nrows_dst; j.src_ld = src_ld; j.rs = rs; j.off = off;
  j.ntn = (nrows_dst + 63) >> 6;
}
DI int conv_lookup(const Params& p, int t, ConvJob& j) {
  const int l = t / CONV_TILES_LAYER;
  int r = t % CONV_TILES_LAYER;
  u16* wl = (u16*)(p.ws + OFF_W) + (size_t)l * W_LAYER;
  if (r < 672) { mk_job(j, p.w_in + (size_t)l * DM * INW, wl + WO_IN, DM, INW, 2688, INW, 32, 0, p.norm1 + l * DM); return r; }
  r -= 672;
  if (r < 1024) { const int i = r >> 8; mk_job(j, p.w_gate + (size_t)(l * 4 + i) * DM * DM, wl + WO_GATE + (size_t)i * DM * DM, DM, DM, DM, DM, 32, 0, p.norm1 + l * DM); return r & 255; }
  r -= 1024;
  if (r < 256) { const int i = r >> 6; mk_job(j, p.w_branch + (size_t)(l * 4 + i) * 256 * DM, wl + WO_BR + (size_t)i * DM * 256, 256, DM, DM, DM, 32, 0); return r & 63; }
  r -= 256;
  if (r < 256) { mk_job(j, p.w_out + (size_t)l * DM * DM, wl + WO_OUT, DM, DM, DM, DM, 32, 0); return r; }
  r -= 256;
  if (r < 704) { mk_job(j, p.w_ffn_gate + (size_t)l * DM * FH, wl + WO_GU, DM, FH, FH, FH, 64, 0, p.norm2 + l * DM); return r; }
  r -= 704;
  if (r < 704) { mk_job(j, p.w_ffn_up + (size_t)l * DM * FH, wl + WO_GU, DM, FH, FH, FH, 64, 32, p.norm2 + l * DM); return r; }
  r -= 704;
  if (r < 704) { mk_job(j, p.w_ffn_down + (size_t)l * FH * DM, wl + WO_DN, FH, DM, DM, DM, 32, 0); return r; }
  r -= 704;
  if (r < 16) { mk_job(j, p.w_glu + (size_t)l * 256 * 512, wl + WO_GLU, 256, 256, 256, 512, 64, 0); return r; }
  r -= 16;
  mk_job(j, p.w_glu + (size_t)l * 256 * 512 + 256, wl + WO_GLU, 256, 256, 256, 512, 64, 32);
  return r;
}
DI void conv_tile(const ConvJob& j, int lt, float* tile) {
  const int tid = my_tid();
  const int tk = lt / j.ntn, tn = lt % j.ntn;
  __syncthreads();
#pragma unroll
  for (int i = 0; i < 4; ++i) {
    int r = (tid >> 4) + 16 * i, c4 = (tid & 15) * 4, n = tn * 64 + c4;
    float4 v = make_float4(0.f, 0.f, 0.f, 0.f);
    if (n < j.ncols) v = *(const float4*)(j.src + (size_t)(tk * 64 + r) * j.src_ld + n);
    if (j.kscale) { const float s = j.kscale[tk * 64 + r]; v.x *= s; v.y *= s; v.z *= s; v.w *= s; }
    tile[r * 65 + c4 + 0] = v.x; tile[r * 65 + c4 + 1] = v.y; tile[r * 65 + c4 + 2] = v.z; tile[r * 65 + c4 + 3] = v.w;
  }
  __syncthreads();
  const int cl = tid >> 2, ks = (tid & 3) * 16, n = tn * 64 + cl;
  if (n < j.nrows_dst) {
    unsigned w[8];
#pragma unroll
    for (int e = 0; e < 8; ++e) w[e] = pack2(tile[(ks + 2 * e) * 65 + cl], tile[(ks + 2 * e + 1) * 65 + cl]);
    const int nm = (n >> 5) * j.rs + (n & 31) + j.off;
    uint4* d = (uint4*)(j.dst + (size_t)nm * j.K + tk * 64 + ks);
    d[0] = make_uint4(w[0], w[1], w[2], w[3]);
    d[1] = make_uint4(w[4], w[5], w[6], w[7]);
  }
}

DI float* ssq_buf(const Params& p, int i) { return (float*)(p.ws + OFF_SSQ) + (size_t)i * T; }
DI float rstd_of(float ssq) { return rsqrtf(ssq * (1.f / DM) + EPS); }
DI void cvt_row_bf16(const float* src, u16* dst, float* ssq_out) {
  const int lane = my_tid() & 63;
  float ss = 0.f;
#pragma unroll
  for (int i = 0; i < 4; ++i) {
    const float4 v = *(const float4*)(src + i * 256 + lane * 4);
    ss += v.x * v.x + v.y * v.y + v.z * v.z + v.w * v.w;
    uint2 o; o.x = pack2(v.x, v.y); o.y = pack2(v.z, v.w);
    *(uint2*)(dst + i * 256 + lane * 4) = o;
  }
  if (ssq_out) { ss = wave_sum(ss); if (lane == 0) *ssq_out = ss; }
}
DI void cvt_phase(const Params& p, int layer, u16* dst, bool write_ssq, int b0, int nb) {
  const int wave = my_tid() >> 6, lane = my_tid() & 63;
  for (int r = b0 * 4 + wave; r < T; r += nb * 8) {
    const int r2 = r + nb * 4;
    const bool has2 = r2 < T;
    const float* s0 = xrow(p, layer, r);
    const float* s1 = xrow(p, layer, has2 ? r2 : r);
    float4 a[4], c[4];
#pragma unroll
    for (int i = 0; i < 4; ++i) { a[i] = *(const float4*)(s0 + i * 256 + lane * 4); c[i] = *(const float4*)(s1 + i * 256 + lane * 4); }
    float ss0 = 0.f, ss1 = 0.f;
#pragma unroll
    for (int i = 0; i < 4; ++i) {
      ss0 += a[i].x * a[i].x + a[i].y * a[i].y + a[i].z * a[i].z + a[i].w * a[i].w;
      ss1 += c[i].x * c[i].x + c[i].y * c[i].y + c[i].z * c[i].z + c[i].w * c[i].w;
      uint2 o; o.x = pack2(a[i].x, a[i].y); o.y = pack2(a[i].z, a[i].w);
      *(uint2*)(dst + (size_t)r * DM + i * 256 + lane * 4) = o;
      if (has2) { uint2 o2; o2.x = pack2(c[i].x, c[i].y); o2.y = pack2(c[i].z, c[i].w); *(uint2*)(dst + (size_t)r2 * DM + i * 256 + lane * 4) = o2; }
    }
    if (write_ssq) {
      ss0 = wave_sum(ss0); ss1 = wave_sum(ss1);
      if (lane == 0) { ssq_buf(p, layer)[r] = ss0; if (has2) ssq_buf(p, layer)[r2] = ss1; }
    }
  }
}

constexpr int GP = 64;
#ifndef GEMM_DMA
#define GEMM_DMA 1
#endif
#if GEMM_DMA
template <int NT, bool SPLIT = false>
DI void gemm_kloop(const u16* __restrict__ A, size_t lda, const u16* __restrict__ B, size_t ldb, int nk,
                   f32x4 (&acc)[4][NT], u16* sm) {
  const int tid = my_tid(), lane = tid & 63;
  const int wave = __builtin_amdgcn_readfirstlane(tid >> 6);
  const int fr = lane & 15, fq = lane >> 4, wr = wave >> 1, wc = wave & 1;
  u16* sa = sm;
  u16* sb = sm + 2 * 128 * 64;
  const int swz = (fr >> 1) & 7;
  const int lr = lane >> 3;
  const int lc = ((lane & 7) ^ ((lr >> 1) & 3)) * 8;
#define DMA_PIECE(BASE, LD, G, KOFF, DST)                                                              \
  {                                                                                                    \
    int lrl_ = lr;                                                                                     \
    asm volatile("" : "+v"(lrl_));   \
    const int row_ = (G) * 8 + lrl_;                                                                   \
    const int col_ = lc ^ ((((G) & 1) * 4) * 8);                                                       \
    __builtin_amdgcn_global_load_lds((const unsigned*)((BASE) + (size_t)row_ * (LD) + (KOFF) + col_),  \
                                     (unsigned*)((DST) + (G) * 512), 16, 0, 0);                        \
  }
#define DMA_TILE(KOFF, STAGE)                                                                          \
  {                                                                                                    \
    u16* da_ = sa + (STAGE) * 8192;                                                                    \
    u16* db_ = sb + (STAGE) * 8192;                                                                    \
    DMA_PIECE(A, lda, wave * 4 + 0, KOFF, da_) DMA_PIECE(A, lda, wave * 4 + 1, KOFF, da_)              \
    DMA_PIECE(A, lda, wave * 4 + 2, KOFF, da_) DMA_PIECE(A, lda, wave * 4 + 3, KOFF, da_)              \
    if (NT == 4) {                                                                                     \
      DMA_PIECE(B, ldb, wave * 4 + 0, KOFF, db_) DMA_PIECE(B, ldb, wave * 4 + 1, KOFF, db_)            \
      DMA_PIECE(B, ldb, wave * 4 + 2, KOFF, db_) DMA_PIECE(B, ldb, wave * 4 + 3, KOFF, db_)            \
    } else {                                                                                           \
      DMA_PIECE(B, ldb, wave * 2 + 0, KOFF, db_) DMA_PIECE(B, ldb, wave * 2 + 1, KOFF, db_)            \
    }                                                                                                  \
  }
  __builtin_amdgcn_s_barrier();
  DMA_TILE(0, 0)
#pragma unroll 1
  for (int kt = 0; kt < nk; ++kt) {
    const int cur = kt & 1;
    asm volatile("s_waitcnt vmcnt(0)" ::: "memory");
    __builtin_amdgcn_s_barrier();
    asm volatile("" ::: "memory");
    const u16* ca = sa + cur * 8192;
    const u16* cb = sb + cur * 8192;
    if (SPLIT) {
      bf16x8 wf[NT], xf[4];
#pragma unroll
      for (int nt = 0; nt < NT; ++nt) wf[nt] = *(const bf16x8*)(cb + (wc * NT * 16 + nt * 16 + fr) * 64 + (((0 * 4 + fq) ^ swz) * 8));
#pragma unroll
      for (int mt = 0; mt < 4; ++mt) xf[mt] = *(const bf16x8*)(ca + (wr * 64 + mt * 16 + fr) * 64 + (((0 * 4 + fq) ^ swz) * 8));
#pragma unroll
      for (int mt = 0; mt < 4; ++mt)
#pragma unroll
        for (int nt = 0; nt < NT; ++nt) acc[mt][nt] = mfma16(wf[nt], xf[mt], acc[mt][nt]);
#pragma unroll
      for (int nt = 0; nt < NT; ++nt) wf[nt] = *(const bf16x8*)(cb + (wc * NT * 16 + nt * 16 + fr) * 64 + (((1 * 4 + fq) ^ swz) * 8));
#pragma unroll
      for (int mt = 0; mt < 4; ++mt) xf[mt] = *(const bf16x8*)(ca + (wr * 64 + mt * 16 + fr) * 64 + (((1 * 4 + fq) ^ swz) * 8));
      __builtin_amdgcn_sched_barrier(0);
      if (kt + 1 < nk) DMA_TILE((kt + 1) * 64, cur ^ 1)
      __builtin_amdgcn_sched_barrier(0);
#pragma unroll
      for (int mt = 0; mt < 4; ++mt)
#pragma unroll
        for (int nt = 0; nt < NT; ++nt) acc[mt][nt] = mfma16(wf[nt], xf[mt], acc[mt][nt]);
      continue;
    }
    bf16x8 wf[2][NT], xf[2][4];
#pragma unroll
    for (int kk = 0; kk < 2; ++kk) {
#pragma unroll
      for (int nt = 0; nt < NT; ++nt) wf[kk][nt] = *(const bf16x8*)(cb + (wc * NT * 16 + nt * 16 + fr) * 64 + (((kk * 4 + fq) ^ swz) * 8));
#pragma unroll
      for (int mt = 0; mt < 4; ++mt) xf[kk][mt] = *(const bf16x8*)(ca + (wr * 64 + mt * 16 + fr) * 64 + (((kk * 4 + fq) ^ swz) * 8));
    }
    __builtin_amdgcn_sched_barrier(0);
    if (kt + 1 < nk) DMA_TILE((kt + 1) * 64, cur ^ 1)
    __builtin_amdgcn_sched_barrier(0);
    __builtin_amdgcn_s_setprio(1);
#pragma unroll
    for (int kk = 0; kk < 2; ++kk)
#pragma unroll
      for (int mt = 0; mt < 4; ++mt)
#pragma unroll
        for (int nt = 0; nt < NT; ++nt) acc[mt][nt] = mfma16(wf[kk][nt], xf[kk][mt], acc[mt][nt]);
    __builtin_amdgcn_s_setprio(0);
  }
}
#else
template <int NT>
DI void gemm_kloop(const u16* __restrict__ A, size_t lda, const u16* __restrict__ B, size_t ldb, int nk,
                   f32x4 (&acc)[4][NT], u16* sm) {
  const int tid = my_tid(), lane = tid & 63, wave = tid >> 6;
  const int fr = lane & 15, fq = lane >> 4, wr = wave >> 1, wc = wave & 1;
  u16* sa = sm;
  u16* sb = sm + 2 * 128 * GP;
  uint4 ra0, ra1, ra2, ra3, rb0, rb1, rb2 = make_uint4(0, 0, 0, 0), rb3 = make_uint4(0, 0, 0, 0);
  uint4 rc0, rc1, rc2, rc3, rd0, rd1, rd2 = make_uint4(0, 0, 0, 0), rd3 = make_uint4(0, 0, 0, 0);
  const int lrow = tid >> 3, lseg = (tid & 7) * 8;
  const int sseg = ((tid & 7) ^ ((lrow >> 1) & 7)) * 8;
  const u16* Ap = A + (size_t)lrow * lda + lseg;
  const u16* Bp = B + (size_t)lrow * ldb + lseg;
#define KL_LOAD(KOFF, A0, A1, A2, A3, B0, B1, B2, B3)                    \
  A0 = *(const uint4*)(Ap + (KOFF));                                     \
  A1 = *(const uint4*)(Ap + 32 * lda + (KOFF));                          \
  A2 = *(const uint4*)(Ap + 64 * lda + (KOFF));                          \
  A3 = *(const uint4*)(Ap + 96 * lda + (KOFF));                          \
  B0 = *(const uint4*)(Bp + (KOFF));                                     \
  B1 = *(const uint4*)(Bp + 32 * ldb + (KOFF));                          \
  if (NT > 2) { B2 = *(const uint4*)(Bp + 64 * ldb + (KOFF)); B3 = *(const uint4*)(Bp + 96 * ldb + (KOFF)); }
#define KL_STORE(SA, SB, A0, A1, A2, A3, B0, B1, B2, B3)                 \
  *(uint4*)((SA) + (lrow + 0) * GP + sseg) = A0;                         \
  *(uint4*)((SA) + (lrow + 32) * GP + sseg) = A1;                        \
  *(uint4*)((SA) + (lrow + 64) * GP + sseg) = A2;                        \
  *(uint4*)((SA) + (lrow + 96) * GP + sseg) = A3;                        \
  *(uint4*)((SB) + (lrow + 0) * GP + sseg) = B0;                         \
  *(uint4*)((SB) + (lrow + 32) * GP + sseg) = B1;                        \
  if (NT > 2) { *(uint4*)((SB) + (lrow + 64) * GP + sseg) = B2; *(uint4*)((SB) + (lrow + 96) * GP + sseg) = B3; }
#define KL_COMPUTE(CA, CB)                                                                                     \
  _Pragma("unroll") for (int kk = 0; kk < 2; ++kk) {                                                           \
    bf16x8 wf[NT], xf[4];                                                                                      \
    _Pragma("unroll") for (int nt = 0; nt < NT; ++nt)                                                          \
      wf[nt] = *(const bf16x8*)((CB) + (wc * NT * 16 + nt * 16 + fr) * GP + (((kk * 4 + fq) ^ swz) * 8));       \
    _Pragma("unroll") for (int mt = 0; mt < 4; ++mt)                                                           \
      xf[mt] = *(const bf16x8*)((CA) + (wr * 64 + mt * 16 + fr) * GP + (((kk * 4 + fq) ^ swz) * 8));            \
    _Pragma("unroll") for (int mt = 0; mt < 4; ++mt)                                                           \
    _Pragma("unroll") for (int nt = 0; nt < NT; ++nt) acc[mt][nt] = mfma16(wf[nt], xf[mt], acc[mt][nt]);      \
  }
  const int swz = (fr >> 1) & 7;
  KL_LOAD(0, ra0, ra1, ra2, ra3, rb0, rb1, rb2, rb3)
  KL_LOAD(64, rc0, rc1, rc2, rc3, rd0, rd1, rd2, rd3)
  KL_STORE(sa, sb, ra0, ra1, ra2, ra3, rb0, rb1, rb2, rb3)
  __syncthreads();
  u16* sa1 = sa + 128 * GP;
  u16* sb1 = sb + 128 * GP;
#pragma unroll 1
  for (int kt = 0; kt < nk; kt += 2) {
    const int k2 = (kt + 2 < nk ? kt + 2 : kt) * 64, k3 = (kt + 3 < nk ? kt + 3 : kt + 1) * 64;
    KL_LOAD(k2, ra0, ra1, ra2, ra3, rb0, rb1, rb2, rb3)
    __builtin_amdgcn_sched_barrier(0);
    KL_COMPUTE(sa, sb)
    KL_STORE(sa1, sb1, rc0, rc1, rc2, rc3, rd0, rd1, rd2, rd3)
    __syncthreads();
    KL_LOAD(k3, rc0, rc1, rc2, rc3, rd0, rd1, rd2, rd3)
    __builtin_amdgcn_sched_barrier(0);
    KL_COMPUTE(sa1, sb1)
    KL_STORE(sa, sb, ra0, ra1, ra2, ra3, rb0, rb1, rb2, rb3)
    __syncthreads();
  }
}
#endif
template <int NT>
DI void zero_acc(f32x4 (&acc)[4][NT]) {
#pragma unroll
  for (int a = 0; a < 4; ++a)
#pragma unroll
    for (int b = 0; b < NT; ++b) acc[a][b] = (f32x4){0.f, 0.f, 0.f, 0.f};
}

struct TileIter {
  int step, nsteps, nfull, nrx, nct, pwl, x, local, mode, idx, stride, L;
  DI void init(int nrt, int nct_, int b, int G) {
    nct = nct_;
    if (G == 512 && (nrt % 64) == 0) {
      mode = 1; x = b & 7; local = b >> 3;
      nrx = nrt / 8;
      const int fullp = nct >> 3;
      pwl = nct & 7;
      nfull = fullp * (nrx / 8);
      nsteps = nfull + (pwl ? (nrx * pwl + 63) / 64 : 0);
      step = 0;
      skip();
    } else {
      mode = 0; idx = b; stride = G; L = nrt * nct;
    }
  }
  DI bool in_range() const { return step < nfull || (step - nfull) * 64 + local < nrx * pwl; }
  DI void skip() { while (step < nsteps && !in_range()) ++step; }
  DI bool valid() const { return mode ? step < nsteps : idx < L; }
  DI int rt() const {
    if (!mode) return idx / nct;
    const int nrb = nrx / 8;
    const int ri = step < nfull ? (step % nrb) * 8 + (local >> 3) : ((step - nfull) * 64 + local) / pwl;
    return x + 8 * ri;
  }
  DI int ct() const {
    if (!mode) return idx % nct;
    const int nrb = nrx / 8;
    return step < nfull ? (step / nrb) * 8 + (local & 7) : (nct & ~7) + ((step - nfull) * 64 + local) % pwl;
  }
  DI void next() { if (mode) { ++step; skip(); } else idx += stride; }
};

#define EPI_COORDS                                                       \
  const int lane = my_tid() & 63, wave = my_tid() >> 6;           \
  const int fr = lane & 15, fq = lane >> 4, wr = wave >> 1, wc = wave & 1; \
  (void)fr; (void)fq; (void)wr; (void)wc;

DI void gemm_inproj(const Params& p, int layer, int b, int G, u16* sm) {
  const u16* H = (const u16*)(p.ws + OFF_H);
  const u16* W = (const u16*)(p.ws + OFF_W) + layer * W_LAYER + WO_IN;
  u16* proj = (u16*)(p.ws + OFF_PROJ);
  float* AB = (float*)(p.ws + OFF_AB);
  EPI_COORDS
  TileIter it; it.init(T / 128, 21, b, G);
  for (; it.valid(); it.next()) {
    const int row0 = it.rt() * 128, col0 = it.ct() * 128;
    f32x4 acc[4][4]; zero_acc<4>(acc);
    gemm_kloop<4>(H + (size_t)row0 * DM, DM, W + (size_t)col0 * DM, DM, 16, acc, sm);
#pragma unroll
    for (int mt = 0; mt < 4; ++mt) {
      const int row = row0 + wr * 64 + mt * 16 + fr;
      const float rs = rstd_of(ssq_buf(p, layer)[row]);
#pragma unroll
      for (int nt = 0; nt < 4; ++nt) {
        const int col = col0 + wc * 64 + nt * 16 + fq * 4;
        acc[mt][nt] *= rs;
        if (col < INW) {
          uint2 o; o.x = pack2(acc[mt][nt][0], acc[mt][nt][1]); o.y = pack2(acc[mt][nt][2], acc[mt][nt][3]);
          *(uint2*)(proj + (size_t)row * INW + col) = o;
          if (col >= 1024 && col < 1040)
            *(float4*)(AB + (size_t)row * 16 + (col - 1024)) = make_float4(acc[mt][nt][0], acc[mt][nt][1], acc[mt][nt][2], acc[mt][nt][3]);
        }
      }
    }
  }
}

DI void gemm_glu(const Params& p, int layer, int b, int G, u16* sm) {
  const u16* Gb = (const u16*)(p.ws + OFF_G);
  const u16* W = (const u16*)(p.ws + OFF_W) + layer * W_LAYER + WO_GLU;
  u16* proj = (u16*)(p.ws + OFF_PROJ);
  EPI_COORDS
  TileIter it; it.init(T / 128, 4, b, G);
  for (; it.valid(); it.next()) {
    const int row0 = it.rt() * 128, ct = it.ct();
    f32x4 acc[4][4]; zero_acc<4>(acc);
    gemm_kloop<4>(Gb + (size_t)row0 * 256, 256, W + (size_t)ct * 128 * 256, 256, 4, acc, sm);
#pragma unroll
    for (int mt = 0; mt < 4; ++mt) {
      const int row = row0 + wr * 64 + mt * 16 + fr;
#pragma unroll
      for (int nt = 0; nt < 2; ++nt) {
        const int col = (ct * 2 + wc) * 32 + nt * 16 + fq * 4;
        float o[4];
#pragma unroll
        for (int j = 0; j < 4; ++j) o[j] = acc[mt][nt][j] * sigmoidf_(acc[mt][nt + 2][j]);
        uint2 ov; ov.x = pack2(o[0], o[1]); ov.y = pack2(o[2], o[3]);
        *(uint2*)(proj + (size_t)row * INW + C_CU + col) = ov;
      }
    }
  }
}

DI void gemm_merge(const Params& p, int layer, int b, int G, u16* sm) {
  const u16* H = (const u16*)(p.ws + OFF_H);
  const u16* Wg = (const u16*)(p.ws + OFF_W) + layer * W_LAYER + WO_GATE;
  const u16* Wb = (const u16*)(p.ws + OFF_W) + layer * W_LAYER + WO_BR;
  const u16* proj = (const u16*)(p.ws + OFF_PROJ);
  u16* merged = (u16*)(p.ws + OFF_MERGED);
  EPI_COORDS
  TileIter it; it.init(T / 128, 8, b, G);
  for (; it.valid(); it.next()) {
    const int row0 = it.rt() * 128, col0 = it.ct() * 128;
    uint2 mg[4][4];
#pragma unroll
    for (int a = 0; a < 4; ++a)
#pragma unroll
      for (int c = 0; c < 4; ++c) mg[a][c] = make_uint2(0u, 0u);
#pragma unroll 1
    for (int i = 0; i < 4; ++i) {
      const int ocol = (i == 0) ? C_AZ : (i == 1) ? C_BQ : (i == 2) ? C_CU : C_DQ;
      f32x4 acc[4][4]; zero_acc<4>(acc);
      gemm_kloop<4, true>(H + (size_t)row0 * DM, DM, Wg + (size_t)i * DM * DM + (size_t)col0 * DM, DM, 16, acc, sm);
      uint2 sg[4][4];
#pragma unroll
      for (int a = 0; a < 4; ++a) {
        const float rs = rstd_of(ssq_buf(p, layer)[row0 + wr * 64 + a * 16 + fr]);
#pragma unroll
        for (int c = 0; c < 4; ++c) {
          sg[a][c].x = pack2(sigmoidf_(rs * acc[a][c][0]), sigmoidf_(rs * acc[a][c][1]));
          sg[a][c].y = pack2(sigmoidf_(rs * acc[a][c][2]), sigmoidf_(rs * acc[a][c][3]));
        }
      }
      zero_acc<4>(acc);
      gemm_kloop<4, true>(proj + (size_t)row0 * INW + ocol, INW, Wb + (size_t)i * DM * 256 + (size_t)col0 * 256, 256, 4, acc, sm);
#pragma unroll
      for (int a = 0; a < 4; ++a)
#pragma unroll
        for (int c = 0; c < 4; ++c) {
          const float m0 = bf2f((u16)(mg[a][c].x & 0xffff)) + bf2f((u16)(sg[a][c].x & 0xffff)) * acc[a][c][0];
          const float m1 = bf2f((u16)(mg[a][c].x >> 16)) + bf2f((u16)(sg[a][c].x >> 16)) * acc[a][c][1];
          const float m2 = bf2f((u16)(mg[a][c].y & 0xffff)) + bf2f((u16)(sg[a][c].y & 0xffff)) * acc[a][c][2];
          const float m3 = bf2f((u16)(mg[a][c].y >> 16)) + bf2f((u16)(sg[a][c].y >> 16)) * acc[a][c][3];
          mg[a][c].x = pack2(m0, m1); mg[a][c].y = pack2(m2, m3);
        }
    }
#pragma unroll
    for (int mt = 0; mt < 4; ++mt) {
      const int row = row0 + wr * 64 + mt * 16 + fr;
#pragma unroll
      for (int nt = 0; nt < 4; ++nt) {
        const int col = col0 + wc * 64 + nt * 16 + fq * 4;
        *(uint2*)(merged + (size_t)row * DM + col) = mg[mt][nt];
      }
    }
  }
}

DI void gemm_resid(const Params& p, int layer_src, const u16* A, int K, const u16* W, int b, int G, u16* sm, u16* xb_out,
                   float* ssq_acc) {
  EPI_COORDS
  TileIter it; it.init(T / 128, 8, b, G);
  for (; it.valid(); it.next()) {
    const int row0 = it.rt() * 128, col0 = it.ct() * 128;
    f32x4 acc[4][4]; zero_acc<4>(acc);
    gemm_kloop<4>(A + (size_t)row0 * K, K, W + (size_t)col0 * K, K, K / 64, acc, sm);
#pragma unroll
    for (int mt = 0; mt < 4; ++mt) {
      const int row = row0 + wr * 64 + mt * 16 + fr;
      const float* xs = xrow(p, layer_src, row);
      float* xd = p.xout + (size_t)row * DM;
      float ss = 0.f;
#pragma unroll
      for (int nt = 0; nt < 4; ++nt) {
        const int col = col0 + wc * 64 + nt * 16 + fq * 4;
        float4 r = *(const float4*)(xs + col);
        r.x += acc[mt][nt][0]; r.y += acc[mt][nt][1]; r.z += acc[mt][nt][2]; r.w += acc[mt][nt][3];
        *(float4*)(xd + col) = r;
        ss += r.x * r.x + r.y * r.y + r.z * r.z + r.w * r.w;
        if (xb_out) { uint2 o; o.x = pack2(r.x, r.y); o.y = pack2(r.z, r.w); *(uint2*)(xb_out + (size_t)row * DM + col) = o; }
      }
      if (ssq_acc) {
        ss += __shfl_xor(ss, 16, 64);
        ss += __shfl_xor(ss, 32, 64);
        if (fq == 0) atomicAdd(ssq_acc + row, ss);
      }
    }
  }
}

DI void gemm_ffn1(const Params& p, int layer, int b, int G, u16* sm) {
  const u16* H = (const u16*)(p.ws + OFF_H2);
  const u16* W = (const u16*)(p.ws + OFF_W) + layer * W_LAYER + WO_GU;
  u16* act = (u16*)(p.ws + OFF_ACT);
  EPI_COORDS
  TileIter it; it.init(T / 128, 44, b, G);
  for (; it.valid(); it.next()) {
    const int row0 = it.rt() * 128, ct = it.ct();
    f32x4 acc[4][4]; zero_acc<4>(acc);
    gemm_kloop<4>(H + (size_t)row0 * DM, DM, W + (size_t)ct * 128 * DM, DM, 16, acc, sm);
#pragma unroll
    for (int mt = 0; mt < 4; ++mt) {
      const int row = row0 + wr * 64 + mt * 16 + fr;
      const float rs = rstd_of(ssq_buf(p, 2 + layer)[row]);
#pragma unroll
      for (int nt = 0; nt < 2; ++nt) {
        const int col = (ct * 2 + wc) * 32 + nt * 16 + fq * 4;
        float o[4];
#pragma unroll
        for (int j = 0; j < 4; ++j) o[j] = siluf_(rs * acc[mt][nt][j]) * (rs * acc[mt][nt + 2][j]);
        uint2 ov; ov.x = pack2(o[0], o[1]); ov.y = pack2(o[2], o[3]);
        *(uint2*)(act + (size_t)row * FH + col) = ov;
      }
    }
  }
}

DI f32x4 mma_t(const u16* X, int xr, const u16* Y, int yr, f32x4 acc, int fr, int fq);
DI void gdn_pre(const Params& p, int layer, int task, char* smem) {
  const int tid = my_tid(), lane = tid & 63, wave = tid >> 6;
  const int fr = lane & 15, fq = lane >> 4;
  const int n = task >> 2, h = task & 3, c0 = n * 64;
  const int lo = seq_lo(c0), hi = seq_hi(c0);
  float* ks = (float*)smem;
  float* vs = ks + 64 * 65;
  u16* Kb = (u16*)vs;
  float* AmT = vs + 64 * 65;
  float* gcs = AmT + 2 * 64 * 68;
  float* bts = gcs + 128;
  const u16* proj = (const u16*)(p.ws + OFF_PROJ);
  u16* QN = (u16*)(p.ws + OFF_QN);
  u16* KN = (u16*)(p.ws + OFF_KN);
  float* GC = (float*)(p.ws + OFF_GC);
  const float* AB = (const float*)(p.ws + OFF_AB);
  u16* UW = (u16*)(p.ws + OFF_UW);
  __syncthreads();
#define GDN_CONV(MAT)                                                                                \
  {                                                                                                  \
    const int ch = (MAT) * 256 + h * 64 + lane;                                                      \
    float w[5];                                                                                      \
    _Pragma("unroll") for (int j = 0; j < 5; ++j) w[j] = p.conv_a[(size_t)(layer * 5 + j) * 768 + ch]; \
    float raw[20];                                                                                   \
    _Pragma("unroll") for (int i = 0; i < 20; ++i) {                                                 \
      const int tok = c0 + wave * 16 + i - 2;                                                        \
      raw[i] = (tok >= lo && tok < hi) ? bf2f(proj[(size_t)tok * INW + ch]) : 0.f;                   \
    }                                                                                                \
    _Pragma("unroll") for (int i = 0; i < 16; ++i) {                                                 \
      float v = 0.f;                                                                                 \
      _Pragma("unroll") for (int j = 0; j < 5; ++j) v += raw[i + j] * w[j];                          \
      v = siluf_(v);                                                                                 \
      const int tl = wave * 16 + i;                                                                  \
      if ((MAT) < 2) {                                                                               \
        const float ss = wave_sum(v * v);                                                            \
        v *= rsqrtf(ss + EPS) * ((MAT) == 0 ? 0.125f : 1.f);                                         \
      }                                                                                              \
      if ((MAT) == 0) QN[(size_t)(c0 + tl) * 256 + h * 64 + lane] = f2bf(v);                         \
      else if ((MAT) == 1) {                                                                         \
        const u16 kb = f2bf(v);                                                                      \
        KN[(size_t)(c0 + tl) * 256 + h * 64 + lane] = kb; ks[tl * 65 + lane] = v; Kb[tl * 72 + lane] = kb; \
      } else vs[tl * 65 + lane] = v;                                                                 \
    }                                                                                                \
  }
  GDN_CONV(0)
  GDN_CONV(1)
  if (wave < 2) {
    const int d = wave;
    const int tok = c0 + (d ? 63 - lane : lane);
    const float al = AB[(size_t)tok * 16 + d * 4 + h];
    const float br = AB[(size_t)tok * 16 + 8 + d * 4 + h];
    const float xx = al + p.dt_bias[(layer * 2 + d) * 4 + h];
    const float sp = fmaxf(xx, 0.f) + log1pf(__expf(-fabsf(xx)));
    float g = -__expf(p.a_log[(layer * 2 + d) * 4 + h]) * sp;
#pragma unroll
    for (int o = 1; o < 64; o <<= 1) {
      const float t = __shfl_up(g, o, 64);
      if (lane >= o) g += t;
    }
    gcs[d * 64 + lane] = g;
    bts[d * 64 + lane] = sigmoidf_(br);
    GC[(size_t)(task * 2 + d) * 64 + lane] = g;
  }
  __syncthreads();
#pragma unroll
  for (int t = 0; t < 4; ++t) {
    if (t <= wave) {
      const f32x4 kk = mma_t(Kb, wave * 16, Kb, t * 16, (f32x4){0.f, 0.f, 0.f, 0.f}, fr, fq);
      const int b = t * 16 + fr;
      const float gb0 = gcs[b], gb1 = gcs[64 + 63 - b], bt1 = bts[64 + 63 - b];
#pragma unroll
      for (int j = 0; j < 4; ++j) {
        const int a = wave * 16 + fq * 4 + j;
        if (a > b) {
          AmT[b * 68 + a] = bts[a] * kk[j] * __expf(gcs[a] - gb0);
          const int i1 = 63 - b, j1 = 63 - a;
          AmT[64 * 68 + j1 * 68 + i1] = bt1 * kk[j] * __expf(gb1 - gcs[64 + j1]);
        }
      }
    }
  }
  __syncthreads();
  GDN_CONV(2)
  __syncthreads();
  {
    int d = tid >> 7, c = tid & 127;
    asm volatile("" : "+v"(d), "+v"(c));
    float r[64];
    {
      const int stride = d ? -65 : 65;
      int off = (d ? 63 * 65 : 0) + (c & 63);
      const float* srcm = (c < 64) ? vs : ks;
      const bool isw = c >= 64;
#pragma unroll
      for (int i = 0; i < 64; ++i) {
        float v = srcm[off] * bts[d * 64 + i];
        if (isw) v *= __expf(gcs[d * 64 + i]);
        r[i] = v;
        off += stride;
        asm volatile("" : "+v"(off));
        if ((i & 7) == 7) __builtin_amdgcn_sched_barrier(0);
      }
    }
    const float* Ad = AmT + d * 64 * 68;
#pragma unroll
    for (int j = 0; j < 63; ++j) {
      const float rj = r[j];
#pragma unroll
      for (int i = j + 1; i < 64; ++i) {
        r[i] = fmaf(-Ad[j * 68 + i], rj, r[i]);
      }
      if ((j & 1) == 1) __builtin_amdgcn_sched_barrier(0);
    }
    u16* base = UW + (size_t)(task * 2 + d) * 8192;
    if (c < 64) {
      uint4* dst = (uint4*)(base + c * 64);
#pragma unroll
      for (int q = 0; q < 8; ++q)
        dst[q] = make_uint4(pack2(r[8 * q], r[8 * q + 1]), pack2(r[8 * q + 2], r[8 * q + 3]), pack2(r[8 * q + 4], r[8 * q + 5]),
                            pack2(r[8 * q + 6], r[8 * q + 7]));
    } else {
      u16* dst = base + 4096 + (c - 64);
#pragma unroll
      for (int i = 0; i < 64; ++i) dst[i * 64] = f2bf(r[i]);
    }
  }
}

DI f32x4 mma_t(const u16* X, int xr, const u16* Y, int yr, f32x4 acc, int fr, int fq) {
#pragma unroll
  for (int kk = 0; kk < 2; ++kk) {
    const bf16x8 x = *(const bf16x8*)(X + (xr + fr) * 72 + kk * 32 + fq * 8);
    const bf16x8 y = *(const bf16x8*)(Y + (yr + fr) * 72 + kk * 32 + fq * 8);
    acc = mfma16(x, y, acc);
  }
  return acc;
}
DI f32x4 mma_t_swz(const u16* X, int xr, const u16* Y, int yr, f32x4 acc, int fr, int fq) {
  const int sw = ((xr + fr) >> 3) & 7;
#pragma unroll
  for (int kk = 0; kk < 2; ++kk) {
    const bf16x8 x = *(const bf16x8*)(X + (xr + fr) * 72 + (((kk * 4 + fq) ^ sw) * 8));
    const bf16x8 y = *(const bf16x8*)(Y + (yr + fr) * 72 + kk * 32 + fq * 8);
    acc = mfma16(x, y, acc);
  }
  return acc;
}

DI void gdn_scan(const Params& p, int item, char* smem) {
  const int tid = my_tid(), lane = tid & 63, w = tid >> 6;
  const int fr = lane & 15, fq = lane >> 4;
  const int chain = item >> 2, eq = item & 3;
  const int s = chain >> 3, h = (chain >> 1) & 3, d = chain & 1;
  const int sb = s == 0 ? 0 : TP + (s - 1) * 4096;
  const int nch = s == 0 ? 256 : 64;
  u16* St = (u16*)smem;
  u16* Vt = St + 16 * 72;
  u16* Vts = Vt + 16 * 72;
  u16* Wc = Vts + 16 * 72;
  u16* Qc = Wc + 64 * 72;
  u16* Kc = Qc + 64 * 72;
  u16* KcT = Kc + 64 * 72;
  u16* QKm = KcT + 64 * 72;
  float* gcs = (float*)(QKm + 64 * 72);
  u16* proj = (u16*)(p.ws + OFF_PROJ);
  const u16* QN = (const u16*)(p.ws + OFF_QN);
  const u16* KN = (const u16*)(p.ws + OFF_KN);
  const float* GC = (const float*)(p.ws + OFF_GC);
  const u16* UW = (const u16*)(p.ws + OFF_UW);
  __syncthreads();
  __builtin_amdgcn_s_setprio(3);
  for (int i = tid; i < 16 * 72; i += 256) St[i] = 0;
  f32x4 S0 = (f32x4){0.f, 0.f, 0.f, 0.f};
  const int prow0 = tid >> 3, prow1 = (tid >> 3) + 32, pseg = (tid & 7) * 8;
  uint4 w0a, w1a, q0a, q1a, k0a, k1a, w0b, w1b, q0b, q1b, k0b, k1b;
  uint2 u0a, u0b;
  float ga, gb;
#define GDN_PREFETCH2(J, S)                                                                          \
  {                                                                                                  \
    const int jj_ = (J) < nch ? (J) : nch - 1;                                                       \
    const int n_ = sb / 64 + (d ? nch - 1 - jj_ : jj_);                                              \
    const int c0_ = n_ * 64;                                                                         \
    const size_t tb_ = (size_t)((n_ * 4 + h) * 2 + d);                                               \
    const u16* ub_ = UW + tb_ * 8192;                                                                \
    const int tok0_ = c0_ + (d ? 63 - prow0 : prow0), tok1_ = c0_ + (d ? 63 - prow1 : prow1);        \
    w0##S = *(const uint4*)(ub_ + 4096 + prow0 * 64 + pseg);                                         \
    w1##S = *(const uint4*)(ub_ + 4096 + prow1 * 64 + pseg);                                         \
    q0##S = *(const uint4*)(QN + (size_t)tok0_ * 256 + h * 64 + pseg);                               \
    q1##S = *(const uint4*)(QN + (size_t)tok1_ * 256 + h * 64 + pseg);                               \
    k0##S = *(const uint4*)(KN + (size_t)tok0_ * 256 + h * 64 + pseg);                               \
    k1##S = *(const uint4*)(KN + (size_t)tok1_ * 256 + h * 64 + pseg);                               \
    u0##S = *(const uint2*)(ub_ + (eq * 16 + fr) * 64 + w * 16 + fq * 4);                            \
    g##S = GC[tb_ * 64 + lane];                                                                      \
  }
#define GDN_STAGE2(ROW, PW, PQ, PK)                                                                  \
  {                                                                                                  \
    *(uint4*)(Wc + (ROW) * 72 + pseg) = PW;                                                          \
    *(uint4*)(Qc + (ROW) * 72 + pseg) = PQ;                                                          \
    *(uint4*)(Kc + (ROW) * 72 + pseg) = PK;                                                          \
    u16* kt_ = KcT + pseg * 72 + ((((ROW) >> 3) ^ (tid & 7)) * 8) + ((ROW) & 7);                     \
    kt_[0 * 72] = (u16)(PK.x & 0xffff); kt_[1 * 72] = (u16)(PK.x >> 16);                             \
    kt_[2 * 72] = (u16)(PK.y & 0xffff); kt_[3 * 72] = (u16)(PK.y >> 16);                             \
    kt_[4 * 72] = (u16)(PK.z & 0xffff); kt_[5 * 72] = (u16)(PK.z >> 16);                             \
    kt_[6 * 72] = (u16)(PK.w & 0xffff); kt_[7 * 72] = (u16)(PK.w >> 16);                             \
  }
#define GDN_STEP(JV, S)                                                                              \
  {                                                                                                  \
    const int j_ = (JV);                                                                             \
    const int n = sb / 64 + (d ? nch - 1 - j_ : j_);                                                 \
    const int c0 = n * 64;                                                                           \
    GDN_STAGE2(prow0, w0##S, q0##S, k0##S)                                                           \
    GDN_STAGE2(prow1, w1##S, q1##S, k1##S)                                                           \
    if (tid < 64) gcs[tid] = g##S;                                                                   \
    const uint2 cu0 = u0##S;                                                                         \
    __syncthreads();                                                                          \
    GDN_PREFETCH2(j_ + 2, S)                                                                         \
    const f32x4 z4 = (f32x4){0.f, 0.f, 0.f, 0.f};                                                    \
    const f32x4 P1a = mma_t(Wc, w * 16, St, 0, z4, fr, fq);                                          \
    const f32x4 P2a = mma_t(St, 0, Qc, w * 16, z4, fr, fq);                                          \
      \
    const float glog = gcs[63];                                                                      \
    const float gcc = gcs[w * 16 + fr];                                                              \
    const float4 gq0 = *(const float4*)(gcs + fq * 4), gq1 = *(const float4*)(gcs + 16 + fq * 4);    \
    const float4 gq2 = *(const float4*)(gcs + 32 + fq * 4), gq3 = *(const float4*)(gcs + 48 + fq * 4); \
    const float4 gw = *(const float4*)(gcs + w * 16 + fq * 4);                                       \
    {                                                                                                \
      const int c = w * 16 + fr;                                                                     \
      _Pragma("unroll") for (int t = 0; t < 4; ++t) {                                                \
        const f32x4 qk = mma_t(Kc, t * 16, Qc, w * 16, z4, fr, fq);                                  \
        const int s0 = t * 16 + fq * 4;                                                              \
        const float4 gs = t == 0 ? gq0 : t == 1 ? gq1 : t == 2 ? gq2 : gq3;                          \
        const float e0 = __expf(fminf(gcc - gs.x, 0.f)), e1 = __expf(fminf(gcc - gs.y, 0.f));       \
        const float e2 = __expf(fminf(gcc - gs.z, 0.f)), e3 = __expf(fminf(gcc - gs.w, 0.f));       \
        const float v0 = (c >= s0 + 0) ? qk[0] * e0 : 0.f;                                           \
        const float v1 = (c >= s0 + 1) ? qk[1] * e1 : 0.f;                                           \
        const float v2 = (c >= s0 + 2) ? qk[2] * e2 : 0.f;                                           \
        const float v3 = (c >= s0 + 3) ? qk[3] * e3 : 0.f;                                           \
        uint2 o; o.x = pack2(v0, v1); o.y = pack2(v2, v3);                                           \
        *(uint2*)(QKm + c * 72 + s0) = o;                                                            \
      }                                                                                              \
    }                                                                                                \
    {                                                                                                \
      const int cc0 = w * 16 + fq * 4;                                                               \
      const float v0 = bf2f((u16)(cu0.x & 0xffff)) - P1a[0], v1 = bf2f((u16)(cu0.x >> 16)) - P1a[1]; \
      const float v2 = bf2f((u16)(cu0.y & 0xffff)) - P1a[2], v3 = bf2f((u16)(cu0.y >> 16)) - P1a[3]; \
      uint2 o; o.x = pack2(v0, v1); o.y = pack2(v2, v3);                                             \
      *(uint2*)(Vt + fr * 72 + cc0) = o;                                                             \
      uint2 o2;                                                                                      \
      o2.x = pack2(v0 * __expf(glog - gw.x), v1 * __expf(glog - gw.y));                              \
      o2.y = pack2(v2 * __expf(glog - gw.z), v3 * __expf(glog - gw.w));                              \
      *(uint2*)(Vts + fr * 72 + cc0) = o2;                                                           \
    }                                                                                                \
    __syncthreads();                                                                          \
    {                                                                                                \
      const int c = w * 16 + fr;                                                                     \
      const float eg = __expf(gcc);                                                                  \
      const int tok = c0 + (d ? 63 - c : c);                                                         \
      u16* orow = proj + (size_t)tok * INW + d * 256 + h * 64 + eq * 16 + fq * 4;                    \
      f32x4 oa = P2a * eg;                                                                           \
      oa = mma_t(Vt, 0, QKm, w * 16, oa, fr, fq);                                                    \
      uint2 o; o.x = pack2(oa[0], oa[1]); o.y = pack2(oa[2], oa[3]);                                 \
      *(uint2*)(orow) = o;                                                                           \
    }                                                                                                \
    {                                                                                                \
      const float gl = __expf(glog);                                                                 \
      S0 *= gl;                                                                                      \
      S0 = mma_t_swz(KcT, w * 16, Vts, 0, S0, fr, fq);                                               \
      const int r0 = w * 16 + fq * 4;                                                                \
      uint2 o; o.x = pack2(S0[0], S0[1]); o.y = pack2(S0[2], S0[3]);                                 \
      *(uint2*)(St + fr * 72 + r0) = o;                                                              \
    }                                                                                                \
    __syncthreads();                                                                          \
  }
  GDN_PREFETCH2(0, a)
  GDN_PREFETCH2(1, b)
  for (int j = 0; j < nch; j += 2) {
    GDN_STEP(j, a)
    GDN_STEP(j + 1, b)
  }
  __builtin_amdgcn_s_setprio(0);
}

DI void gdn_post_row(const Params& p, int layer, int t) {
  const int lane = my_tid() & 63;
  u16* row = (u16*)(p.ws + OFF_PROJ) + (size_t)t * INW;
  const uint2 f = *(const uint2*)(row + lane * 4);
  const uint2 bw = *(const uint2*)(row + 256 + lane * 4);
  const uint2 z = *(const uint2*)(row + C_AZ + lane * 4);
  float o[4], zz[4];
  o[0] = bf2f((u16)(f.x & 0xffff)) + bf2f((u16)(bw.x & 0xffff));
  o[1] = bf2f((u16)(f.x >> 16)) + bf2f((u16)(bw.x >> 16));
  o[2] = bf2f((u16)(f.y & 0xffff)) + bf2f((u16)(bw.y & 0xffff));
  o[3] = bf2f((u16)(f.y >> 16)) + bf2f((u16)(bw.y >> 16));
  zz[0] = bf2f((u16)(z.x & 0xffff)); zz[1] = bf2f((u16)(z.x >> 16)); zz[2] = bf2f((u16)(z.y & 0xffff)); zz[3] = bf2f((u16)(z.y >> 16));
  float ss = o[0] * o[0] + o[1] * o[1] + o[2] * o[2] + o[3] * o[3];
#pragma unroll
  for (int m = 1; m < 16; m <<= 1) ss += __shfl_xor(ss, m, 64);
  const float rs = rsqrtf(ss * (1.f / 64.f) + EPS);
  const int e0 = (lane & 15) * 4;
  float r[4];
#pragma unroll
  for (int j = 0; j < 4; ++j) r[j] = o[j] * rs * p.a_norm[layer * 64 + e0 + j] * siluf_(zz[j]);
  uint2 ov; ov.x = pack2(r[0], r[1]); ov.y = pack2(r[2], r[3]);
  *(uint2*)(row + C_AZ + lane * 4) = ov;
}

constexpr int XP = 20;
struct S5Rec { float are, aim, lr, li, step; };
DI void s5_rec_consts(const Params& p, int layer, int d, int g, int lane, S5Rec& k) {
  const int gi = ((layer * 2 + d) * 16 + g);
  k.lr = p.lam_re[(size_t)gi * 64 + lane];
  k.li = p.lam_im[(size_t)gi * 64 + lane];
  k.step = expf(p.log_step[gi]);
  const float mag = expf(k.lr * k.step);
  float sn, cs; sincosf(k.li * k.step, &sn, &cs);
  k.are = mag * cs; k.aim = mag * sn;
}
DI void s5_bq(const Params& p, int layer, int d, int g, int fr, int fq, bf16x8 (&bq)[8]) {
  const int gi = ((layer * 2 + d) * 16 + g);
  const float step = expf(p.log_step[gi]);
#pragma unroll
  for (int n4 = 0; n4 < 4; ++n4) {
    const int pp = n4 * 16 + fr;
    const float lr = p.lam_re[(size_t)gi * 64 + pp], li = p.lam_im[(size_t)gi * 64 + pp];
    const float mag = expf(lr * step);
    float sn, cs; sincosf(li * step, &sn, &cs);
    const float are = mag * cs, aim = mag * sn;
    const float inv = 1.f / (lr * lr + li * li);
    const float ir = lr * inv, ii = -li * inv;
    const float cr = (are - 1.f) * ir - aim * ii;
    const float ci = (are - 1.f) * ii + aim * ir;
    const float* br = p.b_re + ((size_t)(layer * 16 + g) * 64 + pp) * 16 + (fq & 1) * 8;
    const float* bi = p.b_im + ((size_t)(layer * 16 + g) * 64 + pp) * 16 + (fq & 1) * 8;
    bf16x8 vr, vi;
#pragma unroll
    for (int e = 0; e < 8; ++e) {
      const float a = br[e], b = bi[e];
      vr[e] = (fq < 2) ? (short)f2bf(cr * a - ci * b) : (short)0;
      vi[e] = (fq < 2) ? (short)f2bf(cr * b + ci * a) : (short)0;
    }
    bq[n4] = vr;
    bq[4 + n4] = vi;
  }
}
DI bf16x8 s5_uf(const u16* proj, int tok0, int g, int fr, int fq) {
  const uint4 v = *(const uint4*)(proj + (size_t)(tok0 + fr) * INW + C_CU + g * 16 + (fq & 1) * 8);
  const uint4 z = make_uint4(0u, 0u, 0u, 0u);
  return __builtin_bit_cast(bf16x8, fq < 2 ? v : z);
}
#define S5_BLOCK_X(UF, XS, XR, XI)                                                                   \
  {                                                                                                  \
    asm volatile("s_waitcnt lgkmcnt(0)" ::: "memory");    \
    _Pragma("unroll") for (int n = 0; n < 8; ++n) {                                                  \
      const f32x4 xx = mfma16(bq[n], UF, (f32x4){0.f, 0.f, 0.f, 0.f});   \
      _Pragma("unroll") for (int j = 0; j < 4; ++j) (XS)[(n * 16 + fq * 4 + j) * XP + fr] = xx[j];   \
    }                                                                                                \
    asm volatile("s_waitcnt lgkmcnt(0)" ::: "memory");                                               \
    _Pragma("unroll") for (int q = 0; q < 4; ++q) {                                                  \
      const float4 a = *(const float4*)((XS) + lane * XP + q * 4);                                   \
      const float4 b = *(const float4*)((XS) + (64 + lane) * XP + q * 4);                            \
      XR[q * 4 + 0] = a.x; XR[q * 4 + 1] = a.y; XR[q * 4 + 2] = a.z; XR[q * 4 + 3] = a.w;            \
      XI[q * 4 + 0] = b.x; XI[q * 4 + 1] = b.y; XI[q * 4 + 2] = b.z; XI[q * 4 + 3] = b.w;            \
    }                                                                                                \
  }
DI void s5_build_table(const Params& p, int layer, int dg) {
  const int lane = my_tid() & 63, fr = lane & 15, fq = lane >> 4;
  const int d = dg >> 4, g = dg & 15;
  char* tab = p.ws + OFF_S5TAB + (size_t)dg * S5TAB_STRIDE;
  bf16x8 bq[8]; s5_bq(p, layer, d, g, fr, fq, bq);
#pragma unroll
  for (int n = 0; n < 8; ++n) ((uint4*)tab)[n * 64 + lane] = __builtin_bit_cast(uint4, bq[n]);
  const float* cr = p.c_re + ((size_t)((layer * 2 + d) * 16 + g) * 16 + fr) * 64;
  const float* ci = p.c_im + ((size_t)((layer * 2 + d) * 16 + g) * 16 + fr) * 64;
#pragma unroll
  for (int kk = 0; kk < 4; ++kk) {
    bf16x8 cf;
#pragma unroll
    for (int e = 0; e < 8; ++e) {
      const int kx = (kk & 1) * 32 + fq * 8 + e;
      cf[e] = (short)f2bf((kk < 2) ? cr[kx] : -ci[kx]);
    }
    ((uint4*)(tab + 8192))[kk * 64 + lane] = __builtin_bit_cast(uint4, cf);
  }
  S5Rec k; s5_rec_consts(p, layer, d, g, lane, k);
  const float m64 = expf(k.lr * k.step * 64.f);
  float s64, c64; sincosf(k.li * k.step * 64.f, &s64, &c64);
  ((float4*)(tab + 12288))[lane] = make_float4(k.are, k.aim, m64 * c64, m64 * s64);
}
DI void s5_pass1(const Params& p, int layer, int task, char* smem) {
  const int lane = my_tid() & 63, wave = my_tid() >> 6;
  const int fr = lane & 15, fq = lane >> 4;
  const int n = task >> 2, gq = task & 3, g = gq * 4 + wave, c0 = n * 64;
  float* Xs = (float*)smem + wave * 128 * XP;
  const u16* proj = (const u16*)(p.ws + OFF_PROJ);
  float2* SEND = (float2*)(p.ws + OFF_SEND);
  __syncthreads();
  bf16x8 uf[4];
#pragma unroll
  for (int tb = 0; tb < 4; ++tb) uf[tb] = s5_uf(proj, c0 + tb * 16, g, fr, fq);
#pragma unroll 1
  for (int d = 0; d < 2; ++d) {
    const char* tab = p.ws + OFF_S5TAB + (size_t)(d * 16 + g) * S5TAB_STRIDE;
    bf16x8 bq[8];
#pragma unroll
    for (int n8 = 0; n8 < 8; ++n8) bq[n8] = __builtin_bit_cast(bf16x8, ((const uint4*)tab)[n8 * 64 + lane]);
    const float4 rc = ((const float4*)(tab + 12288))[lane];
    S5Rec k; k.are = rc.x; k.aim = rc.y;
    float sr = 0.f, si = 0.f;
#pragma unroll
    for (int blk = 0; blk < 4; ++blk) {
      const int tb = d ? 3 - blk : blk;
      float xr[16], xi[16];
      S5_BLOCK_X(uf[tb], Xs, xr, xi)
#pragma unroll
      for (int i = 0; i < 16; ++i) {
        const int r = d ? 15 - i : i;
        const float nr = k.are * sr - k.aim * si + xr[r], ni = k.are * si + k.aim * sr + xi[r];
        sr = nr; si = ni;
      }
    }
    SEND[((size_t)(n * 2 + d) * 16 + g) * 64 + lane] = make_float2(sr, si);
  }
}
DI float gelu_tanh(float x) {
  const float u = 0.7978845608028654f * (x + 0.044715f * x * x * x);
  return 0.5f * x * (1.f + tanhf(u));
}
DI void s5_pass3(const Params& p, int layer, int task, char* smem) {
  const int lane = my_tid() & 63, wave = my_tid() >> 6;
  const int fr = lane & 15, fq = lane >> 4;
  const int n = task >> 2, gq = task & 3, g = gq * 4 + wave, c0 = n * 64;
  const int nlo = seq_lo(c0) / 64, nhi = seq_hi(c0) / 64;
  float* Xs = (float*)smem + wave * 128 * XP;
  u16* Sb = (u16*)(smem + 4 * 128 * XP * 4) + wave * 16 * 136;
  const u16* proj = (const u16*)(p.ws + OFF_PROJ);
  const float2* SEND = (const float2*)(p.ws + OFF_SEND);
  u16* Gb = (u16*)(p.ws + OFF_G);
  __syncthreads();
  bf16x8 uf[4];
#pragma unroll
  for (int tb = 0; tb < 4; ++tb) uf[tb] = s5_uf(proj, c0 + tb * 16, g, fr, fq);
  f32x4 yacc[4];
#pragma unroll
  for (int tb = 0; tb < 4; ++tb) yacc[tb] = (f32x4){0.f, 0.f, 0.f, 0.f};
#pragma unroll 1
  for (int d = 0; d < 2; ++d) {
    const char* tab = p.ws + OFF_S5TAB + (size_t)(d * 16 + g) * S5TAB_STRIDE;
    bf16x8 bq[8];
#pragma unroll
    for (int n8 = 0; n8 < 8; ++n8) bq[n8] = __builtin_bit_cast(bf16x8, ((const uint4*)tab)[n8 * 64 + lane]);
    const float4 rc = ((const float4*)(tab + 12288))[lane];
    S5Rec k; k.are = rc.x; k.aim = rc.y;
    const float a64r = rc.z, a64i = rc.w;
    float sr = 0.f, si = 0.f;
    {
      const int cnt = d == 0 ? n - nlo : nhi - 1 - n;
      const int first = d == 0 ? nlo : nhi - 1;
      const int sgn = d == 0 ? 1 : -1;
      const float2* sp = SEND + ((size_t)(first * 2 + d) * 16 + g) * 64 + lane;
      const long stride = (long)sgn * 2 * 16 * 64;
      int m = 0;
      for (; m + 8 <= cnt; m += 8) {
        float2 e0 = sp[0], e1 = sp[stride], e2 = sp[2 * stride], e3 = sp[3 * stride];
        float2 e4 = sp[4 * stride], e5 = sp[5 * stride], e6 = sp[6 * stride], e7 = sp[7 * stride];
        sp += 8 * stride;
#define HSTEP(E) { const float nr = a64r * sr - a64i * si + E.x, ni = a64r * si + a64i * sr + E.y; sr = nr; si = ni; }
        HSTEP(e0) HSTEP(e1) HSTEP(e2) HSTEP(e3) HSTEP(e4) HSTEP(e5) HSTEP(e6) HSTEP(e7)
      }
      for (; m < cnt; ++m) {
        const float2 e = sp[0];
        sp += stride;
        HSTEP(e)
      }
    }
    bf16x8 cf[4];
#pragma unroll
    for (int kk = 0; kk < 4; ++kk) cf[kk] = __builtin_bit_cast(bf16x8, ((const uint4*)(tab + 8192))[kk * 64 + lane]);
#pragma unroll
    for (int blk = 0; blk < 4; ++blk) {
      const int tb = d ? 3 - blk : blk;
      float xr[16], xi[16];
      S5_BLOCK_X(uf[tb], Xs, xr, xi)
#pragma unroll
      for (int i = 0; i < 16; ++i) {
        const int r = d ? 15 - i : i;
        const float nr = k.are * sr - k.aim * si + xr[r], ni = k.are * si + k.aim * sr + xi[r];
        sr = nr; si = ni;
        Sb[r * 136 + lane] = f2bf(sr);
        Sb[r * 136 + 64 + lane] = f2bf(si);
      }
      asm volatile("s_waitcnt lgkmcnt(0)" ::: "memory");
#pragma unroll
      for (int kk = 0; kk < 4; ++kk) {
        const bf16x8 xf = *(const bf16x8*)(Sb + fr * 136 + kk * 32 + fq * 8);
        yacc[tb] = mfma16(xf, cf[kk], yacc[tb]);
      }
      asm volatile("s_waitcnt lgkmcnt(0)" ::: "memory");
    }
  }
  const float dsk = p.s5_d[layer * 256 + g * 16 + fr];
#pragma unroll
  for (int tb = 0; tb < 4; ++tb)
#pragma unroll
    for (int j = 0; j < 4; ++j) {
      const int t = tb * 16 + fq * 4 + j;
      const float u = bf2f(proj[(size_t)(c0 + t) * INW + C_CU + g * 16 + fr]);
      const float y = yacc[tb][j] + u * dsk;
      Gb[(size_t)(c0 + t) * 256 + g * 16 + fr] = f2bf(gelu_tanh(y));
    }
}

struct AttnState { float m, l; f32x4 o[4]; };
DI void attn_segment(const u16* proj, int kcol, int vcol, int tk0, int kstride, int npairs, int R, float slope, int tq,
                     int lo, int hi, const bf16x8 (&qf)[2], AttnState& st, u16* Vt, int lane) {
  const int fr = lane & 15, fq = lane >> 4;
#pragma unroll 1
  for (int pr = 0; pr < npairs; ++pr) {
    const int kbase = tk0 + pr * 32 * kstride;
    f32x4 sacc[2];
#pragma unroll
    for (int t = 0; t < 2; ++t) {
      int tk = kbase + (t * 16 + fr) * kstride;
      tk = min(max(tk, lo), hi - 1);
      const u16* kp = proj + (size_t)tk * INW + kcol + fq * 8;
      const bf16x8 k0 = *(const bf16x8*)(kp), k1 = *(const bf16x8*)(kp + 32);
      sacc[t] = mfma16(k0, qf[0], (f32x4){0.f, 0.f, 0.f, 0.f});
      sacc[t] = mfma16(k1, qf[1], sacc[t]);
    }
    uint4 vr0, vr1, vr2, vr3;
    {
      const int seg = (lane & 7) * 8, kl0 = lane >> 3;
      const int t0 = min(max(kbase + (kl0 + 0) * kstride, lo), hi - 1), t1 = min(max(kbase + (kl0 + 8) * kstride, lo), hi - 1);
      const int t2 = min(max(kbase + (kl0 + 16) * kstride, lo), hi - 1), t3 = min(max(kbase + (kl0 + 24) * kstride, lo), hi - 1);
      vr0 = *(const uint4*)(proj + (size_t)t0 * INW + vcol + seg);
      vr1 = *(const uint4*)(proj + (size_t)t1 * INW + vcol + seg);
      vr2 = *(const uint4*)(proj + (size_t)t2 * INW + vcol + seg);
      vr3 = *(const uint4*)(proj + (size_t)t3 * INW + vcol + seg);
    }
    float sc[2][4]; bool ok[2][4];
    float mx = -1e30f;
#pragma unroll
    for (int t = 0; t < 2; ++t)
#pragma unroll
      for (int j = 0; j < 4; ++j) {
        const int tk = kbase + (t * 16 + fq * 4 + j) * kstride;
        const int ad = abs(tk - tq);
        ok[t][j] = (ad <= R) && (tk >= lo) && (tk < hi);
        sc[t][j] = sacc[t][j] * 0.125f - slope * (float)ad;
        if (ok[t][j]) mx = fmaxf(mx, sc[t][j]);
      }
    mx = fmaxf(mx, __shfl_xor(mx, 16, 64));
    mx = fmaxf(mx, __shfl_xor(mx, 32, 64));
    const float mn = fmaxf(st.m, mx);
    const float alpha = __expf(st.m - mn);
    st.m = mn;
    float pv[2][4], ps = 0.f;
#pragma unroll
    for (int t = 0; t < 2; ++t)
#pragma unroll
      for (int j = 0; j < 4; ++j) { pv[t][j] = ok[t][j] ? __expf(sc[t][j] - mn) : 0.f; ps += pv[t][j]; }
    st.l = st.l * alpha + ps;
#pragma unroll
    for (int dt = 0; dt < 4; ++dt)
#pragma unroll
      for (int j = 0; j < 4; ++j) st.o[dt][j] *= alpha;
    bf16x8 pf;
    {
      const unsigned w0 = pack2(pv[0][0], pv[0][1]), w1 = pack2(pv[0][2], pv[0][3]), w2 = pack2(pv[1][0], pv[1][1]),
                     w3 = pack2(pv[1][2], pv[1][3]);
      uint4 t4 = make_uint4(w0, w1, w2, w3);
      pf = __builtin_bit_cast(bf16x8, t4);
    }
    asm volatile("s_waitcnt lgkmcnt(0)" ::: "memory");
    {
      u16* vdst = Vt + (lane >> 3) * 72 + (lane & 7) * 8;
      *(uint4*)(vdst) = vr0; *(uint4*)(vdst + 8 * 72) = vr1; *(uint4*)(vdst + 16 * 72) = vr2; *(uint4*)(vdst + 24 * 72) = vr3;
    }
    {
      const int q = fr >> 2, pp = fr & 3;
      const unsigned a0 = (unsigned)(size_t)Vt + (unsigned)(((fq * 4 + q) * 72 + 4 * pp) * 2);
      {
        uint2 x0, x1, y0, y1;
        asm volatile(
            "s_waitcnt lgkmcnt(0)\n\t"
            "ds_read_b64_tr_b16 %0, %4\n\t"
            "ds_read_b64_tr_b16 %1, %4 offset:32\n\t"
            "ds_read_b64_tr_b16 %2, %4 offset:2304\n\t"
            "ds_read_b64_tr_b16 %3, %4 offset:2336\n\t"
            "s_waitcnt lgkmcnt(0)"
            : "=&v"(x0), "=&v"(x1), "=&v"(y0), "=&v"(y1) : "v"(a0) : "memory");
        st.o[0] = mfma16(__builtin_bit_cast(bf16x8, make_uint4(x0.x, x0.y, y0.x, y0.y)), pf, st.o[0]);
        st.o[1] = mfma16(__builtin_bit_cast(bf16x8, make_uint4(x1.x, x1.y, y1.x, y1.y)), pf, st.o[1]);
      }
      {
        uint2 x0, x1, y0, y1;
        asm volatile(
            "ds_read_b64_tr_b16 %0, %4 offset:64\n\t"
            "ds_read_b64_tr_b16 %1, %4 offset:96\n\t"
            "ds_read_b64_tr_b16 %2, %4 offset:2368\n\t"
            "ds_read_b64_tr_b16 %3, %4 offset:2400\n\t"
            "s_waitcnt lgkmcnt(0)"
            : "=&v"(x0), "=&v"(x1), "=&v"(y0), "=&v"(y1) : "v"(a0) : "memory");
        st.o[2] = mfma16(__builtin_bit_cast(bf16x8, make_uint4(x0.x, x0.y, y0.x, y0.y)), pf, st.o[2]);
        st.o[3] = mfma16(__builtin_bit_cast(bf16x8, make_uint4(x1.x, x1.y, y1.x, y1.y)), pf, st.o[3]);
      }
    }
  }
}
DI void attn_task(const Params& p, int layer, int mode, int task, char* smem) {
  const int lane = my_tid() & 63, wave = my_tid() >> 6;
  const int fr = lane & 15, fq = lane >> 4;
  u16* proj = (u16*)(p.ws + OFF_PROJ);
  u16* Vt = (u16*)smem + wave * 32 * 72;
  int tq0, qstride, qcol, kcol, vcol; float slope;
  int hq;
  if (mode == 0) {
    const int blk = task >> 4, h = (task >> 2) & 3, rq = task & 3;
    hq = h; tq0 = blk * 256 + rq * 4 + wave; qstride = 16;
    qcol = C_BQ + h * 64; kcol = C_BK + h * 64; vcol = C_BV + h * 64;
    slope = exp2f(-(float)(5 + h));
  } else {
    const int blk = task >> 2, qh = task & 3;
    hq = qh; tq0 = blk * 64 + wave * 16; qstride = 1;
    qcol = C_DQ + qh * 64; kcol = C_DK + (qh >> 1) * 64; vcol = C_DV + (qh >> 1) * 64;
    slope = exp2f(-(float)(1 + qh));
  }
  const int lo = seq_lo(tq0), hi = seq_hi(tq0);
  const int tq = tq0 + fr * qstride;
  bf16x8 qf[2];
  {
    const u16* qp = proj + (size_t)tq * INW + qcol + fq * 8;
    qf[0] = *(const bf16x8*)(qp); qf[1] = *(const bf16x8*)(qp + 32);
  }
  AttnState st; st.m = -1e30f; st.l = 0.f;
#pragma unroll
  for (int dt = 0; dt < 4; ++dt) st.o[dt] = (f32x4){0.f, 0.f, 0.f, 0.f};
  __syncthreads();
  float scale;
  if (mode == 0) {
    attn_segment(proj, kcol, vcol, tq0 - 64, 1, 12, 64, slope, tq, lo, hi, qf, st, Vt, lane);
    attn_segment(proj, kcol, vcol, tq0 - 256, 4, 6, 256, slope, tq, lo, hi, qf, st, Vt, lane);
    attn_segment(proj, kcol, vcol, tq0 - 1024, 16, 5, 1024, slope, tq, lo, hi, qf, st, Vt, lane);
    float l = st.l; l += __shfl_xor(l, 16, 64); l += __shfl_xor(l, 32, 64);
    scale = 1.f / l;
  } else {
    attn_segment(proj, kcol, vcol, tq0 - 128, 1, 9, 128, slope, tq, lo, hi, qf, st, Vt, lane);
    float l = st.l; l += __shfl_xor(l, 16, 64); l += __shfl_xor(l, 32, 64);
    const float sink = p.attn_sink[layer * 4 + hq];
    const float mf = fmaxf(st.m, sink);
    const float sc = __expf(st.m - mf);
    scale = sc / (l * sc + __expf(sink - mf));
  }
#pragma unroll
  for (int dt = 0; dt < 4; ++dt) {
    uint2 o; o.x = pack2(st.o[dt][0] * scale, st.o[dt][1] * scale); o.y = pack2(st.o[dt][2] * scale, st.o[dt][3] * scale);
    *(uint2*)(proj + (size_t)tq * INW + qcol + dt * 16 + fq * 4) = o;
  }
}

DI void final_row(const Params& p, int t) {
  const int lane = my_tid() & 63;
  float* row = p.xout + (size_t)t * DM;
  float4 v[4]; float ss = 0.f;
#pragma unroll
  for (int i = 0; i < 4; ++i) {
    v[i] = *(const float4*)(row + i * 256 + lane * 4);
    ss += v[i].x * v[i].x + v[i].y * v[i].y + v[i].z * v[i].z + v[i].w * v[i].w;
  }
  ss = wave_sum(ss);
  const float rs = rstd_of(ss);
#pragma unroll
  for (int i = 0; i < 4; ++i) {
    const float4 g = *(const float4*)(p.final_norm + i * 256 + lane * 4);
    *(float4*)(row + i * 256 + lane * 4) = make_float4(v[i].x * rs * g.x, v[i].y * rs * g.y, v[i].z * rs * g.z, v[i].w * rs * g.w);
  }
}

#define XB_TMO      128
#define XB_XCNT(j)  (256  + 64 * (j))
#define XB_XSUB(j)  (1280 + 64 * (j))
#define XB_XGEN(j)  (2304 + 64 * (j))
#define XB_TOP      3328
#define XB_TOPGEN   3392
#define XB_SPIN_CAP (1u << 22)
#define LAS __attribute__((address_space(3)))
DI unsigned xb_ld(unsigned* p) { return __hip_atomic_load(p, __ATOMIC_RELAXED, __HIP_MEMORY_SCOPE_AGENT); }
DI unsigned xb_add(unsigned* p, unsigned v) { return __hip_atomic_fetch_add(p, v, __ATOMIC_RELAXED, __HIP_MEMORY_SCOPE_AGENT); }
DI unsigned xb_xcc_id() { return (unsigned)__builtin_amdgcn_s_getreg((3 << 11) | 20) & 0xFu; }
#define XB_SPIN(cond, bar) do { unsigned _sp = 0; while (cond) { __builtin_amdgcn_s_sleep(1); \
    if ((++_sp & 255u) == 0u) { if (xb_ld(&(bar)[XB_TMO])) break; if (_sp > XB_SPIN_CAP) { atomicAdd(&(bar)[XB_TMO], 1u); break; } } } } while (0)
struct XcdBarrier { unsigned* bar; unsigned x; volatile LAS unsigned* st; };
DI XcdBarrier xcd_barrier_post(unsigned* bar, volatile LAS unsigned* st) {
  XcdBarrier b; b.bar = bar; b.x = xb_xcc_id(); b.st = st;
  if (threadIdx.x == 0) (void)xb_add(&bar[XB_XCNT(b.x)], 1u);
  return b;
}
DI void xcd_barrier_complete(unsigned* bar, unsigned x, unsigned& nloc, unsigned& nx) {
  const unsigned G = gridDim.x * gridDim.y * gridDim.z;
  unsigned sum, cnt, mine, sp = 0u;
  for (;;) {
    sum = 0u; cnt = 0u; mine = 0u;
#pragma unroll
    for (unsigned j = 0; j < 16; ++j) { const unsigned c = xb_ld(&bar[XB_XCNT(j)]); sum += c; cnt += (c > 0u) ? 1u : 0u; mine = (j == x) ? c : mine; }
    if (sum == G) break;
    __builtin_amdgcn_s_sleep(1);
    if ((++sp & 255u) == 0u) { if (xb_ld(&bar[XB_TMO])) break; if (sp > XB_SPIN_CAP) { atomicAdd(&bar[XB_TMO], 1u); break; } }
  }
  nloc = mine > 0u ? mine : 1u; nx = cnt > 0u ? cnt : 1u;
}
DI void xcd_barrier(const XcdBarrier& b) {
  asm volatile("s_waitcnt vmcnt(0)" ::: "memory");
  __syncthreads();
  if (threadIdx.x == 0) {
    unsigned* bar = b.bar;
    __builtin_amdgcn_s_waitcnt(0);
    unsigned nloc = b.st[0], nx = b.st[1];
    if (nloc == 0u) { xcd_barrier_complete(bar, b.x, nloc, nx); b.st[0] = nloc; b.st[1] = nx; }
    const unsigned old = xb_add(&bar[XB_XSUB(b.x)], 1u);
    const unsigned gen = old / nloc;
    if (old + 1u == (gen + 1u) * nloc) {
      __builtin_amdgcn_fence(__ATOMIC_RELEASE, "agent");
      asm volatile("s_waitcnt vmcnt(0)" ::: "memory");
      const unsigned og = xb_add(&bar[XB_TOP], 1u);
      const unsigned tg = og / nx;
      if (og + 1u == (tg + 1u) * nx) xb_add(&bar[XB_TOPGEN], 1u);
      else XB_SPIN(xb_ld(&bar[XB_TOPGEN]) == tg, bar);
      __builtin_amdgcn_fence(__ATOMIC_ACQUIRE, "agent");
      xb_add(&bar[XB_XGEN(b.x)], 1u);
      asm volatile("s_waitcnt vmcnt(0)" ::: "memory");
    } else {
      XB_SPIN(xb_ld(&bar[XB_XGEN(b.x)]) == gen, bar);
      __builtin_amdgcn_fence(__ATOMIC_ACQUIRE, "agent");
      asm volatile("s_waitcnt vmcnt(0)" ::: "memory");
    }
  }
  __syncthreads();
}

enum { PH_NORM1 = 0, PH_INPROJ, PH_MIX1, PH_MIX2, PH_MIX3, PH_MERGE, PH_OUT, PH_FFN1, PH_FFN2, PH_PER_LAYER, PH_FINAL = 100 };

DI void run_phase(const Params& p, int ph, int layer, char* smem) {
  const int b = blockIdx.x, G = gridDim.x;
  const int wave = my_tid() >> 6;
  switch (ph) {
    case PH_NORM1: {
      if (layer == 0) {
        for (int t = b; t < 2 * CONV_TILES_LAYER; t += G) {
          ConvJob j;
          const int lt = conv_lookup(p, t, j);
          conv_tile(j, lt, (float*)smem);
        }
      }
      if (b == 0 && my_tid() == 0) *(unsigned*)(p.ws + OFF_CNT) = 0u;
      if (layer == 0) {
        float* z = ssq_buf(p, 2);
        for (int i = b * 256 + my_tid(); i < 2 * T; i += G * 256) z[i] = 0.f;
      }
      if (b < 8) s5_build_table(p, layer, b * 4 + wave);
      cvt_phase(p, layer, (u16*)(p.ws + OFF_H), true, b, G);
    } break;
    case PH_INPROJ: gemm_inproj(p, layer, b, G, (u16*)smem); break;
    case PH_MIX1: {
      for (int t = b; t < 2 * 3072; t += G) {
        const int kind = t / 3072, idx = t % 3072;
        if (kind == 0) gdn_pre(p, layer, idx, smem);
        else s5_pass1(p, layer, idx, smem);
      }
    } break;
    case PH_MIX2: {
      for (int c = b; c < 288; c += G) gdn_scan(p, c, smem);
      {
        unsigned* cnt = (unsigned*)(p.ws + OFF_CNT);
        int* slot = (int*)(smem + SMEM_BYTES - 16);
        for (;;) {
          __syncthreads();
          if (my_tid() == 0) *slot = (int)atomicAdd(cnt, 1u);
          __syncthreads();
          const int t = *slot;
          if (t >= 3 * 3072) break;
          if (t < 3072) s5_pass3(p, layer, t, smem);
          else if (t < 2 * 3072) attn_task(p, layer, 0, t - 3072, smem);
          else attn_task(p, layer, 1, t - 2 * 3072, smem);
        }
      }
    } break;
    case PH_MIX3: {
      gemm_glu(p, layer, b, G, (u16*)smem);
      for (int t = b * 4 + wave; t < T; t += G * 4) gdn_post_row(p, layer, t);
      cvt_phase(p, layer, (u16*)(p.ws + OFF_H), false, b, G);
    } break;
    case PH_MERGE: gemm_merge(p, layer, b, G, (u16*)smem); break;
    case PH_OUT:
      gemm_resid(p, layer, (const u16*)(p.ws + OFF_MERGED), DM, (const u16*)(p.ws + OFF_W) + layer * W_LAYER + WO_OUT, b, G, (u16*)smem,
                 (u16*)(p.ws + OFF_H2), ssq_buf(p, 2 + layer));
      break;
    case PH_FFN1: gemm_ffn1(p, layer, b, G, (u16*)smem); break;
    case PH_FFN2:
      gemm_resid(p, 1, (const u16*)(p.ws + OFF_ACT), FH, (const u16*)(p.ws + OFF_W) + layer * W_LAYER + WO_DN, b, G, (u16*)smem,
                 nullptr, nullptr);
      break;
    case PH_FINAL:
      for (int t = b * 4 + wave; t < T; t += G * 8) {
        const int t2 = t + G * 4;
        const bool has2 = t2 < T;
        const int lane = my_tid() & 63;
        float* r0 = p.xout + (size_t)t * DM;
        float* r1 = p.xout + (size_t)(has2 ? t2 : t) * DM;
        float4 a[4], c[4];
#pragma unroll
        for (int i = 0; i < 4; ++i) { a[i] = *(const float4*)(r0 + i * 256 + lane * 4); c[i] = *(const float4*)(r1 + i * 256 + lane * 4); }
        float s0 = 0.f, s1 = 0.f;
#pragma unroll
        for (int i = 0; i < 4; ++i) {
          s0 += a[i].x * a[i].x + a[i].y * a[i].y + a[i].z * a[i].z + a[i].w * a[i].w;
          s1 += c[i].x * c[i].x + c[i].y * c[i].y + c[i].z * c[i].z + c[i].w * c[i].w;
        }
        s0 = wave_sum(s0); s1 = wave_sum(s1);
        const float q0 = rstd_of(s0), q1 = rstd_of(s1);
#pragma unroll
        for (int i = 0; i < 4; ++i) {
          const float4 g = *(const float4*)(p.final_norm + i * 256 + lane * 4);
          *(float4*)(r0 + i * 256 + lane * 4) = make_float4(a[i].x * q0 * g.x, a[i].y * q0 * g.y, a[i].z * q0 * g.z, a[i].w * q0 * g.w);
          if (has2) *(float4*)(r1 + i * 256 + lane * 4) = make_float4(c[i].x * q1 * g.x, c[i].y * q1 * g.y, c[i].z * q1 * g.z, c[i].w * q1 * g.w);
        }
      }
      break;
    default: break;
  }
}

#if !MEGA
__global__ void __launch_bounds__(256, 2) k_phase(Params p, int ph, int layer) {
  __shared__ __attribute__((aligned(16))) char smem[SMEM_BYTES];
  run_phase(p, ph, layer, smem);
}

#else
__global__ void __launch_bounds__(256, 2) k_mega(Params p) {
  __shared__ __attribute__((aligned(16))) char smem[SMEM_BYTES];
  __shared__ uint4 xb_words;
  cg::grid_group grid = cg::this_grid();
  if (threadIdx.x == 0) xb_words = make_uint4(0u, 0u, 0u, 0u);
  __syncthreads();
  const XcdBarrier xb = xcd_barrier_post((unsigned*)(p.ws + OFF_BAR), (volatile LAS unsigned*)&xb_words);
  for (int layer = 0; layer < 2; ++layer)
    for (int ph = 0; ph < PH_PER_LAYER; ++ph) {
      run_phase(p, ph, layer, smem);
      if (p.ws == nullptr) grid.sync();
      xcd_barrier(xb);
#ifdef PROBE_DUP
      if (ph == PROBE_DUP) { run_phase(p, ph, layer, smem); grid.sync(); }
#endif
    }
  run_phase(p, PH_FINAL, 0, smem);
}
#endif

extern "C" void kernel_launch(void* const* d_in, const int* in_sizes, int n_in, void* d_out, int out_size, void* d_ws,
                              size_t ws_size, hipStream_t stream) {
  (void)in_sizes; (void)n_in; (void)out_size;
  if (ws_size < WS_NEED) { fprintf(stderr, "workspace too small: %zu < %zu\n", ws_size, (size_t)WS_NEED); return; }
  Params p;
  memset(&p, 0, sizeof(p));
  const float* const* in = (const float* const*)d_in;
  p.x_prompt = in[0]; p.x_sample = in[1]; p.norm1 = in[2]; p.conv_a = in[4]; p.a_log = in[5]; p.dt_bias = in[6];
  p.a_norm = in[7]; p.lam_re = in[8]; p.lam_im = in[9]; p.log_step = in[10]; p.b_re = in[11]; p.b_im = in[12];
  p.c_re = in[13]; p.c_im = in[14]; p.s5_d = in[15]; p.attn_sink = in[17]; p.norm2 = in[21]; p.final_norm = in[25];
  p.xout = (float*)d_out;
  p.ws = (char*)d_ws;
  p.w_in = in[3]; p.w_glu = in[16]; p.w_gate = in[18]; p.w_branch = in[19]; p.w_out = in[20];
  p.w_ffn_gate = in[22]; p.w_ffn_up = in[23]; p.w_ffn_down = in[24];
  static int grid_blocks = 0;
  if (!grid_blocks) {
    int dev = 0, cus = 0, per_cu = 0;
    hipGetDevice(&dev);
    hipDeviceGetAttribute(&cus, hipDeviceAttributeMultiprocessorCount, dev);
#if MEGA
    hipOccupancyMaxActiveBlocksPerMultiprocessor(&per_cu, k_mega, 256, 0);
#else
    hipOccupancyMaxActiveBlocksPerMultiprocessor(&per_cu, k_phase, 256, 0);
#endif
    per_cu = 2;
    grid_blocks = cus * per_cu;
  }
#if MEGA
  hipMemsetAsync((char*)d_ws + OFF_BAR, 0, BAR_BYTES, stream);
  void* args[] = {&p};
  hipError_t e = hipLaunchCooperativeKernel((void*)k_mega, dim3(grid_blocks), dim3(256), args, 0, stream);
  if (e != hipSuccess) fprintf(stderr, "cooperative launch failed: %s (grid %d)\n", hipGetErrorString(e), grid_blocks);
#else
  for (int layer = 0; layer < 2; ++layer)
    for (int ph = 0; ph < PH_PER_LAYER; ++ph) hipLaunchKernelGGL(k_phase, dim3(grid_blocks), dim3(256), 0, stream, p, ph, layer);
  hipLaunchKernelGGL(k_phase, dim3(grid_blocks), dim3(256), 0, stream, p, (int)PH_FINAL, 0);
#endif
}
```

```cpp
#include <hip/hip_runtime.h>
#include <hip/hip_cooperative_groups.h>
#include <cstdio>
#include <cstring>
namespace cg = cooperative_groups;

#ifndef MEGA
#define MEGA 1
#endif

#define DI __device__ __forceinline__
typedef unsigned short u16;
typedef __attribute__((ext_vector_type(8))) short bf16x8;
typedef __attribute__((ext_vector_type(4))) float f32x4;

constexpr int T = 49152;
constexpr int TP = 16384;
constexpr int DM = 1024;
constexpr int INW = 2576;
constexpr int FH = 2816;
constexpr int NCH64 = T / 64;
constexpr float EPS = 1e-6f;

constexpr int C_AQ = 0, C_AK = 256, C_AV = 512, C_AZ = 768, C_BQ = 1040, C_BK = 1296, C_BV = 1552, C_CU = 1808,
              C_DQ = 2064, C_DK = 2320, C_DV = 2448;

constexpr size_t WO_IN = 0, WO_GATE = 2752512, WO_BR = 6946816, WO_OUT = 7995392, WO_GU = 9043968, WO_DN = 14811136,
                 WO_GLU = 17694720, W_LAYER = 17825792;
constexpr size_t OFF_W = 0;
constexpr size_t OFF_PROJ = 2 * W_LAYER * 2;
constexpr size_t SZ_PROJ = (size_t)T * INW * 2;
constexpr size_t OFF_R1 = OFF_PROJ + SZ_PROJ;
constexpr size_t SZ_H = (size_t)T * DM * 2;
constexpr size_t OFF_H = OFF_R1;
constexpr size_t OFF_UW = OFF_R1;
constexpr size_t OFF_QN = OFF_R1 + SZ_H;
constexpr size_t OFF_KN = OFF_QN + (size_t)T * 256 * 2;
constexpr size_t OFF_GC = OFF_KN + (size_t)T * 256 * 2;
constexpr size_t OFF_SEND = OFF_GC + (size_t)NCH64 * 8 * 64 * 4;
constexpr size_t OFF_G = OFF_SEND + (size_t)NCH64 * 2 * 1024 * 8;
constexpr size_t OFF_AB = OFF_G + (size_t)T * 256 * 2;
constexpr size_t OFF_CNT = OFF_AB + (size_t)T * 16 * 4;
constexpr size_t OFF_MERGED = OFF_R1 + SZ_H;
constexpr size_t OFF_H2 = OFF_PROJ;
constexpr size_t OFF_ACT = OFF_PROJ + SZ_H;
constexpr size_t OFF_BAR = OFF_MERGED + SZ_H;
constexpr size_t BAR_BYTES = 3456 * 4;
constexpr size_t OFF_SSQ = OFF_BAR + 16384;
constexpr size_t OFF_S5TAB = OFF_SSQ + 5 * (size_t)T * 4;
constexpr size_t S5TAB_STRIDE = 13 * 1024;
constexpr size_t WS_NEED = OFF_S5TAB + 32 * S5TAB_STRIDE;

constexpr int SMEM_BYTES = 75776;

struct ConvJob { const float* src; u16* dst; const float* kscale; int K, ncols, nrows_dst, src_ld, rs, off, ntn; };
struct Params;
DI float* ssq_buf(const Params& p, int i);
struct Params {
  const float *x_prompt, *x_sample, *norm1, *conv_a, *a_log, *dt_bias, *a_norm, *lam_re, *lam_im, *log_step, *b_re,
      *b_im, *c_re, *c_im, *s5_d, *attn_sink, *norm2, *final_norm;
  const float *w_in, *w_gate, *w_branch, *w_out, *w_ffn_gate, *w_ffn_up, *w_ffn_down, *w_glu;
  float* xout;
  char* ws;
};
constexpr int CONV_TILES_LAYER = 4352;

DI int my_tid() { int t = threadIdx.x; asm volatile("" : "+v"(t)); return t; }
DI u16 f2bf(float x) { unsigned u = __float_as_uint(x); u += 0x7fffu + ((u >> 16) & 1u); return (u16)(u >> 16); }
DI float bf2f(u16 v) { return __uint_as_float(((unsigned)v) << 16); }
DI unsigned pack2(float a, float b) { return (unsigned)f2bf(a) | ((unsigned)f2bf(b) << 16); }
DI float sigmoidf_(float x) { return 1.f / (1.f + __expf(-x)); }
DI float siluf_(float x) { return x / (1.f + __expf(-x)); }
DI float wave_sum(float v) {
#pragma unroll
  for (int o = 32; o > 0; o >>= 1) v += __shfl_xor(v, o, 64);
  return v;
}
DI int seq_lo(int t) { return t < TP ? 0 : (t & ~4095); }
DI int seq_hi(int t) { return t < TP ? TP : (t & ~4095) + 4096; }
DI const float* xrow(const Params& p, int layer, int t) {
  if (layer == 0) return t < TP ? p.x_prompt + (size_t)t * DM : p.x_sample + (size_t)(t - TP) * DM;
  return p.xout + (size_t)t * DM;
}
DI f32x4 mfma16(bf16x8 a, bf16x8 b, f32x4 c) { return __builtin_amdgcn_mfma_f32_16x16x32_bf16(a, b, c, 0, 0, 0); }

DI void mk_job(ConvJob& j, const float* src, u16* dst, int K, int ncols, int nrows_dst, int src_ld, int rs, int off,
                const float* kscale = nullptr) {
  j.kscale = kscale;
  j.src = src; j.dst = dst; j.K = K; j.ncols = ncols; j.nrows_dst = nrows_dst; j.src_ld = src_ld; j.rs = rs; j.off = off;
  j.ntn = (nrows_dst + 63) >> 6;
}
DI int conv_lookup(const Params& p, int t, ConvJob& j) {
  const int l = t / CONV_TILES_LAYER;
  int r = t % CONV_TILES_LAYER;
  u16* wl = (u16*)(p.ws + OFF_W) + (size_t)l * W_LAYER;
  if (r < 672) { mk_job(j, p.w_in + (size_t)l * DM * INW, wl + WO_IN, DM, INW, 2688, INW, 32, 0, p.norm1 + l * DM); return r; }
  r -= 672;
  if (r < 1024) { const int i = r >> 8; mk_job(j, p.w_gate + (size_t)(l * 4 + i) * DM * DM, wl + WO_GATE + (size_t)i * DM * DM, DM, DM, DM, DM, 32, 0, p.norm1 + l * DM); return r & 255; }
  r -= 1024;
  if (r < 256) { const int i = r >> 6; mk_job(j, p.w_branch + (size_t)(l * 4 + i) * 256 * DM, wl + WO_BR + (size_t)i * DM * 256, 256, DM, DM, DM, 32, 0); return r & 63; }
  r -= 256;
  if (r < 256) { mk_job(j, p.w_out + (size_t)l * DM * DM, wl + WO_OUT, DM, DM, DM, DM, 32, 0); return r; }
  r -= 256;
  if (r < 704) { mk_job(j, p.w_ffn_gate + (size_t)l * DM * FH, wl + WO_GU, DM, FH, FH, FH, 64, 0, p.norm2 + l * DM); return r; }
  r -= 704;
  if (r < 704) { mk_job(j, p.w_ffn_up + (size_t)l * DM * FH, wl + WO_GU, DM, FH, FH, FH, 64, 32, p.norm2 + l * DM); return r; }
  r -= 704;
  if (r < 704) { mk_job(j, p.w_ffn_down + (size_t)l * FH * DM, wl + WO_DN, FH, DM, DM, DM, 32, 0); return r; }
  r -= 704;
  if (r < 16) { mk_job(j, p.w_glu + (size_t)l * 256 * 512, wl + WO_GLU, 256, 256, 256, 512, 64, 0); return r; }
  r -= 16;
  mk_job(j, p.w_glu + (size_t)l * 256 * 512 + 256, wl + WO_GLU, 256, 256, 256, 512, 64, 32);
  return r;
}
DI void conv_tile(const ConvJob& j, int lt, float* tile) {
  const int tid = my_tid();
  const int tk = lt / j.ntn, tn = lt % j.ntn;
  __syncthreads();
#pragma unroll
  for (int i = 0; i < 4; ++i) {
    int r = (tid >> 4) + 16 * i, c4 = (tid & 15) * 4, n = tn * 64 + c4;
    float4 v = make_float4(0.f, 0.f, 0.f, 0.f);
    if (n < j.ncols) v = *(const float4*)(j.src + (size_t)(tk * 64 + r) * j.src_ld + n);
    if (j.kscale) { const float s = j.kscale[tk * 64 + r]; v.x *= s; v.y *= s; v.z *= s; v.w *= s; }
    tile[r * 65 + c4 + 0] = v.x; tile[r * 65 + c4 + 1] = v.y; tile[r * 65 + c4 + 2] = v.z; tile[r * 65 + c4 + 3] = v.w;
  }
  __syncthreads();
  const int cl = tid >> 2, ks = (tid & 3) * 16, n = tn * 64 + cl;
  if (n < j.nrows_dst) {
    unsigned w[8];
#pragma unroll
    for (int e = 0; e < 8; ++e) w[e] = pack2(tile[(ks + 2 * e) * 65 + cl], tile[(ks + 2 * e + 1) * 65 + cl]);
    const int nm = (n >> 5) * j.rs + (n & 31) + j.off;
    uint4* d = (uint4*)(j.dst + (size_t)nm * j.K + tk * 64 + ks);
    d[0] = make_uint4(w[0], w[1], w[2], w[3]);
    d[1] = make_uint4(w[4], w[5], w[6], w[7]);
  }
}

DI float* ssq_buf(const Params& p, int i) { return (float*)(p.ws + OFF_SSQ) + (size_t)i * T; }
DI float rstd_of(float ssq) { return rsqrtf(ssq * (1.f / DM) + EPS); }
DI void cvt_row_bf16(const float* src, u16* dst, float* ssq_out) {
  const int lane = my_tid() & 63;
  float ss = 0.f;
#pragma unroll
  for (int i = 0; i < 4; ++i) {
    const float4 v = *(const float4*)(src + i * 256 + lane * 4);
    ss += v.x * v.x + v.y * v.y + v.z * v.z + v.w * v.w;
    uint2 o; o.x = pack2(v.x, v.y); o.y = pack2(v.z, v.w);
    *(uint2*)(dst + i * 256 + lane * 4) = o;
  }
  if (ssq_out) { ss = wave_sum(ss); if (lane == 0) *ssq_out = ss; }
}
DI void cvt_phase(const Params& p, int layer, u16* dst, bool write_ssq, int b0, int nb) {
  const int wave = my_tid() >> 6, lane = my_tid() & 63;
  for (int r = b0 * 4 + wave; r < T; r += nb * 8) {
    const int r2 = r + nb * 4;
    const bool has2 = r2 < T;
    const float* s0 = xrow(p, layer, r);
    const float* s1 = xrow(p, layer, has2 ? r2 : r);
    float4 a[4], c[4];
#pragma unroll
    for (int i = 0; i < 4; ++i) { a[i] = *(const float4*)(s0 + i * 256 + lane * 4); c[i] = *(const float4*)(s1 + i * 256 + lane * 4); }
    float ss0 = 0.f, ss1 = 0.f;
#pragma unroll
    for (int i = 0; i < 4; ++i) {
      ss0 += a[i].x * a[i].x + a[i].y * a[i].y + a[i].z * a[i].z + a[i].w * a[i].w;
      ss1 += c[i].x * c[i].x + c[i].y * c[i].y + c[i].z * c[i].z + c[i].w * c[i].w;
      uint2 o; o.x = pack2(a[i].x, a[i].y); o.y = pack2(a[i].z, a[i].w);
      *(uint2*)(dst + (size_t)r * DM + i * 256 + lane * 4) = o;
      if (has2) { uint2 o2; o2.x = pack2(c[i].x, c[i].y); o2.y = pack2(c[i].z, c[i].w); *(uint2*)(dst + (size_t)r2 * DM + i * 256 + lane * 4) = o2; }
    }
    if (write_ssq) {
      ss0 = wave_sum(ss0); ss1 = wave_sum(ss1);
      if (lane == 0) { ssq_buf(p, layer)[r] = ss0; if (has2) ssq_buf(p, layer)[r2] = ss1; }
    }
  }
}

constexpr int GP = 64;
#ifndef GEMM_DMA
#define GEMM_DMA 1
#endif
#if GEMM_DMA
template <int NT, bool SPLIT = false>
DI void gemm_kloop(const u16* __restrict__ A, size_t lda, const u16* __restrict__ B, size_t ldb, int nk,
                   f32x4 (&acc)[4][NT], u16* sm) {
  const int tid = my_tid(), lane = tid & 63;
  const int wave = __builtin_amdgcn_readfirstlane(tid >> 6);
  const int fr = lane & 15, fq = lane >> 4, wr = wave >> 1, wc = wave & 1;
  u16* sa = sm;
  u16* sb = sm + 2 * 128 * 64;
  const int swz = (fr >> 1) & 7;
  const int lr = lane >> 3;
  const int lc = ((lane & 7) ^ ((lr >> 1) & 3)) * 8;
#define DMA_PIECE(BASE, LD, G, KOFF, DST)                                                              \
  {                                                                                                    \
    int lrl_ = lr;                                                                                     \
    asm volatile("" : "+v"(lrl_));   \
    const int row_ = (G) * 8 + lrl_;                                                                   \
    const int col_ = lc ^ ((((G) & 1) * 4) * 8);                                                       \
    __builtin_amdgcn_global_load_lds((const unsigned*)((BASE) + (size_t)row_ * (LD) + (KOFF) + col_),  \
                                     (unsigned*)((DST) + (G) * 512), 16, 0, 0);                        \
  }
#define DMA_TILE(KOFF, STAGE)                                                                          \
  {                                                                                                    \
    u16* da_ = sa + (STAGE) * 8192;                                                                    \
    u16* db_ = sb + (STAGE) * 8192;                                                                    \
    DMA_PIECE(A, lda, wave * 4 + 0, KOFF, da_) DMA_PIECE(A, lda, wave * 4 + 1, KOFF, da_)              \
    DMA_PIECE(A, lda, wave * 4 + 2, KOFF, da_) DMA_PIECE(A, lda, wave * 4 + 3, KOFF, da_)              \
    if (NT == 4) {                                                                                     \
      DMA_PIECE(B, ldb, wave * 4 + 0, KOFF, db_) DMA_PIECE(B, ldb, wave * 4 + 1, KOFF, db_)            \
      DMA_PIECE(B, ldb, wave * 4 + 2, KOFF, db_) DMA_PIECE(B, ldb, wave * 4 + 3, KOFF, db_)            \
    } else {                                                                                           \
      DMA_PIECE(B, ldb, wave * 2 + 0, KOFF, db_) DMA_PIECE(B, ldb, wave * 2 + 1, KOFF, db_)            \
    }                                                                                                  \
  }
  __builtin_amdgcn_s_barrier();
  DMA_TILE(0, 0)
#pragma unroll 1
  for (int kt = 0; kt < nk; ++kt) {
    const int cur = kt & 1;
    asm volatile("s_waitcnt vmcnt(0)" ::: "memory");
    __builtin_amdgcn_s_barrier();
    asm volatile("" ::: "memory");
    const u16* ca = sa + cur * 8192;
    const u16* cb = sb + cur * 8192;
    if (SPLIT) {
      bf16x8 wf[NT], xf[4];
#pragma unroll
      for (int nt = 0; nt < NT; ++nt) wf[nt] = *(const bf16x8*)(cb + (wc * NT * 16 + nt * 16 + fr) * 64 + (((0 * 4 + fq) ^ swz) * 8));
#pragma unroll
      for (int mt = 0; mt < 4; ++mt) xf[mt] = *(const bf16x8*)(ca + (wr * 64 + mt * 16 + fr) * 64 + (((0 * 4 + fq) ^ swz) * 8));
#pragma unroll
      for (int mt = 0; mt < 4; ++mt)
#pragma unroll
        for (int nt = 0; nt < NT; ++nt) acc[mt][nt] = mfma16(wf[nt], xf[mt], acc[mt][nt]);
#pragma unroll
      for (int nt = 0; nt < NT; ++nt) wf[nt] = *(const bf16x8*)(cb + (wc * NT * 16 + nt * 16 + fr) * 64 + (((1 * 4 + fq) ^ swz) * 8));
#pragma unroll
      for (int mt = 0; mt < 4; ++mt) xf[mt] = *(const bf16x8*)(ca + (wr * 64 + mt * 16 + fr) * 64 + (((1 * 4 + fq) ^ swz) * 8));
      __builtin_amdgcn_sched_barrier(0);
      if (kt + 1 < nk) DMA_TILE((kt + 1) * 64, cur ^ 1)
      __builtin_amdgcn_sched_barrier(0);
#pragma unroll
      for (int mt = 0; mt < 4; ++mt)
#pragma unroll
        for (int nt = 0; nt < NT; ++nt) acc[mt][nt] = mfma16(wf[nt], xf[mt], acc[mt][nt]);
      continue;
    }
    bf16x8 wf[2][NT], xf[2][4];
#pragma unroll
    for (int kk = 0; kk < 2; ++kk) {
#pragma unroll
      for (int nt = 0; nt < NT; ++nt) wf[kk][nt] = *(const bf16x8*)(cb + (wc * NT * 16 + nt * 16 + fr) * 64 + (((kk * 4 + fq) ^ swz) * 8));
#pragma unroll
      for (int mt = 0; mt < 4; ++mt) xf[kk][mt] = *(const bf16x8*)(ca + (wr * 64 + mt * 16 + fr) * 64 + (((kk * 4 + fq) ^ swz) * 8));
    }
    __builtin_amdgcn_sched_barrier(0);
    if (kt + 1 < nk) DMA_TILE((kt + 1) * 64, cur ^ 1)
    __builtin_amdgcn_sched_barrier(0);
    __builtin_amdgcn_s_setprio(1);
#pragma unroll
    for (int kk = 0; kk < 2; ++kk)
#pragma unroll
      for (int mt = 0; mt < 4; ++mt)
#pragma unroll
        for (int nt = 0; nt < NT; ++nt) acc[mt][nt] = mfma16(wf[kk][nt], xf[kk][mt], acc[mt][nt]);
    __builtin_amdgcn_s_setprio(0);
  }
}
#else
template <int NT>
DI void gemm_kloop(const u16* __restrict__ A, size_t lda, const u16* __restrict__ B, size_t ldb, int nk,
                   f32x4 (&acc)[4][NT], u16* sm) {
  const int tid = my_tid(), lane = tid & 63, wave = tid >> 6;
  const int fr = lane & 15, fq = lane >> 4, wr = wave >> 1, wc = wave & 1;
  u16* sa = sm;
  u16* sb = sm + 2 * 128 * GP;
  uint4 ra0, ra1, ra2, ra3, rb0, rb1, rb2 = make_uint4(0, 0, 0, 0), rb3 = make_uint4(0, 0, 0, 0);
  uint4 rc0, rc1, rc2, rc3, rd0, rd1, rd2 = make_uint4(0, 0, 0, 0), rd3 = make_uint4(0, 0, 0, 0);
  const int lrow = tid >> 3, lseg = (tid & 7) * 8;
  const int sseg = ((tid & 7) ^ ((lrow >> 1) & 7)) * 8;
  const u16* Ap = A + (size_t)lrow * lda + lseg;
  const u16* Bp = B + (size_t)lrow * ldb + lseg;
#define KL_LOAD(KOFF, A0, A1, A2, A3, B0, B1, B2, B3)                    \
  A0 = *(const uint4*)(Ap + (KOFF));                                     \
  A1 = *(const uint4*)(Ap + 32 * lda + (KOFF));                          \
  A2 = *(const uint4*)(Ap + 64 * lda + (KOFF));                          \
  A3 = *(const uint4*)(Ap + 96 * lda + (KOFF));                          \
  B0 = *(const uint4*)(Bp + (KOFF));                                     \
  B1 = *(const uint4*)(Bp + 32 * ldb + (KOFF));                          \
  if (NT > 2) { B2 = *(const uint4*)(Bp + 64 * ldb + (KOFF)); B3 = *(const uint4*)(Bp + 96 * ldb + (KOFF)); }
#define KL_STORE(SA, SB, A0, A1, A2, A3, B0, B1, B2, B3)                 \
  *(uint4*)((SA) + (lrow + 0) * GP + sseg) = A0;                         \
  *(uint4*)((SA) + (lrow + 32) * GP + sseg) = A1;                        \
  *(uint4*)((SA) + (lrow + 64) * GP + sseg) = A2;                        \
  *(uint4*)((SA) + (lrow + 96) * GP + sseg) = A3;                        \
  *(uint4*)((SB) + (lrow + 0) * GP + sseg) = B0;                         \
  *(uint4*)((SB) + (lrow + 32) * GP + sseg) = B1;                        \
  if (NT > 2) { *(uint4*)((SB) + (lrow + 64) * GP + sseg) = B2; *(uint4*)((SB) + (lrow + 96) * GP + sseg) = B3; }
#define KL_COMPUTE(CA, CB)                                                                                     \
  _Pragma("unroll") for (int kk = 0; kk < 2; ++kk) {                                                           \
    bf16x8 wf[NT], xf[4];                                                                                      \
    _Pragma("unroll") for (int nt = 0; nt < NT; ++nt)                                                          \
      wf[nt] = *(const bf16x8*)((CB) + (wc * NT * 16 + nt * 16 + fr) * GP + (((kk * 4 + fq) ^ swz) * 8));       \
    _Pragma("unroll") for (int mt = 0; mt < 4; ++mt)                                                           \
      xf[mt] = *(const bf16x8*)((CA) + (wr * 64 + mt * 16 + fr) * GP + (((kk * 4 + fq) ^ swz) * 8));            \
    _Pragma("unroll") for (int mt = 0; mt < 4; ++mt)                                                           \
    _Pragma("unroll") for (int nt = 0; nt < NT; ++nt) acc[mt][nt] = mfma16(wf[nt], xf[mt], acc[mt][nt]);      \
  }
  const int swz = (fr >> 1) & 7;
  KL_LOAD(0, ra0, ra1, ra2, ra3, rb0, rb1, rb2, rb3)
  KL_LOAD(64, rc0, rc1, rc2, rc3, rd0, rd1, rd2, rd3)
  KL_STORE(sa, sb, ra0, ra1, ra2, ra3, rb0, rb1, rb2, rb3)
  __syncthreads();
  u16* sa1 = sa + 128 * GP;
  u16* sb1 = sb + 128 * GP;
#pragma unroll 1
  for (int kt = 0; kt < nk; kt += 2) {
    const int k2 = (kt + 2 < nk ? kt + 2 : kt) * 64, k3 = (kt + 3 < nk ? kt + 3 : kt + 1) * 64;
    KL_LOAD(k2, ra0, ra1, ra2, ra3, rb0, rb1, rb2, rb3)
    __builtin_amdgcn_sched_barrier(0);
    KL_COMPUTE(sa, sb)
    KL_STORE(sa1, sb1, rc0, rc1, rc2, rc3, rd0, rd1, rd2, rd3)
    __syncthreads();
    KL_LOAD(k3, rc0, rc1, rc2, rc3, rd0, rd1, rd2, rd3)
    __builtin_amdgcn_sched_barrier(0);
    KL_COMPUTE(sa1, sb1)
    KL_STORE(sa, sb, ra0, ra1, ra2, ra3, rb0, rb1, rb2, rb3)
    __syncthreads();
  }
}
#endif
template <int NT>
DI void zero_acc(f32x4 (&acc)[4][NT]) {
#pragma unroll
  for (int a = 0; a < 4; ++a)
#pragma unroll
    for (int b = 0; b < NT; ++b) acc[a][b] = (f32x4){0.f, 0.f, 0.f, 0.f};
}

struct TileIter {
  int step, nsteps, nfull, nrx, nct, pwl, x, local, mode, idx, stride, L;
  DI void init(int nrt, int nct_, int b, int G) {
    nct = nct_;
    if (G == 512 && (nrt % 64) == 0) {
      mode = 1; x = b & 7; local = b >> 3;
      nrx = nrt / 8;
      const int fullp = nct >> 3;
      pwl = nct & 7;
      nfull = fullp * (nrx / 8);
      nsteps = nfull + (pwl ? (nrx * pwl + 63) / 64 : 0);
      step = 0;
      skip();
    } else {
      mode = 0; idx = b; stride = G; L = nrt * nct;
    }
  }
  DI bool in_range() const { return step < nfull || (step - nfull) * 64 + local < nrx * pwl; }
  DI void skip() { while (step < nsteps && !in_range()) ++step; }
  DI bool valid() const { return mode ? step < nsteps : idx < L; }
  DI int rt() const {
    if (!mode) return idx / nct;
    const int nrb = nrx / 8;
    const int ri = step < nfull ? (step % nrb) * 8 + (local >> 3) : ((step - nfull) * 64 + local) / pwl;
    return x + 8 * ri;
  }
  DI int ct() const {
    if (!mode) return idx % nct;
    const int nrb = nrx / 8;
    return step < nfull ? (step / nrb) * 8 + (local & 7) : (nct & ~7) + ((step - nfull) * 64 + local) % pwl;
  }
  DI void next() { if (mode) { ++step; skip(); } else idx += stride; }
};

#define EPI_COORDS                                                       \
  const int lane = my_tid() & 63, wave = my_tid() >> 6;           \
  const int fr = lane & 15, fq = lane >> 4, wr = wave >> 1, wc = wave & 1; \
  (void)fr; (void)fq; (void)wr; (void)wc;

DI void gemm_inproj(const Params& p, int layer, int b, int G, u16* sm) {
  const u16* H = (const u16*)(p.ws + OFF_H);
  const u16* W = (const u16*)(p.ws + OFF_W) + layer * W_LAYER + WO_IN;
  u16* proj = (u16*)(p.ws + OFF_PROJ);
  float* AB = (float*)(p.ws + OFF_AB);
  EPI_COORDS
  TileIter it; it.init(T / 128, 21, b, G);
  for (; it.valid(); it.next()) {
    const int row0 = it.rt() * 128, col0 = it.ct() * 128;
    f32x4 acc[4][4]; zero_acc<4>(acc);
    gemm_kloop<4>(H + (size_t)row0 * DM, DM, W + (size_t)col0 * DM, DM, 16, acc, sm);
#pragma unroll
    for (int mt = 0; mt < 4; ++mt) {
      const int row = row0 + wr * 64 + mt * 16 + fr;
      const float rs = rstd_of(ssq_buf(p, layer)[row]);
#pragma unroll
      for (int nt = 0; nt < 4; ++nt) {
        const int col = col0 + wc * 64 + nt * 16 + fq * 4;
        acc[mt][nt] *= rs;
        if (col < INW) {
          uint2 o; o.x = pack2(acc[mt][nt][0], acc[mt][nt][1]); o.y = pack2(acc[mt][nt][2], acc[mt][nt][3]);
          *(uint2*)(proj + (size_t)row * INW + col) = o;
          if (col >= 1024 && col < 1040)
            *(float4*)(AB + (size_t)row * 16 + (col - 1024)) = make_float4(acc[mt][nt][0], acc[mt][nt][1], acc[mt][nt][2], acc[mt][nt][3]);
        }
      }
    }
  }
}

DI void gemm_glu(const Params& p, int layer, int b, int G, u16* sm) {
  const u16* Gb = (const u16*)(p.ws + OFF_G);
  const u16* W = (const u16*)(p.ws + OFF_W) + layer * W_LAYER + WO_GLU;
  u16* proj = (u16*)(p.ws + OFF_PROJ);
  EPI_COORDS
  TileIter it; it.init(T / 128, 4, b, G);
  for (; it.valid(); it.next()) {
    const int row0 = it.rt() * 128, ct = it.ct();
    f32x4 acc[4][4]; zero_acc<4>(acc);
    gemm_kloop<4>(Gb + (size_t)row0 * 256, 256, W + (size_t)ct * 128 * 256, 256, 4, acc, sm);
#pragma unroll
    for (int mt = 0; mt < 4; ++mt) {
      const int row = row0 + wr * 64 + mt * 16 + fr;
#pragma unroll
      for (int nt = 0; nt < 2; ++nt) {
        const int col = (ct * 2 + wc) * 32 + nt * 16 + fq * 4;
        float o[4];
#pragma unroll
        for (int j = 0; j < 4; ++j) o[j] = acc[mt][nt][j] * sigmoidf_(acc[mt][nt + 2][j]);
        uint2 ov; ov.x = pack2(o[0], o[1]); ov.y = pack2(o[2], o[3]);
        *(uint2*)(proj + (size_t)row * INW + C_CU + col) = ov;
      }
    }
  }
}

DI void gemm_merge(const Params& p, int layer, int b, int G, u16* sm) {
  const u16* H = (const u16*)(p.ws + OFF_H);
  const u16* Wg = (const u16*)(p.ws + OFF_W) + layer * W_LAYER + WO_GATE;
  const u16* Wb = (const u16*)(p.ws + OFF_W) + layer * W_LAYER + WO_BR;
  const u16* proj = (const u16*)(p.ws + OFF_PROJ);
  u16* merged = (u16*)(p.ws + OFF_MERGED);
  EPI_COORDS
  TileIter it; it.init(T / 128, 8, b, G);
  for (; it.valid(); it.next()) {
    const int row0 = it.rt() * 128, col0 = it.ct() * 128;
    uint2 mg[4][4];
#pragma unroll
    for (int a = 0; a < 4; ++a)
#pragma unroll
      for (int c = 0; c < 4; ++c) mg[a][c] = make_uint2(0u, 0u);
#pragma unroll 1
    for (int i = 0; i < 4; ++i) {
      const int ocol = (i == 0) ? C_AZ : (i == 1) ? C_BQ : (i == 2) ? C_CU : C_DQ;
      f32x4 acc[4][4]; zero_acc<4>(acc);
      gemm_kloop<4, true>(H + (size_t)row0 * DM, DM, Wg + (size_t)i * DM * DM + (size_t)col0 * DM, DM, 16, acc, sm);
      uint2 sg[4][4];
#pragma unroll
      for (int a = 0; a < 4; ++a) {
        const float rs = rstd_of(ssq_buf(p, layer)[row0 + wr * 64 + a * 16 + fr]);
#pragma unroll
        for (int c = 0; c < 4; ++c) {
          sg[a][c].x = pack2(sigmoidf_(rs * acc[a][c][0]), sigmoidf_(rs * acc[a][c][1]));
          sg[a][c].y = pack2(sigmoidf_(rs * acc[a][c][2]), sigmoidf_(rs * acc[a][c][3]));
        }
      }
      zero_acc<4>(acc);
      gemm_kloop<4, true>(proj + (size_t)row0 * INW + ocol, INW, Wb + (size_t)i * DM * 256 + (size_t)col0 * 256, 256, 4, acc, sm);
#pragma unroll
      for (int a = 0; a < 4; ++a)
#pragma unroll
        for (int c = 0; c < 4; ++c) {
          const float m0 = bf2f((u16)(mg[a][c].x & 0xffff)) + bf2f((u16)(sg[a][c].x & 0xffff)) * acc[a][c][0];
          const float m1 = bf2f((u16)(mg[a][c].x >> 16)) + bf2f((u16)(sg[a][c].x >> 16)) * acc[a][c][1];
          const float m2 = bf2f((u16)(mg[a][c].y & 0xffff)) + bf2f((u16)(sg[a][c].y & 0xffff)) * acc[a][c][2];
          const float m3 = bf2f((u16)(mg[a][c].y >> 16)) + bf2f((u16)(sg[a][c].y >> 16)) * acc[a][c][3];
          mg[a][c].x = pack2(m0, m1); mg[a][c].y = pack2(m2, m3);
        }
    }
#pragma unroll
    for (int mt = 0; mt < 4; ++mt) {
      const int row = row0 + wr * 64 + mt * 16 + fr;
#pragma unroll
      for (int nt = 0; nt < 4; ++nt) {
        const int col = col0 + wc * 64 + nt * 16 + fq * 4;
        *(uint2*)(merged + (size_t)row * DM + col) = mg[mt][nt];
      }
    }
  }
}

DI void gemm_resid(const Params& p, int layer_src, const u16* A, int K, const u16* W, int b, int G, u16* sm, u16* xb_out,
                   float* ssq_acc) {
  EPI_COORDS
  TileIter it; it.init(T / 128, 8, b, G);
  for (; it.valid(); it.next()) {
    const int row0 = it.rt() * 128, col0 = it.ct() * 128;
    f32x4 acc[4][4]; zero_acc<4>(acc);
    gemm_kloop<4>(A + (size_t)row0 * K, K, W + (size_t)col0 * K, K, K / 64, acc, sm);
#pragma unroll
    for (int mt = 0; mt < 4; ++mt) {
      const int row = row0 + wr * 64 + mt * 16 + fr;
      const float* xs = xrow(p, layer_src, row);
      float* xd = p.xout + (size_t)row * DM;
      float ss = 0.f;
#pragma unroll
      for (int nt = 0; nt < 4; ++nt) {
        const int col = col0 + wc * 64 + nt * 16 + fq * 4;
        float4 r = *(const float4*)(xs + col);
        r.x += acc[mt][nt][0]; r.y += acc[mt][nt][1]; r.z += acc[mt][nt][2]; r.w += acc[mt][nt][3];
        *(float4*)(xd + col) = r;
        ss += r.x * r.x + r.y * r.y + r.z * r.z + r.w * r.w;
        if (xb_out) { uint2 o; o.x = pack2(r.x, r.y); o.y = pack2(r.z, r.w); *(uint2*)(xb_out + (size_t)row * DM + col) = o; }
      }
      if (ssq_acc) {
        ss += __shfl_xor(ss, 16, 64);
        ss += __shfl_xor(ss, 32, 64);
        if (fq == 0) atomicAdd(ssq_acc + row, ss);
      }
    }
  }
}

DI void gemm_ffn1(const Params& p, int layer, int b, int G, u16* sm) {
  const u16* H = (const u16*)(p.ws + OFF_H2);
  const u16* W = (const u16*)(p.ws + OFF_W) + layer * W_LAYER + WO_GU;
  u16* act = (u16*)(p.ws + OFF_ACT);
  EPI_COORDS
  TileIter it; it.init(T / 128, 44, b, G);
  for (; it.valid(); it.next()) {
    const int row0 = it.rt() * 128, ct = it.ct();
    f32x4 acc[4][4]; zero_acc<4>(acc);
    gemm_kloop<4>(H + (size_t)row0 * DM, DM, W + (size_t)ct * 128 * DM, DM, 16, acc, sm);
#pragma unroll
    for (int mt = 0; mt < 4; ++mt) {
      const int row = row0 + wr * 64 + mt * 16 + fr;
      const float rs = rstd_of(ssq_buf(p, 2 + layer)[row]);
#pragma unroll
      for (int nt = 0; nt < 2; ++nt) {
        const int col = (ct * 2 + wc) * 32 + nt * 16 + fq * 4;
        float o[4];
#pragma unroll
        for (int j = 0; j < 4; ++j) o[j] = siluf_(rs * acc[mt][nt][j]) * (rs * acc[mt][nt + 2][j]);
        uint2 ov; ov.x = pack2(o[0], o[1]); ov.y = pack2(o[2], o[3]);
        *(uint2*)(act + (size_t)row * FH + col) = ov;
      }
    }
  }
}

DI f32x4 mma_t(const u16* X, int xr, const u16* Y, int yr, f32x4 acc, int fr, int fq);
DI void gdn_pre(const Params& p, int layer, int task, char* smem) {
  const int tid = my_tid(), lane = tid & 63, wave = tid >> 6;
  const int fr = lane & 15, fq = lane >> 4;
  const int n = task >> 2, h = task & 3, c0 = n * 64;
  const int lo = seq_lo(c0), hi = seq_hi(c0);
  float* ks = (float*)smem;
  float* vs = ks + 64 * 65;
  u16* Kb = (u16*)vs;
  float* AmT = vs + 64 * 65;
  float* gcs = AmT + 2 * 64 * 68;
  float* bts = gcs + 128;
  const u16* proj = (const u16*)(p.ws + OFF_PROJ);
  u16* QN = (u16*)(p.ws + OFF_QN);
  u16* KN = (u16*)(p.ws + OFF_KN);
  float* GC = (float*)(p.ws + OFF_GC);
  const float* AB = (const float*)(p.ws + OFF_AB);
  u16* UW = (u16*)(p.ws + OFF_UW);
  __syncthreads();
#define GDN_CONV(MAT)                                                                                \
  {                                                                                                  \
    const int ch = (MAT) * 256 + h * 64 + lane;                                                      \
    float w[5];                                                                                      \
    _Pragma("unroll") for (int j = 0; j < 5; ++j) w[j] = p.conv_a[(size_t)(layer * 5 + j) * 768 + ch]; \
    float raw[20];                                                                                   \
    _Pragma("unroll") for (int i = 0; i < 20; ++i) {                                                 \
      const int tok = c0 + wave * 16 + i - 2;                                                        \
      raw[i] = (tok >= lo && tok < hi) ? bf2f(proj[(size_t)tok * INW + ch]) : 0.f;                   \
    }                                                                                                \
    _Pragma("unroll") for (int i = 0; i < 16; ++i) {                                                 \
      float v = 0.f;                                                                                 \
      _Pragma("unroll") for (int j = 0; j < 5; ++j) v += raw[i + j] * w[j];                          \
      v = siluf_(v);                                                                                 \
      const int tl = wave * 16 + i;                                                                  \
      if ((MAT) < 2) {                                                                               \
        const float ss = wave_sum(v * v);                                                            \
        v *= rsqrtf(ss + EPS) * ((MAT) == 0 ? 0.125f : 1.f);                                         \
      }                                                                                              \
      if ((MAT) == 0) QN[(size_t)(c0 + tl) * 256 + h * 64 + lane] = f2bf(v);                         \
      else if ((MAT) == 1) {                                                                         \
        const u16 kb = f2bf(v);                                                                      \
        KN[(size_t)(c0 + tl) * 256 + h * 64 + lane] = kb; ks[tl * 65 + lane] = v; Kb[tl * 72 + lane] = kb; \
      } else vs[tl * 65 + lane] = v;                                                                 \
    }                                                                                                \
  }
  GDN_CONV(0)
  GDN_CONV(1)
  if (wave < 2) {
    const int d = wave;
    const int tok = c0 + (d ? 63 - lane : lane);
    const float al = AB[(size_t)tok * 16 + d * 4 + h];
    const float br = AB[(size_t)tok * 16 + 8 + d * 4 + h];
    const float xx = al + p.dt_bias[(layer * 2 + d) * 4 + h];
    const float sp = fmaxf(xx, 0.f) + log1pf(__expf(-fabsf(xx)));
    float g = -__expf(p.a_log[(layer * 2 + d) * 4 + h]) * sp;
#pragma unroll
    for (int o = 1; o < 64; o <<= 1) {
      const float t = __shfl_up(g, o, 64);
      if (lane >= o) g += t;
    }
    gcs[d * 64 + lane] = g;
    bts[d * 64 + lane] = sigmoidf_(br);
    GC[(size_t)(task * 2 + d) * 64 + lane] = g;
  }
  __syncthreads();
#pragma unroll
  for (int t = 0; t < 4; ++t) {
    if (t <= wave) {
      const f32x4 kk = mma_t(Kb, wave * 16, Kb, t * 16, (f32x4){0.f, 0.f, 0.f, 0.f}, fr, fq);
      const int b = t * 16 + fr;
      const float gb0 = gcs[b], gb1 = gcs[64 + 63 - b], bt1 = bts[64 + 63 - b];
#pragma unroll
      for (int j = 0; j < 4; ++j) {
        const int a = wave * 16 + fq * 4 + j;
        if (a > b) {
          AmT[b * 68 + a] = bts[a] * kk[j] * __expf(gcs[a] - gb0);
          const int i1 = 63 - b, j1 = 63 - a;
          AmT[64 * 68 + j1 * 68 + i1] = bt1 * kk[j] * __expf(gb1 - gcs[64 + j1]);
        }
      }
    }
  }
  __syncthreads();
  GDN_CONV(2)
  __syncthreads();
  {
    int d = tid >> 7, c = tid & 127;
    asm volatile("" : "+v"(d), "+v"(c));
    float r[64];
    {
      const int stride = d ? -65 : 65;
      int off = (d ? 63 * 65 : 0) + (c & 63);
      const float* srcm = (c < 64) ? vs : ks;
      const bool isw = c >= 64;
#pragma unroll
      for (int i = 0; i < 64; ++i) {
        float v = srcm[off] * bts[d * 64 + i];
        if (isw) v *= __expf(gcs[d * 64 + i]);
        r[i] = v;
        off += stride;
        asm volatile("" : "+v"(off));
        if ((i & 7) == 7) __builtin_amdgcn_sched_barrier(0);
      }
    }
    const float* Ad = AmT + d * 64 * 68;
#pragma unroll
    for (int j = 0; j < 63; ++j) {
      const float rj = r[j];
#pragma unroll
      for (int i = j + 1; i < 64; ++i) {
        r[i] = fmaf(-Ad[j * 68 + i], rj, r[i]);
      }
      if ((j & 1) == 1) __builtin_amdgcn_sched_barrier(0);
    }
    u16* base = UW + (size_t)(task * 2 + d) * 8192;
    if (c < 64) {
      uint4* dst = (uint4*)(base + c * 64);
#pragma unroll
      for (int q = 0; q < 8; ++q)
        dst[q] = make_uint4(pack2(r[8 * q], r[8 * q + 1]), pack2(r[8 * q + 2], r[8 * q + 3]), pack2(r[8 * q + 4], r[8 * q + 5]),
                            pack2(r[8 * q + 6], r[8 * q + 7]));
    } else {
      u16* dst = base + 4096 + (c - 64);
#pragma unroll
      for (int i = 0; i < 64; ++i) dst[i * 64] = f2bf(r[i]);
    }
  }
}

DI f32x4 mma_t(const u16* X, int xr, const u16* Y, int yr, f32x4 acc, int fr, int fq) {
#pragma unroll
  for (int kk = 0; kk < 2; ++kk) {
    const bf16x8 x = *(const bf16x8*)(X + (xr + fr) * 72 + kk * 32 + fq * 8);
    const bf16x8 y = *(const bf16x8*)(Y + (yr + fr) * 72 + kk * 32 + fq * 8);
    acc = mfma16(x, y, acc);
  }
  return acc;
}
DI f32x4 mma_t_swz(const u16* X, int xr, const u16* Y, int yr, f32x4 acc, int fr, int fq) {
  const int sw = ((xr + fr) >> 3) & 7;
#pragma unroll
  for (int kk = 0; kk < 2; ++kk) {
    const bf16x8 x = *(const bf16x8*)(X + (xr + fr) * 72 + (((kk * 4 + fq) ^ sw) * 8));
    const bf16x8 y = *(const bf16x8*)(Y + (yr + fr) * 72 + kk * 32 + fq * 8);
    acc = mfma16(x, y, acc);
  }
  return acc;
}

DI void gdn_scan(const Params& p, int item, char* smem) {
  const int tid = my_tid(), lane = tid & 63, w = tid >> 6;
  const int fr = lane & 15, fq = lane >> 4;
  const int chain = item >> 2, eq = item & 3;
  const int s = chain >> 3, h = (chain >> 1) & 3, d = chain & 1;
  const int sb = s == 0 ? 0 : TP + (s - 1) * 4096;
  const int nch = s == 0 ? 256 : 64;
  u16* St = (u16*)smem;
  u16* Vt = St + 16 * 72;
  u16* Vts = Vt + 16 * 72;
  u16* Wc = Vts + 16 * 72;
  u16* Qc = Wc + 64 * 72;
  u16* Kc = Qc + 64 * 72;
  u16* KcT = Kc + 64 * 72;
  u16* QKm = KcT + 64 * 72;
  float* gcs = (float*)(QKm + 64 * 72);
  u16* proj = (u16*)(p.ws + OFF_PROJ);
  const u16* QN = (const u16*)(p.ws + OFF_QN);
  const u16* KN = (const u16*)(p.ws + OFF_KN);
  const float* GC = (const float*)(p.ws + OFF_GC);
  const u16* UW = (const u16*)(p.ws + OFF_UW);
  __syncthreads();
  __builtin_amdgcn_s_setprio(3);
  for (int i = tid; i < 16 * 72; i += 256) St[i] = 0;
  f32x4 S0 = (f32x4){0.f, 0.f, 0.f, 0.f};
  const int prow0 = tid >> 3, prow1 = (tid >> 3) + 32, pseg = (tid & 7) * 8;
  uint4 w0a, w1a, q0a, q1a, k0a, k1a, w0b, w1b, q0b, q1b, k0b, k1b;
  uint2 u0a, u0b;
  float ga, gb;
#define GDN_PREFETCH2(J, S)                                                                          \
  {                                                                                                  \
    const int jj_ = (J) < nch ? (J) : nch - 1;                                                       \
    const int n_ = sb / 64 + (d ? nch - 1 - jj_ : jj_);                                              \
    const int c0_ = n_ * 64;                                                                         \
    const size_t tb_ = (size_t)((n_ * 4 + h) * 2 + d);                                               \
    const u16* ub_ = UW + tb_ * 8192;                                                                \
    const int tok0_ = c0_ + (d ? 63 - prow0 : prow0), tok1_ = c0_ + (d ? 63 - prow1 : prow1);        \
    w0##S = *(const uint4*)(ub_ + 4096 + prow0 * 64 + pseg);                                         \
    w1##S = *(const uint4*)(ub_ + 4096 + prow1 * 64 + pseg);                                         \
    q0##S = *(const uint4*)(QN + (size_t)tok0_ * 256 + h * 64 + pseg);                               \
    q1##S = *(const uint4*)(QN + (size_t)tok1_ * 256 + h * 64 + pseg);                               \
    k0##S = *(const uint4*)(KN + (size_t)tok0_ * 256 + h * 64 + pseg);                               \
    k1##S = *(const uint4*)(KN + (size_t)tok1_ * 256 + h * 64 + pseg);                               \
    u0##S = *(const uint2*)(ub_ + (eq * 16 + fr) * 64 + w * 16 + fq * 4);                            \
    g##S = GC[tb_ * 64 + lane];                                                                      \
  }
#define GDN_STAGE2(ROW, PW, PQ, PK)                                                                  \
  {                                                                                                  \
    *(uint4*)(Wc + (ROW) * 72 + pseg) = PW;                                                          \
    *(uint4*)(Qc + (ROW) * 72 + pseg) = PQ;                                                          \
    *(uint4*)(Kc + (ROW) * 72 + pseg) = PK;                                                          \
    u16* kt_ = KcT + pseg * 72 + ((((ROW) >> 3) ^ (tid & 7)) * 8) + ((ROW) & 7);                     \
    kt_[0 * 72] = (u16)(PK.x & 0xffff); kt_[1 * 72] = (u16)(PK.x >> 16);                             \
    kt_[2 * 72] = (u16)(PK.y & 0xffff); kt_[3 * 72] = (u16)(PK.y >> 16);                             \
    kt_[4 * 72] = (u16)(PK.z & 0xffff); kt_[5 * 72] = (u16)(PK.z >> 16);                             \
    kt_[6 * 72] = (u16)(PK.w & 0xffff); kt_[7 * 72] = (u16)(PK.w >> 16);                             \
  }
#define GDN_STEP(JV, S)                                                                              \
  {                                                                                                  \
    const int j_ = (JV);                                                                             \
    const int n = sb / 64 + (d ? nch - 1 - j_ : j_);                                                 \
    const int c0 = n * 64;                                                                           \
    GDN_STAGE2(prow0, w0##S, q0##S, k0##S)                                                           \
    GDN_STAGE2(prow1, w1##S, q1##S, k1##S)                                                           \
    if (tid < 64) gcs[tid] = g##S;                                                                   \
    const uint2 cu0 = u0##S;                                                                         \
    __syncthreads();                                                                          \
    GDN_PREFETCH2(j_ + 2, S)                                                                         \
    const f32x4 z4 = (f32x4){0.f, 0.f, 0.f, 0.f};                                                    \
    const f32x4 P1a = mma_t(Wc, w * 16, St, 0, z4, fr, fq);                                          \
    const f32x4 P2a = mma_t(St, 0, Qc, w * 16, z4, fr, fq);                                          \
      \
    const float glog = gcs[63];                                                                      \
    const float gcc = gcs[w * 16 + fr];                                                              \
    const float4 gq0 = *(const float4*)(gcs + fq * 4), gq1 = *(const float4*)(gcs + 16 + fq * 4);    \
    const float4 gq2 = *(const float4*)(gcs + 32 + fq * 4), gq3 = *(const float4*)(gcs + 48 + fq * 4); \
    const float4 gw = *(const float4*)(gcs + w * 16 + fq * 4);                                       \
    {                                                                                                \
      const int c = w * 16 + fr;                                                                     \
      _Pragma("unroll") for (int t = 0; t < 4; ++t) {                                                \
        const f32x4 qk = mma_t(Kc, t * 16, Qc, w * 16, z4, fr, fq);                                  \
        const int s0 = t * 16 + fq * 4;                                                              \
        const float4 gs = t == 0 ? gq0 : t == 1 ? gq1 : t == 2 ? gq2 : gq3;                          \
        const float e0 = __expf(fminf(gcc - gs.x, 0.f)), e1 = __expf(fminf(gcc - gs.y, 0.f));       \
        const float e2 = __expf(fminf(gcc - gs.z, 0.f)), e3 = __expf(fminf(gcc - gs.w, 0.f));       \
        const float v0 = (c >= s0 + 0) ? qk[0] * e0 : 0.f;                                           \
        const float v1 = (c >= s0 + 1) ? qk[1] * e1 : 0.f;                                           \
        const float v2 = (c >= s0 + 2) ? qk[2] * e2 : 0.f;                                           \
        const float v3 = (c >= s0 + 3) ? qk[3] * e3 : 0.f;                                           \
        uint2 o; o.x = pack2(v0, v1); o.y = pack2(v2, v3);                                           \
        *(uint2*)(QKm + c * 72 + s0) = o;                                                            \
      }                                                                                              \
    }                                                                                                \
    {                                                                                                \
      const int cc0 = w * 16 + fq * 4;                                                               \
      const float v0 = bf2f((u16)(cu0.x & 0xffff)) - P1a[0], v1 = bf2f((u16)(cu0.x >> 16)) - P1a[1]; \
      const float v2 = bf2f((u16)(cu0.y & 0xffff)) - P1a[2], v3 = bf2f((u16)(cu0.y >> 16)) - P1a[3]; \
      uint2 o; o.x = pack2(v0, v1); o.y = pack2(v2, v3);                                             \
      *(uint2*)(Vt + fr * 72 + cc0) = o;                                                             \
      uint2 o2;                                                                                      \
      o2.x = pack2(v0 * __expf(glog - gw.x), v1 * __expf(glog - gw.y));                              \
      o2.y = pack2(v2 * __expf(glog - gw.z), v3 * __expf(glog - gw.w));                              \
      *(uint2*)(Vts + fr * 72 + cc0) = o2;                                                           \
    }                                                                                                \
    __syncthreads();                                                                          \
    {                                                                                                \
      const int c = w * 16 + fr;                                                                     \
      const float eg = __expf(gcc);                                                                  \
      const int tok = c0 + (d ? 63 - c : c);                                                         \
      u16* orow = proj + (size_t)tok * INW + d * 256 + h * 64 + eq * 16 + fq * 4;                    \
      f32x4 oa = P2a * eg;                                                                           \
      oa = mma_t(Vt, 0, QKm, w * 16, oa, fr, fq);                                                    \
      uint2 o; o.x = pack2(oa[0], oa[1]); o.y = pack2(oa[2], oa[3]);                                 \
      *(uint2*)(orow) = o;                                                                           \
    }                                                                                                \
    {                                                                                                \
      const float gl = __expf(glog);                                                                 \
      S0 *= gl;                                                                                      \
      S0 = mma_t_swz(KcT, w * 16, Vts, 0, S0, fr, fq);                                               \
      const int r0 = w * 16 + fq * 4;                                                                \
      uint2 o; o.x = pack2(S0[0], S0[1]); o.y = pack2(S0[2], S0[3]);                                 \
      *(uint2*)(St + fr * 72 + r0) = o;                                                              \
    }                                                                                                \
    __syncthreads();                                                                          \
  }
  GDN_PREFETCH2(0, a)
  GDN_PREFETCH2(1, b)
  for (int j = 0; j < nch; j += 2) {
    GDN_STEP(j, a)
    GDN_STEP(j + 1, b)
  }
  __builtin_amdgcn_s_setprio(0);
}

DI void gdn_post_rows4(const Params& p, int layer, int t0, int tstride) {
  const int lane = my_tid() & 63;
  u16* base = (u16*)(p.ws + OFF_PROJ);
  uint2 f[4], bw[4], z[4];
#pragma unroll
  for (int i = 0; i < 4; ++i) {
    const int t = min(t0 + i * tstride, T - 1);
    const u16* row = base + (size_t)t * INW;
    f[i] = *(const uint2*)(row + lane * 4);
    bw[i] = *(const uint2*)(row + 256 + lane * 4);
    z[i] = *(const uint2*)(row + C_AZ + lane * 4);
  }
  const int e0 = (lane & 15) * 4;
  const float4 an = *(const float4*)(p.a_norm + layer * 64 + e0);
#pragma unroll
  for (int i = 0; i < 4; ++i) {
    const int t = t0 + i * tstride;
    float o0 = bf2f((u16)(f[i].x & 0xffff)) + bf2f((u16)(bw[i].x & 0xffff));
    float o1 = bf2f((u16)(f[i].x >> 16)) + bf2f((u16)(bw[i].x >> 16));
    float o2 = bf2f((u16)(f[i].y & 0xffff)) + bf2f((u16)(bw[i].y & 0xffff));
    float o3 = bf2f((u16)(f[i].y >> 16)) + bf2f((u16)(bw[i].y >> 16));
    float ss = o0 * o0 + o1 * o1 + o2 * o2 + o3 * o3;
#pragma unroll
    for (int m = 1; m < 16; m <<= 1) ss += __shfl_xor(ss, m, 64);
    const float rs = rsqrtf(ss * (1.f / 64.f) + EPS);
    const float r0 = o0 * rs * an.x * siluf_(bf2f((u16)(z[i].x & 0xffff)));
    const float r1 = o1 * rs * an.y * siluf_(bf2f((u16)(z[i].x >> 16)));
    const float r2 = o2 * rs * an.z * siluf_(bf2f((u16)(z[i].y & 0xffff)));
    const float r3 = o3 * rs * an.w * siluf_(bf2f((u16)(z[i].y >> 16)));
    if (t < T) { uint2 ov; ov.x = pack2(r0, r1); ov.y = pack2(r2, r3); *(uint2*)(base + (size_t)t * INW + C_AZ + lane * 4) = ov; }
  }
}

constexpr int XP = 20;
struct S5Rec { float are, aim, lr, li, step; };
DI void s5_rec_consts(const Params& p, int layer, int d, int g, int lane, S5Rec& k) {
  const int gi = ((layer * 2 + d) * 16 + g);
  k.lr = p.lam_re[(size_t)gi * 64 + lane];
  k.li = p.lam_im[(size_t)gi * 64 + lane];
  k.step = expf(p.log_step[gi]);
  const float mag = expf(k.lr * k.step);
  float sn, cs; sincosf(k.li * k.step, &sn, &cs);
  k.are = mag * cs; k.aim = mag * sn;
}
DI void s5_bq(const Params& p, int layer, int d, int g, int fr, int fq, bf16x8 (&bq)[8]) {
  const int gi = ((layer * 2 + d) * 16 + g);
  const float step = expf(p.log_step[gi]);
#pragma unroll
  for (int n4 = 0; n4 < 4; ++n4) {
    const int pp = n4 * 16 + fr;
    const float lr = p.lam_re[(size_t)gi * 64 + pp], li = p.lam_im[(size_t)gi * 64 + pp];
    const float mag = expf(lr * step);
    float sn, cs; sincosf(li * step, &sn, &cs);
    const float are = mag * cs, aim = mag * sn;
    const float inv = 1.f / (lr * lr + li * li);
    const float ir = lr * inv, ii = -li * inv;
    const float cr = (are - 1.f) * ir - aim * ii;
    const float ci = (are - 1.f) * ii + aim * ir;
    const float* br = p.b_re + ((size_t)(layer * 16 + g) * 64 + pp) * 16 + (fq & 1) * 8;
    const float* bi = p.b_im + ((size_t)(layer * 16 + g) * 64 + pp) * 16 + (fq & 1) * 8;
    bf16x8 vr, vi;
#pragma unroll
    for (int e = 0; e < 8; ++e) {
      const float a = br[e], b = bi[e];
      vr[e] = (fq < 2) ? (short)f2bf(cr * a - ci * b) : (short)0;
      vi[e] = (fq < 2) ? (short)f2bf(cr * b + ci * a) : (short)0;
    }
    bq[n4] = vr;
    bq[4 + n4] = vi;
  }
}
DI bf16x8 s5_uf(const u16* proj, int tok0, int g, int fr, int fq) {
  const uint4 v = *(const uint4*)(proj + (size_t)(tok0 + fr) * INW + C_CU + g * 16 + (fq & 1) * 8);
  const uint4 z = make_uint4(0u, 0u, 0u, 0u);
  return __builtin_bit_cast(bf16x8, fq < 2 ? v : z);
}
#define S5_BLOCK_X(UF, XS, XR, XI)                                                                   \
  {                                                                                                  \
    asm volatile("s_waitcnt lgkmcnt(0)" ::: "memory");    \
    _Pragma("unroll") for (int n = 0; n < 8; ++n) {                                                  \
      const f32x4 xx = mfma16(bq[n], UF, (f32x4){0.f, 0.f, 0.f, 0.f});   \
      _Pragma("unroll") for (int j = 0; j < 4; ++j) (XS)[(n * 16 + fq * 4 + j) * XP + fr] = xx[j];   \
    }                                                                                                \
    asm volatile("s_waitcnt lgkmcnt(0)" ::: "memory");                                               \
    _Pragma("unroll") for (int q = 0; q < 4; ++q) {                                                  \
      const float4 a = *(const float4*)((XS) + lane * XP + q * 4);                                   \
      const float4 b = *(const float4*)((XS) + (64 + lane) * XP + q * 4);                            \
      XR[q * 4 + 0] = a.x; XR[q * 4 + 1] = a.y; XR[q * 4 + 2] = a.z; XR[q * 4 + 3] = a.w;            \
      XI[q * 4 + 0] = b.x; XI[q * 4 + 1] = b.y; XI[q * 4 + 2] = b.z; XI[q * 4 + 3] = b.w;            \
    }                                                                                                \
  }
DI void s5_build_table(const Params& p, int layer, int dg) {
  const int lane = my_tid() & 63, fr = lane & 15, fq = lane >> 4;
  const int d = dg >> 4, g = dg & 15;
  char* tab = p.ws + OFF_S5TAB + (size_t)dg * S5TAB_STRIDE;
  bf16x8 bq[8]; s5_bq(p, layer, d, g, fr, fq, bq);
#pragma unroll
  for (int n = 0; n < 8; ++n) ((uint4*)tab)[n * 64 + lane] = __builtin_bit_cast(uint4, bq[n]);
  const float* cr = p.c_re + ((size_t)((layer * 2 + d) * 16 + g) * 16 + fr) * 64;
  const float* ci = p.c_im + ((size_t)((layer * 2 + d) * 16 + g) * 16 + fr) * 64;
#pragma unroll
  for (int kk = 0; kk < 4; ++kk) {
    bf16x8 cf;
#pragma unroll
    for (int e = 0; e < 8; ++e) {
      const int kx = (kk & 1) * 32 + fq * 8 + e;
      cf[e] = (short)f2bf((kk < 2) ? cr[kx] : -ci[kx]);
    }
    ((uint4*)(tab + 8192))[kk * 64 + lane] = __builtin_bit_cast(uint4, cf);
  }
  S5Rec k; s5_rec_consts(p, layer, d, g, lane, k);
  const float m64 = expf(k.lr * k.step * 64.f);
  float s64, c64; sincosf(k.li * k.step * 64.f, &s64, &c64);
  ((float4*)(tab + 12288))[lane] = make_float4(k.are, k.aim, m64 * c64, m64 * s64);
}
DI void s5_pass1(const Params& p, int layer, int task, char* smem) {
  const int lane = my_tid() & 63, wave = my_tid() >> 6;
  const int fr = lane & 15, fq = lane >> 4;
  const int n = task >> 2, gq = task & 3, g = gq * 4 + wave, c0 = n * 64;
  float* Xs = (float*)smem + wave * 128 * XP;
  const u16* proj = (const u16*)(p.ws + OFF_PROJ);
  float2* SEND = (float2*)(p.ws + OFF_SEND);
  __syncthreads();
  bf16x8 uf[4];
#pragma unroll
  for (int tb = 0; tb < 4; ++tb) uf[tb] = s5_uf(proj, c0 + tb * 16, g, fr, fq);
#pragma unroll 1
  for (int d = 0; d < 2; ++d) {
    const char* tab = p.ws + OFF_S5TAB + (size_t)(d * 16 + g) * S5TAB_STRIDE;
    bf16x8 bq[8];
#pragma unroll
    for (int n8 = 0; n8 < 8; ++n8) bq[n8] = __builtin_bit_cast(bf16x8, ((const uint4*)tab)[n8 * 64 + lane]);
    const float4 rc = ((const float4*)(tab + 12288))[lane];
    S5Rec k; k.are = rc.x; k.aim = rc.y;
    float sr = 0.f, si = 0.f;
#pragma unroll
    for (int blk = 0; blk < 4; ++blk) {
      const int tb = d ? 3 - blk : blk;
      float xr[16], xi[16];
      S5_BLOCK_X(uf[tb], Xs, xr, xi)
#pragma unroll
      for (int i = 0; i < 16; ++i) {
        const int r = d ? 15 - i : i;
        const float nr = k.are * sr - k.aim * si + xr[r], ni = k.are * si + k.aim * sr + xi[r];
        sr = nr; si = ni;
      }
    }
    SEND[((size_t)(n * 2 + d) * 16 + g) * 64 + lane] = make_float2(sr, si);
  }
}
DI float gelu_tanh(float x) {
  const float u = 0.7978845608028654f * (x + 0.044715f * x * x * x);
  return 0.5f * x * (1.f + tanhf(u));
}
DI void s5_pass3(const Params& p, int layer, int task, char* smem) {
  const int lane = my_tid() & 63, wave = my_tid() >> 6;
  const int fr = lane & 15, fq = lane >> 4;
  const int n = task >> 2, gq = task & 3, g = gq * 4 + wave, c0 = n * 64;
  const int nlo = seq_lo(c0) / 64, nhi = seq_hi(c0) / 64;
  float* Xs = (float*)smem + wave * 128 * XP;
  u16* Sb = (u16*)(smem + 4 * 128 * XP * 4) + wave * 16 * 136;
  const u16* proj = (const u16*)(p.ws + OFF_PROJ);
  const float2* SEND = (const float2*)(p.ws + OFF_SEND);
  u16* Gb = (u16*)(p.ws + OFF_G);
  __syncthreads();
  bf16x8 uf[4];
#pragma unroll
  for (int tb = 0; tb < 4; ++tb) uf[tb] = s5_uf(proj, c0 + tb * 16, g, fr, fq);
  f32x4 yacc[4];
#pragma unroll
  for (int tb = 0; tb < 4; ++tb) yacc[tb] = (f32x4){0.f, 0.f, 0.f, 0.f};
#pragma unroll 1
  for (int d = 0; d < 2; ++d) {
    const char* tab = p.ws + OFF_S5TAB + (size_t)(d * 16 + g) * S5TAB_STRIDE;
    bf16x8 bq[8];
#pragma unroll
    for (int n8 = 0; n8 < 8; ++n8) bq[n8] = __builtin_bit_cast(bf16x8, ((const uint4*)tab)[n8 * 64 + lane]);
    const float4 rc = ((const float4*)(tab + 12288))[lane];
    S5Rec k; k.are = rc.x; k.aim = rc.y;
    const float a64r = rc.z, a64i = rc.w;
    float sr = 0.f, si = 0.f;
    {
      const int cnt = d == 0 ? n - nlo : nhi - 1 - n;
      const int first = d == 0 ? nlo : nhi - 1;
      const int sgn = d == 0 ? 1 : -1;
      const float2* sp = SEND + ((size_t)(first * 2 + d) * 16 + g) * 64 + lane;
      const long stride = (long)sgn * 2 * 16 * 64;
      int m = 0;
      for (; m + 8 <= cnt; m += 8) {
        float2 e0 = sp[0], e1 = sp[stride], e2 = sp[2 * stride], e3 = sp[3 * stride];
        float2 e4 = sp[4 * stride], e5 = sp[5 * stride], e6 = sp[6 * stride], e7 = sp[7 * stride];
        sp += 8 * stride;
#define HSTEP(E) { const float nr = a64r * sr - a64i * si + E.x, ni = a64r * si + a64i * sr + E.y; sr = nr; si = ni; }
        HSTEP(e0) HSTEP(e1) HSTEP(e2) HSTEP(e3) HSTEP(e4) HSTEP(e5) HSTEP(e6) HSTEP(e7)
      }
      for (; m < cnt; ++m) {
        const float2 e = sp[0];
        sp += stride;
        HSTEP(e)
      }
    }
    bf16x8 cf[4];
#pragma unroll
    for (int kk = 0; kk < 4; ++kk) cf[kk] = __builtin_bit_cast(bf16x8, ((const uint4*)(tab + 8192))[kk * 64 + lane]);
#pragma unroll
    for (int blk = 0; blk < 4; ++blk) {
      const int tb = d ? 3 - blk : blk;
      float xr[16], xi[16];
      S5_BLOCK_X(uf[tb], Xs, xr, xi)
#pragma unroll
      for (int i = 0; i < 16; ++i) {
        const int r = d ? 15 - i : i;
        const float nr = k.are * sr - k.aim * si + xr[r], ni = k.are * si + k.aim * sr + xi[r];
        sr = nr; si = ni;
        Sb[r * 136 + lane] = f2bf(sr);
        Sb[r * 136 + 64 + lane] = f2bf(si);
      }
      asm volatile("s_waitcnt lgkmcnt(0)" ::: "memory");
#pragma unroll
      for (int kk = 0; kk < 4; ++kk) {
        const bf16x8 xf = *(const bf16x8*)(Sb + fr * 136 + kk * 32 + fq * 8);
        yacc[tb] = mfma16(xf, cf[kk], yacc[tb]);
      }
      asm volatile("s_waitcnt lgkmcnt(0)" ::: "memory");
    }
  }
  const float dsk = p.s5_d[layer * 256 + g * 16 + fr];
#pragma unroll
  for (int tb = 0; tb < 4; ++tb)
#pragma unroll
    for (int j = 0; j < 4; ++j) {
      const int t = tb * 16 + fq * 4 + j;
      const float u = bf2f(proj[(size_t)(c0 + t) * INW + C_CU + g * 16 + fr]);
      const float y = yacc[tb][j] + u * dsk;
      Gb[(size_t)(c0 + t) * 256 + g * 16 + fr] = f2bf(gelu_tanh(y));
    }
}

struct AttnState { float m, l; f32x4 o[4]; };
DI void attn_segment(const u16* proj, int kcol, int vcol, int tk0, int kstride, int npairs, int R, float slope, int tq,
                     int lo, int hi, const bf16x8 (&qf)[2], AttnState& st, u16* Vt, int lane) {
  const int fr = lane & 15, fq = lane >> 4;
#pragma unroll 1
  for (int pr = 0; pr < npairs; ++pr) {
    const int kbase = tk0 + pr * 32 * kstride;
    f32x4 sacc[2];
#pragma unroll
    for (int t = 0; t < 2; ++t) {
      int tk = kbase + (t * 16 + fr) * kstride;
      tk = min(max(tk, lo), hi - 1);
      const u16* kp = proj + (size_t)tk * INW + kcol + fq * 8;
      const bf16x8 k0 = *(const bf16x8*)(kp), k1 = *(const bf16x8*)(kp + 32);
      sacc[t] = mfma16(k0, qf[0], (f32x4){0.f, 0.f, 0.f, 0.f});
      sacc[t] = mfma16(k1, qf[1], sacc[t]);
    }
    uint4 vr0, vr1, vr2, vr3;
    {
      const int seg = (lane & 7) * 8, kl0 = lane >> 3;
      const int t0 = min(max(kbase + (kl0 + 0) * kstride, lo), hi - 1), t1 = min(max(kbase + (kl0 + 8) * kstride, lo), hi - 1);
      const int t2 = min(max(kbase + (kl0 + 16) * kstride, lo), hi - 1), t3 = min(max(kbase + (kl0 + 24) * kstride, lo), hi - 1);
      vr0 = *(const uint4*)(proj + (size_t)t0 * INW + vcol + seg);
      vr1 = *(const uint4*)(proj + (size_t)t1 * INW + vcol + seg);
      vr2 = *(const uint4*)(proj + (size_t)t2 * INW + vcol + seg);
      vr3 = *(const uint4*)(proj + (size_t)t3 * INW + vcol + seg);
    }
    float sc[2][4]; bool ok[2][4];
    float mx = -1e30f;
#pragma unroll
    for (int t = 0; t < 2; ++t)
#pragma unroll
      for (int j = 0; j < 4; ++j) {
        const int tk = kbase + (t * 16 + fq * 4 + j) * kstride;
        const int ad = abs(tk - tq);
        ok[t][j] = (ad <= R) && (tk >= lo) && (tk < hi);
        sc[t][j] = sacc[t][j] * 0.125f - slope * (float)ad;
        if (ok[t][j]) mx = fmaxf(mx, sc[t][j]);
      }
    mx = fmaxf(mx, __shfl_xor(mx, 16, 64));
    mx = fmaxf(mx, __shfl_xor(mx, 32, 64));
    const float mn = fmaxf(st.m, mx);
    const float alpha = __expf(st.m - mn);
    st.m = mn;
    float pv[2][4], ps = 0.f;
#pragma unroll
    for (int t = 0; t < 2; ++t)
#pragma unroll
      for (int j = 0; j < 4; ++j) { pv[t][j] = ok[t][j] ? __expf(sc[t][j] - mn) : 0.f; ps += pv[t][j]; }
    st.l = st.l * alpha + ps;
#pragma unroll
    for (int dt = 0; dt < 4; ++dt)
#pragma unroll
      for (int j = 0; j < 4; ++j) st.o[dt][j] *= alpha;
    bf16x8 pf;
    {
      const unsigned w0 = pack2(pv[0][0], pv[0][1]), w1 = pack2(pv[0][2], pv[0][3]), w2 = pack2(pv[1][0], pv[1][1]),
                     w3 = pack2(pv[1][2], pv[1][3]);
      uint4 t4 = make_uint4(w0, w1, w2, w3);
      pf = __builtin_bit_cast(bf16x8, t4);
    }
    asm volatile("s_waitcnt lgkmcnt(0)" ::: "memory");
    {
      u16* vdst = Vt + (lane >> 3) * 72 + (lane & 7) * 8;
      *(uint4*)(vdst) = vr0; *(uint4*)(vdst + 8 * 72) = vr1; *(uint4*)(vdst + 16 * 72) = vr2; *(uint4*)(vdst + 24 * 72) = vr3;
    }
    {
      const int q = fr >> 2, pp = fr & 3;
      const unsigned a0 = (unsigned)(size_t)Vt + (unsigned)(((fq * 4 + q) * 72 + 4 * pp) * 2);
      {
        uint2 x0, x1, y0, y1;
        asm volatile(
            "s_waitcnt lgkmcnt(0)\n\t"
            "ds_read_b64_tr_b16 %0, %4\n\t"
            "ds_read_b64_tr_b16 %1, %4 offset:32\n\t"
            "ds_read_b64_tr_b16 %2, %4 offset:2304\n\t"
            "ds_read_b64_tr_b16 %3, %4 offset:2336\n\t"
            "s_waitcnt lgkmcnt(0)"
            : "=&v"(x0), "=&v"(x1), "=&v"(y0), "=&v"(y1) : "v"(a0) : "memory");
        st.o[0] = mfma16(__builtin_bit_cast(bf16x8, make_uint4(x0.x, x0.y, y0.x, y0.y)), pf, st.o[0]);
        st.o[1] = mfma16(__builtin_bit_cast(bf16x8, make_uint4(x1.x, x1.y, y1.x, y1.y)), pf, st.o[1]);
      }
      {
        uint2 x0, x1, y0, y1;
        asm volatile(
            "ds_read_b64_tr_b16 %0, %4 offset:64\n\t"
            "ds_read_b64_tr_b16 %1, %4 offset:96\n\t"
            "ds_read_b64_tr_b16 %2, %4 offset:2368\n\t"
            "ds_read_b64_tr_b16 %3, %4 offset:2400\n\t"
            "s_waitcnt lgkmcnt(0)"
            : "=&v"(x0), "=&v"(x1), "=&v"(y0), "=&v"(y1) : "v"(a0) : "memory");
        st.o[2] = mfma16(__builtin_bit_cast(bf16x8, make_uint4(x0.x, x0.y, y0.x, y0.y)), pf, st.o[2]);
        st.o[3] = mfma16(__builtin_bit_cast(bf16x8, make_uint4(x1.x, x1.y, y1.x, y1.y)), pf, st.o[3]);
      }
    }
  }
}
DI void attn_task(const Params& p, int layer, int mode, int task, char* smem) {
  const int lane = my_tid() & 63, wave = my_tid() >> 6;
  const int fr = lane & 15, fq = lane >> 4;
  u16* proj = (u16*)(p.ws + OFF_PROJ);
  u16* Vt = (u16*)smem + wave * 32 * 72;
  int tq0, qstride, qcol, kcol, vcol; float slope;
  int hq;
  if (mode == 0) {
    const int blk = task >> 4, h = (task >> 2) & 3, rq = task & 3;
    hq = h; tq0 = blk * 256 + rq * 4 + wave; qstride = 16;
    qcol = C_BQ + h * 64; kcol = C_BK + h * 64; vcol = C_BV + h * 64;
    slope = exp2f(-(float)(5 + h));
  } else {
    const int blk = task >> 2, qh = task & 3;
    hq = qh; tq0 = blk * 64 + wave * 16; qstride = 1;
    qcol = C_DQ + qh * 64; kcol = C_DK + (qh >> 1) * 64; vcol = C_DV + (qh >> 1) * 64;
    slope = exp2f(-(float)(1 + qh));
  }
  const int lo = seq_lo(tq0), hi = seq_hi(tq0);
  const int tq = tq0 + fr * qstride;
  bf16x8 qf[2];
  {
    const u16* qp = proj + (size_t)tq * INW + qcol + fq * 8;
    qf[0] = *(const bf16x8*)(qp); qf[1] = *(const bf16x8*)(qp + 32);
  }
  AttnState st; st.m = -1e30f; st.l = 0.f;
#pragma unroll
  for (int dt = 0; dt < 4; ++dt) st.o[dt] = (f32x4){0.f, 0.f, 0.f, 0.f};
  __syncthreads();
  float scale;
  if (mode == 0) {
    attn_segment(proj, kcol, vcol, tq0 - 64, 1, 12, 64, slope, tq, lo, hi, qf, st, Vt, lane);
    attn_segment(proj, kcol, vcol, tq0 - 256, 4, 6, 256, slope, tq, lo, hi, qf, st, Vt, lane);
    attn_segment(proj, kcol, vcol, tq0 - 1024, 16, 5, 1024, slope, tq, lo, hi, qf, st, Vt, lane);
    float l = st.l; l += __shfl_xor(l, 16, 64); l += __shfl_xor(l, 32, 64);
    scale = 1.f / l;
  } else {
    attn_segment(proj, kcol, vcol, tq0 - 128, 1, 9, 128, slope, tq, lo, hi, qf, st, Vt, lane);
    float l = st.l; l += __shfl_xor(l, 16, 64); l += __shfl_xor(l, 32, 64);
    const float sink = p.attn_sink[layer * 4 + hq];
    const float mf = fmaxf(st.m, sink);
    const float sc = __expf(st.m - mf);
    scale = sc / (l * sc + __expf(sink - mf));
  }
#pragma unroll
  for (int dt = 0; dt < 4; ++dt) {
    uint2 o; o.x = pack2(st.o[dt][0] * scale, st.o[dt][1] * scale); o.y = pack2(st.o[dt][2] * scale, st.o[dt][3] * scale);
    *(uint2*)(proj + (size_t)tq * INW + qcol + dt * 16 + fq * 4) = o;
  }
}

DI void final_row(const Params& p, int t) {
  const int lane = my_tid() & 63;
  float* row = p.xout + (size_t)t * DM;
  float4 v[4]; float ss = 0.f;
#pragma unroll
  for (int i = 0; i < 4; ++i) {
    v[i] = *(const float4*)(row + i * 256 + lane * 4);
    ss += v[i].x * v[i].x + v[i].y * v[i].y + v[i].z * v[i].z + v[i].w * v[i].w;
  }
  ss = wave_sum(ss);
  const float rs = rstd_of(ss);
#pragma unroll
  for (int i = 0; i < 4; ++i) {
    const float4 g = *(const float4*)(p.final_norm + i * 256 + lane * 4);
    *(float4*)(row + i * 256 + lane * 4) = make_float4(v[i].x * rs * g.x, v[i].y * rs * g.y, v[i].z * rs * g.z, v[i].w * rs * g.w);
  }
}

#define XB_TMO      128
#define XB_XCNT(j)  (256  + 64 * (j))
#define XB_XSUB(j)  (1280 + 64 * (j))
#define XB_XGEN(j)  (2304 + 64 * (j))
#define XB_TOP      3328
#define XB_TOPGEN   3392
#define XB_SPIN_CAP (1u << 22)
#define LAS __attribute__((address_space(3)))
DI unsigned xb_ld(unsigned* p) { return __hip_atomic_load(p, __ATOMIC_RELAXED, __HIP_MEMORY_SCOPE_AGENT); }
DI unsigned xb_add(unsigned* p, unsigned v) { return __hip_atomic_fetch_add(p, v, __ATOMIC_RELAXED, __HIP_MEMORY_SCOPE_AGENT); }
DI unsigned xb_xcc_id() { return (unsigned)__builtin_amdgcn_s_getreg((3 << 11) | 20) & 0xFu; }
#define XB_SPIN(cond, bar) do { unsigned _sp = 0; while (cond) { __builtin_amdgcn_s_sleep(1); \
    if ((++_sp & 255u) == 0u) { if (xb_ld(&(bar)[XB_TMO])) break; if (_sp > XB_SPIN_CAP) { atomicAdd(&(bar)[XB_TMO], 1u); break; } } } } while (0)
struct XcdBarrier { unsigned* bar; unsigned x; volatile LAS unsigned* st; };
DI XcdBarrier xcd_barrier_post(unsigned* bar, volatile LAS unsigned* st) {
  XcdBarrier b; b.bar = bar; b.x = xb_xcc_id(); b.st = st;
  if (threadIdx.x == 0) (void)xb_add(&bar[XB_XCNT(b.x)], 1u);
  return b;
}
DI void xcd_barrier_complete(unsigned* bar, unsigned x, unsigned& nloc, unsigned& nx) {
  const unsigned G = gridDim.x * gridDim.y * gridDim.z;
  unsigned sum, cnt, mine, sp = 0u;
  for (;;) {
    sum = 0u; cnt = 0u; mine = 0u;
#pragma unroll
    for (unsigned j = 0; j < 16; ++j) { const unsigned c = xb_ld(&bar[XB_XCNT(j)]); sum += c; cnt += (c > 0u) ? 1u : 0u; mine = (j == x) ? c : mine; }
    if (sum == G) break;
    __builtin_amdgcn_s_sleep(1);
    if ((++sp & 255u) == 0u) { if (xb_ld(&bar[XB_TMO])) break; if (sp > XB_SPIN_CAP) { atomicAdd(&bar[XB_TMO], 1u); break; } }
  }
  nloc = mine > 0u ? mine : 1u; nx = cnt > 0u ? cnt : 1u;
}
DI void xcd_barrier(const XcdBarrier& b) {
  asm volatile("s_waitcnt vmcnt(0)" ::: "memory");
  __syncthreads();
  if (threadIdx.x == 0) {
    unsigned* bar = b.bar;
    __builtin_amdgcn_s_waitcnt(0);
    unsigned nloc = b.st[0], nx = b.st[1];
    if (nloc == 0u) { xcd_barrier_complete(bar, b.x, nloc, nx); b.st[0] = nloc; b.st[1] = nx; }
    const unsigned old = xb_add(&bar[XB_XSUB(b.x)], 1u);
    const unsigned gen = old / nloc;
    if (old + 1u == (gen + 1u) * nloc) {
      __builtin_amdgcn_fence(__ATOMIC_RELEASE, "agent");
      asm volatile("s_waitcnt vmcnt(0)" ::: "memory");
      const unsigned og = xb_add(&bar[XB_TOP], 1u);
      const unsigned tg = og / nx;
      if (og + 1u == (tg + 1u) * nx) xb_add(&bar[XB_TOPGEN], 1u);
      else XB_SPIN(xb_ld(&bar[XB_TOPGEN]) == tg, bar);
      __builtin_amdgcn_fence(__ATOMIC_ACQUIRE, "agent");
      xb_add(&bar[XB_XGEN(b.x)], 1u);
      asm volatile("s_waitcnt vmcnt(0)" ::: "memory");
    } else {
      XB_SPIN(xb_ld(&bar[XB_XGEN(b.x)]) == gen, bar);
      __builtin_amdgcn_fence(__ATOMIC_ACQUIRE, "agent");
      asm volatile("s_waitcnt vmcnt(0)" ::: "memory");
    }
  }
  __syncthreads();
}

enum { PH_NORM1 = 0, PH_INPROJ, PH_MIX1, PH_MIX2, PH_MIX3, PH_MERGE, PH_OUT, PH_FFN1, PH_FFN2, PH_PER_LAYER, PH_FINAL = 100 };

DI void run_phase(const Params& p, int ph, int layer, char* smem) {
  const int b = blockIdx.x, G = gridDim.x;
  const int wave = my_tid() >> 6;
  switch (ph) {
    case PH_NORM1: {
      if (layer == 0) {
        for (int t = b; t < 2 * CONV_TILES_LAYER; t += G) {
          ConvJob j;
          const int lt = conv_lookup(p, t, j);
          conv_tile(j, lt, (float*)smem);
        }
      }
      if (b == 0 && my_tid() == 0) *(unsigned*)(p.ws + OFF_CNT) = 0u;
      if (layer == 0) {
        float* z = ssq_buf(p, 2);
        for (int i = b * 256 + my_tid(); i < 2 * T; i += G * 256) z[i] = 0.f;
      }
      if (b < 8) s5_build_table(p, layer, b * 4 + wave);
      cvt_phase(p, layer, (u16*)(p.ws + OFF_H), true, b, G);
    } break;
    case PH_INPROJ: gemm_inproj(p, layer, b, G, (u16*)smem); break;
    case PH_MIX1: {
      for (int t = b; t < 2 * 3072; t += G) {
        const int kind = t / 3072, idx = t % 3072;
        if (kind == 0) gdn_pre(p, layer, idx, smem);
        else s5_pass1(p, layer, idx, smem);
      }
    } break;
    case PH_MIX2: {
      for (int c = b; c < 288; c += G) gdn_scan(p, c, smem);
      {
        unsigned* cnt = (unsigned*)(p.ws + OFF_CNT);
        int* slot = (int*)(smem + SMEM_BYTES - 16);
        for (;;) {
          __syncthreads();
          if (my_tid() == 0) *slot = (int)atomicAdd(cnt, 1u);
          __syncthreads();
          const int t = *slot;
          if (t >= 3 * 3072) break;
          if (t < 3072) s5_pass3(p, layer, t, smem);
          else if (t < 2 * 3072) attn_task(p, layer, 0, t - 3072, smem);
          else attn_task(p, layer, 1, t - 2 * 3072, smem);
        }
      }
    } break;
    case PH_MIX3: {
      gemm_glu(p, layer, b, G, (u16*)smem);
      for (int t = b * 4 + wave; t < T; t += G * 16) gdn_post_rows4(p, layer, t, G * 4);
      cvt_phase(p, layer, (u16*)(p.ws + OFF_H), false, b, G);
    } break;
    case PH_MERGE: gemm_merge(p, layer, b, G, (u16*)smem); break;
    case PH_OUT:
      gemm_resid(p, layer, (const u16*)(p.ws + OFF_MERGED), DM, (const u16*)(p.ws + OFF_W) + layer * W_LAYER + WO_OUT, b, G, (u16*)smem,
                 (u16*)(p.ws + OFF_H2), ssq_buf(p, 2 + layer));
      break;
    case PH_FFN1: gemm_ffn1(p, layer, b, G, (u16*)smem); break;
    case PH_FFN2:
      gemm_resid(p, 1, (const u16*)(p.ws + OFF_ACT), FH, (const u16*)(p.ws + OFF_W) + layer * W_LAYER + WO_DN, b, G, (u16*)smem,
                 nullptr, nullptr);
      break;
    case PH_FINAL:
      for (int t = b * 4 + wave; t < T; t += G * 8) {
        const int t2 = t + G * 4;
        const bool has2 = t2 < T;
        const int lane = my_tid() & 63;
        float* r0 = p.xout + (size_t)t * DM;
        float* r1 = p.xout + (size_t)(has2 ? t2 : t) * DM;
        float4 a[4], c[4];
#pragma unroll
        for (int i = 0; i < 4; ++i) { a[i] = *(const float4*)(r0 + i * 256 + lane * 4); c[i] = *(const float4*)(r1 + i * 256 + lane * 4); }
        float s0 = 0.f, s1 = 0.f;
#pragma unroll
        for (int i = 0; i < 4; ++i) {
          s0 += a[i].x * a[i].x + a[i].y * a[i].y + a[i].z * a[i].z + a[i].w * a[i].w;
          s1 += c[i].x * c[i].x + c[i].y * c[i].y + c[i].z * c[i].z + c[i].w * c[i].w;
        }
        s0 = wave_sum(s0); s1 = wave_sum(s1);
        const float q0 = rstd_of(s0), q1 = rstd_of(s1);
#pragma unroll
        for (int i = 0; i < 4; ++i) {
          const float4 g = *(const float4*)(p.final_norm + i * 256 + lane * 4);
          *(float4*)(r0 + i * 256 + lane * 4) = make_float4(a[i].x * q0 * g.x, a[i].y * q0 * g.y, a[i].z * q0 * g.z, a[i].w * q0 * g.w);
          if (has2) *(float4*)(r1 + i * 256 + lane * 4) = make_float4(c[i].x * q1 * g.x, c[i].y * q1 * g.y, c[i].z * q1 * g.z, c[i].w * q1 * g.w);
        }
      }
      break;
    default: break;
  }
}

#if !MEGA
__global__ void __launch_bounds__(256, 2) k_phase(Params p, int ph, int layer) {
  __shared__ __attribute__((aligned(16))) char smem[SMEM_BYTES];
  run_phase(p, ph, layer, smem);
}

#else
__global__ void __launch_bounds__(256, 2) k_mega(Params p) {
  __shared__ __attribute__((aligned(16))) char smem[SMEM_BYTES];
  __shared__ uint4 xb_words;
  cg::grid_group grid = cg::this_grid();
  if (threadIdx.x == 0) xb_words = make_uint4(0u, 0u, 0u, 0u);
  __syncthreads();
  const XcdBarrier xb = xcd_barrier_post((unsigned*)(p.ws + OFF_BAR), (volatile LAS unsigned*)&xb_words);
  for (int layer = 0; layer < 2; ++layer)
    for (int ph = 0; ph < PH_PER_LAYER; ++ph) {
      run_phase(p, ph, layer, smem);
      if (p.ws == nullptr) grid.sync();
      xcd_barrier(xb);
#ifdef PROBE_DUP
      if (ph == PROBE_DUP) { run_phase(p, ph, layer, smem); grid.sync(); }
#endif
    }
  run_phase(p, PH_FINAL, 0, smem);
}
#endif

extern "C" void kernel_launch(void* const* d_in, const int* in_sizes, int n_in, void* d_out, int out_size, void* d_ws,
                              size_t ws_size, hipStream_t stream) {
  (void)in_sizes; (void)n_in; (void)out_size;
  if (ws_size < WS_NEED) { fprintf(stderr, "workspace too small: %zu < %zu\n", ws_size, (size_t)WS_NEED); return; }
  Params p;
  memset(&p, 0, sizeof(p));
  const float* const* in = (const float* const*)d_in;
  p.x_prompt = in[0]; p.x_sample = in[1]; p.norm1 = in[2]; p.conv_a = in[4]; p.a_log = in[5]; p.dt_bias = in[6];
  p.a_norm = in[7]; p.lam_re = in[8]; p.lam_im = in[9]; p.log_step = in[10]; p.b_re = in[11]; p.b_im = in[12];
  p.c_re = in[13]; p.c_im = in[14]; p.s5_d = in[15]; p.attn_sink = in[17]; p.norm2 = in[21]; p.final_norm = in[25];
  p.xout = (float*)d_out;
  p.ws = (char*)d_ws;
  p.w_in = in[3]; p.w_glu = in[16]; p.w_gate = in[18]; p.w_branch = in[19]; p.w_out = in[20];
  p.w_ffn_gate = in[22]; p.w_ffn_up = in[23]; p.w_ffn_down = in[24];
  static int grid_blocks = 0;
  if (!grid_blocks) {
    int dev = 0, cus = 0, per_cu = 0;
    hipGetDevice(&dev);
    hipDeviceGetAttribute(&cus, hipDeviceAttributeMultiprocessorCount, dev);
#if MEGA
    hipOccupancyMaxActiveBlocksPerMultiprocessor(&per_cu, k_mega, 256, 0);
#else
    hipOccupancyMaxActiveBlocksPerMultiprocessor(&per_cu, k_phase, 256, 0);
#endif
    per_cu = 2;
    grid_blocks = cus * per_cu;
  }
#if MEGA
  hipMemsetAsync((char*)d_ws + OFF_BAR, 0, BAR_BYTES, stream);
  void* args[] = {&p};
  hipError_t e = hipLaunchCooperativeKernel((void*)k_mega, dim3(grid_blocks), dim3(256), args, 0, stream);
  if (e != hipSuccess) fprintf(stderr, "cooperative launch failed: %s (grid %d)\n", hipGetErrorString(e), grid_blocks);
#else
  for (int layer = 0; layer < 2; ++layer)
    for (int ph = 0; ph < PH_PER_LAYER; ++ph) hipLaunchKernelGGL(k_phase, dim3(grid_blocks), dim3(256), 0, stream, p, ph, layer);
  hipLaunchKernelGGL(k_phase, dim3(grid_blocks), dim3(256), 0, stream, p, (int)PH_FINAL, 0);
#endif
}
```
